# Optimizing an MI355X kernel written in HIP

```python
import math
import jax
import jax.numpy as jnp
from jax import lax
import numpy as np

D_MODEL = 2048
BATCH = 1
SEQ = 16384
DEPTH = 2
DEC_BATCH = 16
DEC_SEQ = 16
PAST_LEN = 1024

CHUNK = 64
Q_BLOCK = 128
EPS = 1e-6

D_FF = 5504
FFN_RES = 0.5

MLA_HEADS = 8
MLA_NOPE = 128
MLA_ROPE = 64
MLA_V = 128
MLA_Q_LORA = 512
MLA_KV_LORA = 512
MLA_WIDTH = MLA_HEADS * MLA_V
MLA_SCALE = (MLA_NOPE + MLA_ROPE) ** -0.5
ROPE_BASE = 10000.0

SSM_HEADS = 16
SSM_HEAD_DIM = 64
SSM_D_INNER = SSM_HEADS * SSM_HEAD_DIM
SSM_GROUPS = 2
SSM_STATE = 128
SSM_CONV_W = 4
SSM_CONV_DIM = SSM_D_INNER + 2 * SSM_GROUPS * SSM_STATE
SSD_CHUNK = CHUNK
DT_MIN = 1e-3
DT_MAX = 1e-1

FOX_HEADS = 8
FOX_HEAD_DIM = 128
FOX_WIDTH = FOX_HEADS * FOX_HEAD_DIM
FOX_SCALE = FOX_HEAD_DIM ** -0.5
FOX_FORGET_BIAS = 2.0

N_BRANCH = 3
IN_SIZES = (MLA_Q_LORA, MLA_KV_LORA, MLA_ROPE,
            SSM_D_INNER, SSM_CONV_DIM, SSM_HEADS,
            FOX_WIDTH, FOX_WIDTH, FOX_WIDTH, FOX_HEADS,
            N_BRANCH * D_MODEL)
IN_COLS = sum(IN_SIZES)

kernel_name = "hybrid_streaming_mla_ssd_fox_step"


def rmsnorm(x, g):
    xf = x.astype(jnp.float32)
    y = xf * lax.rsqrt(jnp.mean(xf * xf, axis=-1, keepdims=True) + EPS)
    return (y * g.astype(jnp.float32)).astype(x.dtype)


def swiglu(x, w_gate, w_up, w_down):
    return (jax.nn.silu(x @ w_gate) * (x @ w_up)) @ w_down


def split_cols(u, sizes):
    parts, start = [], 0
    for n in sizes:
        parts.append(u[..., start:start + n])
        start += n
    return parts


def rope(x, pos):
    half = x.shape[-1] // 2
    inv_freq = ROPE_BASE ** (-jnp.arange(half, dtype=jnp.float32) / half)
    ang = pos.astype(jnp.float32)[:, None] * inv_freq[None, :]
    cos, sin = jnp.cos(ang)[:, None, :], jnp.sin(ang)[:, None, :]
    xf = x.astype(jnp.float32)
    x1, x2 = xf[..., :half], xf[..., half:]
    return jnp.concatenate([x1 * cos - x2 * sin, x2 * cos + x1 * sin], axis=-1).astype(x.dtype)


def sweep_query_blocks(attend, qs, qpos):
    sq = qpos.shape[0]
    if sq <= Q_BLOCK:
        return attend(qs, qpos)
    nb = sq // Q_BLOCK

    def to_blocks(t):
        return jnp.moveaxis(t.reshape((t.shape[0], nb, Q_BLOCK) + t.shape[2:]), 1, 0)

    out = lax.map(lambda a: attend(a[0], a[1]),
                  (tuple(to_blocks(t) for t in qs), qpos.reshape(nb, Q_BLOCK)))
    out = jnp.moveaxis(out, 0, 1)
    return out.reshape((out.shape[0], sq) + out.shape[3:])


def mla_block(qs, qpos, k_nope, k_pe, v, kpos):
    q_nope, q_pe = qs
    s = jnp.einsum("bqhd,bkhd->bhqk", q_nope, k_nope) + jnp.einsum("bqhr,bkr->bhqk", q_pe, k_pe)
    s = s.astype(jnp.float32) * MLA_SCALE
    visible = (kpos[None, :] // CHUNK) <= (qpos[:, None] // CHUNK)
    prob = jax.nn.softmax(jnp.where(visible, s, -jnp.inf), axis=-1)
    return jnp.einsum("bhqk,bkhd->bqhd", prob.astype(v.dtype), v)


def fox_block(qs, qpos, k, v, cum_k, kpos):
    q, cum_q = qs
    s = jnp.einsum("bqhd,bkhd->bhqk", q, k).astype(jnp.float32) * FOX_SCALE
    decay = jnp.swapaxes(cum_q, 1, 2)[..., :, None] - jnp.swapaxes(cum_k, 1, 2)[..., None, :]
    visible = kpos[None, :] <= qpos[:, None]
    prob = jax.nn.softmax(jnp.where(visible, s + decay, -jnp.inf), axis=-1)
    return jnp.einsum("bhqk,bkhd->bqhd", prob.astype(v.dtype), v)


def causal_conv(xbc, conv_state, w, b):
    s = xbc.shape[1]
    xp = jnp.concatenate([conv_state.astype(xbc.dtype), xbc], axis=1)
    y = b
    for k in range(SSM_CONV_W):
        y = y + xp[:, k:k + s] * w[k]
    return y, xp[:, xp.shape[1] - (SSM_CONV_W - 1):]


def ssd_scan(x, dt, a, bm, cm, h0):
    bsz, length, nh, hp = x.shape
    q = min(SSD_CHUNK, length)
    nc = length // q
    f32 = jnp.float32
    adt = dt.astype(f32) * a.astype(f32)
    xdt = x.astype(f32) * dt.astype(f32)[..., None]

    def chunks(t):
        return t.astype(f32).reshape((bsz, nc, q) + t.shape[2:])

    adt, xdt, bm, cm = chunks(adt), chunks(xdt), chunks(bm), chunks(cm)
    acs = jnp.cumsum(adt, axis=2)
    seg = acs[:, :, :, None, :] - acs[:, :, None, :, :]
    causal = jnp.tril(jnp.ones((q, q), dtype=bool))[None, None, :, :, None]
    decay = jnp.exp(jnp.where(causal, seg, -jnp.inf))
    y_diag = jnp.einsum("bclhn,bcshn,bclsh,bcshp->bclhp", cm, bm, decay, xdt)
    decay_to_end = jnp.exp(acs[:, :, -1:, :] - acs)
    chunk_states = jnp.einsum("bclhn,bclh,bclhp->bchpn", bm, decay_to_end, xdt)
    chunk_decay = jnp.exp(acs[:, :, -1, :])

    def step(h, inp):
        st, d = inp
        return h * d[:, :, None, None] + st, h

    h_last, h_in = lax.scan(step, h0.astype(f32),
                            (jnp.moveaxis(chunk_states, 1, 0), jnp.moveaxis(chunk_decay, 1, 0)))
    h_in = jnp.moveaxis(h_in, 0, 1)
    y_off = jnp.einsum("bclhn,bchpn,bclh->bclhp", cm, h_in, jnp.exp(acs))
    return (y_diag + y_off).reshape(bsz, length, nh, hp), h_last


def token_mixers(h, pos, p, past):
    bsz, s, _ = h.shape
    f32 = jnp.float32
    (u_q, u_ckv, u_kpe, u_z, u_xbc, u_dt,
     u_fq, u_fk, u_fv, u_ff, u_gate) = split_cols(h @ p["w_in"], IN_SIZES)

    q = (rmsnorm(u_q, p["mla_q_norm"]) @ p["mla_w_uq"]).reshape(bsz, s, MLA_HEADS, MLA_NOPE + MLA_ROPE)
    q_nope, q_pe = q[..., :MLA_NOPE], rope(q[..., MLA_NOPE:], pos)
    ckv_new = rmsnorm(u_ckv, p["mla_kv_norm"])
    kpe_new = rope(u_kpe[:, :, None, :], pos)[:, :, 0, :]
    if past is None:
        ckv, kpe = ckv_new, kpe_new
    else:
        ckv = jnp.concatenate([past["mla_ckv"], ckv_new], axis=1)
        kpe = jnp.concatenate([past["mla_kpe"], kpe_new], axis=1)
    kpos = jnp.arange(ckv.shape[1], dtype=jnp.int32)
    kv = (ckv @ p["mla_w_ukv"]).reshape(bsz, ckv.shape[1], MLA_HEADS, MLA_NOPE + MLA_V)
    k_nope, v_mla = kv[..., :MLA_NOPE], kv[..., MLA_NOPE:]
    o_mla = sweep_query_blocks(lambda qs, qp: mla_block(qs, qp, k_nope, kpe, v_mla, kpos),
                               (q_nope, q_pe), pos).reshape(bsz, s, MLA_WIDTH)

    if past is None:
        conv_state = jnp.zeros((bsz, SSM_CONV_W - 1, SSM_CONV_DIM), h.dtype)
        h0 = jnp.zeros((bsz, SSM_HEADS, SSM_HEAD_DIM, SSM_STATE), f32)
    else:
        conv_state, h0 = past["conv"], past["ssm"]
    xbc, conv_new = causal_conv(u_xbc, conv_state, p["ssm_conv_w"], p["ssm_conv_b"])
    xbc = jax.nn.silu(xbc)
    xs, bm, cm = split_cols(xbc, (SSM_D_INNER, SSM_GROUPS * SSM_STATE, SSM_GROUPS * SSM_STATE))
    xs = xs.reshape(bsz, s, SSM_HEADS, SSM_HEAD_DIM)
    rep = SSM_HEADS // SSM_GROUPS
    bm = jnp.repeat(bm.reshape(bsz, s, SSM_GROUPS, SSM_STATE), rep, axis=2)
    cm = jnp.repeat(cm.reshape(bsz, s, SSM_GROUPS, SSM_STATE), rep, axis=2)
    dt = jax.nn.softplus(u_dt.astype(f32) + p["ssm_dt_bias"].astype(f32))
    a = -jnp.exp(p["ssm_a_log"].astype(f32))
    y, ssm_new = ssd_scan(xs, dt, a, bm, cm, h0)
    y = y + p["ssm_d"].astype(f32)[:, None] * xs.astype(f32)
    y = y.reshape(bsz, s, SSM_D_INNER) * jax.nn.silu(u_z.astype(f32))
    o_ssd = rmsnorm(y.reshape(bsz, s, SSM_GROUPS, SSM_D_INNER // SSM_GROUPS),
                    p["ssm_norm"].reshape(SSM_GROUPS, SSM_D_INNER // SSM_GROUPS))
    o_ssd = o_ssd.reshape(bsz, s, SSM_D_INNER).astype(h.dtype)

    fq = u_fq.reshape(bsz, s, FOX_HEADS, FOX_HEAD_DIM)
    fk = u_fk.reshape(bsz, s, FOX_HEADS, FOX_HEAD_DIM)
    fv = u_fv.reshape(bsz, s, FOX_HEADS, FOX_HEAD_DIM)
    logf_new = jax.nn.log_sigmoid(u_ff.astype(f32) + p["fox_b_f"].astype(f32))
    if past is None:
        k_all, v_all, logf_all = fk, fv, logf_new
    else:
        k_all = jnp.concatenate([past["fox_k"], fk], axis=1)
        v_all = jnp.concatenate([past["fox_v"], fv], axis=1)
        logf_all = jnp.concatenate([past["fox_logf"].astype(f32), logf_new], axis=1)
    cum = jnp.cumsum(logf_all, axis=1)
    fpos = jnp.arange(k_all.shape[1], dtype=jnp.int32)
    o_fox = sweep_query_blocks(lambda qs, qp: fox_block(qs, qp, k_all, v_all, cum, fpos),
                               (fq, cum[:, cum.shape[1] - s:]), pos).reshape(bsz, s, FOX_WIDTH)

    gates = jax.nn.sigmoid(u_gate.astype(f32)).astype(h.dtype).reshape(bsz, s, N_BRANCH, D_MODEL)
    merged = (gates[:, :, 0] * (o_mla @ p["w_br_mla"])
              + gates[:, :, 1] * (o_ssd @ p["w_br_ssd"])
              + gates[:, :, 2] * (o_fox @ p["w_br_fox"]))
    out = merged @ p["w_out"]
    return out, (ckv_new, kpe_new, fk, fv, logf_new, ssm_new, conv_new)


def trunk_layer(x, pos, p, past):
    x = x + FFN_RES * swiglu(rmsnorm(x, p["ffn1_norm"]), p["ffn1_w_gate"], p["ffn1_w_up"], p["ffn1_w_down"])
    mix, state = token_mixers(rmsnorm(x, p["mix_norm"]), pos, p, past)
    x = x + mix
    x = x + FFN_RES * swiglu(rmsnorm(x, p["ffn2_norm"]), p["ffn2_w_gate"], p["ffn2_w_up"], p["ffn2_w_down"])
    return x, state


def setup_inputs(seed: int = 0) -> dict:
    key = jax.random.key(seed)
    ks = iter(jax.random.split(key, 48))
    L = DEPTH
    f32 = jnp.float32

    def nrm(shape):
        return jax.random.normal(next(ks), shape, f32)

    def w(shape, fan_in):
        return nrm(shape) * fan_in ** -0.5

    def gain(shape):
        return 1.0 + 0.02 * nrm(shape)

    x_prompt = nrm((BATCH, SEQ, D_MODEL))
    x_sample = nrm((DEC_BATCH, DEC_SEQ, D_MODEL))
    cache_mla_ckv = nrm((L, DEC_BATCH, PAST_LEN, MLA_KV_LORA))
    cache_mla_kpe = nrm((L, DEC_BATCH, PAST_LEN, MLA_ROPE))
    cache_fox_k = nrm((L, DEC_BATCH, PAST_LEN, FOX_HEADS, FOX_HEAD_DIM))
    cache_fox_v = nrm((L, DEC_BATCH, PAST_LEN, FOX_HEADS, FOX_HEAD_DIM))
    cache_fox_logf = jax.nn.log_sigmoid(FOX_FORGET_BIAS + nrm((L, DEC_BATCH, PAST_LEN, FOX_HEADS)))
    state_ssm = 0.1 * nrm((L, DEC_BATCH, SSM_HEADS, SSM_HEAD_DIM, SSM_STATE))
    state_conv = nrm((L, DEC_BATCH, SSM_CONV_W - 1, SSM_CONV_DIM))

    dt = jnp.exp(jax.random.uniform(next(ks), (L, SSM_HEADS), f32,
                                    minval=math.log(DT_MIN), maxval=math.log(DT_MAX)))
    ssm_dt_bias = dt + jnp.log(-jnp.expm1(-dt))
    ssm_a_log = jnp.log(jax.random.uniform(next(ks), (L, SSM_HEADS), f32, minval=1.0, maxval=16.0))

    return {
        "x_prompt": x_prompt,
        "x_sample": x_sample,
        "cache_mla_ckv": cache_mla_ckv,
        "cache_mla_kpe": cache_mla_kpe,
        "cache_fox_k": cache_fox_k,
        "cache_fox_v": cache_fox_v,
        "cache_fox_logf": cache_fox_logf,
        "state_ssm": state_ssm,
        "state_conv": state_conv,
        "ffn1_norm": gain((L, D_MODEL)),
        "ffn1_w_gate": w((L, D_MODEL, D_FF), D_MODEL),
        "ffn1_w_up": w((L, D_MODEL, D_FF), D_MODEL),
        "ffn1_w_down": w((L, D_FF, D_MODEL), D_FF),
        "mix_norm": gain((L, D_MODEL)),
        "w_in": w((L, D_MODEL, IN_COLS), D_MODEL),
        "mla_q_norm": gain((L, MLA_Q_LORA)),
        "mla_w_uq": w((L, MLA_Q_LORA, MLA_HEADS * (MLA_NOPE + MLA_ROPE)), MLA_Q_LORA),
        "mla_kv_norm": gain((L, MLA_KV_LORA)),
        "mla_w_ukv": w((L, MLA_KV_LORA, MLA_HEADS * (MLA_NOPE + MLA_V)), MLA_KV_LORA),
        "ssm_conv_w": w((L, SSM_CONV_W, SSM_CONV_DIM), SSM_CONV_W),
        "ssm_conv_b": 0.02 * nrm((L, SSM_CONV_DIM)),
        "ssm_dt_bias": ssm_dt_bias,
        "ssm_a_log": ssm_a_log,
        "ssm_d": 1.0 + 0.1 * nrm((L, SSM_HEADS)),
        "ssm_norm": gain((L, SSM_D_INNER)),
        "fox_b_f": FOX_FORGET_BIAS + 0.5 * nrm((L, FOX_HEADS)),
        "w_br_mla": w((L, MLA_WIDTH, D_MODEL), MLA_WIDTH),
        "w_br_ssd": w((L, SSM_D_INNER, D_MODEL), SSM_D_INNER),
        "w_br_fox": w((L, FOX_WIDTH, D_MODEL), FOX_WIDTH),
        "w_out": w((L, D_MODEL, D_MODEL), D_MODEL),
        "ffn2_norm": gain((L, D_MODEL)),
        "ffn2_w_gate": w((L, D_MODEL, D_FF), D_MODEL),
        "ffn2_w_up": w((L, D_MODEL, D_FF), D_MODEL),
        "ffn2_w_down": w((L, D_FF, D_MODEL), D_FF),
        "final_norm": gain((D_MODEL,)),
    }


def reference(x_prompt, x_sample, cache_mla_ckv, cache_mla_kpe, cache_fox_k, cache_fox_v,
              cache_fox_logf, state_ssm, state_conv,
              ffn1_norm, ffn1_w_gate, ffn1_w_up, ffn1_w_down, mix_norm, w_in,
              mla_q_norm, mla_w_uq, mla_kv_norm, mla_w_ukv,
              ssm_conv_w, ssm_conv_b, ssm_dt_bias, ssm_a_log, ssm_d, ssm_norm,
              fox_b_f, w_br_mla, w_br_ssd, w_br_fox, w_out,
              ffn2_norm, ffn2_w_gate, ffn2_w_up, ffn2_w_down, final_norm):
    pos_p = jnp.arange(x_prompt.shape[1], dtype=jnp.int32)
    past_len = cache_mla_ckv.shape[2]
    pos_s = past_len + jnp.arange(x_sample.shape[1], dtype=jnp.int32)
    hp, hs = x_prompt, x_sample
    new_p, new_s = [], []
    for l in range(DEPTH):
        p = {
            "ffn1_norm": ffn1_norm[l], "ffn1_w_gate": ffn1_w_gate[l], "ffn1_w_up": ffn1_w_up[l],
            "ffn1_w_down": ffn1_w_down[l], "mix_norm": mix_norm[l], "w_in": w_in[l],
            "mla_q_norm": mla_q_norm[l], "mla_w_uq": mla_w_uq[l], "mla_kv_norm": mla_kv_norm[l],
            "mla_w_ukv": mla_w_ukv[l], "ssm_conv_w": ssm_conv_w[l], "ssm_conv_b": ssm_conv_b[l],
            "ssm_dt_bias": ssm_dt_bias[l], "ssm_a_log": ssm_a_log[l], "ssm_d": ssm_d[l],
            "ssm_norm": ssm_norm[l], "fox_b_f": fox_b_f[l], "w_br_mla": w_br_mla[l],
            "w_br_ssd": w_br_ssd[l], "w_br_fox": w_br_fox[l], "w_out": w_out[l],
            "ffn2_norm": ffn2_norm[l], "ffn2_w_gate": ffn2_w_gate[l], "ffn2_w_up": ffn2_w_up[l],
            "ffn2_w_down": ffn2_w_down[l],
        }
        past = {
            "mla_ckv": cache_mla_ckv[l], "mla_kpe": cache_mla_kpe[l], "fox_k": cache_fox_k[l],
            "fox_v": cache_fox_v[l], "fox_logf": cache_fox_logf[l], "ssm": state_ssm[l],
            "conv": state_conv[l],
        }
        hp, st_p = trunk_layer(hp, pos_p, p, None)
        hs, st_s = trunk_layer(hs, pos_s, p, past)
        new_p.append(st_p)
        new_s.append(st_s)
    y_prompt = rmsnorm(hp, final_norm)
    y_sample = rmsnorm(hs, final_norm)

    def stk(states, i):
        return jnp.stack([st[i] for st in states], axis=0)

    return (y_prompt, y_sample,
            stk(new_p, 0), stk(new_p, 1), stk(new_p, 2), stk(new_p, 3), stk(new_p, 4), stk(new_p, 5), stk(new_p, 6),
            stk(new_s, 0), stk(new_s, 1), stk(new_s, 2), stk(new_s, 3), stk(new_s, 4), stk(new_s, 5), stk(new_s, 6))
```

```cpp
#include <hip/hip_runtime.h>
#include <cstdio>
#include <cstdint>

#define LAS __attribute__((address_space(3)))
typedef unsigned short bf16_t;
typedef short bf16x8 __attribute__((ext_vector_type(8)));
typedef float f32x4 __attribute__((ext_vector_type(4)));
typedef float f32x2 __attribute__((ext_vector_type(2)));
typedef float f32x16 __attribute__((ext_vector_type(16)));
typedef unsigned u32x4 __attribute__((ext_vector_type(4)));
typedef unsigned u32x2 __attribute__((ext_vector_type(2)));
typedef __bf16 bf2_t __attribute__((ext_vector_type(2)));

constexpr int D = 2048, SEQ = 16384, NB = 16, NS = 16, PAST = 1024, FF = 5504, NL = 2;
constexpr int MP = SEQ, MS = NB * NS, MT = MP + MS;
constexpr int KVS = 1088, KVLEN_S = PAST + NS;
constexpr int KVROWS = MP + NB * KVS;
constexpr int LDU = 12800;
constexpr int IN_COLS = 12888, NWIN = 13056;
constexpr float LOG2E = 1.4426950408889634f;
constexpr float MLA_QSCALE = 0.07216878364870322f * LOG2E;
constexpr float FOX_QSCALE = 0.08838834764831845f * LOG2E;
constexpr float EPS = 1e-6f;
constexpr int UC_QLAT = 0, UC_CKV = 512, UC_Z = 1024, UC_XBC = 2048, UC_FQ = 3584, UC_FK = 4608, UC_FV = 5632, UC_GATE = 6656;
constexpr int UC_OMLA = 0, UC_OSSD = UC_Z, UC_OFOX = UC_FQ;
constexpr int US_KPE = 0, US_DT = 64, US_FF = 80, LDUS = 128;

enum { I_XP = 0, I_XS, I_CCKV, I_CKPE, I_CFK, I_CFV, I_CLOGF, I_SSM, I_CONV, I_F1N, I_F1G, I_F1U, I_F1D, I_MIXN, I_WIN, I_QN, I_WUQ, I_KVN, I_WUKV,
       I_CW, I_CB, I_DTB, I_ALOG, I_SD, I_SN, I_FBF, I_BRM, I_BRS, I_BRF, I_WOUT, I_F2N, I_F2G, I_F2U, I_F2D, I_FN, N_IN };
constexpr size_t O_YP = 0, O_YS = 33554432, O_PCKV = 34078720, O_PKPE = 50855936, O_PFK = 52953088, O_PFV = 86507520, O_PLOGF = 120061952,
                 O_PSSM = 120324096, O_PCONV = 120586240, O_SCKV = 120595456, O_SKPE = 120857600, O_SFK = 120890368, O_SFV = 121414656,
                 O_SLOGF = 121938944, O_SSSM = 121943040, O_SCONV = 126137344, O_TOTAL = 126284800;

constexpr size_t W_GU1 = 0, W_D1 = W_GU1 + (size_t)2 * FF * D, W_IN = W_D1 + (size_t)D * FF, W_UQ = W_IN + (size_t)NWIN * D, W_UKV = W_UQ + (size_t)1536 * 512,
                 W_BR = W_UKV + (size_t)2048 * 512, W_OUT = W_BR + (size_t)3 * 2048 * 1024, W_GU2 = W_OUT + (size_t)D * D, W_D2 = W_GU2 + (size_t)2 * FF * D,
                 W_TOTAL = W_D2 + (size_t)D * FF;

constexpr size_t MiB = 1u << 20;
constexpr size_t al(size_t x) { return (x + MiB - 1) / MiB * MiB; }
constexpr size_t WS_CTL = 0, CTL_BYTES = 1 * MiB;
constexpr size_t WS_ROPE = WS_CTL + CTL_BYTES;
constexpr size_t WS_W = WS_ROPE + al((size_t)SEQ * 32 * 8);
constexpr size_t WS_XN = WS_W + al(W_TOTAL * 2);
constexpr size_t WS_U = WS_XN + al((size_t)MT * D * 2);
constexpr size_t WS_US = WS_U + al((size_t)MT * LDU * 2);
constexpr size_t WS_DT = WS_US + al((size_t)MT * LDUS * 4);
constexpr size_t WS_QM = WS_DT + al((size_t)MT * 16 * 4);
constexpr size_t WS_CKV = WS_QM + al((size_t)MT * 1536 * 2);
constexpr size_t WS_KM = WS_CKV + al((size_t)KVROWS * 512 * 2);
constexpr size_t WS_VTM = WS_KM + al((size_t)KVROWS * 1536 * 2);
constexpr size_t WS_KFS = WS_VTM + al((size_t)1024 * KVROWS * 2);
constexpr size_t WS_VTF = WS_KFS + al((size_t)NB * KVS * 1024 * 2);
constexpr size_t WS_LOGF = WS_VTF + al((size_t)1024 * KVROWS * 2);
constexpr size_t WS_CUM = WS_LOGF + al((size_t)KVROWS * 8 * 4);
constexpr int NCHUNK = 256 + NB;
constexpr size_t WS_ST = WS_CUM + al((size_t)KVROWS * 8 * 4);
constexpr size_t WS_CDEC = WS_ST + al((size_t)NCHUNK * 131072 * 4);
constexpr size_t WS_PART = WS_CDEC + MiB;
constexpr size_t WS_HB = WS_PART + al((size_t)8 * MS * D * 4);
constexpr size_t WS_END = WS_HB + al((size_t)NCHUNK * 131072 * 2);

constexpr int CW_TMO = 0, CW_BAR = 4096;
constexpr int CW_MGC = 12288;
constexpr int CW_QN2 = 8192, CW_KN2 = CW_QN2 + NL * 64 * 8;

constexpr int RING_BYTES = 131072, LDS_BYTES = 163840, LDSCTL_OFF = LDS_BYTES - 512, MISC_OFF = LDSCTL_OFF + 320;

struct Params {
    const float* in[N_IN];
    float* out;
    unsigned char* ws;
    int ph_lo, ph_hi;
};

typedef const __attribute__((address_space(4))) unsigned char* KA;
struct PV { KA k;
    __device__ __forceinline__ const float* in(int i) const { return *(const float* const __attribute__((address_space(4)))*)(k + 8 * i); }
    __device__ __forceinline__ float* out() const { return *(float* const __attribute__((address_space(4)))*)(k + 8 * N_IN); }
    __device__ __forceinline__ unsigned char* ws() const { return *(unsigned char* const __attribute__((address_space(4)))*)(k + 8 * N_IN + 8); }
    __device__ __forceinline__ int ph_lo() const { return *(const __attribute__((address_space(4))) int*)(k + 8 * N_IN + 16); }
    __device__ __forceinline__ int ph_hi() const { return *(const __attribute__((address_space(4))) int*)(k + 8 * N_IN + 20); }
};
__device__ __forceinline__ PV pv_get() { PV v; v.k = (KA)__builtin_amdgcn_kernarg_segment_ptr(); asm volatile("" : "+s"(v.k)); return v; }
static_assert(sizeof(Params) == 8 * N_IN + 24, "Params layout");

#define LDS_WAIT() asm volatile("s_waitcnt lgkmcnt(0)" ::: "memory")
#define VM_WAIT() asm volatile("s_waitcnt vmcnt(0)" ::: "memory")
__device__ __forceinline__ unsigned pk2(float lo, float hi) { bf2_t v = {(__bf16)lo, (__bf16)hi}; return __builtin_bit_cast(unsigned, v); }
__device__ __forceinline__ float bf_lo(unsigned w) { return __uint_as_float(w << 16); }
__device__ __forceinline__ float bf_hi(unsigned w) { return __uint_as_float(w & 0xffff0000u); }
__device__ __forceinline__ float bf2f(bf16_t b) { return __uint_as_float((unsigned)b << 16); }
__device__ __forceinline__ bf16_t f2bf(float f) { return (bf16_t)(pk2(f, 0.f) & 0xffffu); }
__device__ __forceinline__ float shx(float v, int o, int lane) { return __int_as_float(__builtin_amdgcn_ds_bpermute((lane ^ o) << 2, __float_as_int(v))); }
__device__ __forceinline__ float wave_sum(float v, int lane) {
#pragma unroll
    for (int o = 1; o < 64; o <<= 1) v += shx(v, o, lane);
    return v;
}
__device__ __forceinline__ float fast_exp2(float x) { return __builtin_amdgcn_exp2f(x); }
__device__ __forceinline__ float fast_exp(float x) { return __builtin_amdgcn_exp2f(x * LOG2E); }
__device__ __forceinline__ float fast_rsqrt(float x) { return __builtin_amdgcn_rsqf(x); }
__device__ __forceinline__ float fast_log(float x) { return __builtin_amdgcn_logf(x) * 0.6931471805599453f; }
__device__ __forceinline__ float sigmoidf_(float x) { return __builtin_amdgcn_rcpf(1.f + fast_exp2(-x * LOG2E)); }
__device__ __forceinline__ float siluf_(float x) { return x * sigmoidf_(x); }
__device__ __forceinline__ int kvrow_of(int m) { return m < MP ? m : MP + ((m - MP) >> 4) * KVS + PAST + ((m - MP) & 15); }
__device__ __forceinline__ int pos_of(int m) { return m < MP ? m : PAST + ((m - MP) & 15); }

#define XB_TMO      128
#define XB_XCNT(j)  (256  + 64 * (j))
#define XB_XSUB(j)  (1280 + 64 * (j))
#define XB_XGEN(j)  (2304 + 64 * (j))
#define XB_TOP      3328
#define XB_TOPGEN   3392
#define XCD_BAR_WORDS 3456
#define XB_SPIN_CAP (1u << 22)
__device__ __forceinline__ unsigned xb_ld(unsigned* p)              { return __hip_atomic_load(p, __ATOMIC_RELAXED, __HIP_MEMORY_SCOPE_AGENT); }
__device__ __forceinline__ unsigned xb_add(unsigned* p, unsigned v) { return __hip_atomic_fetch_add(p, v, __ATOMIC_RELAXED, __HIP_MEMORY_SCOPE_AGENT); }
__device__ __forceinline__ unsigned xb_xcc_id() { return (unsigned)__builtin_amdgcn_s_getreg((3 << 11) | 20) & 0xFu; }
#define XB_SPIN(cond, bar) do { unsigned _sp = 0; while (cond) { __builtin_amdgcn_s_sleep(1); \
    if ((++_sp & 255u) == 0u) { if (xb_ld(&(bar)[XB_TMO])) break; if (_sp > XB_SPIN_CAP) { atomicAdd(&(bar)[XB_TMO], 1u); break; } } } } while (0)
struct XcdBarrier { unsigned* bar; unsigned x; volatile LAS unsigned* st; };
__device__ __forceinline__ XcdBarrier xcd_barrier_post(unsigned* bar, volatile LAS unsigned* st, int tid) {
    XcdBarrier b; b.bar = bar; b.x = xb_xcc_id(); b.st = st;
    if (tid == 0) (void)xb_add(&bar[XB_XCNT(b.x)], 1u);
    return b;
}
__device__ __forceinline__ void xcd_barrier_complete(unsigned* bar, unsigned x, unsigned& nloc, unsigned& nx) {
    const unsigned G = gridDim.x * gridDim.y * gridDim.z;
    unsigned sum, cnt, mine, sp = 0u;
    for (;;) {
        sum = 0u; cnt = 0u; mine = 0u;
#pragma unroll
        for (unsigned j = 0; j < 16; ++j) { const unsigned c = xb_ld(&bar[XB_XCNT(j)]); sum += c; cnt += (c > 0u) ? 1u : 0u; mine = (j == x) ? c : mine; }
        if (sum == G) break;
        __builtin_amdgcn_s_sleep(1);
        if ((++sp & 255u) == 0u) { if (xb_ld(&bar[XB_TMO])) break; if (sp > XB_SPIN_CAP) { atomicAdd(&bar[XB_TMO], 1u); break; } }
    }
    nloc = mine > 0u ? mine : 1u; nx = cnt > 0u ? cnt : 1u;
}
__device__ __forceinline__ void xcd_barrier(const XcdBarrier& b, int wave_s) {
    asm volatile("s_waitcnt vmcnt(0)" ::: "memory");
    __syncthreads();
    int tid_b; { unsigned z_ = 0u; asm volatile("" : "+s"(z_)); tid_b = wave_s * 64 + (int)__builtin_amdgcn_mbcnt_hi(~0u, __builtin_amdgcn_mbcnt_lo(~0u, z_)); }
    if (tid_b == 0) {
        unsigned* bar = b.bar; asm volatile("" : "+s"(bar));
        __builtin_amdgcn_s_waitcnt(0);
        unsigned nloc = b.st[0], nx = b.st[1];
        if (nloc == 0u) { xcd_barrier_complete(bar, b.x, nloc, nx); b.st[0] = nloc; b.st[1] = nx; }
        const unsigned old = xb_add(&bar[XB_XSUB(b.x)], 1u);
        const unsigned gen = old / nloc;
        if (old + 1u == (gen + 1u) * nloc) {
            __builtin_amdgcn_fence(__ATOMIC_RELEASE, "agent");
            asm volatile("s_waitcnt vmcnt(0)" ::: "memory");
            const unsigned og = xb_add(&bar[XB_TOP], 1u);
            const unsigned tg = og / nx;
            if (og + 1u == (tg + 1u) * nx) xb_add(&bar[XB_TOPGEN], 1u);
            else XB_SPIN(xb_ld(&bar[XB_TOPGEN]) == tg, bar);
            __builtin_amdgcn_fence(__ATOMIC_ACQUIRE, "agent");
            xb_add(&bar[XB_XGEN(b.x)], 1u);
            asm volatile("s_waitcnt vmcnt(0)" ::: "memory");
        } else {
            XB_SPIN(xb_ld(&bar[XB_XGEN(b.x)]) == gen, bar);
            __builtin_amdgcn_fence(__ATOMIC_ACQUIRE, "agent");
            asm volatile("s_waitcnt vmcnt(0)" ::: "memory");
        }
    }
    __syncthreads();
}

namespace pg8 {
constexpr int BM = 256, BK = 64, HALF = 128, HTB = HALF * BK * 2, STAGE_BYTES = 8 * HTB, NXCD = 8, WGM = 8;
__host__ __device__ __forceinline__ int lds_byte(int r, int c) { const int st = (r >> 4) * 2 + (c >> 5), rr = r & 15, cc = c & 31, ob = rr * 64 + cc * 2; return st * 1024 + (ob ^ (((ob >> 9) & 1) << 5)); }
__host__ __device__ __forceinline__ void stage_rc(int b, int& R, int& C) { const int st = b / 1024, sb = b % 1024, swz = sb ^ (((sb >> 9) & 1) << 5); R = (st >> 1) * 16 + swz / 64; C = (st & 1) * 32 + (swz % 64) / 2; }
__host__ __device__ __forceinline__ int perm32(int rho) { const int n = rho >> 4, i = rho & 15; return 8 * (i >> 2) + 4 * n + (i & 3); }
struct Unit { int pm, pn, k0, nt, sp; };
struct Gemm { const bf16_t* A; const bf16_t* Bt; int lda, ldb, M, N, K; };
struct StaticOrder {
    int nM, nN, nwg, G, c, ntK; bool nfast; bool nrev = false;
    __host__ __device__ __forceinline__ void init(int M, int N, int G_, int c_, int K_ = 0, bool nfast_ = false) { nM = M / BM; nN = N / BM; nwg = nM * nN; G = G_; c = c_; ntK = K_ / BK; nfast = nfast_; }
    __host__ __device__ __forceinline__ bool next(int i, Unit& u) const {
        const long L = (long)i * G + c; if (L >= nwg) return false;
        int wgid = (int)L; { const int q = nwg / NXCD, r = nwg % NXCD, xcd = wgid % NXCD, off = wgid / NXCD; wgid = (xcd < r ? xcd * (q + 1) : r * (q + 1) + (xcd - r) * q) + off; }
        const int nig = WGM * nN, gid = wgid / nig, fm = gid * WGM, gsz = (nM - fm) < WGM ? (nM - fm) : WGM;
        const int ig = wgid % nig;
        u.pm = nfast ? fm + ig / nN : fm + (ig % gsz); u.pn = nfast ? ig % nN : ig / gsz; if (nrev) u.pn = nN - 1 - u.pn; u.k0 = 0; u.nt = ntK; u.sp = 0; return true;
    }
    __device__ __forceinline__ void a_ready(const Unit&) const {}
    __device__ __forceinline__ void done(const Unit&) const {}
    __device__ __forceinline__ size_t a_extra(const Unit&) const { return 0; }
};
struct SplitOrder : StaticOrder {
    __host__ __device__ __forceinline__ void init(int M, int N, int G_, int c_, int K_) { StaticOrder::init(M - BM, N, G_, c_, K_, true); }
    __host__ __device__ __forceinline__ bool next(int i, Unit& u) const {
        const long L = (long)i * G + c;
        const bool reg = L < nwg; const int idx = (int)(L - nwg);
        const int ns = 8;
        if (!reg && idx >= nN * ns) return false;
        Unit a; a.pm = 0; a.pn = 0; a.k0 = 0; a.nt = ntK; a.sp = 0;
        if (reg) { Unit t; StaticOrder::next(i, t); a.pm = t.pm; a.pn = t.pn; }
        const int sp = idx / nN;
        const int base = (ntK / ns) & ~1, extra = (ntK - ns * base) / 2;
        const int s_nt = base + (sp < extra ? 2 : 0), s_k0 = base * sp + 2 * (sp < extra ? sp : extra);
        u.pm = reg ? a.pm : nM; u.pn = reg ? a.pn : idx % nN; u.k0 = reg ? 0 : s_k0; u.nt = reg ? ntK : s_nt; u.sp = reg ? 0 : sp;
        return true;
    }
};
struct SampleMergeOrder {
    int c;
    __host__ __device__ __forceinline__ bool next(int i, Unit& u) const {
        if (i != 0 || c >= 24) return false;
        u.pm = MP / BM; u.pn = c; u.k0 = 0; u.nt = 16; u.sp = 0; return true;
    }
    __device__ __forceinline__ void a_ready(const Unit&) const {}
    __device__ __forceinline__ void done(const Unit&) const {}
    __device__ __forceinline__ size_t a_extra(const Unit& u) const { const int br = u.pn >> 3; return (size_t)(br == 0 ? UC_OMLA : (br == 1 ? UC_OSSD : UC_OFOX)) * 2; }
};
template <class Epi, class Sched, bool ALIGN_EPI = false, bool SP2 = false>
__device__ __forceinline__ void gemm_phase(LAS unsigned char* lds, const Gemm g, const Sched& S, const Epi& E, int wave_s) {
    int tid_; { unsigned z_ = 0u; asm volatile("" : "+s"(z_)); tid_ = wave_s * 64 + (int)__builtin_amdgcn_mbcnt_hi(~0u, __builtin_amdgcn_mbcnt_lo(~0u, z_)); }
    const int tid = tid_, wid = __builtin_amdgcn_readfirstlane(tid >> 6), lane = tid & 63, wr = wid >> 2, wc = wid & 3, fr = lane & 15, fq = lane >> 4;
    unsigned voffA[2], voffB[2];
#pragma unroll
    for (int i = 0; i < 2; ++i) { int R, C; stage_rc(tid * 16 + i * 8192, R, C); const int Rb = Epi::PERM ? ((R & ~31) + perm32(R & 31)) : R;
        voffA[i] = (unsigned)(R * g.lda + C) * 2u; voffB[i] = (unsigned)(Rb * g.ldb + C) * 2u; }
    const size_t kstep = (size_t)(BK * 2);
    const size_t hstepA = (size_t)HALF * g.lda * 2, hstepB = (size_t)HALF * g.ldb * 2;
    const size_t tstepA = 2 * hstepA, tstepB = 2 * hstepB;
    const unsigned ldsw = (unsigned)wid * 1024u;
    const int aoff = lds_byte(wr * 64 + fr, fq * 8), boff = lds_byte(wc * 32 + fr, fq * 8);
#define PG8_SA(b, h) (((b) * 2 + (h)) * HTB)
#define PG8_SB(b, h) ((4 + (b) * 2 + (h)) * HTB)
#define PG8_STAGE(bufoff, gbase, voff) do { _Pragma("unroll") for (int _i = 0; _i < 2; ++_i) \
        __builtin_amdgcn_global_load_lds((const unsigned*)((const char*)(gbase) + (voff)[_i]), (LAS unsigned*)(lds + (bufoff) + ldsw + _i * 8192), 16, 0, 0); } while (0)
#define PG8_LDA(dst, b, h) do { _Pragma("unroll") for (int m = 0; m < 4; ++m) _Pragma("unroll") for (int k = 0; k < 2; ++k) dst[m][k] = *(const LAS bf16x8*)(lds + PG8_SA(b, h) + aoff + m * 2048 + k * 1024); } while (0)
#define PG8_LDB(dst, b, h) do { _Pragma("unroll") for (int n = 0; n < 2; ++n) _Pragma("unroll") for (int k = 0; k < 2; ++k) dst[n][k] = *(const LAS bf16x8*)(lds + PG8_SB(b, h) + boff + n * 2048 + k * 1024); } while (0)
#define PG8_MMA(ai, bj, At, Bt) do { __builtin_amdgcn_s_setprio(1); _Pragma("unroll") for (int m = 0; m < 4; ++m) _Pragma("unroll") for (int n = 0; n < 2; ++n) _Pragma("unroll") for (int k = 0; k < 2; ++k) \
        acc[ai][bj][m][n] = __builtin_amdgcn_mfma_f32_16x16x32_bf16(Bt[n][k], At[m][k], acc[ai][bj][m][n], 0, 0, 0); __builtin_amdgcn_s_setprio(0); } while (0)
#define PG8_WAIT_V(n) asm volatile("s_waitcnt vmcnt(" #n ")" ::: "memory")
#define PG8_WAIT_L(n) asm volatile("s_waitcnt lgkmcnt(" #n ")" ::: "memory")
#define PG8_BAR __builtin_amdgcn_s_barrier()
#define PG8_SCHED __builtin_amdgcn_sched_barrier(0)
    Unit cur, nxt; int ui = 0;
    if (!S.next(0, cur)) return;
    float zf_ = 0.f; asm volatile("" : "+v"(zf_));
    const f32x4 zero4 = {zf_, zf_, zf_, zf_};
    f32x4 acc[2][2][4][2];
#pragma unroll
    for (int a = 0; a < 2; ++a)
#pragma unroll
        for (int b = 0; b < 2; ++b)
#pragma unroll
            for (int m = 0; m < 4; ++m)
#pragma unroll
                for (int n = 0; n < 2; ++n) acc[a][b][m][n] = zero4;
    bf16x8 At[4][2], B0[2][2], B1[2][2];
    const char* cA = (const char*)g.A + (size_t)cur.pm * tstepA + (size_t)cur.k0 * kstep + S.a_extra(cur); const char* cB = (const char*)g.Bt + (size_t)cur.pn * tstepB + (size_t)cur.k0 * kstep;
    S.a_ready(cur);
    if constexpr (SP2) {
        PG8_STAGE(PG8_SB(0, 0), cB, voffB); PG8_STAGE(PG8_SB(0, 1), cB + hstepB, voffB); PG8_STAGE(PG8_SA(0, 0), cA, voffA); PG8_STAGE(PG8_SA(0, 1), cA + hstepA, voffA);
        if (wr == 1) PG8_BAR;
        PG8_WAIT_V(2); PG8_BAR;
        PG8_STAGE(PG8_SB(1, 0), cB + kstep, voffB); PG8_STAGE(PG8_SA(1, 0), cA + kstep, voffA); PG8_STAGE(PG8_SB(1, 1), cB + hstepB + kstep, voffB);
        PG8_WAIT_V(6); PG8_BAR;
    } else {
        PG8_STAGE(PG8_SB(0, 0), cB, voffB); PG8_STAGE(PG8_SA(0, 0), cA, voffA); PG8_STAGE(PG8_SB(0, 1), cB + hstepB, voffB); PG8_STAGE(PG8_SA(0, 1), cA + hstepA, voffA);
        if (wr == 1) PG8_BAR;
        PG8_WAIT_V(4); PG8_BAR;
        PG8_STAGE(PG8_SB(1, 0), cB + kstep, voffB); PG8_STAGE(PG8_SA(1, 0), cA + kstep, voffA); PG8_STAGE(PG8_SB(1, 1), cB + hstepB + kstep, voffB);
        PG8_WAIT_V(6); PG8_BAR;
    }
    for (;;) {
        const bool has_next = S.next(ui + 1, nxt);
        const char* nA = has_next ? (const char*)g.A + (size_t)nxt.pm * tstepA + (size_t)nxt.k0 * kstep + S.a_extra(nxt) : cA; const char* nB = has_next ? (const char*)g.Bt + (size_t)nxt.pn * tstepB + (size_t)nxt.k0 * kstep : cB;
        const int nt = cur.nt;
        for (int t = 0; t < nt; t += 2) {
            const bool last = (t == nt - 2);
            const char* a1 = cA + (size_t)(t + 1) * kstep;
            const char* a2 = last ? nA : cA + (size_t)(t + 2) * kstep; const char* b2 = last ? nB : cB + (size_t)(t + 2) * kstep;
            const char* a3 = a2 + kstep; const char* b3 = b2 + kstep;
            if (last && has_next) S.a_ready(nxt);
            if constexpr (SP2) {
            PG8_LDB(B0, 0, 0); PG8_LDB(B1, 0, 1); PG8_SCHED; PG8_LDA(At, 0, 0); PG8_STAGE(PG8_SA(1, 1), a1 + hstepA, voffA);
            PG8_WAIT_V(8); PG8_WAIT_L(0); PG8_BAR; PG8_MMA(0, 0, At, B0); PG8_MMA(0, 1, At, B1); PG8_BAR; PG8_SCHED;
            PG8_LDA(At, 0, 1); PG8_STAGE(PG8_SB(0, 0), b2, voffB); PG8_STAGE(PG8_SB(0, 1), b2 + hstepB, voffB); PG8_STAGE(PG8_SA(0, 0), a2, voffA);
            PG8_WAIT_V(8); PG8_WAIT_L(0); PG8_BAR; PG8_MMA(1, 0, At, B0); PG8_MMA(1, 1, At, B1); PG8_BAR; PG8_SCHED;
            PG8_LDB(B0, 1, 0); PG8_LDB(B1, 1, 1); PG8_SCHED; PG8_LDA(At, 1, 0); PG8_STAGE(PG8_SA(0, 1), a2 + hstepA, voffA);
            PG8_WAIT_V(8); PG8_WAIT_L(0); PG8_BAR; PG8_MMA(0, 0, At, B0); PG8_MMA(0, 1, At, B1); PG8_BAR; PG8_SCHED;
            PG8_LDA(At, 1, 1); PG8_STAGE(PG8_SB(1, 0), b3, voffB); PG8_STAGE(PG8_SB(1, 1), b3 + hstepB, voffB); PG8_STAGE(PG8_SA(1, 0), a3, voffA);
            PG8_WAIT_V(8); PG8_WAIT_L(0); PG8_BAR; PG8_MMA(1, 0, At, B0); PG8_MMA(1, 1, At, B1); PG8_BAR; PG8_SCHED;
            } else {
            PG8_LDB(B0, 0, 0); PG8_SCHED; PG8_LDA(At, 0, 0); PG8_STAGE(PG8_SA(1, 1), a1 + hstepA, voffA);
            PG8_WAIT_L(8); PG8_BAR; PG8_WAIT_L(0); PG8_MMA(0, 0, At, B0); PG8_BAR; PG8_SCHED;
            PG8_LDB(B1, 0, 1); PG8_STAGE(PG8_SB(0, 0), b2, voffB);
            PG8_BAR; PG8_WAIT_L(0); PG8_MMA(0, 1, At, B1); PG8_BAR;
            PG8_LDA(At, 0, 1); PG8_STAGE(PG8_SA(0, 0), a2, voffA);
            PG8_BAR; PG8_WAIT_L(0); PG8_MMA(1, 0, At, B0); PG8_BAR; PG8_SCHED;
            PG8_STAGE(PG8_SB(0, 1), b2 + hstepB, voffB);
            PG8_WAIT_V(6); PG8_BAR; PG8_MMA(1, 1, At, B1); PG8_BAR;
            PG8_LDB(B0, 1, 0); PG8_SCHED; PG8_LDA(At, 1, 0); PG8_STAGE(PG8_SA(0, 1), a2 + hstepA, voffA);
            PG8_WAIT_L(8); PG8_BAR; PG8_WAIT_L(0); PG8_MMA(0, 0, At, B0); PG8_BAR; PG8_SCHED;
            PG8_LDB(B1, 1, 1); PG8_STAGE(PG8_SB(1, 0), b3, voffB);
            PG8_BAR; PG8_WAIT_L(0); PG8_MMA(0, 1, At, B1); PG8_BAR;
            PG8_LDA(At, 1, 1); PG8_STAGE(PG8_SA(1, 0), a3, voffA);
            PG8_BAR; PG8_WAIT_L(0); PG8_MMA(1, 0, At, B0); PG8_BAR; PG8_SCHED;
            PG8_STAGE(PG8_SB(1, 1), b3 + hstepB, voffB);
            PG8_WAIT_V(6); PG8_BAR; PG8_MMA(1, 1, At, B1); PG8_BAR;
            }
        }
        if constexpr (ALIGN_EPI) { if (wr == 0) PG8_BAR; }
        E(acc, cur, wr, wc, fr, fq); S.done(cur);
        if (!has_next) break;
#pragma unroll
        for (int a = 0; a < 2; ++a)
#pragma unroll
            for (int b = 0; b < 2; ++b)
#pragma unroll
                for (int m = 0; m < 4; ++m)
#pragma unroll
                    for (int n = 0; n < 2; ++n) acc[a][b][m][n] = zero4;
        cur = nxt; cA = nA; cB = nB; ++ui;
        if constexpr (ALIGN_EPI) { if (wr == 1) PG8_BAR; }
    }
    PG8_WAIT_V(0);
    if constexpr (!ALIGN_EPI) { if (wr == 0) PG8_BAR; }
    PG8_BAR;
#undef PG8_SA
#undef PG8_SB
#undef PG8_STAGE
#undef PG8_LDA
#undef PG8_LDB
#undef PG8_MMA
#undef PG8_WAIT_V
#undef PG8_WAIT_L
#undef PG8_BAR
#undef PG8_SCHED
}
}
using pg8::Unit;
typedef const f32x4 (&AccRef)[2][2][4][2];

struct EpiSwiGLU {
    static constexpr bool PERM = true;
    bf16_t* H;
    __device__ __forceinline__ void operator()(AccRef acc, const Unit& u, int wr, int wc, int fr, int fq) const {
        const int row0 = u.pm * 256 + wr * 64 + fr, col0 = u.pn * 128 + wc * 32 + 8 * fq;
#pragma unroll
        for (int ai = 0; ai < 2; ++ai)
#pragma unroll
            for (int m = 0; m < 4; ++m) {
                const f32x4 g0 = acc[ai][0][m][0], g1 = acc[ai][0][m][1], u0 = acc[ai][1][m][0], u1 = acc[ai][1][m][1];
                u32x4 w;
                w.x = pk2(siluf_(g0[0]) * u0[0], siluf_(g0[1]) * u0[1]); w.y = pk2(siluf_(g0[2]) * u0[2], siluf_(g0[3]) * u0[3]);
                w.z = pk2(siluf_(g1[0]) * u1[0], siluf_(g1[1]) * u1[1]); w.w = pk2(siluf_(g1[2]) * u1[2], siluf_(g1[3]) * u1[3]);
                *(u32x4*)(H + (size_t)(row0 + ai * 128 + m * 16) * FF + col0) = w;
            }
    }
};
struct EpiResid {
    static constexpr bool PERM = false;
    const float* xin_p; const float* xin_s; float* xout; float alpha; bool split; float* part;
    __device__ __forceinline__ void operator()(AccRef acc, const Unit& u, int wr, int wc, int fr, int fq) const {
        const int row0 = u.pm * 256 + wr * 64 + fr, col0 = u.pn * 256 + wc * 32 + 4 * fq;
        if (split && u.pm * 256 >= MP) {
            float* pb_ = part + ((size_t)u.sp * MS - MP) * D;
#pragma unroll
            for (int ai = 0; ai < 2; ++ai)
#pragma unroll
                for (int m = 0; m < 4; ++m) { float* o = pb_ + (size_t)(row0 + ai * 128 + m * 16) * D + col0;
#pragma unroll
                    for (int bj = 0; bj < 2; ++bj)
#pragma unroll
                        for (int n = 0; n < 2; ++n) *(f32x4*)(o + bj * 128 + n * 16) = acc[ai][bj][m][n] * alpha; }
            return;
        }
        const float* xin = (u.pm * 256 < MP) ? xin_p : xin_s - (size_t)MP * D;
#pragma unroll
        for (int ai = 0; ai < 2; ++ai) {
            f32x4 b[4][2][2];
#pragma unroll
            for (int m = 0; m < 4; ++m) { const size_t off = (size_t)(row0 + ai * 128 + m * 16) * D + col0;
#pragma unroll
                for (int bj = 0; bj < 2; ++bj)
#pragma unroll
                    for (int n = 0; n < 2; ++n) b[m][bj][n] = *(const f32x4*)(xin + off + bj * 128 + n * 16); }
#pragma unroll
            for (int m = 0; m < 4; ++m) { const size_t off = (size_t)(row0 + ai * 128 + m * 16) * D + col0;
#pragma unroll
                for (int bj = 0; bj < 2; ++bj)
#pragma unroll
                    for (int n = 0; n < 2; ++n) *(f32x4*)(xout + off + bj * 128 + n * 16) = b[m][bj][n] + acc[ai][bj][m][n] * alpha; }
        }
    }
};
struct EpiWin {
    static constexpr bool PERM = true;
    bf16_t* U; float* US; float* fk_p; float* fk_s; float* fv_p; float* fv_s;
    __device__ __forceinline__ void operator()(AccRef acc, const Unit& u, int wr, int wc, int fr, int fq) const {
        const int row0 = u.pm * 256 + wr * 64 + fr, cw = wc * 32 + 8 * fq;
        const int pn = u.pn;
        if (pn < 26) {
            float* fo = nullptr;
            if (pn >= 18) { const bool isv = pn >= 22; const int hc = (pn - (isv ? 22 : 18)) * 256;
                fo = (u.pm * 256 < MP) ? (isv ? fv_p : fk_p) : (isv ? fv_s : fk_s) - (size_t)MP * 1024; fo += hc; }
#pragma unroll
            for (int ai = 0; ai < 2; ++ai)
#pragma unroll
                for (int m = 0; m < 4; ++m) { const int row = row0 + ai * 128 + m * 16;
#pragma unroll
                    for (int bj = 0; bj < 2; ++bj) { const f32x4 v0 = acc[ai][bj][m][0], v1 = acc[ai][bj][m][1];
                        u32x4 w; w.x = pk2(v0[0], v0[1]); w.y = pk2(v0[2], v0[3]); w.z = pk2(v1[0], v1[1]); w.w = pk2(v1[2], v1[3]);
                        *(u32x4*)(U + (size_t)row * LDU + pn * 256 + bj * 128 + cw) = w;
                        if (fo) { float* o = fo + (size_t)row * 1024 + bj * 128 + cw; *(f32x4*)o = v0; *(f32x4*)(o + 4) = v1; } } }
        } else if (pn < 50) {
#pragma unroll
            for (int ai = 0; ai < 2; ++ai)
#pragma unroll
                for (int m = 0; m < 4; ++m) { const int row = row0 + ai * 128 + m * 16;
#pragma unroll
                    for (int bj = 0; bj < 2; ++bj) { const f32x4 v0 = acc[ai][bj][m][0], v1 = acc[ai][bj][m][1];
                        u32x4 w; w.x = pk2(sigmoidf_(v0[0]), sigmoidf_(v0[1])); w.y = pk2(sigmoidf_(v0[2]), sigmoidf_(v0[3]));
                        w.z = pk2(sigmoidf_(v1[0]), sigmoidf_(v1[1])); w.w = pk2(sigmoidf_(v1[2]), sigmoidf_(v1[3]));
                        *(u32x4*)(U + (size_t)row * LDU + pn * 256 + bj * 128 + cw) = w; } }
        } else {
#pragma unroll
            for (int ai = 0; ai < 2; ++ai)
#pragma unroll
                for (int m = 0; m < 4; ++m) { const int row = row0 + ai * 128 + m * 16;
                    float* o = US + (size_t)row * LDUS + cw; *(f32x4*)o = acc[ai][0][m][0]; *(f32x4*)(o + 4) = acc[ai][0][m][1]; }
        }
    }
};
struct EpiUq {
    static constexpr bool PERM = true;
    bf16_t* Q; const f32x2* rope;
    __device__ __forceinline__ void operator()(AccRef acc, const Unit& u, int wr, int wc, int fr, int fq) const {
        const int row0 = u.pm * 256 + wr * 64 + fr;
#pragma unroll
        for (int bj = 0; bj < 2; ++bj) {
            const int c0 = u.pn * 256 + bj * 128 + wc * 32 + 8 * fq, r = c0 % 192;
            const bool isrope = r >= 128; const int j0 = (r - 128) >> 1;
#pragma unroll
            for (int ai = 0; ai < 2; ++ai)
#pragma unroll
                for (int m = 0; m < 4; ++m) { const int row = row0 + ai * 128 + m * 16;
                    f32x4 v0 = acc[ai][bj][m][0], v1 = acc[ai][bj][m][1];
                    if (isrope) { const f32x2* cs = rope + (size_t)pos_of(row) * 32 + j0;
                        const f32x2 a = cs[0], b = cs[1], c = cs[2], d = cs[3];
                        const f32x4 t0 = v0, t1 = v1;
                        v0[0] = t0[0] * a.x - t0[1] * a.y; v0[1] = t0[1] * a.x + t0[0] * a.y; v0[2] = t0[2] * b.x - t0[3] * b.y; v0[3] = t0[3] * b.x + t0[2] * b.y;
                        v1[0] = t1[0] * c.x - t1[1] * c.y; v1[1] = t1[1] * c.x + t1[0] * c.y; v1[2] = t1[2] * d.x - t1[3] * d.y; v1[3] = t1[3] * d.x + t1[2] * d.y; }
                    u32x4 w; w.x = pk2(v0[0], v0[1]); w.y = pk2(v0[2], v0[3]); w.z = pk2(v1[0], v1[1]); w.w = pk2(v1[2], v1[3]);
                    *(u32x4*)(Q + (size_t)row * 1536 + c0) = w; }
        }
    }
};
struct EpiUkv {
    static constexpr bool PERM = true;
    bf16_t* KM; bf16_t* VT;
    __device__ __forceinline__ void operator()(AccRef acc, const Unit& u, int wr, int wc, int fr, int fq) const {
        const int row0 = u.pm * 256 + wr * 64 + fr, h = u.pn, d0 = wc * 32 + 8 * fq;
#pragma unroll
        for (int ai = 0; ai < 2; ++ai)
#pragma unroll
            for (int m = 0; m < 4; ++m) { const int row = row0 + ai * 128 + m * 16;
                { const f32x4 v0 = acc[ai][0][m][0], v1 = acc[ai][0][m][1];
                  u32x4 w; w.x = pk2(v0[0], v0[1]); w.y = pk2(v0[2], v0[3]); w.z = pk2(v1[0], v1[1]); w.w = pk2(v1[2], v1[3]);
                  *(u32x4*)(KM + ((size_t)row * 8 + h) * 192 + d0) = w; }
                { const f32x4 v0 = acc[ai][1][m][0], v1 = acc[ai][1][m][1];
                  bf16_t* vt = VT + (size_t)(h * 128 + d0) * KVROWS + row;
#pragma unroll
                  for (int j = 0; j < 4; ++j) { vt[(size_t)j * KVROWS] = f2bf(v0[j]); vt[(size_t)(j + 4) * KVROWS] = f2bf(v1[j]); } } }
    }
};
template <int BR> struct EpiMerge {
    static constexpr bool PERM = true;
    const bf16_t* U; bf16_t* MG;
    __device__ __forceinline__ void operator()(AccRef acc, const Unit& u, int wr, int wc, int fr, int fq) const {
        const int row0 = u.pm * 256 + wr * 64 + fr, colb = u.pn * 256 + wc * 32 + 8 * fq;
#pragma unroll
        for (int ai = 0; ai < 2; ++ai) {
            u32x4 gt[4][2], od[4][2];
#pragma unroll
            for (int m = 0; m < 4; ++m) { const int row = row0 + ai * 128 + m * 16;
#pragma unroll
                for (int bj = 0; bj < 2; ++bj) { gt[m][bj] = *(const u32x4*)(U + (size_t)row * LDU + UC_GATE + BR * D + colb + bj * 128);
                    if (BR > 0) od[m][bj] = *(const u32x4*)(MG + (size_t)row * D + colb + bj * 128); } }
#pragma unroll
            for (int m = 0; m < 4; ++m) { const int row = row0 + ai * 128 + m * 16;
#pragma unroll
                for (int bj = 0; bj < 2; ++bj) { const u32x4 g = gt[m][bj];
                    f32x4 v0 = acc[ai][bj][m][0], v1 = acc[ai][bj][m][1];
                    v0[0] *= bf_lo(g.x); v0[1] *= bf_hi(g.x); v0[2] *= bf_lo(g.y); v0[3] *= bf_hi(g.y);
                    v1[0] *= bf_lo(g.z); v1[1] *= bf_hi(g.z); v1[2] *= bf_lo(g.w); v1[3] *= bf_hi(g.w);
                    if (BR > 0) { const u32x4 o = od[m][bj];
                        v0[0] += bf_lo(o.x); v0[1] += bf_hi(o.x); v0[2] += bf_lo(o.y); v0[3] += bf_hi(o.y);
                        v1[0] += bf_lo(o.z); v1[1] += bf_hi(o.z); v1[2] += bf_lo(o.w); v1[3] += bf_hi(o.w); }
                    u32x4 w; w.x = pk2(v0[0], v0[1]); w.y = pk2(v0[2], v0[3]); w.z = pk2(v1[0], v1[1]); w.w = pk2(v1[2], v1[3]);
                    *(u32x4*)(MG + (size_t)row * D + colb + bj * 128) = w; } }
        }
    }
};

struct EpiMergeSample {
    static constexpr bool PERM = true;
    const bf16_t* U; bf16_t* MG; float* part; unsigned* cnt; LAS unsigned* flag;
    __device__ __forceinline__ void operator()(AccRef acc, const Unit& u, int wr, int wc, int fr, int fq) const {
        const int br = u.pn >> 3, pn8 = u.pn & 7;
        const int row0 = wr * 64 + fr, colb = pn8 * 256 + wc * 32 + 8 * fq;
        float* pb = part + (size_t)br * MS * D;
#pragma unroll
        for (int ai = 0; ai < 2; ++ai)
#pragma unroll
            for (int m = 0; m < 4; ++m) { const int row = row0 + ai * 128 + m * 16;
#pragma unroll
                for (int bj = 0; bj < 2; ++bj) { const u32x4 g = *(const u32x4*)(U + (size_t)(MP + row) * LDU + UC_GATE + br * D + colb + bj * 128);
                    f32x4 v0 = acc[ai][bj][m][0], v1 = acc[ai][bj][m][1];
                    v0[0] *= bf_lo(g.x); v0[1] *= bf_hi(g.x); v0[2] *= bf_lo(g.y); v0[3] *= bf_hi(g.y);
                    v1[0] *= bf_lo(g.z); v1[1] *= bf_hi(g.z); v1[2] *= bf_lo(g.w); v1[3] *= bf_hi(g.w);
                    unsigned long long* o = (unsigned long long*)(pb + (size_t)row * D + colb + bj * 128);
                    __hip_atomic_store(o + 0, ((unsigned long long)__float_as_uint(v0[1]) << 32) | __float_as_uint(v0[0]), __ATOMIC_RELAXED, __HIP_MEMORY_SCOPE_AGENT);
                    __hip_atomic_store(o + 1, ((unsigned long long)__float_as_uint(v0[3]) << 32) | __float_as_uint(v0[2]), __ATOMIC_RELAXED, __HIP_MEMORY_SCOPE_AGENT);
                    __hip_atomic_store(o + 2, ((unsigned long long)__float_as_uint(v1[1]) << 32) | __float_as_uint(v1[0]), __ATOMIC_RELAXED, __HIP_MEMORY_SCOPE_AGENT);
                    __hip_atomic_store(o + 3, ((unsigned long long)__float_as_uint(v1[3]) << 32) | __float_as_uint(v1[2]), __ATOMIC_RELAXED, __HIP_MEMORY_SCOPE_AGENT); } }
        asm volatile("s_waitcnt vmcnt(0)" ::: "memory");
        __builtin_amdgcn_s_barrier();
        const int t = (wr * 4 + wc) * 64 + fq * 16 + fr;
        if (t == 0) { const unsigned old = __hip_atomic_fetch_add(cnt + 64 * pn8, 1u, __ATOMIC_RELAXED, __HIP_MEMORY_SCOPE_AGENT); *flag = (old == 2u) ? 1u : 0u; }
        asm volatile("s_waitcnt vmcnt(0) lgkmcnt(0)" ::: "memory");
        __builtin_amdgcn_s_barrier();
        asm volatile("" ::: "memory");
        if (*flag != 0u) {
            __builtin_amdgcn_fence(__ATOMIC_ACQUIRE, "agent");
            asm volatile("s_waitcnt vmcnt(0)" ::: "memory");
#pragma unroll 2
            for (int k = 0; k < 16; ++k) { const int e = (k * 512 + t) * 8, r = e >> 8, c = e & 255;
                const float* src = part + (size_t)r * D + pn8 * 256 + c;
                f32x4 a = *(const f32x4*)src, b = *(const f32x4*)(src + 4);
                a = a + *(const f32x4*)(src + (size_t)MS * D) + *(const f32x4*)(src + (size_t)2 * MS * D);
                b = b + *(const f32x4*)(src + (size_t)MS * D + 4) + *(const f32x4*)(src + (size_t)2 * MS * D + 4);
                u32x4 w; w.x = pk2(a[0], a[1]); w.y = pk2(a[2], a[3]); w.z = pk2(b[0], b[1]); w.w = pk2(b[2], b[3]);
                *(u32x4*)(MG + (size_t)(MP + r) * D + pn8 * 256 + c) = w; }
        }
    }
};

struct Frame {
    LAS unsigned char* lds;
    int tid, lane, wave, vcu, G, bx;
    int gw, NGW;
};
__device__ __forceinline__ int lane_now() { unsigned z = 0u; asm volatile("" : "+s"(z)); return (int)__builtin_amdgcn_mbcnt_hi(~0u, __builtin_amdgcn_mbcnt_lo(~0u, z)); }
__device__ __forceinline__ Frame mk_frame(int wave_s) {
    extern __shared__ __attribute__((aligned(16))) unsigned char lds_raw[];
    Frame F; F.lds = (LAS unsigned char*)lds_raw;
    asm volatile("" : "+s"(wave_s)); const int t = wave_s * 64 + lane_now();
    int bx = blockIdx.x, G = gridDim.x; asm volatile("" : "+s"(bx), "+s"(G));
    F.tid = t; F.lane = t & 63; F.wave = __builtin_amdgcn_readfirstlane(t >> 6);
    F.G = G; F.bx = bx; F.vcu = (G % 8 == 0) ? (bx % 8) * (G / 8) + bx / 8 : bx;
    F.gw = F.vcu * 8 + F.wave; F.NGW = G * 8;
    return F;
}

template <int KIND> __device__ __forceinline__ int map_row(int n, float& sc) {
    sc = 1.f;
    if (KIND == 0) return n;
    if (KIND == 1) return 256 * (n >> 7) + (n & 127);
    if (KIND == 2) return 256 * (n >> 7) + 128 + (n & 127);
    if (KIND == 3) {
        if (n < 1024) return n;
        if (n < 1088) return 12800 + (n - 1024);
        if (n < 2112) return UC_Z + (n - 1088);
        if (n < 3648) return UC_XBC + (n - 2112);
        if (n < 3664) return 12864 + (n - 3648);
        if (n < 4688) { sc = FOX_QSCALE; return UC_FQ + (n - 3664); }
        if (n < 5712) return UC_FK + (n - 4688);
        if (n < 6736) return UC_FV + (n - 5712);
        if (n < 6744) return 12880 + (n - 6736);
        return UC_GATE + (n - 6744);
    }
    if (KIND == 4) {
        sc = MLA_QSCALE; const int h = n / 192, r = n % 192;
        if (r < 128) return n;
        const int rr = r - 128; return h * 192 + 128 + 2 * (rr & 31) + (rr >> 5);
    }
    return n;
}
template <int KIND>
__device__ __forceinline__ void cvt_item(const float* W, int N, bf16_t* WT, size_t ldo, size_t coloff, LAS float* scr, int item, int lane) {
    const int nblk = (N + 31) / 32, kb = item / nblk, nb = item % nblk, k0 = 64 * kb, n0 = 32 * nb;
    const int nn = n0 + (lane & 31); const bool ok = nn < N;
#pragma unroll
    for (int i = 0; i < 32; ++i) { const int kk = 2 * i + (lane >> 5); scr[kk * 33 + (lane & 31)] = ok ? W[(size_t)(k0 + kk) * N + nn] : 0.f; }
    LDS_WAIT(); asm volatile("" ::: "memory");
    const int c = lane & 7;
#pragma unroll
    for (int j = 0; j < 4; ++j) { const int n = (lane >> 3) + 8 * j;
        if (n0 + n < N) { float sc; const int dr = map_row<KIND>(n0 + n, sc); const LAS float* s = scr + (8 * c) * 33 + n;
            u32x4 o; o.x = pk2(s[0 * 33] * sc, s[1 * 33] * sc); o.y = pk2(s[2 * 33] * sc, s[3 * 33] * sc); o.z = pk2(s[4 * 33] * sc, s[5 * 33] * sc); o.w = pk2(s[6 * 33] * sc, s[7 * 33] * sc);
            *(u32x4*)(WT + (size_t)dr * ldo + coloff + k0 + 8 * c) = o; } }
    LDS_WAIT(); asm volatile("" ::: "memory");
}

__device__ __forceinline__ void phase_convert(const Params&, const Frame& F0, int layer0) {
    const Frame F = mk_frame(F0.wave);
    const PV p = pv_get(); int layer = layer0; asm volatile("" : "+s"(layer));
    LAS float* scr = (LAS float*)(F.lds + F.wave * 16384);
    unsigned z0_ = 0u; asm volatile("" : "+v"(z0_)); const u32x4 Z4 = {z0_, z0_, z0_, z0_};
    bf16_t* W = (bf16_t*)(p.ws() + WS_W);
    const size_t lFF = (size_t)layer * D * FF;
    constexpr int IT_FF = (D / 64) * (FF / 32), IT_DN = (FF / 64) * (D / 32), IT_IN = (D / 64) * ((IN_COLS + 31) / 32), IT_UQ = 8 * 48, IT_UKV = 8 * 64, IT_BR = 16 * 64, IT_OUT = 32 * 64;
    constexpr int IT_FV = NB * 16 * 32;
    constexpr int NITEMS = 6 * IT_FF + IT_IN + IT_UQ + IT_UKV + 3 * IT_BR + IT_OUT + IT_FV;
    static_assert(IT_FF == IT_DN, "items");
    for (int it = F.gw; it < NITEMS; it += F.NGW) {
        int r = it;
        if (r < IT_FF) { cvt_item<1>(p.in(I_F1G) + lFF, FF, W + W_GU1, D, 0, scr, r, F.lane); continue; } r -= IT_FF;
        if (r < IT_FF) { cvt_item<2>(p.in(I_F1U) + lFF, FF, W + W_GU1, D, 0, scr, r, F.lane); continue; } r -= IT_FF;
        if (r < IT_DN) { cvt_item<0>(p.in(I_F1D) + lFF, D, W + W_D1, FF, 0, scr, r, F.lane); continue; } r -= IT_DN;
        if (r < IT_FF) { cvt_item<1>(p.in(I_F2G) + lFF, FF, W + W_GU2, D, 0, scr, r, F.lane); continue; } r -= IT_FF;
        if (r < IT_FF) { cvt_item<2>(p.in(I_F2U) + lFF, FF, W + W_GU2, D, 0, scr, r, F.lane); continue; } r -= IT_FF;
        if (r < IT_DN) { cvt_item<0>(p.in(I_F2D) + lFF, D, W + W_D2, FF, 0, scr, r, F.lane); continue; } r -= IT_DN;
        if (r < IT_IN) { cvt_item<3>(p.in(I_WIN) + (size_t)layer * D * IN_COLS, IN_COLS, W + W_IN, D, 0, scr, r, F.lane); continue; } r -= IT_IN;
        if (r < IT_UQ) { cvt_item<4>(p.in(I_WUQ) + (size_t)layer * 512 * 1536, 1536, W + W_UQ, 512, 0, scr, r, F.lane); continue; } r -= IT_UQ;
        if (r < IT_UKV) { cvt_item<0>(p.in(I_WUKV) + (size_t)layer * 512 * 2048, 2048, W + W_UKV, 512, 0, scr, r, F.lane); continue; } r -= IT_UKV;
        if (r < IT_BR) { cvt_item<0>(p.in(I_BRM) + (size_t)layer * 1024 * D, D, W + W_BR, 1024, 0, scr, r, F.lane); continue; } r -= IT_BR;
        if (r < IT_BR) { cvt_item<0>(p.in(I_BRS) + (size_t)layer * 1024 * D, D, W + W_BR + (size_t)D * 1024, 1024, 0, scr, r, F.lane); continue; } r -= IT_BR;
        if (r < IT_BR) { cvt_item<0>(p.in(I_BRF) + (size_t)layer * 1024 * D, D, W + W_BR + (size_t)2 * D * 1024, 1024, 0, scr, r, F.lane); continue; } r -= IT_BR;
        if (r < IT_OUT) { cvt_item<0>(p.in(I_WOUT) + (size_t)layer * D * D, D, W + W_OUT, D, 0, scr, r, F.lane); continue; } r -= IT_OUT;
        { const int b = r / 512, ri = r % 512;
          cvt_item<0>(p.in(I_CFV) + ((size_t)layer * NB + b) * PAST * 1024, 1024, (bf16_t*)(p.ws() + WS_VTF), KVROWS, (size_t)MP + (size_t)b * KVS, scr, ri, F.lane); }
    }
    const size_t gt = (size_t)F.gw * 64 + F.lane, NT = (size_t)F.NGW * 64;
    {
        u32x4* z = (u32x4*)(W + W_IN + (size_t)IN_COLS * D);
        for (size_t i = gt; i < (size_t)(NWIN - IN_COLS) * D / 8; i += NT) z[i] = Z4;
    }
    {
        const float* src = p.in(I_CCKV) + (size_t)layer * NB * PAST * 512; bf16_t* dst = (bf16_t*)(p.ws() + WS_CKV);
        for (size_t i = gt; i < (size_t)NB * PAST * 512 / 8; i += NT) { const size_t e = i * 8; const int b = (int)(e / (PAST * 512)), rem = (int)(e % (PAST * 512));
            const f32x4 a = *(const f32x4*)(src + e), c = *(const f32x4*)(src + e + 4);
            u32x4 w; w.x = pk2(a[0], a[1]); w.y = pk2(a[2], a[3]); w.z = pk2(c[0], c[1]); w.w = pk2(c[2], c[3]);
            *(u32x4*)(dst + ((size_t)MP + (size_t)b * KVS) * 512 + rem) = w; }
        for (size_t i = gt; i < (size_t)NB * (KVS - KVLEN_S) * 512 / 8; i += NT) { const size_t e = i * 8; const int b = (int)(e / ((KVS - KVLEN_S) * 512)), rem = (int)(e % ((KVS - KVLEN_S) * 512));
            *(u32x4*)(dst + ((size_t)MP + (size_t)b * KVS + KVLEN_S) * 512 + rem) = Z4; }
    }
    {
        const float* src = p.in(I_CFK) + (size_t)layer * NB * PAST * 1024; bf16_t* dst = (bf16_t*)(p.ws() + WS_KFS);
        for (size_t i = gt; i < (size_t)NB * PAST * 1024 / 8; i += NT) { const size_t e = i * 8; const int b = (int)(e / (PAST * 1024)), rem = (int)(e % (PAST * 1024));
            const f32x4 a = *(const f32x4*)(src + e), c = *(const f32x4*)(src + e + 4);
            u32x4 w; w.x = pk2(a[0], a[1]); w.y = pk2(a[2], a[3]); w.z = pk2(c[0], c[1]); w.w = pk2(c[2], c[3]);
            *(u32x4*)(dst + (size_t)b * KVS * 1024 + rem) = w; }
        for (size_t i = gt; i < (size_t)NB * (KVS - KVLEN_S) * 1024 / 8; i += NT) { const size_t e = i * 8; const int b = (int)(e / ((KVS - KVLEN_S) * 1024)), rem = (int)(e % ((KVS - KVLEN_S) * 1024));
            *(u32x4*)(dst + ((size_t)b * KVS + KVLEN_S) * 1024 + rem) = Z4; }
    }
    {
        const float* src = p.in(I_CKPE) + (size_t)layer * NB * PAST * 64; bf16_t* km = (bf16_t*)(p.ws() + WS_KM);
        for (size_t i = gt; i < (size_t)NB * KVS * 32; i += NT) { const int j = (int)(i & 31); const int pr = (int)(i >> 5) % KVS, b = (int)(i >> 5) / KVS;
            unsigned w = 0u;
            if (pr < PAST) { const float* s = src + ((size_t)b * PAST + pr) * 64; w = pk2(s[j], s[32 + j]); }
            if (pr < PAST || pr >= KVLEN_S) { const size_t kr = (size_t)MP + (size_t)b * KVS + pr;
#pragma unroll
                for (int h = 0; h < 8; ++h) *(unsigned*)(km + (kr * 8 + h) * 192 + 128 + 2 * j) = w; } }
        const float* ls = p.in(I_CLOGF) + (size_t)layer * NB * PAST * 8; float* ld = (float*)(p.ws() + WS_LOGF);
        for (size_t i = gt; i < (size_t)NB * KVS * 8; i += NT) { const int hh = (int)(i & 7); const int pr = (int)(i >> 3) % KVS, b = (int)(i >> 3) / KVS;
            if (pr < PAST) ld[((size_t)MP + (size_t)b * KVS + pr) * 8 + hh] = ls[((size_t)b * PAST + pr) * 8 + hh];
            else if (pr >= KVLEN_S) ld[((size_t)MP + (size_t)b * KVS + pr) * 8 + hh] = 0.f; }
        bf16_t* vtf = (bf16_t*)(p.ws() + WS_VTF);
        for (size_t i = gt; i < (size_t)1024 * NB * (KVS - KVLEN_S); i += NT) { const int pc = (int)(i % (KVS - KVLEN_S)); const int b = (int)(i / (KVS - KVLEN_S)) % NB, ch = (int)(i / (KVS - KVLEN_S)) / NB;
            vtf[(size_t)ch * KVROWS + MP + (size_t)b * KVS + KVLEN_S + pc] = 0; }
    }
}

__device__ __forceinline__ void phase_rope_table(const Frame& F0) {
    const Frame F = mk_frame(F0.wave);
    const PV p = pv_get();
    const size_t gt = (size_t)F.gw * 64 + F.lane, NT = (size_t)F.NGW * 64;
    f32x2* rt = (f32x2*)(p.ws() + WS_ROPE);
    for (size_t i = gt; i < (size_t)SEQ * 32; i += NT) { const int j = (int)(i & 31), ps = (int)(i >> 5);
        const float inv = powf(10000.0f, -(float)j / 32.0f); const float ang = (float)ps * inv;
        float sn, cs; sincosf(ang, &sn, &cs); rt[i] = (f32x2){cs, sn}; }
}
__device__ __forceinline__ void phase_norm(const Frame& F, const float* xp, const float* xs, const float* gain, bf16_t* XN, float* copy_s, const float* part) {
    f32x4 g[8];
#pragma unroll
    for (int j = 0; j < 8; ++j) g[j] = *(const f32x4*)(gain + 4 * F.lane + 256 * j);
    for (int m = F.gw; m < MT; m += F.NGW) {
        const float* xr = (m < MP) ? xp + (size_t)m * D : xs + (size_t)(m - MP) * D;
        f32x4 v[8]; float s = 0.f;
#pragma unroll
        for (int j = 0; j < 8; ++j) { v[j] = *(const f32x4*)(xr + 4 * F.lane + 256 * j); s += (v[j][0] * v[j][0] + v[j][1] * v[j][1]) + (v[j][2] * v[j][2] + v[j][3] * v[j][3]); }
        if (m >= MP && (copy_s || part)) {
            if (part) { s = 0.f;
#pragma unroll
                for (int sp = 0; sp < 8; ++sp)
#pragma unroll
                    for (int j = 0; j < 8; ++j) v[j] += *(const f32x4*)(part + ((size_t)sp * MS + (m - MP)) * D + 4 * F.lane + 256 * j);
#pragma unroll
                for (int j = 0; j < 8; ++j) s += (v[j][0] * v[j][0] + v[j][1] * v[j][1]) + (v[j][2] * v[j][2] + v[j][3] * v[j][3]); }
            float* xo = (copy_s ? copy_s : const_cast<float*>(xs)) + (size_t)(m - MP) * D;
#pragma unroll
            for (int j = 0; j < 8; ++j) *(f32x4*)(xo + 4 * F.lane + 256 * j) = v[j]; }
        const float rs = fast_rsqrt(wave_sum(s, F.lane) * (1.0f / D) + EPS);
        bf16_t* o = XN + (size_t)m * D + 4 * F.lane;
#pragma unroll
        for (int j = 0; j < 8; ++j) { u32x2 w; w.x = pk2(v[j][0] * rs * g[j][0], v[j][1] * rs * g[j][1]); w.y = pk2(v[j][2] * rs * g[j][2], v[j][3] * rs * g[j][3]); *(u32x2*)(o + 256 * j) = w; }
    }
}
__device__ __forceinline__ void phase_final_norm(const Frame& F, float* x, const float* gain, const float* part) {
    f32x4 g[8];
#pragma unroll
    for (int j = 0; j < 8; ++j) g[j] = *(const f32x4*)(gain + 4 * F.lane + 256 * j);
    for (int m = F.gw; m < MT; m += F.NGW) {
        float* xr = x + (size_t)m * D;
        f32x4 v[8]; float s = 0.f;
#pragma unroll
        for (int j = 0; j < 8; ++j) v[j] = *(const f32x4*)(xr + 4 * F.lane + 256 * j);
        if (m >= MP) {
#pragma unroll
            for (int sp = 0; sp < 8; ++sp)
#pragma unroll
                for (int j = 0; j < 8; ++j) v[j] += *(const f32x4*)(part + ((size_t)sp * MS + (m - MP)) * D + 4 * F.lane + 256 * j); }
#pragma unroll
        for (int j = 0; j < 8; ++j) s += (v[j][0] * v[j][0] + v[j][1] * v[j][1]) + (v[j][2] * v[j][2] + v[j][3] * v[j][3]);
        const float rs = fast_rsqrt(wave_sum(s, F.lane) * (1.0f / D) + EPS);
#pragma unroll
        for (int j = 0; j < 8; ++j) *(f32x4*)(xr + 4 * F.lane + 256 * j) = v[j] * rs * g[j];
    }
}
__device__ __forceinline__ float softplusf_(float x) {
    if (x > 20.f) return x; const float y = fast_exp(x); return y < 0.03125f ? y * (1.0f + y * (-0.5f + y * (0.33333333f - 0.25f * y))) : fast_log(1.0f + y); }
__device__ __forceinline__ void unpack8(const u32x4 w, float (&v)[8]) {
    v[0] = bf_lo(w.x); v[1] = bf_hi(w.x); v[2] = bf_lo(w.y); v[3] = bf_hi(w.y); v[4] = bf_lo(w.z); v[5] = bf_hi(w.z); v[6] = bf_lo(w.w); v[7] = bf_hi(w.w);
}
__device__ __forceinline__ void phase_t1(const Params&, const Frame& F0, int layer0) {
    const Frame F = mk_frame(F0.wave);
    const PV p = pv_get(); int layer = layer0; asm volatile("" : "+s"(layer));
    bf16_t* U = (bf16_t*)(p.ws() + WS_U); const float* US = (const float*)(p.ws() + WS_US);
    bf16_t* CKV = (bf16_t*)(p.ws() + WS_CKV); bf16_t* KM = (bf16_t*)(p.ws() + WS_KM); bf16_t* KFS = (bf16_t*)(p.ws() + WS_KFS); bf16_t* VTF = (bf16_t*)(p.ws() + WS_VTF);
    float* LOGF = (float*)(p.ws() + WS_LOGF); float* DTB = (float*)(p.ws() + WS_DT); const f32x2* rope = (const f32x2*)(p.ws() + WS_ROPE);
    unsigned* ctl = (unsigned*)(p.ws() + WS_CTL);
    float* o_pckv = p.out() + O_PCKV + (size_t)layer * MP * 512; float* o_sckv = p.out() + O_SCKV + (size_t)layer * MS * 512;
    float* o_pkpe = p.out() + O_PKPE + (size_t)layer * MP * 64; float* o_skpe = p.out() + O_SKPE + (size_t)layer * MS * 64;
    float* o_plf = p.out() + O_PLOGF + (size_t)layer * MP * 8; float* o_slf = p.out() + O_SLOGF + (size_t)layer * MS * 8;
    float* o_pconv = p.out() + O_PCONV + (size_t)layer * 3 * 1536; float* o_sconv = p.out() + O_SCONV + (size_t)layer * NB * 3 * 1536;
    float qg[8], kg[8];
#pragma unroll
    for (int j = 0; j < 8; ++j) { qg[j] = p.in(I_QN)[layer * 512 + 8 * F.lane + j]; kg[j] = p.in(I_KVN)[layer * 512 + 8 * F.lane + j]; }
    const float fb = (F.lane < 8) ? p.in(I_FBF)[layer * 8 + F.lane] : 0.f;
    const float db = (F.lane < 16) ? p.in(I_DTB)[layer * 16 + F.lane] : 0.f;
    for (int m = F.gw; m < MT; m += F.NGW) {
        const int kr = kvrow_of(m), ps = pos_of(m); const bool smp = m >= MP; const int mi = m - MP;
        bf16_t* ur = U + (size_t)m * LDU;
        const float* us = US + (size_t)m * LDUS;
        const u32x4 wq = *(const u32x4*)(ur + UC_QLAT + 8 * F.lane), wc = *(const u32x4*)(ur + UC_CKV + 8 * F.lane);
        const u32x4 fq0 = *(const u32x4*)(ur + UC_FQ + 16 * F.lane), fq1 = *(const u32x4*)(ur + UC_FQ + 16 * F.lane + 8);
        const u32x4 fk0 = *(const u32x4*)(ur + UC_FK + 16 * F.lane), fk1 = *(const u32x4*)(ur + UC_FK + 16 * F.lane + 8);
        float x1 = 0.f, x2 = 0.f; f32x2 cs = {0.f, 0.f};
        if (F.lane < 32) { x1 = us[US_KPE + F.lane]; x2 = us[US_KPE + 32 + F.lane]; cs = rope[(size_t)ps * 32 + F.lane]; }
        const float uff = (F.lane < 8) ? us[US_FF + F.lane] : 0.f, udt = (F.lane < 16) ? us[US_DT + F.lane] : 0.f;
        float vq[8], vc[8]; unpack8(wq, vq); unpack8(wc, vc);
        float sq_ = 0.f, sc_ = 0.f;
#pragma unroll
        for (int j = 0; j < 8; ++j) { sq_ += vq[j] * vq[j]; sc_ += vc[j] * vc[j]; }
        float nq = 0.f, nk = 0.f;
        { float a8[8], b8[8]; unpack8(fq0, a8); unpack8(fq1, b8);
#pragma unroll
          for (int j = 0; j < 8; ++j) nq += a8[j] * a8[j] + b8[j] * b8[j];
          unpack8(fk0, a8); unpack8(fk1, b8);
#pragma unroll
          for (int j = 0; j < 8; ++j) nk += a8[j] * a8[j] + b8[j] * b8[j]; }
#pragma unroll
        for (int o = 1; o < 64; o <<= 1) { const float t0 = shx(sq_, o, F.lane), t1 = shx(sc_, o, F.lane); sq_ += t0; sc_ += t1;
            if (o < 8) { const float t2 = shx(nq, o, F.lane), t3 = shx(nk, o, F.lane); nq += t2; nk += t3; } }
        {
            const float rs = fast_rsqrt(sq_ * (1.0f / 512) + EPS);
            u32x4 w; w.x = pk2(vq[0] * rs * qg[0], vq[1] * rs * qg[1]); w.y = pk2(vq[2] * rs * qg[2], vq[3] * rs * qg[3]); w.z = pk2(vq[4] * rs * qg[4], vq[5] * rs * qg[5]); w.w = pk2(vq[6] * rs * qg[6], vq[7] * rs * qg[7]);
            *(u32x4*)(ur + UC_QLAT + 8 * F.lane) = w;
        }
        {
            const float rs = fast_rsqrt(sc_ * (1.0f / 512) + EPS);
#pragma unroll
            for (int j = 0; j < 8; ++j) vc[j] = vc[j] * rs * kg[j];
            float* o = (smp ? o_sckv + (size_t)mi * 512 : o_pckv + (size_t)m * 512) + 8 * F.lane;
            *(f32x4*)o = (f32x4){vc[0], vc[1], vc[2], vc[3]}; *(f32x4*)(o + 4) = (f32x4){vc[4], vc[5], vc[6], vc[7]};
            u32x4 w; w.x = pk2(vc[0], vc[1]); w.y = pk2(vc[2], vc[3]); w.z = pk2(vc[4], vc[5]); w.w = pk2(vc[6], vc[7]);
            *(u32x4*)(CKV + (size_t)kr * 512 + 8 * F.lane) = w;
        }
        if (F.lane < 32) {
            const float o1 = x1 * cs.x - x2 * cs.y, o2 = x2 * cs.x + x1 * cs.y;
            float* o = smp ? o_skpe + (size_t)mi * 64 : o_pkpe + (size_t)m * 64; o[F.lane] = o1; o[32 + F.lane] = o2;
            const unsigned w = pk2(o1, o2);
#pragma unroll
            for (int h = 0; h < 8; ++h) *(unsigned*)(KM + ((size_t)kr * 8 + h) * 192 + 128 + 2 * F.lane) = w;
        }
        if (F.lane < 8) {
            const float lf = -softplusf_(-(uff + fb));
            (smp ? o_slf + (size_t)mi * 8 : o_plf + (size_t)m * 8)[F.lane] = lf; LOGF[(size_t)kr * 8 + F.lane] = lf;
        }
        if (F.lane < 16) DTB[(size_t)m * 16 + F.lane] = softplusf_(udt + db);
        if (!smp) {
            if ((F.lane & 7) == 0) { const int hh = F.lane >> 3;
                atomicMax(ctl + CW_QN2 + (layer * 64 + (m >> 8)) * 8 + hh, __float_as_uint(nq));
                atomicMax(ctl + CW_KN2 + (layer * 64 + (m >> 8)) * 8 + hh, __float_as_uint(nk)); }
        } else {
            bf16_t* kd = KFS + (size_t)(kr - MP) * 1024 + 16 * F.lane; *(u32x4*)kd = fk0; *(u32x4*)(kd + 8) = fk1;
        }
        {
            int slot = -1; float* od = nullptr;
            if (!smp) { if (m >= MP - 3) { slot = m - (MP - 3); od = o_pconv; } }
            else { const int t = mi & 15; if (t >= 13) { slot = t - 13; od = o_sconv + (size_t)(mi >> 4) * 3 * 1536; } }
            if (slot >= 0) { for (int c = F.lane; c < 1536; c += 64) od[slot * 1536 + c] = bf2f(ur[UC_XBC + c]); }
        }
    }
    {
        bf16_t* XC = (bf16_t*)(p.ws() + WS_XN);
        const float* cw = p.in(I_CW) + (size_t)layer * 4 * 1536; const float* cb = p.in(I_CB) + (size_t)layer * 1536; const float* cst = p.in(I_CONV) + (size_t)layer * NB * 3 * 1536;
        const size_t gt = (size_t)F.gw * 64 + F.lane, NT = (size_t)F.NGW * 64;
        constexpr int STRIP = 25, NSTRIP = (MP + STRIP - 1) / STRIP;
        for (size_t it = gt; it < (size_t)NSTRIP * 192; it += NT) { const int strip = (int)(it / 192), ch0 = (int)(it % 192) * 8; const int r0 = strip * STRIP;
            float wt[4][8], bs[8];
            { const f32x4 b0 = *(const f32x4*)(cb + ch0), b1 = *(const f32x4*)(cb + ch0 + 4); bs[0] = b0[0]; bs[1] = b0[1]; bs[2] = b0[2]; bs[3] = b0[3]; bs[4] = b1[0]; bs[5] = b1[1]; bs[6] = b1[2]; bs[7] = b1[3]; }
#pragma unroll
            for (int k = 0; k < 4; ++k) { const f32x4 w0 = *(const f32x4*)(cw + k * 1536 + ch0), w1 = *(const f32x4*)(cw + k * 1536 + ch0 + 4);
                wt[k][0] = w0[0]; wt[k][1] = w0[1]; wt[k][2] = w0[2]; wt[k][3] = w0[3]; wt[k][4] = w1[0]; wt[k][5] = w1[1]; wt[k][6] = w1[2]; wt[k][7] = w1[3]; }
            const bf16_t* up = U + UC_XBC + ch0;
            u32x4 win[3];
#pragma unroll
            for (int k = 0; k < 3; ++k) { const int rr = r0 - 3 + k; u32x4 z = {0u, 0u, 0u, 0u}; if (rr >= 0) z = *(const u32x4*)(up + (size_t)rr * LDU); win[k] = z; }
#pragma unroll 1
            for (int rb = 0; rb < STRIP; rb += 5) {
                u32x4 nw[5];
#pragma unroll
                for (int e = 0; e < 5; ++e) { const int rr = r0 + rb + e; nw[e] = (rr < MP) ? *(const u32x4*)(up + (size_t)rr * LDU) : (u32x4){0u, 0u, 0u, 0u}; }
#pragma unroll
                for (int e = 0; e < 5; ++e) { const int rr = r0 + rb + e;
                    float x0[8], x1[8], x2[8], x3[8]; unpack8(win[0], x0); unpack8(win[1], x1); unpack8(win[2], x2); unpack8(nw[e], x3);
                    float acc[8];
#pragma unroll
                    for (int j = 0; j < 8; ++j) acc[j] = bs[j] + wt[0][j] * x0[j] + wt[1][j] * x1[j] + wt[2][j] * x2[j] + wt[3][j] * x3[j];
                    u32x4 o; o.x = pk2(siluf_(acc[0]), siluf_(acc[1])); o.y = pk2(siluf_(acc[2]), siluf_(acc[3])); o.z = pk2(siluf_(acc[4]), siluf_(acc[5])); o.w = pk2(siluf_(acc[6]), siluf_(acc[7]));
                    if (rr < MP) *(u32x4*)(XC + (size_t)rr * 1536 + ch0) = o;
                    win[0] = win[1]; win[1] = win[2]; win[2] = nw[e]; }
            }
        }
        for (size_t i = gt; i < (size_t)MS * 192; i += NT) { const int m = MP + (int)(i / 192), ch0 = (int)(i % 192) * 8;
            const int t = (m - MP) & 15;
            float acc[8];
            { const f32x4 b0 = *(const f32x4*)(cb + ch0), b1 = *(const f32x4*)(cb + ch0 + 4); acc[0] = b0[0]; acc[1] = b0[1]; acc[2] = b0[2]; acc[3] = b0[3]; acc[4] = b1[0]; acc[5] = b1[1]; acc[6] = b1[2]; acc[7] = b1[3]; }
#pragma unroll
            for (int k = 0; k < 4; ++k) { const int ii = t - 3 + k; float xv[8];
                if (ii >= 0) unpack8(*(const u32x4*)(U + (size_t)(m - 3 + k) * LDU + UC_XBC + ch0), xv);
                else { const float* sp = cst + ((size_t)((m - MP) >> 4) * 3 + (ii + 3)) * 1536 + ch0; const f32x4 s0 = *(const f32x4*)sp, s1 = *(const f32x4*)(sp + 4);
                    xv[0] = s0[0]; xv[1] = s0[1]; xv[2] = s0[2]; xv[3] = s0[3]; xv[4] = s1[0]; xv[5] = s1[1]; xv[6] = s1[2]; xv[7] = s1[3]; }
                const f32x4 w0 = *(const f32x4*)(cw + k * 1536 + ch0), w1 = *(const f32x4*)(cw + k * 1536 + ch0 + 4);
                acc[0] += w0[0] * xv[0]; acc[1] += w0[1] * xv[1]; acc[2] += w0[2] * xv[2]; acc[3] += w0[3] * xv[3];
                acc[4] += w1[0] * xv[4]; acc[5] += w1[1] * xv[5]; acc[6] += w1[2] * xv[6]; acc[7] += w1[3] * xv[7]; }
            u32x4 o; o.x = pk2(siluf_(acc[0]), siluf_(acc[1])); o.y = pk2(siluf_(acc[2]), siluf_(acc[3])); o.z = pk2(siluf_(acc[4]), siluf_(acc[5])); o.w = pk2(siluf_(acc[6]), siluf_(acc[7]));
            *(u32x4*)(XC + (size_t)m * 1536 + ch0) = o; }
    }
    {
        constexpr int PITCH = 72;
        LAS bf16_t* tile = (LAS bf16_t*)(F.lds + F.wave * (64 * PITCH * 2));
        for (int it = F.gw; it < (MP / 64) * 16; it += F.NGW) {
            const int rt = it >> 4, ct = it & 15, row0 = rt * 64, ch0 = ct * 64;
            u32x4 v[8];
#pragma unroll
            for (int k = 0; k < 8; ++k) { const int r = 8 * k + (F.lane >> 3), c8 = F.lane & 7; v[k] = *(const u32x4*)(U + (size_t)(row0 + r) * LDU + UC_FV + ch0 + 8 * c8); }
#pragma unroll
            for (int k = 0; k < 8; ++k) { const int r = 8 * k + (F.lane >> 3), c8 = F.lane & 7; bf16_t e8[8]; *(u32x4*)e8 = v[k];
#pragma unroll
                for (int e = 0; e < 8; ++e) tile[(8 * c8 + e) * PITCH + r] = e8[e]; }
            LDS_WAIT(); asm volatile("" ::: "memory");
#pragma unroll
            for (int k = 0; k < 8; ++k) { const int ch = 8 * k + (F.lane >> 3), r8 = F.lane & 7; const u32x4 w = *(const LAS u32x4*)(tile + ch * PITCH + 8 * r8);
                *(u32x4*)(VTF + (size_t)(ch0 + ch) * KVROWS + row0 + 8 * r8) = w; }
            LDS_WAIT(); asm volatile("" ::: "memory");
        }
        const size_t gt = (size_t)F.gw * 64 + F.lane, NT = (size_t)F.NGW * 64;
        for (size_t i = gt; i < (size_t)MS * 1024; i += NT) { const int mi = (int)(i >> 10), ch = (int)(i & 1023);
            VTF[(size_t)ch * KVROWS + kvrow_of(MP + mi)] = U[(size_t)(MP + mi) * LDU + UC_FV + ch]; }
    }
}

__device__ __forceinline__ void phase_t2(const Params&, const Frame& F0) {
    const Frame F = mk_frame(F0.wave);
    const PV p = pv_get();
    const float* LOGF = (const float*)(p.ws() + WS_LOGF); float* CUM = (float*)(p.ws() + WS_CUM);
    LAS double* wt = (LAS double*)F.lds;
    for (int job = (F.G == 256) ? (F.bx + 56) % 256 : F.bx; job < 1 + NB; job += F.G) {
        const int base = job == 0 ? 0 : MP + (job - 1) * KVS, n = job == 0 ? MP : KVS;
        const int per = (n + 511) / 512, i0 = F.tid * per, i1 = (i0 + per < n) ? i0 + per : n;
        double s[8];
#pragma unroll
        for (int h = 0; h < 8; ++h) s[h] = 0.0;
        for (int i = i0; i < i1; ++i) { const f32x4 a = *(const f32x4*)(LOGF + (size_t)(base + i) * 8), b = *(const f32x4*)(LOGF + (size_t)(base + i) * 8 + 4);
            s[0] += a[0]; s[1] += a[1]; s[2] += a[2]; s[3] += a[3]; s[4] += b[0]; s[5] += b[1]; s[6] += b[2]; s[7] += b[3]; }
        double pre[8];
#pragma unroll
        for (int h = 0; h < 8; ++h) { double v = s[h];
#pragma unroll
            for (int o = 1; o < 64; o <<= 1) { const long long vb = __builtin_bit_cast(long long, v); const int src = ((F.lane - o) & 63) << 2;
                const unsigned lo_ = (unsigned)__builtin_amdgcn_ds_bpermute(src, (int)(unsigned)vb), hi_ = (unsigned)__builtin_amdgcn_ds_bpermute(src, (int)(unsigned)(vb >> 32));
                const double t = __builtin_bit_cast(double, ((unsigned long long)hi_ << 32) | lo_); if (F.lane >= o) v += t; }
            pre[h] = v - s[h]; if (F.lane == 63) wt[F.wave * 8 + h] = v; }
        __syncthreads();
#pragma unroll
        for (int h = 0; h < 8; ++h) { double off = 0.0; for (int ww = 0; ww < F.wave; ++ww) off += wt[ww * 8 + h]; pre[h] += off; }
        for (int i = i0; i < i1; ++i) { const f32x4 a = *(const f32x4*)(LOGF + (size_t)(base + i) * 8), b = *(const f32x4*)(LOGF + (size_t)(base + i) * 8 + 4);
            pre[0] += a[0]; pre[1] += a[1]; pre[2] += a[2]; pre[3] += a[3]; pre[4] += b[0]; pre[5] += b[1]; pre[6] += b[2]; pre[7] += b[3];
            *(f32x4*)(CUM + (size_t)(base + i) * 8) = (f32x4){(float)pre[0] * LOG2E, (float)pre[1] * LOG2E, (float)pre[2] * LOG2E, (float)pre[3] * LOG2E};
            *(f32x4*)(CUM + (size_t)(base + i) * 8 + 4) = (f32x4){(float)pre[4] * LOG2E, (float)pre[5] * LOG2E, (float)pre[6] * LOG2E, (float)pre[7] * LOG2E}; }
        __syncthreads();
    }
}

#define MFMA32(a, b, c) __builtin_amdgcn_mfma_f32_32x32x16_bf16((a), (b), (c), 0, 0, 0)
__device__ __forceinline__ int crow(int r, int hi) { return (r & 3) + 8 * (r >> 2) + 4 * hi; }
struct AttnSeq {
    const bf16_t* Q; int qs;
    const bf16_t* K; int ks;
    const bf16_t* VT;
    bf16_t* O; int os;
    const float* cq; const float* ck;
};
__device__ __forceinline__ void softmax_tile(f32x16& s0, f32x16& s1, float& m, float& l, f32x16 (&o)[4], bf16x8 (&pa)[4]) {
    float pmax = s0[0];
#pragma unroll
    for (int r = 1; r < 16; ++r) pmax = fmaxf(pmax, s0[r]);
#pragma unroll
    for (int r = 0; r < 16; ++r) pmax = fmaxf(pmax, s1[r]);
    { auto rr = __builtin_amdgcn_permlane32_swap(__float_as_uint(pmax), __float_as_uint(pmax), false, false);
      pmax = fmaxf(__uint_as_float(rr[0]), __uint_as_float(rr[1])); }
    const bool resc = !__all(pmax - m <= 8.0f);
    const float mn = resc ? fmaxf(m, pmax) : m;
    const float alpha = resc ? fast_exp2(m - mn) : 1.0f; m = mn;
    float ps = 0.f;
#pragma unroll
    for (int r = 0; r < 16; ++r) { s0[r] = fast_exp2(s0[r] - mn); ps += s0[r]; }
#pragma unroll
    for (int r = 0; r < 16; ++r) { s1[r] = fast_exp2(s1[r] - mn); ps += s1[r]; }
    { auto rr = __builtin_amdgcn_permlane32_swap(__float_as_uint(ps), __float_as_uint(ps), false, false);
      ps = __uint_as_float(rr[0]) + __uint_as_float(rr[1]); }
    l = l * alpha + ps;
    if (resc) {
#pragma unroll
        for (int d = 0; d < 4; ++d)
#pragma unroll
            for (int r = 0; r < 16; ++r) o[d][r] *= alpha;
    }
#define PK4(P, B_, OUT) do { const unsigned a0 = pk2(P[B_ + 0], P[B_ + 1]), a1 = pk2(P[B_ + 2], P[B_ + 3]), b0 = pk2(P[B_ + 4], P[B_ + 5]), b1 = pk2(P[B_ + 6], P[B_ + 7]); \
        auto r0 = __builtin_amdgcn_permlane32_swap(a0, b0, false, false); auto r1 = __builtin_amdgcn_permlane32_swap(a1, b1, false, false); \
        u32x4 w_ = {r0[0], r1[0], r0[1], r1[1]}; OUT = __builtin_bit_cast(bf16x8, w_); } while (0)
    PK4(s0, 0, pa[0]); PK4(s0, 8, pa[1]); PK4(s1, 0, pa[2]); PK4(s1, 8, pa[3]);
#undef PK4
}
__device__ __forceinline__ void store_o(const f32x16 (&o)[4], float inv, bf16_t* orow, int hi) {
#pragma unroll
    for (int d = 0; d < 4; ++d)
#pragma unroll
        for (int rq = 0; rq < 4; ++rq) { u32x2 w; w.x = pk2(o[d][4 * rq] * inv, o[d][4 * rq + 1] * inv); w.y = pk2(o[d][4 * rq + 2] * inv, o[d][4 * rq + 3] * inv);
            *(u32x2*)(orow + 32 * d + 8 * rq + 4 * hi) = w; }
}

template <int DQK, bool FOX>
__device__ __forceinline__ void attn_prefill_unit(LAS unsigned char* lds, const AttnSeq& a, int qb, int tid0, float bound2 = 0.f) {
    int tid = tid0; asm volatile("" : "+v"(tid));
    constexpr int RB = DQK * 2, CPR = DQK / 8, KBUF = 64 * RB, NKI = DQK / 64, NKS = DQK / 16;
    constexpr int OFF_V = 2 * KBUF, OFF_CK = OFF_V + 2 * 16384, OFF_QR = OFF_CK + 1024;
    constexpr int NQR = NKS;
    static_assert(OFF_QR + 8 * 4096 <= LDSCTL_OFF, "attention LDS map");
    const int w = __builtin_amdgcn_readfirstlane(tid >> 6), lane = tid & 63, c = lane & 31, hi = lane >> 5;
    const int q0w = qb * 256 + 32 * w, qrow = q0w + c;
    const int last_tile = q0w >> 6, ntiles = 4 * qb + 4;
    int jmin = 0;
    if (FOX) {
        LAS int* jm = (LAS int*)(lds + 2 * KBUF + 2 * 16384 + 512);
        if (tid == 0) *jm = ntiles - 1;
        __syncthreads();
        if (tid < ntiles) { const float d = a.cq[(size_t)(qb * 256) * 8] - a.ck[(size_t)(tid * 64 + 63) * 8];
            if (!(d + bound2 < -40.f)) __hip_atomic_fetch_min(jm, tid, __ATOMIC_RELAXED, __HIP_MEMORY_SCOPE_WORKGROUP); }
        __syncthreads();
        jmin = __builtin_amdgcn_readfirstlane(*jm);
    }
    int koff[NKI], voff[2];
#pragma unroll
    for (int i = 0; i < NKI; ++i) { const int s = (i * 8 + w) * 64 + lane, row = s / CPR, cp = s % CPR;
        const int ch = (DQK == 128) ? (cp ^ (row & 15)) : ((cp & ~7) | ((cp & 7) ^ ((row >> 1) & 7)));
        koff[i] = row * a.ks + ch * 8; }
#pragma unroll
    for (int i = 0; i < 2; ++i) { const int s = (i * 8 + w) * 64 + lane, d = s >> 3, cp = s & 7; voff[i] = d * KVROWS + ((cp ^ ((d >> 1) & 7)) * 8); }
    const int krow_b = c * RB;
    const int vsw = (c >> 1) & 7;
    bf16x8 qf[NQR];
    { const bf16_t* qp = a.Q + (size_t)qrow * a.qs + 8 * hi;
#pragma unroll
      for (int ks = 0; ks < NQR; ++ks) qf[ks] = *(const bf16x8*)(qp + 16 * ks);
      if (DQK == 192) {
#pragma unroll
          for (int ks = 8; ks < NKS; ++ks) *(LAS bf16x8*)(lds + OFF_QR + w * 4096 + c * 128 + (((2 * (ks - 8) + hi) ^ vsw) * 16)) = *(const bf16x8*)(qp + 16 * ks); } }
    float cq = 0.f; if (FOX) cq = a.cq[(size_t)qrow * 8];
    f32x16 o[4];
#pragma unroll
    for (int d = 0; d < 4; ++d)
#pragma unroll
        for (int r = 0; r < 16; ++r) o[d][r] = 0.f;
    float m = -1e30f, l = 0.f;
#define ATT_ISSUE(j_, b_) do { const bf16_t* kb_ = a.K + (size_t)(j_) * 64 * a.ks; const bf16_t* vb_ = a.VT + (size_t)(j_) * 64; \
        _Pragma("unroll") for (int i_ = 0; i_ < NKI; ++i_) __builtin_amdgcn_global_load_lds((const unsigned*)(kb_ + koff[i_]), (LAS unsigned*)(lds + (b_) * KBUF + (i_ * 8 + w) * 1024), 16, 0, 0); \
        _Pragma("unroll") for (int i_ = 0; i_ < 2; ++i_) __builtin_amdgcn_global_load_lds((const unsigned*)(vb_ + voff[i_]), (LAS unsigned*)(lds + OFF_V + (b_) * 16384 + (i_ * 8 + w) * 1024), 16, 0, 0); } while (0)
    ATT_ISSUE(jmin, jmin & 1);
    float ckn = 0.f;
    if (FOX && w == 0) { ckn = a.ck[(size_t)(jmin * 64 + lane) * 8]; ((LAS float*)(lds + OFF_CK))[(jmin & 1) * 64 + lane] = ckn; }
    for (int j = jmin; j < ntiles; ++j) {
        const int b = j & 1;
        VM_WAIT();
        __syncthreads();
        if (j + 1 < ntiles) { ATT_ISSUE(j + 1, b ^ 1); if (FOX && w == 0) ckn = a.ck[(size_t)((j + 1) * 64 + lane) * 8]; }
        if (j <= last_tile) {
            const LAS unsigned char* kb = lds + b * KBUF; const LAS unsigned char* vb = lds + OFF_V + b * 16384;
            f32x16 s0, s1;
#pragma unroll
            for (int r = 0; r < 16; ++r) { s0[r] = 0.f; s1[r] = 0.f; }
            constexpr int NB4 = NKS / 4;
            bf16x8 kfa[2][4], kfb[2][4];
#define ATT_LDK(dst, b4) do { _Pragma("unroll") for (int e_ = 0; e_ < 4; ++e_) { const int ks_ = 4 * (b4) + e_, ch_ = 2 * ks_ + hi; \
                const int cp_ = (DQK == 128) ? (ch_ ^ (c & 15)) : ((ch_ & ~7) | ((ch_ & 7) ^ ((c >> 1) & 7))); \
                dst[0][e_] = *(const LAS bf16x8*)(kb + krow_b + cp_ * 16); dst[1][e_] = *(const LAS bf16x8*)(kb + 32 * RB + krow_b + cp_ * 16); } } while (0)
#define ATT_MMK(src, b4) do { _Pragma("unroll") for (int e_ = 0; e_ < 4; ++e_) { const int ks_ = 4 * (b4) + e_; \
                bf16x8 qv_; if (ks_ < NQR) qv_ = qf[ks_ < NQR ? ks_ : 0]; else qv_ = *(const LAS bf16x8*)(lds + OFF_QR + w * 4096 + c * 128 + (((2 * (ks_ - 8) + hi) ^ vsw) * 16)); \
                s0 = MFMA32(src[0][e_], qv_, s0); s1 = MFMA32(src[1][e_], qv_, s1); } } while (0)
            ATT_LDK(kfa, 0);
            __builtin_amdgcn_sched_barrier(0);
            ATT_LDK(kfb, 1);
            __builtin_amdgcn_sched_barrier(0);
            ATT_MMK(kfa, 0);
            __builtin_amdgcn_sched_barrier(0);
            if (NB4 > 2) { ATT_LDK(kfa, 2 < NB4 ? 2 : 0); }
            __builtin_amdgcn_sched_barrier(0);
            ATT_MMK(kfb, 1);
            __builtin_amdgcn_sched_barrier(0);
            if (NB4 > 2) { ATT_MMK(kfa, 2 < NB4 ? 2 : 0); }
            __builtin_amdgcn_sched_barrier(0);
#undef ATT_LDK
#undef ATT_MMK
            if (FOX) {
                const LAS float* ckb = (const LAS float*)(lds + OFF_CK) + b * 64;
#pragma unroll
                for (int r = 0; r < 16; ++r) { s0[r] += cq - ckb[crow(r, hi)]; s1[r] += cq - ckb[32 + crow(r, hi)]; }
                if (j == last_tile) { const int dq = qrow - j * 64;
#pragma unroll
                    for (int r = 0; r < 16; ++r) { if (crow(r, hi) > dq) s0[r] = -__builtin_inff(); if (32 + crow(r, hi) > dq) s1[r] = -__builtin_inff(); } }
            }
            bf16x8 pa[4];
            softmax_tile(s0, s1, m, l, o, pa);
            {
                bf16x8 va[2][4], vb2[2][4];
#define ATT_LDV(dst, k0_) do { _Pragma("unroll") for (int kk_ = 0; kk_ < 2; ++kk_) _Pragma("unroll") for (int d_ = 0; d_ < 4; ++d_) { const int cp_ = (2 * ((k0_) + kk_) + hi) ^ vsw; \
                    dst[kk_][d_] = *(const LAS bf16x8*)(vb + (32 * d_ + c) * 128 + cp_ * 16); } } while (0)
#define ATT_MMV(src, k0_) do { _Pragma("unroll") for (int kk_ = 0; kk_ < 2; ++kk_) _Pragma("unroll") for (int d_ = 0; d_ < 4; ++d_) o[d_] = MFMA32(src[kk_][d_], pa[(k0_) + kk_], o[d_]); } while (0)
                ATT_LDV(va, 0);
                __builtin_amdgcn_sched_barrier(0);
                ATT_LDV(vb2, 2);
                __builtin_amdgcn_sched_barrier(0);
                ATT_MMV(va, 0);
                __builtin_amdgcn_sched_barrier(0);
                ATT_MMV(vb2, 2);
#undef ATT_LDV
#undef ATT_MMV
            }
        }
        if (FOX && w == 0 && j + 1 < ntiles) ((LAS float*)(lds + OFF_CK))[(b ^ 1) * 64 + lane] = ckn;
    }
#undef ATT_ISSUE
    store_o(o, __builtin_amdgcn_rcpf(l), a.O + (size_t)qrow * a.os, hi);
    __syncthreads();
}

template <int DQK, bool FOX>
__device__ __forceinline__ void attn_decode_unit(LAS unsigned char* lds, const AttnSeq& a, int tid0) {
    int tid = tid0; asm volatile("" : "+v"(tid));
    constexpr int NKS = DQK / 16;
    const int w = __builtin_amdgcn_readfirstlane(tid >> 6), lane = tid & 63, c = lane & 31, hi = lane >> 5, t = c & 15;
    bf16x8 qf[NKS];
    { const bf16_t* qp = a.Q + (size_t)t * a.qs + 8 * hi;
#pragma unroll
      for (int ks = 0; ks < NKS; ++ks) qf[ks] = *(const bf16x8*)(qp + 16 * ks); }
    float cq = 0.f; if (FOX) cq = a.cq[(size_t)t * 8];
    f32x16 o[4];
#pragma unroll
    for (int d = 0; d < 4; ++d)
#pragma unroll
        for (int r = 0; r < 16; ++r) o[d][r] = 0.f;
    float m = -1e30f, l = 0.f;
    const int lim = FOX ? PAST + t : KVLEN_S - 1;
    for (int j = w; j < KVS / 64; j += 8) {
        f32x16 s0, s1;
#pragma unroll
        for (int r = 0; r < 16; ++r) { s0[r] = 0.f; s1[r] = 0.f; }
        const bf16_t* kp = a.K + (size_t)(j * 64 + c) * a.ks + 8 * hi;
#pragma unroll
        for (int ks = 0; ks < NKS; ++ks) {
            if ((ks & 3) == 0) __builtin_amdgcn_sched_barrier(0);
            const bf16x8 k0 = *(const bf16x8*)(kp + 16 * ks), k1 = *(const bf16x8*)(kp + (size_t)32 * a.ks + 16 * ks);
            s0 = MFMA32(k0, qf[ks], s0); s1 = MFMA32(k1, qf[ks], s1);
        }
#pragma unroll
        for (int r = 0; r < 16; ++r) { const int k0i = j * 64 + crow(r, hi), k1i = k0i + 32;
            if (FOX) { s0[r] += cq - a.ck[(size_t)k0i * 8]; s1[r] += cq - a.ck[(size_t)k1i * 8]; }
            if (k0i > lim) s0[r] = -__builtin_inff(); if (k1i > lim) s1[r] = -__builtin_inff(); }
        bf16x8 pa[4];
        softmax_tile(s0, s1, m, l, o, pa);
#pragma unroll
        for (int d = 0; d < 4; ++d) {
            __builtin_amdgcn_sched_barrier(0);
#pragma unroll
            for (int ks = 0; ks < 4; ++ks) { const bf16x8 vf = *(const bf16x8*)(a.VT + (size_t)(32 * d + c) * KVROWS + j * 64 + 16 * ks + 8 * hi);
                o[d] = MFMA32(vf, pa[ks], o[d]); } }
    }
    LAS float* Ot = (LAS float*)lds; LAS float* ML = (LAS float*)(lds + 8 * 128 * 16 * 4);
    if (c < 16) {
#pragma unroll
        for (int d = 0; d < 4; ++d)
#pragma unroll
            for (int r = 0; r < 16; ++r) Ot[(w * 128 + 32 * d + crow(r, hi)) * 16 + c] = o[d][r];
        if (hi == 0) { ML[(w * 16 + c) * 2] = m; ML[(w * 16 + c) * 2 + 1] = l; }
    }
    __syncthreads();
    { const int q = tid & 15, dg = tid >> 4;
      float M = -1e30f;
#pragma unroll
      for (int ww = 0; ww < 8; ++ww) M = fmaxf(M, ML[(ww * 16 + q) * 2]);
      float L = 0.f, acc[4] = {0.f, 0.f, 0.f, 0.f};
#pragma unroll
      for (int ww = 0; ww < 8; ++ww) { const float f = fast_exp2(ML[(ww * 16 + q) * 2] - M); L += ML[(ww * 16 + q) * 2 + 1] * f;
#pragma unroll
          for (int e = 0; e < 4; ++e) acc[e] += Ot[(ww * 128 + 4 * dg + e) * 16 + q] * f; }
      const float inv = __builtin_amdgcn_rcpf(L);
      u32x2 wv; wv.x = pk2(acc[0] * inv, acc[1] * inv); wv.y = pk2(acc[2] * inv, acc[3] * inv);
      *(u32x2*)(a.O + (size_t)q * a.os + 4 * dg) = wv; }
    __syncthreads();
}
#define MFMA16(a, b, c) __builtin_amdgcn_mfma_f32_16x16x32_bf16((a), (b), (c), 0, 0, 0)
constexpr int SSD_XP = 72;
constexpr int SSD_BP = 136;
__device__ __forceinline__ void ssd_dt_acs(const Frame& F, const float* DTB, int m0, int L, int g, float a_neg  , LAS float* Dt, LAS float* Ac) {
    { const int l = F.tid >> 3, h = F.tid & 7; Dt[F.tid] = (l < L) ? DTB[(size_t)(m0 + l) * 16 + 8 * g + h] : 0.f; }
    __syncthreads();
    if (F.tid < 8) { float acs = 0.f; for (int l = 0; l < 64; ++l) { acs += Dt[l * 8 + F.tid] * a_neg; Ac[l * 8 + F.tid] = acs; } }
    __syncthreads();
}
__device__ __forceinline__ void phase_s1(const Params&, const Frame& F0, int layer0) {
    const Frame F = mk_frame(F0.wave);
    const PV p = pv_get(); int layer = layer0; asm volatile("" : "+s"(layer));
    const bf16_t* XC = (const bf16_t*)(p.ws() + WS_XN);
    const float* DTB = (const float*)(p.ws() + WS_DT); float* ST = (float*)(p.ws() + WS_ST); float* CDEC = (float*)(p.ws() + WS_CDEC);
    LAS float* Dt = (LAS float*)F.lds; LAS float* Ac = (LAS float*)(F.lds + 2048);
    LAS bf16_t* BT = (LAS bf16_t*)(F.lds + 4096);
    LAS bf16_t* XT = (LAS bf16_t*)(F.lds + 4096 + 128 * SSD_XP * 2) + F.wave * 64 * SSD_XP;
    const int w = F.wave, lane = F.lane, fr = lane & 15, q = lane >> 4;
    for (int unit = (F.G == 256) ? (F.bx + 88) % 256 : F.bx; unit < NCHUNK * 2; unit += F.G) {
        const int ci = unit >> 1, g = unit & 1; const bool smp = ci >= 256; const int L = smp ? 16 : 64; const int m0 = smp ? MP + (ci - 256) * 16 : ci * 64;
        const int head = 8 * g + w;
        const float a_neg = (F.tid < 8) ? -fast_exp(p.in(I_ALOG)[layer * 16 + 8 * g + F.tid]) : 0.f;
        ssd_dt_acs(F, DTB, m0, L, g, a_neg, Dt, Ac);
        const float alast = Ac[63 * 8 + w];
        if (lane == 0) CDEC[ci * 16 + head] = fast_exp(alast);
        for (int idx = F.tid; idx < 64 * 16; idx += 512) { const int l = idx >> 4, n8 = idx & 15; bf16_t v[8];
            if (l < L) *(u32x4*)v = *(const u32x4*)(XC + (size_t)(m0 + l) * 1536 + 1024 + 128 * g + 8 * n8); else *(u32x4*)v = (u32x4){0u, 0u, 0u, 0u};
#pragma unroll
            for (int e = 0; e < 8; ++e) BT[(8 * n8 + e) * SSD_XP + l] = v[e]; }
#pragma unroll
        for (int it = 0; it < 8; ++it) { const int l = 8 * it + (lane >> 3), p8 = lane & 7; float xv[8];
            if (l < L) unpack8(*(const u32x4*)(XC + (size_t)(m0 + l) * 1536 + head * 64 + 8 * p8), xv); else { for (int e = 0; e < 8; ++e) xv[e] = 0.f; }
            const float wgt = fast_exp(alast - Ac[l * 8 + w]) * Dt[l * 8 + w];
#pragma unroll
            for (int e = 0; e < 8; ++e) XT[(8 * p8 + e) * SSD_XP + l] = f2bf(xv[e] * wgt); }
        __syncthreads();
#pragma unroll 1
        for (int nh = 0; nh < 2; ++nh) {
            f32x4 acc[4][4];
#pragma unroll
            for (int nb = 0; nb < 4; ++nb)
#pragma unroll
                for (int pb = 0; pb < 4; ++pb) acc[nb][pb] = (f32x4){0.f, 0.f, 0.f, 0.f};
#pragma unroll
            for (int ks = 0; ks < 2; ++ks) {
                bf16x8 xf[4];
#pragma unroll
                for (int pb = 0; pb < 4; ++pb) xf[pb] = *(const LAS bf16x8*)(XT + (16 * pb + fr) * SSD_XP + 32 * ks + 8 * q);
#pragma unroll
                for (int nb = 0; nb < 4; ++nb) { const bf16x8 bf = *(const LAS bf16x8*)(BT + (64 * nh + 16 * nb + fr) * SSD_XP + 32 * ks + 8 * q);
#pragma unroll
                    for (int pb = 0; pb < 4; ++pb) acc[nb][pb] = MFMA16(bf, xf[pb], acc[nb][pb]); }
            }
            float* so = ST + (size_t)(ci * 16 + head) * 8192;
#pragma unroll
            for (int nb = 0; nb < 4; ++nb)
#pragma unroll
                for (int pb = 0; pb < 4; ++pb) *(f32x4*)(so + (size_t)(16 * pb + fr) * 128 + 64 * nh + 16 * nb + 4 * q) = acc[nb][pb];
        }
        __syncthreads();
    }
}
__device__ __forceinline__ void phase_s2(const Params&, const Frame& F0, int layer0) {
    const Frame F = mk_frame(F0.wave);
    const PV p = pv_get(); int layer = layer0; asm volatile("" : "+s"(layer));
    float* ST = (float*)(p.ws() + WS_ST); const float* CDEC = (const float*)(p.ws() + WS_CDEC); bf16_t* HB = (bf16_t*)(p.ws() + WS_HB);
    float* o_p = p.out() + O_PSSM + (size_t)layer * 131072; float* o_s = p.out() + O_SSSM + (size_t)layer * NB * 131072;
    const float* h0s = p.in(I_SSM) + (size_t)layer * NB * 131072;
    const size_t gt = (size_t)F.bx * 512 + F.tid, NT = (size_t)F.G * 512;
    for (size_t e = gt; e < 131072; e += NT) { const int head = (int)(e >> 13);
        float h = 0.f;
        for (int c0 = 0; c0 < 256; c0 += 32) { float tv[32], dv[32];
#pragma unroll
            for (int i = 0; i < 32; ++i) { tv[i] = ST[(size_t)(c0 + i) * 131072 + e]; dv[i] = CDEC[(c0 + i) * 16 + head]; }
#pragma unroll
            for (int i = 0; i < 32; ++i) { ST[(size_t)(c0 + i) * 131072 + e] = h; HB[(size_t)(c0 + i) * 131072 + e] = f2bf(h); h = h * dv[i] + tv[i]; } }
        o_p[e] = h; }
    for (size_t i = gt; i < (size_t)NB * 131072; i += NT) { const int b = (int)(i >> 17); const size_t e = i & 131071; const int head = (int)(e >> 13), ci = 256 + b;
        const float h0 = h0s[i], tv = ST[(size_t)ci * 131072 + e];
        ST[(size_t)ci * 131072 + e] = h0; HB[(size_t)ci * 131072 + e] = f2bf(h0); o_s[i] = h0 * CDEC[ci * 16 + head] + tv; }
}
__device__ __forceinline__ void phase_s3(const Params&, const Frame& F0, int layer0) {
    const Frame F = mk_frame(F0.wave);
    const PV p = pv_get(); int layer = layer0; asm volatile("" : "+s"(layer));
    const bf16_t* XC = (const bf16_t*)(p.ws() + WS_XN); bf16_t* U = (bf16_t*)(p.ws() + WS_U);
    const float* DTB = (const float*)(p.ws() + WS_DT);
    LAS float* Dt = (LAS float*)F.lds; LAS float* Ac = (LAS float*)(F.lds + 2048); LAS float* Rs = (LAS float*)(F.lds + 4096);
    LAS bf16_t* Bs = (LAS bf16_t*)(F.lds + 4608);
    LAS bf16_t* Cs = (LAS bf16_t*)(F.lds + 4608 + 64 * SSD_BP * 2);
    LAS bf16_t* XT = (LAS bf16_t*)(F.lds + 4608 + 2 * 64 * SSD_BP * 2) + F.wave * 64 * SSD_XP;
    const int w = F.wave, lane = F.lane, fr = lane & 15, q = lane >> 4;
    for (int unit = F.bx; unit < NCHUNK * 2; unit += F.G) {
        const int ci = unit >> 1, g = unit & 1; const bool smp = ci >= 256; const int L = smp ? 16 : 64; const int m0 = smp ? MP + (ci - 256) * 16 : ci * 64;
        const int head = 8 * g + w;
        const float a_neg = (F.tid < 8) ? -fast_exp(p.in(I_ALOG)[layer * 16 + 8 * g + F.tid]) : 0.f;
        bf16x8 hfr[4][4];
        { const bf16_t* hb = (const bf16_t*)(p.ws() + WS_HB) + (size_t)(ci * 16 + head) * 8192 + (size_t)fr * 128 + 8 * q;
#pragma unroll
          for (int ks = 0; ks < 4; ++ks)
#pragma unroll
              for (int pb = 0; pb < 4; ++pb) hfr[ks][pb] = *(const bf16x8*)(hb + (size_t)(16 * pb) * 128 + 32 * ks); }
        __builtin_amdgcn_sched_barrier(0);
        if (F.tid < 64) Rs[F.tid] = 0.f;
        ssd_dt_acs(F, DTB, m0, L, g, a_neg, Dt, Ac);
        for (int idx = F.tid; idx < 64 * 16; idx += 512) { const int l = idx >> 4, n8 = idx & 15; u32x4 vb = {0u, 0u, 0u, 0u}, vc = {0u, 0u, 0u, 0u};
            if (l < L) { const bf16_t* src = XC + (size_t)(m0 + l) * 1536 + 1024 + 128 * g + 8 * n8; vb = *(const u32x4*)src; vc = *(const u32x4*)(src + 256); }
            *(LAS u32x4*)(Bs + l * SSD_BP + 8 * n8) = vb; *(LAS u32x4*)(Cs + l * SSD_BP + 8 * n8) = vc; }
#pragma unroll
        for (int it = 0; it < 8; ++it) { const int l = 8 * it + (lane >> 3), p8 = lane & 7; bf16_t v[8];
            if (l < L) *(u32x4*)v = *(const u32x4*)(XC + (size_t)(m0 + l) * 1536 + head * 64 + 8 * p8); else *(u32x4*)v = (u32x4){0u, 0u, 0u, 0u};
#pragma unroll
            for (int e = 0; e < 8; ++e) XT[(8 * p8 + e) * SSD_XP + l] = v[e]; }
        __syncthreads();
        f32x4 acc[4][4];
#pragma unroll
        for (int pb = 0; pb < 4; ++pb)
#pragma unroll
            for (int lb = 0; lb < 4; ++lb) acc[pb][lb] = (f32x4){0.f, 0.f, 0.f, 0.f};
#pragma unroll
        for (int ks = 0; ks < 4; ++ks) { bf16x8 cf[4];
#pragma unroll
            for (int lb = 0; lb < 4; ++lb) cf[lb] = *(const LAS bf16x8*)(Cs + (16 * lb + fr) * SSD_BP + 32 * ks + 8 * q);
#pragma unroll
            for (int pb = 0; pb < 4; ++pb) {
#pragma unroll
                for (int lb = 0; lb < 4; ++lb) acc[pb][lb] = MFMA16(hfr[ks][pb], cf[lb], acc[pb][lb]); } }
        f32x4 gt[4][4];
#pragma unroll
        for (int sb = 0; sb < 4; ++sb)
#pragma unroll
            for (int lb = 0; lb < 4; ++lb) gt[sb][lb] = (f32x4){0.f, 0.f, 0.f, 0.f};
#pragma unroll
        for (int ks = 0; ks < 4; ++ks) { bf16x8 cf[4];
#pragma unroll
            for (int lb = 0; lb < 4; ++lb) cf[lb] = *(const LAS bf16x8*)(Cs + (16 * lb + fr) * SSD_BP + 32 * ks + 8 * q);
#pragma unroll
            for (int sb = 0; sb < 4; ++sb) { const bf16x8 bf = *(const LAS bf16x8*)(Bs + (16 * sb + fr) * SSD_BP + 32 * ks + 8 * q);
#pragma unroll
                for (int lb = 0; lb < 4; ++lb) gt[sb][lb] = MFMA16(bf, cf[lb], gt[sb][lb]); } }
        float al[4];
#pragma unroll
        for (int lb = 0; lb < 4; ++lb) { al[lb] = Ac[(16 * lb + fr) * 8 + w]; const float el = fast_exp(al[lb]);
#pragma unroll
            for (int pb = 0; pb < 4; ++pb) acc[pb][lb] = acc[pb][lb] * el; }
#pragma unroll
        for (int ks2 = 0; ks2 < 2; ++ks2) {
            float as_[2][4], ds_[2][4];
#pragma unroll
            for (int jh = 0; jh < 2; ++jh)
#pragma unroll
                for (int r = 0; r < 4; ++r) { const int s = 32 * ks2 + 16 * jh + 4 * q + r; as_[jh][r] = Ac[s * 8 + w]; ds_[jh][r] = Dt[s * 8 + w]; }
            bf16x8 mf[4];
#pragma unroll
            for (int lb = 0; lb < 4; ++lb) { const int l = 16 * lb + fr; float mv[8];
#pragma unroll
                for (int jh = 0; jh < 2; ++jh)
#pragma unroll
                    for (int r = 0; r < 4; ++r) { const int s = 32 * ks2 + 16 * jh + 4 * q + r;
                        mv[4 * jh + r] = (s <= l) ? gt[2 * ks2 + jh][lb][r] * fast_exp(al[lb] - as_[jh][r]) * ds_[jh][r] : 0.f; }
                u32x4 mw; mw.x = pk2(mv[0], mv[1]); mw.y = pk2(mv[2], mv[3]); mw.z = pk2(mv[4], mv[5]); mw.w = pk2(mv[6], mv[7]);
                mf[lb] = __builtin_bit_cast(bf16x8, mw); }
#pragma unroll
            for (int pb = 0; pb < 4; ++pb) { const LAS bf16_t* xp = XT + (16 * pb + fr) * SSD_XP + 32 * ks2 + 4 * q;
                const u32x2 x0 = *(const LAS u32x2*)xp, x1 = *(const LAS u32x2*)(xp + 16);
                const u32x4 xw = {x0.x, x0.y, x1.x, x1.y}; const bf16x8 xf = __builtin_bit_cast(bf16x8, xw);
#pragma unroll
                for (int lb = 0; lb < 4; ++lb) acc[pb][lb] = MFMA16(xf, mf[lb], acc[pb][lb]); }
        }
        const float dsk = p.in(I_SD)[layer * 16 + head];
        float sq[4] = {0.f, 0.f, 0.f, 0.f};
#pragma unroll
        for (int lb = 0; lb < 4; ++lb) { const int l = 16 * lb + fr; const bool ok = l < L;
#pragma unroll
            for (int pb = 0; pb < 4; ++pb) { const int pc = 16 * pb + 4 * q;
                u32x2 xw = {0u, 0u}, zw = {0u, 0u};
                if (ok) { xw = *(const u32x2*)(XC + (size_t)(m0 + l) * 1536 + head * 64 + pc); zw = *(const u32x2*)(U + (size_t)(m0 + l) * LDU + UC_Z + head * 64 + pc); }
                f32x4 y = acc[pb][lb];
                y[0] = (y[0] + dsk * bf_lo(xw.x)) * siluf_(bf_lo(zw.x)); y[1] = (y[1] + dsk * bf_hi(xw.x)) * siluf_(bf_hi(zw.x));
                y[2] = (y[2] + dsk * bf_lo(xw.y)) * siluf_(bf_lo(zw.y)); y[3] = (y[3] + dsk * bf_hi(xw.y)) * siluf_(bf_hi(zw.y));
                acc[pb][lb] = y; sq[lb] += (y[0] * y[0] + y[1] * y[1]) + (y[2] * y[2] + y[3] * y[3]); } }
#pragma unroll
        for (int lb = 0; lb < 4; ++lb) { float s = sq[lb]; s += shx(s, 16, F.lane); s += shx(s, 32, F.lane);
            if (q == 0) __hip_atomic_fetch_add(Rs + 16 * lb + fr, s, __ATOMIC_RELAXED, __HIP_MEMORY_SCOPE_WORKGROUP); }
        __syncthreads();
#pragma unroll
        for (int lb = 0; lb < 4; ++lb) { const int l = 16 * lb + fr;
            if (l < L) { const float rs = fast_rsqrt(Rs[l] * (1.0f / 512) + EPS);
#pragma unroll
                for (int pb = 0; pb < 4; ++pb) { const int pc = 16 * pb + 4 * q; const f32x4 gn = *(const f32x4*)(p.in(I_SN) + layer * 1024 + head * 64 + pc); const f32x4 y = acc[pb][lb];
                    u32x2 ow; ow.x = pk2(y[0] * rs * gn[0], y[1] * rs * gn[1]); ow.y = pk2(y[2] * rs * gn[2], y[3] * rs * gn[3]);
                    *(u32x2*)(U + (size_t)(m0 + l) * LDU + UC_OSSD + head * 64 + pc) = ow; } } }
        __syncthreads();
    }
}
#ifndef DUPMASK
#define DUPMASK 0
#endif
__device__ __forceinline__ void phase_attn(const Params&, const Frame& F0, int layer0) {
    const Frame F = mk_frame(F0.wave);
    const PV p = pv_get(); int layer = layer0; asm volatile("" : "+s"(layer));
    bf16_t* U = (bf16_t*)(p.ws() + WS_U); const bf16_t* QM = (const bf16_t*)(p.ws() + WS_QM); const bf16_t* KM = (const bf16_t*)(p.ws() + WS_KM);
    const bf16_t* VTM = (const bf16_t*)(p.ws() + WS_VTM); const bf16_t* KFS = (const bf16_t*)(p.ws() + WS_KFS); const bf16_t* VTF = (const bf16_t*)(p.ws() + WS_VTF);
    const float* CUM = (const float*)(p.ws() + WS_CUM);
    for (int it = F.vcu; it < 256; it += F.G) {
        const int h = it >> 5, pr = it & 31;
        AttnSeq a; a.Q = QM + h * 192; a.qs = 1536; a.K = KM + h * 192; a.ks = 1536; a.VT = VTM + (size_t)h * 128 * KVROWS; a.O = U + UC_OMLA + h * 128; a.os = LDU; a.cq = nullptr; a.ck = nullptr;
#pragma unroll 1
        for (int half = 0; half < 2; ++half) attn_prefill_unit<192, false>(F.lds, a, half ? pr : 63 - pr, F.tid);
    }
#if defined(DUPMASK)
    if ((DUPMASK >> 8) & 1) for (int it = F.vcu; it < 256; it += F.G) {
        const int h = it >> 5, pr = it & 31;
        AttnSeq a; a.Q = QM + h * 192; a.qs = 1536; a.K = KM + h * 192; a.ks = 1536; a.VT = VTM + (size_t)h * 128 * KVROWS; a.O = U + UC_OMLA + h * 128; a.os = LDU; a.cq = nullptr; a.ck = nullptr;
#pragma unroll 1
        for (int half = 0; half < 2; ++half) attn_prefill_unit<192, false>(F.lds, a, half ? pr : 63 - pr, F.tid);
    }
#endif
    for (int it = F.vcu; it < 256; it += F.G) {
        const int h = it >> 5, pr = it & 31;
        AttnSeq a; a.Q = U + UC_FQ + h * 128; a.qs = LDU; a.K = U + UC_FK + h * 128; a.ks = LDU; a.VT = VTF + (size_t)h * 128 * KVROWS; a.O = U + UC_OFOX + h * 128; a.os = LDU; a.cq = CUM + h; a.ck = CUM + h;
        const unsigned* ctl = (const unsigned*)(p.ws() + WS_CTL);
        float kn2; { float v = __uint_as_float(ctl[CW_KN2 + (layer * 64 + F.lane) * 8 + h]);
#pragma unroll
            for (int o = 1; o < 64; o <<= 1) v = fmaxf(v, shx(v, o, F.lane)); kn2 = v; }
#pragma unroll 1
        for (int half = 0; half < 2; ++half) { const int qb = half ? pr : 63 - pr;
            attn_prefill_unit<128, true>(F.lds, a, qb, F.tid, 2.02f * __builtin_amdgcn_sqrtf(__uint_as_float(ctl[CW_QN2 + (layer * 64 + qb) * 8 + h]) * kn2)); }
    }
#if defined(DUPMASK)
    if ((DUPMASK >> 9) & 1) for (int it = F.vcu; it < 256; it += F.G) {
        const int h = it >> 5, pr = it & 31;
        AttnSeq a; a.Q = U + UC_FQ + h * 128; a.qs = LDU; a.K = U + UC_FK + h * 128; a.ks = LDU; a.VT = VTF + (size_t)h * 128 * KVROWS; a.O = (bf16_t*)(p.ws() + WS_ST) + h * 128; a.os = 1024; a.cq = CUM + h; a.ck = CUM + h;
        const unsigned* ctl = (const unsigned*)(p.ws() + WS_CTL);
        float kn2; { float v = __uint_as_float(ctl[CW_KN2 + (layer * 64 + F.lane) * 8 + h]);
#pragma unroll
            for (int o = 1; o < 64; o <<= 1) v = fmaxf(v, shx(v, o, F.lane)); kn2 = v; }
#pragma unroll 1
        for (int half = 0; half < 2; ++half) { const int qb = half ? pr : 63 - pr;
            attn_prefill_unit<128, true>(F.lds, a, qb, F.tid, 2.02f * __builtin_amdgcn_sqrtf(__uint_as_float(ctl[CW_QN2 + (layer * 64 + qb) * 8 + h]) * kn2)); }
    }
#endif
    for (int it = F.vcu; it < 2 * NB * 8; it += F.G) {
        const int kind = it >> 7, s = (it & 127) >> 3, h = it & 7; const size_t q0 = (size_t)MP + 16 * s, k0 = (size_t)MP + (size_t)s * KVS;
        if (kind == 0) { AttnSeq a; a.Q = QM + q0 * 1536 + h * 192; a.qs = 1536; a.K = KM + k0 * 1536 + h * 192; a.ks = 1536; a.VT = VTM + (size_t)h * 128 * KVROWS + k0; a.O = U + q0 * LDU + UC_OMLA + h * 128; a.os = LDU; a.cq = nullptr; a.ck = nullptr;
          attn_decode_unit<192, false>(F.lds, a, F.tid); }
        else { AttnSeq a; a.Q = U + q0 * LDU + UC_FQ + h * 128; a.qs = LDU; a.K = KFS + (size_t)s * KVS * 1024 + h * 128; a.ks = 1024; a.VT = VTF + (size_t)h * 128 * KVROWS + k0; a.O = U + q0 * LDU + UC_OFOX + h * 128; a.os = LDU;
          a.cq = CUM + (k0 + PAST) * 8 + h; a.ck = CUM + k0 * 8 + h;
          attn_decode_unit<128, true>(F.lds, a, F.tid); }
    }
}

#define LAUNDER_P const PV p = pv_get()
#define LAUNDER_PL const PV p = pv_get(); int layer = layer0; asm volatile("" : "+s"(layer))
__device__ __forceinline__ void ph_gateup(const Params&, const Frame& F0, size_t woff) {
    const Frame F = mk_frame(F0.wave);
    LAUNDER_P; bf16_t* W = (bf16_t*)(p.ws() + WS_W); bf16_t* XN = (bf16_t*)(p.ws() + WS_XN); bf16_t* H = (bf16_t*)(p.ws() + WS_U);
    pg8::Gemm g{XN, W + woff, D, D, MT, 2 * FF, D}; pg8::StaticOrder S; S.init(MT, 2 * FF, F.G, F.bx, D); S.nrev = true;
    EpiSwiGLU E{H}; pg8::gemm_phase<EpiSwiGLU, pg8::StaticOrder, true, true>(F.lds, g, S, E, F.wave);
}
__device__ __forceinline__ void ph_down(const Params&, const Frame& F0, size_t woff, bool from_input, bool dummy = false) {
    const Frame F = mk_frame(F0.wave);
    LAUNDER_P; bf16_t* W = (bf16_t*)(p.ws() + WS_W); bf16_t* H = (bf16_t*)(p.ws() + WS_U);
    float* yp = p.out() + O_YP; float* ys = p.out() + O_YS;
    pg8::Gemm g{H, W + woff, FF, FF, MT, D, FF}; pg8::SplitOrder S; S.init(MT, D, F.G, F.bx, FF);
    EpiResid E{from_input ? p.in(I_XP) : yp, from_input ? p.in(I_XS) : ys, dummy ? (float*)(p.ws() + WS_ST) : yp, 0.5f, true, (float*)(p.ws() + WS_PART)}; pg8::gemm_phase<EpiResid, pg8::SplitOrder, true, true>(F.lds, g, S, E, F.wave);
}
__device__ __forceinline__ void ph_win(const Params&, const Frame& F0, int layer0) {
    const Frame F = mk_frame(F0.wave);
    LAUNDER_PL; bf16_t* W = (bf16_t*)(p.ws() + WS_W); bf16_t* XN = (bf16_t*)(p.ws() + WS_XN); bf16_t* U = (bf16_t*)(p.ws() + WS_U);
    pg8::Gemm g{XN, W + W_IN, D, D, MT, NWIN, D}; pg8::StaticOrder S; S.init(MT, NWIN, F.G, F.bx, D);
    EpiWin E{U, (float*)(p.ws() + WS_US), p.out() + O_PFK + (size_t)layer * MP * 1024, p.out() + O_SFK + (size_t)layer * MS * 1024,
             p.out() + O_PFV + (size_t)layer * MP * 1024, p.out() + O_SFV + (size_t)layer * MS * 1024};
    pg8::gemm_phase<EpiWin, pg8::StaticOrder, true, true>(F.lds, g, S, E, F.wave);
}
__device__ __forceinline__ void ph_uq(const Params&, const Frame& F0) {
    const Frame F = mk_frame(F0.wave);
    LAUNDER_P; bf16_t* W = (bf16_t*)(p.ws() + WS_W); bf16_t* U = (bf16_t*)(p.ws() + WS_U);
    pg8::Gemm g{U + UC_QLAT, W + W_UQ, LDU, 512, MT, 1536, 512}; pg8::StaticOrder S; S.init(MT, 1536, F.G, F.bx, 512);
    EpiUq E{(bf16_t*)(p.ws() + WS_QM), (const f32x2*)(p.ws() + WS_ROPE)}; pg8::gemm_phase<EpiUq, pg8::StaticOrder, true, true>(F.lds, g, S, E, F.wave);
}
__device__ __forceinline__ void ph_ukv(const Params&, const Frame& F0) {
    const Frame F = mk_frame(F0.wave);
    LAUNDER_P; bf16_t* W = (bf16_t*)(p.ws() + WS_W);
    pg8::Gemm g{(const bf16_t*)(p.ws() + WS_CKV), W + W_UKV, 512, 512, KVROWS, 2048, 512}; pg8::StaticOrder S; S.init(KVROWS, 2048, F.G, (F.G == 256) ? (F.bx + 120) % 256 : F.bx, 512);
    EpiUkv E{(bf16_t*)(p.ws() + WS_KM), (bf16_t*)(p.ws() + WS_VTM)}; pg8::gemm_phase<EpiUkv, pg8::StaticOrder, true, true>(F.lds, g, S, E, F.wave);
}
template <int BR> __device__ __forceinline__ void ph_merge(const Params&, const Frame& F0) {
    const Frame F = mk_frame(F0.wave);
    LAUNDER_P; bf16_t* W = (bf16_t*)(p.ws() + WS_W); bf16_t* U = (bf16_t*)(p.ws() + WS_U); bf16_t* XN = (bf16_t*)(p.ws() + WS_XN);
    constexpr int acol = BR == 0 ? UC_OMLA : (BR == 1 ? UC_OSSD : UC_OFOX);
    pg8::StaticOrder S; S.init(MP, D, F.G, F.bx, 1024, true);
    pg8::Gemm g{U + acol, W + W_BR + (size_t)BR * D * 1024, LDU, 1024, MP, D, 1024}; EpiMerge<BR> E{U, XN}; pg8::gemm_phase<EpiMerge<BR>, pg8::StaticOrder, true, true>(F.lds, g, S, E, F.wave);
}
__device__ __forceinline__ void ph_merge_sample(const Params&, const Frame& F0, int layer0) {
    const Frame F = mk_frame(F0.wave);
    LAUNDER_PL; bf16_t* W = (bf16_t*)(p.ws() + WS_W); bf16_t* U = (bf16_t*)(p.ws() + WS_U); bf16_t* XN = (bf16_t*)(p.ws() + WS_XN);
    pg8::SampleMergeOrder S; S.c = F.bx;
    pg8::Gemm g{U, W + W_BR, LDU, 1024, MT, 3 * D, 1024};
    EpiMergeSample E{U, XN, (float*)(p.ws() + WS_PART), (unsigned*)(p.ws() + WS_CTL) + CW_MGC + layer * 8 * 64, (LAS unsigned*)(F.lds + RING_BYTES)};
    pg8::gemm_phase<EpiMergeSample, pg8::SampleMergeOrder, true, true>(F.lds, g, S, E, F.wave);
}
__device__ __forceinline__ void ph_wout(const Params&, const Frame& F0, bool dummy = false) {
    const Frame F = mk_frame(F0.wave);
    LAUNDER_P; bf16_t* W = (bf16_t*)(p.ws() + WS_W); bf16_t* XN = (bf16_t*)(p.ws() + WS_XN); float* yp = p.out() + O_YP; float* ys = p.out() + O_YS;
    pg8::Gemm g{XN, W + W_OUT, D, D, MT, D, D}; pg8::SplitOrder S; S.init(MT, D, F.G, F.bx, D);
    EpiResid E{yp, ys, dummy ? (float*)(p.ws() + WS_ST) : yp, 1.0f, true, (float*)(p.ws() + WS_PART)}; pg8::gemm_phase<EpiResid, pg8::SplitOrder, true, true>(F.lds, g, S, E, F.wave);
}
__device__ __forceinline__ void ph_norm(const Params&, const Frame& F0, int layer0, int which, bool from_input) {
    const Frame F = mk_frame(F0.wave);
    LAUNDER_PL; float* yp = p.out() + O_YP; float* ys = p.out() + O_YS;
    phase_norm(F, from_input ? p.in(I_XP) : yp, from_input ? p.in(I_XS) : ys, p.in(which) + layer * D, (bf16_t*)(p.ws() + WS_XN), from_input ? ys : nullptr, from_input ? nullptr : (const float*)(p.ws() + WS_PART));
}

constexpr int PH_PER_LAYER = 15, N_PHASES = NL * PH_PER_LAYER + 1;
#ifndef N_LAUNCHES
#define N_LAUNCHES 1
#endif
#ifndef PHMASK
#define PHMASK 0xffff
#endif
#ifndef DUPMASK
#define DUPMASK 0
#endif
#define DUP(k) (((DUPMASK) >> (k)) & 1)

__global__ void __launch_bounds__(512, 2) hybrid_fwd(Params p) {
    extern __shared__ __attribute__((aligned(16))) unsigned char lds_raw[];
    const int wave_k = __builtin_amdgcn_readfirstlane((int)threadIdx.x >> 6);
    const Frame F = mk_frame(wave_k);
    volatile LAS unsigned* MISC = (volatile LAS unsigned*)(F.lds + MISC_OFF);
    for (int u = F.tid; u < (LDS_BYTES - LDSCTL_OFF) / 4; u += 512) ((LAS unsigned*)(F.lds + LDSCTL_OFF))[u] = 0u;
    __syncthreads();
    const PV pk = pv_get();
    unsigned* ctl = (unsigned*)(pk.ws() + WS_CTL);
    const int lo = pk.ph_lo(), hi = pk.ph_hi();
    XcdBarrier bar; bar.bar = ctl + CW_BAR; bar.x = 0; bar.st = nullptr;
    if (hi - lo > 1) bar = xcd_barrier_post(ctl + CW_BAR, MISC + 8, F.tid);
#define IN(k) ((((PHMASK) >> (((k) == NL * PH_PER_LAYER) ? 15 : ((k) % PH_PER_LAYER))) & 1) && lo <= (k) && (k) < hi)
#define SEAM(k) do { if (IN(k) && IN((k) + 1)) xcd_barrier(bar, wave_k); } while (0)
    if (IN(0)) phase_rope_table(F);
#pragma unroll 1
    for (int layer = 0; layer < NL; ++layer) {
        const int pb = layer * PH_PER_LAYER;
        if (IN(pb + 0)) { phase_convert(p, F, layer); if (DUP(0)) phase_convert(p, F, layer); }
        if (IN(pb + 1)) { ph_norm(p, F, layer, I_F1N, layer == 0); if (DUP(1)) ph_norm(p, F, layer, I_F1N, layer == 0); }
        SEAM(pb + 1);
        if (IN(pb + 2)) { ph_gateup(p, F, W_GU1); if (DUP(2)) ph_gateup(p, F, W_GU1); }
        SEAM(pb + 2);
        if (IN(pb + 3)) { if (DUP(3)) ph_down(p, F, W_D1, layer == 0, true); ph_down(p, F, W_D1, layer == 0); }
        SEAM(pb + 3);
        if (IN(pb + 4)) ph_norm(p, F, layer, I_MIXN, false);
        SEAM(pb + 4);
        if (IN(pb + 5)) { ph_win(p, F, layer); if (DUP(5)) ph_win(p, F, layer); }
        SEAM(pb + 5);
        if (IN(pb + 6)) phase_t1(p, F, layer);
        SEAM(pb + 6);
        if (IN(pb + 7)) { phase_t2(p, F); ph_uq(p, F); ph_ukv(p, F); phase_s1(p, F, layer); if (DUP(7)) { ph_uq(p, F); ph_ukv(p, F); } if (DUP(6)) phase_s1(p, F, layer); }
        SEAM(pb + 7);
        if (IN(pb + 8)) { phase_attn(p, F, layer); phase_s2(p, F, layer); }
        SEAM(pb + 8);
        if (IN(pb + 9)) phase_s3(p, F, layer);
        SEAM(pb + 9);
        if (IN(pb + 10)) { ph_merge_sample(p, F, layer); ph_merge<0>(p, F); ph_merge<1>(p, F); ph_merge<2>(p, F); }
        SEAM(pb + 10);
        if (IN(pb + 11)) { if (DUP(11)) ph_wout(p, F, true); ph_wout(p, F); }
        SEAM(pb + 11);
        if (IN(pb + 12)) ph_norm(p, F, layer, I_F2N, false);
        SEAM(pb + 12);
        if (IN(pb + 13)) ph_gateup(p, F, W_GU2);
        SEAM(pb + 13);
        if (IN(pb + 14)) ph_down(p, F, W_D2, false);
        SEAM(pb + 14);
    }
    if (IN(NL * PH_PER_LAYER)) { const PV q = pv_get(); const Frame F2 = mk_frame(wave_k); phase_final_norm(F2, q.out() + O_YP, q.in(I_FN), (const float*)(q.ws() + WS_PART)); }
#undef IN
#undef SEAM
}

extern "C" void kernel_launch(void* const* d_in, const int* in_sizes, int n_in, void* d_out, int out_size, void* d_ws, size_t ws_size, hipStream_t stream) {
    static int grid = 0;
    if (grid == 0) {
        if (n_in != N_IN || (size_t)out_size != O_TOTAL || ws_size < WS_END) { fprintf(stderr, "kernel_launch: unexpected shapes: n_in %d out %d ws %zu (need %zu)\n", n_in, out_size, ws_size, (size_t)WS_END); grid = -1; return; }
        int dev = 0, cus = 0, per_cu = 0;
        if (hipGetDevice(&dev) != hipSuccess || hipDeviceGetAttribute(&cus, hipDeviceAttributeMultiprocessorCount, dev) != hipSuccess) { grid = -1; return; }
        if (hipFuncSetAttribute((const void*)hybrid_fwd, hipFuncAttributeMaxDynamicSharedMemorySize, LDS_BYTES) != hipSuccess) { fprintf(stderr, "kernel_launch: hipFuncSetAttribute failed\n"); grid = -1; return; }
        if (hipOccupancyMaxActiveBlocksPerMultiprocessor(&per_cu, (const void*)hybrid_fwd, 512, LDS_BYTES) != hipSuccess || per_cu < 1) { fprintf(stderr, "kernel_launch: occupancy query says %d\n", per_cu); }
        (void)hipGetLastError();
        grid = cus;
    }
    if (grid < 0) return;
    (void)hipMemsetAsync((char*)d_ws + WS_CTL, 0, CTL_BYTES, stream);
    Params p{};
    for (int i = 0; i < N_IN; ++i) p.in[i] = (const float*)d_in[i];
    p.out = (float*)d_out; p.ws = (unsigned char*)d_ws;
#if defined(PROBE_K)
    p.ph_lo = 0; p.ph_hi = PROBE_K;
    hipLaunchKernelGGL(hybrid_fwd, dim3(grid), dim3(512), LDS_BYTES, stream, p);
    (void)hipMemsetAsync((char*)d_ws + WS_CTL, 0, CTL_BYTES, stream);
    p.ph_lo = 0; p.ph_hi = N_PHASES;
    hipLaunchKernelGGL(hybrid_fwd, dim3(grid), dim3(512), LDS_BYTES, stream, p);
#elif N_LAUNCHES == 1
    p.ph_lo = 0; p.ph_hi = N_PHASES;
    hipLaunchKernelGGL(hybrid_fwd, dim3(grid), dim3(512), LDS_BYTES, stream, p);
#else
    for (int k = 0; k < N_PHASES; ++k) { p.ph_lo = k; p.ph_hi = k + 1; hipLaunchKernelGGL(hybrid_fwd, dim3(grid), dim3(512), LDS_BYTES, stream, p); }
#endif
}
```

```cpp
#include <hip/hip_runtime.h>
#include <cstdio>
#include <cstdint>

#define LAS __attribute__((address_space(3)))
typedef unsigned short bf16_t;
typedef short bf16x8 __attribute__((ext_vector_type(8)));
typedef float f32x4 __attribute__((ext_vector_type(4)));
typedef float f32x2 __attribute__((ext_vector_type(2)));
typedef float f32x16 __attribute__((ext_vector_type(16)));
typedef unsigned u32x4 __attribute__((ext_vector_type(4)));
typedef unsigned u32x2 __attribute__((ext_vector_type(2)));
typedef __bf16 bf2_t __attribute__((ext_vector_type(2)));

constexpr int D = 2048, SEQ = 16384, NB = 16, NS = 16, PAST = 1024, FF = 5504, NL = 2;
constexpr int MP = SEQ, MS = NB * NS, MT = MP + MS;
constexpr int KVS = 1088, KVLEN_S = PAST + NS;
constexpr int KVROWS = MP + NB * KVS;
constexpr int LDU = 12800;
constexpr int IN_COLS = 12888, NWIN = 13056;
constexpr float LOG2E = 1.4426950408889634f;
constexpr float MLA_QSCALE = 0.07216878364870322f * LOG2E;
constexpr float FOX_QSCALE = 0.08838834764831845f * LOG2E;
constexpr float EPS = 1e-6f;
constexpr int UC_QLAT = 0, UC_CKV = 512, UC_Z = 1024, UC_XBC = 2048, UC_FQ = 3584, UC_FK = 4608, UC_FV = 5632, UC_GATE = 6656;
constexpr int UC_OMLA = 0, UC_OSSD = UC_Z, UC_OFOX = UC_FQ;
constexpr int US_KPE = 0, US_DT = 64, US_FF = 80, LDUS = 128;

enum { I_XP = 0, I_XS, I_CCKV, I_CKPE, I_CFK, I_CFV, I_CLOGF, I_SSM, I_CONV, I_F1N, I_F1G, I_F1U, I_F1D, I_MIXN, I_WIN, I_QN, I_WUQ, I_KVN, I_WUKV,
       I_CW, I_CB, I_DTB, I_ALOG, I_SD, I_SN, I_FBF, I_BRM, I_BRS, I_BRF, I_WOUT, I_F2N, I_F2G, I_F2U, I_F2D, I_FN, N_IN };
constexpr size_t O_YP = 0, O_YS = 33554432, O_PCKV = 34078720, O_PKPE = 50855936, O_PFK = 52953088, O_PFV = 86507520, O_PLOGF = 120061952,
                 O_PSSM = 120324096, O_PCONV = 120586240, O_SCKV = 120595456, O_SKPE = 120857600, O_SFK = 120890368, O_SFV = 121414656,
                 O_SLOGF = 121938944, O_SSSM = 121943040, O_SCONV = 126137344, O_TOTAL = 126284800;

constexpr size_t W_GU1 = 0, W_D1 = W_GU1 + (size_t)2 * FF * D, W_IN = W_D1 + (size_t)D * FF, W_UQ = W_IN + (size_t)NWIN * D, W_UKV = W_UQ + (size_t)1536 * 512,
                 W_BR = W_UKV + (size_t)2048 * 512, W_OUT = W_BR + (size_t)3 * 2048 * 1024, W_GU2 = W_OUT + (size_t)D * D, W_D2 = W_GU2 + (size_t)2 * FF * D,
                 W_TOTAL = W_D2 + (size_t)D * FF;

constexpr size_t MiB = 1u << 20;
constexpr size_t al(size_t x) { return (x + MiB - 1) / MiB * MiB; }
constexpr size_t WS_CTL = 0, CTL_BYTES = 1 * MiB;
constexpr size_t WS_ROPE = WS_CTL + CTL_BYTES;
constexpr size_t WS_W = WS_ROPE + al((size_t)SEQ * 32 * 8);
constexpr size_t WS_XN = WS_W + al(W_TOTAL * 2);
constexpr size_t WS_U = WS_XN + al((size_t)MT * D * 2);
constexpr size_t WS_US = WS_U + al((size_t)MT * LDU * 2);
constexpr size_t WS_DT = WS_US + al((size_t)MT * LDUS * 4);
constexpr size_t WS_QM = WS_DT + al((size_t)MT * 16 * 4);
constexpr size_t WS_CKV = WS_QM + al((size_t)MT * 1536 * 2);
constexpr size_t WS_KM = WS_CKV + al((size_t)KVROWS * 512 * 2);
constexpr size_t WS_VTM = WS_KM + al((size_t)KVROWS * 1536 * 2);
constexpr size_t WS_KFS = WS_VTM + al((size_t)1024 * KVROWS * 2);
constexpr size_t WS_VTF = WS_KFS + al((size_t)NB * KVS * 1024 * 2);
constexpr size_t WS_LOGF = WS_VTF + al((size_t)1024 * KVROWS * 2);
constexpr size_t WS_CUM = WS_LOGF + al((size_t)KVROWS * 8 * 4);
constexpr int NCHUNK = 256 + NB;
constexpr size_t WS_ST = WS_CUM + al((size_t)KVROWS * 8 * 4);
constexpr size_t WS_CDEC = WS_ST + al((size_t)NCHUNK * 131072 * 4);
constexpr size_t WS_PART = WS_CDEC + MiB;
constexpr size_t WS_END = WS_PART + al((size_t)8 * MS * D * 4);

constexpr int CW_TMO = 0, CW_BAR = 4096;
constexpr int CW_MGC = 12288;
constexpr int CW_QN2 = 8192, CW_KN2 = CW_QN2 + NL * 64 * 8;

constexpr int RING_BYTES = 131072, LDS_BYTES = 163840, LDSCTL_OFF = LDS_BYTES - 512, MISC_OFF = LDSCTL_OFF + 320;

struct Params {
    const float* in[N_IN];
    float* out;
    unsigned char* ws;
    int ph_lo, ph_hi;
};

typedef const __attribute__((address_space(4))) unsigned char* KA;
struct PV { KA k;
    __device__ __forceinline__ const float* in(int i) const { return *(const float* const __attribute__((address_space(4)))*)(k + 8 * i); }
    __device__ __forceinline__ float* out() const { return *(float* const __attribute__((address_space(4)))*)(k + 8 * N_IN); }
    __device__ __forceinline__ unsigned char* ws() const { return *(unsigned char* const __attribute__((address_space(4)))*)(k + 8 * N_IN + 8); }
    __device__ __forceinline__ int ph_lo() const { return *(const __attribute__((address_space(4))) int*)(k + 8 * N_IN + 16); }
    __device__ __forceinline__ int ph_hi() const { return *(const __attribute__((address_space(4))) int*)(k + 8 * N_IN + 20); }
};
__device__ __forceinline__ PV pv_get() { PV v; v.k = (KA)__builtin_amdgcn_kernarg_segment_ptr(); asm volatile("" : "+s"(v.k)); return v; }
static_assert(sizeof(Params) == 8 * N_IN + 24, "Params layout");

#define LDS_WAIT() asm volatile("s_waitcnt lgkmcnt(0)" ::: "memory")
#define VM_WAIT() asm volatile("s_waitcnt vmcnt(0)" ::: "memory")
__device__ __forceinline__ unsigned pk2(float lo, float hi) { bf2_t v = {(__bf16)lo, (__bf16)hi}; return __builtin_bit_cast(unsigned, v); }
__device__ __forceinline__ float bf_lo(unsigned w) { return __uint_as_float(w << 16); }
__device__ __forceinline__ float bf_hi(unsigned w) { return __uint_as_float(w & 0xffff0000u); }
__device__ __forceinline__ float bf2f(bf16_t b) { return __uint_as_float((unsigned)b << 16); }
__device__ __forceinline__ bf16_t f2bf(float f) { return (bf16_t)(pk2(f, 0.f) & 0xffffu); }
__device__ __forceinline__ float shx(float v, int o, int lane) { return __int_as_float(__builtin_amdgcn_ds_bpermute((lane ^ o) << 2, __float_as_int(v))); }
__device__ __forceinline__ float wave_sum(float v, int lane) {
#pragma unroll
    for (int o = 1; o < 64; o <<= 1) v += shx(v, o, lane);
    return v;
}
__device__ __forceinline__ float fast_exp2(float x) { return __builtin_amdgcn_exp2f(x); }
__device__ __forceinline__ float fast_exp(float x) { return __builtin_amdgcn_exp2f(x * LOG2E); }
__device__ __forceinline__ float fast_rsqrt(float x) { return __builtin_amdgcn_rsqf(x); }
__device__ __forceinline__ float fast_log(float x) { return __builtin_amdgcn_logf(x) * 0.6931471805599453f; }
__device__ __forceinline__ float sigmoidf_(float x) { return __builtin_amdgcn_rcpf(1.f + fast_exp2(-x * LOG2E)); }
__device__ __forceinline__ float siluf_(float x) { return x * sigmoidf_(x); }
__device__ __forceinline__ int kvrow_of(int m) { return m < MP ? m : MP + ((m - MP) >> 4) * KVS + PAST + ((m - MP) & 15); }
__device__ __forceinline__ int pos_of(int m) { return m < MP ? m : PAST + ((m - MP) & 15); }

#define XB_TMO      128
#define XB_XCNT(j)  (256  + 64 * (j))
#define XB_XSUB(j)  (1280 + 64 * (j))
#define XB_XGEN(j)  (2304 + 64 * (j))
#define XB_TOP      3328
#define XB_TOPGEN   3392
#define XCD_BAR_WORDS 3456
#define XB_SPIN_CAP (1u << 22)
__device__ __forceinline__ unsigned xb_ld(unsigned* p)              { return __hip_atomic_load(p, __ATOMIC_RELAXED, __HIP_MEMORY_SCOPE_AGENT); }
__device__ __forceinline__ unsigned xb_add(unsigned* p, unsigned v) { return __hip_atomic_fetch_add(p, v, __ATOMIC_RELAXED, __HIP_MEMORY_SCOPE_AGENT); }
__device__ __forceinline__ unsigned xb_xcc_id() { return (unsigned)__builtin_amdgcn_s_getreg((3 << 11) | 20) & 0xFu; }
#define XB_SPIN(cond, bar) do { unsigned _sp = 0; while (cond) { __builtin_amdgcn_s_sleep(1); \
    if ((++_sp & 255u) == 0u) { if (xb_ld(&(bar)[XB_TMO])) break; if (_sp > XB_SPIN_CAP) { atomicAdd(&(bar)[XB_TMO], 1u); break; } } } } while (0)
struct XcdBarrier { unsigned* bar; unsigned x; volatile LAS unsigned* st; };
__device__ __forceinline__ XcdBarrier xcd_barrier_post(unsigned* bar, volatile LAS unsigned* st, int tid) {
    XcdBarrier b; b.bar = bar; b.x = xb_xcc_id(); b.st = st;
    if (tid == 0) (void)xb_add(&bar[XB_XCNT(b.x)], 1u);
    return b;
}
__device__ __forceinline__ void xcd_barrier_complete(unsigned* bar, unsigned x, unsigned& nloc, unsigned& nx) {
    const unsigned G = gridDim.x * gridDim.y * gridDim.z;
    unsigned sum, cnt, mine, sp = 0u;
    for (;;) {
        sum = 0u; cnt = 0u; mine = 0u;
#pragma unroll
        for (unsigned j = 0; j < 16; ++j) { const unsigned c = xb_ld(&bar[XB_XCNT(j)]); sum += c; cnt += (c > 0u) ? 1u : 0u; mine = (j == x) ? c : mine; }
        if (sum == G) break;
        __builtin_amdgcn_s_sleep(1);
        if ((++sp & 255u) == 0u) { if (xb_ld(&bar[XB_TMO])) break; if (sp > XB_SPIN_CAP) { atomicAdd(&bar[XB_TMO], 1u); break; } }
    }
    nloc = mine > 0u ? mine : 1u; nx = cnt > 0u ? cnt : 1u;
}
__device__ __forceinline__ void xcd_barrier(const XcdBarrier& b, int wave_s) {
    asm volatile("s_waitcnt vmcnt(0)" ::: "memory");
    __syncthreads();
    int tid_b; { unsigned z_ = 0u; asm volatile("" : "+s"(z_)); tid_b = wave_s * 64 + (int)__builtin_amdgcn_mbcnt_hi(~0u, __builtin_amdgcn_mbcnt_lo(~0u, z_)); }
    if (tid_b == 0) {
        unsigned* bar = b.bar; asm volatile("" : "+s"(bar));
        __builtin_amdgcn_s_waitcnt(0);
        unsigned nloc = b.st[0], nx = b.st[1];
        if (nloc == 0u) { xcd_barrier_complete(bar, b.x, nloc, nx); b.st[0] = nloc; b.st[1] = nx; }
        const unsigned old = xb_add(&bar[XB_XSUB(b.x)], 1u);
        const unsigned gen = old / nloc;
        if (old + 1u == (gen + 1u) * nloc) {
            __builtin_amdgcn_fence(__ATOMIC_RELEASE, "agent");
            asm volatile("s_waitcnt vmcnt(0)" ::: "memory");
            const unsigned og = xb_add(&bar[XB_TOP], 1u);
            const unsigned tg = og / nx;
            if (og + 1u == (tg + 1u) * nx) xb_add(&bar[XB_TOPGEN], 1u);
            else XB_SPIN(xb_ld(&bar[XB_TOPGEN]) == tg, bar);
            __builtin_amdgcn_fence(__ATOMIC_ACQUIRE, "agent");
            xb_add(&bar[XB_XGEN(b.x)], 1u);
            asm volatile("s_waitcnt vmcnt(0)" ::: "memory");
        } else {
            XB_SPIN(xb_ld(&bar[XB_XGEN(b.x)]) == gen, bar);
            __builtin_amdgcn_fence(__ATOMIC_ACQUIRE, "agent");
            asm volatile("s_waitcnt vmcnt(0)" ::: "memory");
        }
    }
    __syncthreads();
}

namespace pg8 {
constexpr int BM = 256, BK = 64, HALF = 128, HTB = HALF * BK * 2, STAGE_BYTES = 8 * HTB, NXCD = 8, WGM = 8;
__host__ __device__ __forceinline__ int lds_byte(int r, int c) { const int st = (r >> 4) * 2 + (c >> 5), rr = r & 15, cc = c & 31, ob = rr * 64 + cc * 2; return st * 1024 + (ob ^ (((ob >> 9) & 1) << 5)); }
__host__ __device__ __forceinline__ void stage_rc(int b, int& R, int& C) { const int st = b / 1024, sb = b % 1024, swz = sb ^ (((sb >> 9) & 1) << 5); R = (st >> 1) * 16 + swz / 64; C = (st & 1) * 32 + (swz % 64) / 2; }
__host__ __device__ __forceinline__ int perm32(int rho) { const int n = rho >> 4, i = rho & 15; return 8 * (i >> 2) + 4 * n + (i & 3); }
struct Unit { int pm, pn, k0, nt, sp; };
struct Gemm { const bf16_t* A; const bf16_t* Bt; int lda, ldb, M, N, K; size_t ksA = 128, ksB = 128; };
struct StaticOrder {
    int nM, nN, nwg, G, c, ntK; bool nfast; bool nrev = false;
    __host__ __device__ __forceinline__ void init(int M, int N, int G_, int c_, int K_ = 0, bool nfast_ = false) { nM = M / BM; nN = N / BM; nwg = nM * nN; G = G_; c = c_; ntK = K_ / BK; nfast = nfast_; }
    __host__ __device__ __forceinline__ bool next(int i, Unit& u) const {
        const long L = (long)i * G + c; if (L >= nwg) return false;
        int wgid = (int)L; { const int q = nwg / NXCD, r = nwg % NXCD, xcd = wgid % NXCD, off = wgid / NXCD; wgid = (xcd < r ? xcd * (q + 1) : r * (q + 1) + (xcd - r) * q) + off; }
        const int nig = WGM * nN, gid = wgid / nig, fm = gid * WGM, gsz = (nM - fm) < WGM ? (nM - fm) : WGM;
        const int ig = wgid % nig;
        u.pm = nfast ? fm + ig / nN : fm + (ig % gsz); u.pn = nfast ? ig % nN : ig / gsz; if (nrev) u.pn = nN - 1 - u.pn; u.k0 = 0; u.nt = ntK; u.sp = 0; return true;
    }
    __device__ __forceinline__ void a_ready(const Unit&) const {}
    __device__ __forceinline__ void done(const Unit&) const {}
    __device__ __forceinline__ size_t a_extra(const Unit&) const { return 0; }
};
struct SplitOrder : StaticOrder {
    __host__ __device__ __forceinline__ void init(int M, int N, int G_, int c_, int K_) { StaticOrder::init(M - BM, N, G_, c_, K_, true); }
    __host__ __device__ __forceinline__ bool next(int i, Unit& u) const {
        const long L = (long)i * G + c;
        const bool reg = L < nwg; const int idx = (int)(L - nwg);
        const int ns = 8;
        if (!reg && idx >= nN * ns) return false;
        Unit a; a.pm = 0; a.pn = 0; a.k0 = 0; a.nt = ntK; a.sp = 0;
        if (reg) { Unit t; StaticOrder::next(i, t); a.pm = t.pm; a.pn = t.pn; }
        const int sp = idx / nN;
        const int base = (ntK / ns) & ~1, extra = (ntK - ns * base) / 2;
        const int s_nt = base + (sp < extra ? 2 : 0), s_k0 = base * sp + 2 * (sp < extra ? sp : extra);
        u.pm = reg ? a.pm : nM; u.pn = reg ? a.pn : idx % nN; u.k0 = reg ? 0 : s_k0; u.nt = reg ? ntK : s_nt; u.sp = reg ? 0 : sp;
        return true;
    }
};
struct SampleMergeOrder {
    int c;
    __host__ __device__ __forceinline__ bool next(int i, Unit& u) const {
        if (i != 0 || c >= 24) return false;
        u.pm = MP / BM; u.pn = c; u.k0 = 0; u.nt = 16; u.sp = 0; return true;
    }
    __device__ __forceinline__ void a_ready(const Unit&) const {}
    __device__ __forceinline__ void done(const Unit&) const {}
    __device__ __forceinline__ size_t a_extra(const Unit& u) const { const int br = u.pn >> 3; return (size_t)(br == 0 ? UC_OMLA : (br == 1 ? UC_OSSD : UC_OFOX)) * 2; }
};
template <class Epi, class Sched, bool ALIGN_EPI = false, bool SP2 = false>
__device__ __forceinline__ void gemm_phase(LAS unsigned char* lds, const Gemm g, const Sched& S, const Epi& E, int wave_s) {
    int tid_; { unsigned z_ = 0u; asm volatile("" : "+s"(z_)); tid_ = wave_s * 64 + (int)__builtin_amdgcn_mbcnt_hi(~0u, __builtin_amdgcn_mbcnt_lo(~0u, z_)); }
    const int tid = tid_, wid = __builtin_amdgcn_readfirstlane(tid >> 6), lane = tid & 63, wr = wid >> 2, wc = wid & 3, fr = lane & 15, fq = lane >> 4;
    unsigned voffA[2], voffB[2];
#pragma unroll
    for (int i = 0; i < 2; ++i) { int R, C; stage_rc(tid * 16 + i * 8192, R, C); const int Rb = Epi::PERM ? ((R & ~31) + perm32(R & 31)) : R;
        voffA[i] = (unsigned)(R * g.lda + C) * 2u; voffB[i] = (unsigned)(Rb * g.ldb + C) * 2u; }
    const size_t kstepA = g.ksA, kstepB = g.ksB;
    const size_t hstepA = (size_t)HALF * g.lda * 2, hstepB = (size_t)HALF * g.ldb * 2;
    const size_t tstepA = 2 * hstepA, tstepB = 2 * hstepB;
    const unsigned ldsw = (unsigned)wid * 1024u;
    const int aoff = lds_byte(wr * 64 + fr, fq * 8), boff = lds_byte(wc * 32 + fr, fq * 8);
#define PG8_SA(b, h) (((b) * 2 + (h)) * HTB)
#define PG8_SB(b, h) ((4 + (b) * 2 + (h)) * HTB)
#define PG8_STAGE(bufoff, gbase, voff) do { _Pragma("unroll") for (int _i = 0; _i < 2; ++_i) \
        __builtin_amdgcn_global_load_lds((const unsigned*)((const char*)(gbase) + (voff)[_i]), (LAS unsigned*)(lds + (bufoff) + ldsw + _i * 8192), 16, 0, 0); } while (0)
#define PG8_LDA(dst, b, h) do { _Pragma("unroll") for (int m = 0; m < 4; ++m) _Pragma("unroll") for (int k = 0; k < 2; ++k) dst[m][k] = *(const LAS bf16x8*)(lds + PG8_SA(b, h) + aoff + m * 2048 + k * 1024); } while (0)
#define PG8_LDB(dst, b, h) do { _Pragma("unroll") for (int n = 0; n < 2; ++n) _Pragma("unroll") for (int k = 0; k < 2; ++k) dst[n][k] = *(const LAS bf16x8*)(lds + PG8_SB(b, h) + boff + n * 2048 + k * 1024); } while (0)
#define PG8_MMA(ai, bj, At, Bt) do { __builtin_amdgcn_s_setprio(1); _Pragma("unroll") for (int m = 0; m < 4; ++m) _Pragma("unroll") for (int n = 0; n < 2; ++n) _Pragma("unroll") for (int k = 0; k < 2; ++k) \
        acc[ai][bj][m][n] = __builtin_amdgcn_mfma_f32_16x16x32_bf16(Bt[n][k], At[m][k], acc[ai][bj][m][n], 0, 0, 0); __builtin_amdgcn_s_setprio(0); } while (0)
#define PG8_WAIT_V(n) asm volatile("s_waitcnt vmcnt(" #n ")" ::: "memory")
#define PG8_WAIT_L(n) asm volatile("s_waitcnt lgkmcnt(" #n ")" ::: "memory")
#define PG8_BAR __builtin_amdgcn_s_barrier()
#define PG8_SCHED __builtin_amdgcn_sched_barrier(0)
    Unit cur, nxt; int ui = 0;
    if (!S.next(0, cur)) return;
    float zf_ = 0.f; asm volatile("" : "+v"(zf_));
    const f32x4 zero4 = {zf_, zf_, zf_, zf_};
    f32x4 acc[2][2][4][2];
#pragma unroll
    for (int a = 0; a < 2; ++a)
#pragma unroll
        for (int b = 0; b < 2; ++b)
#pragma unroll
            for (int m = 0; m < 4; ++m)
#pragma unroll
                for (int n = 0; n < 2; ++n) acc[a][b][m][n] = zero4;
    bf16x8 At[4][2], B0[2][2], B1[2][2];
    const char* cA = (const char*)g.A + (size_t)cur.pm * tstepA + (size_t)cur.k0 * kstepA + S.a_extra(cur); const char* cB = (const char*)g.Bt + (size_t)cur.pn * tstepB + (size_t)cur.k0 * kstepB;
    S.a_ready(cur);
    if constexpr (SP2) {
        PG8_STAGE(PG8_SB(0, 0), cB, voffB); PG8_STAGE(PG8_SB(0, 1), cB + hstepB, voffB); PG8_STAGE(PG8_SA(0, 0), cA, voffA); PG8_STAGE(PG8_SA(0, 1), cA + hstepA, voffA);
        if (wr == 1) PG8_BAR;
        PG8_WAIT_V(2); PG8_BAR;
        PG8_STAGE(PG8_SB(1, 0), cB + kstepB, voffB); PG8_STAGE(PG8_SA(1, 0), cA + kstepA, voffA); PG8_STAGE(PG8_SB(1, 1), cB + hstepB + kstepB, voffB);
        PG8_WAIT_V(6); PG8_BAR;
    } else {
        PG8_STAGE(PG8_SB(0, 0), cB, voffB); PG8_STAGE(PG8_SA(0, 0), cA, voffA); PG8_STAGE(PG8_SB(0, 1), cB + hstepB, voffB); PG8_STAGE(PG8_SA(0, 1), cA + hstepA, voffA);
        if (wr == 1) PG8_BAR;
        PG8_WAIT_V(4); PG8_BAR;
        PG8_STAGE(PG8_SB(1, 0), cB + kstepB, voffB); PG8_STAGE(PG8_SA(1, 0), cA + kstepA, voffA); PG8_STAGE(PG8_SB(1, 1), cB + hstepB + kstepB, voffB);
        PG8_WAIT_V(6); PG8_BAR;
    }
    for (;;) {
        const bool has_next = S.next(ui + 1, nxt);
        const char* nA = has_next ? (const char*)g.A + (size_t)nxt.pm * tstepA + (size_t)nxt.k0 * kstepA + S.a_extra(nxt) : cA; const char* nB = has_next ? (const char*)g.Bt + (size_t)nxt.pn * tstepB + (size_t)nxt.k0 * kstepB : cB;
        const int nt = cur.nt;
        for (int t = 0; t < nt; t += 2) {
            const bool last = (t == nt - 2);
            const char* a1 = cA + (size_t)(t + 1) * kstepA;
            const char* a2 = last ? nA : cA + (size_t)(t + 2) * kstepA; const char* b2 = last ? nB : cB + (size_t)(t + 2) * kstepB;
            const char* a3 = a2 + kstepA; const char* b3 = b2 + kstepB;
            if (last && has_next) S.a_ready(nxt);
            if constexpr (SP2) {
            PG8_LDB(B0, 0, 0); PG8_LDB(B1, 0, 1); PG8_SCHED; PG8_LDA(At, 0, 0); PG8_STAGE(PG8_SA(1, 1), a1 + hstepA, voffA);
            PG8_WAIT_V(8); PG8_WAIT_L(0); PG8_BAR; PG8_MMA(0, 0, At, B0); PG8_MMA(0, 1, At, B1); PG8_BAR; PG8_SCHED;
            PG8_LDA(At, 0, 1); PG8_STAGE(PG8_SB(0, 0), b2, voffB); PG8_STAGE(PG8_SB(0, 1), b2 + hstepB, voffB); PG8_STAGE(PG8_SA(0, 0), a2, voffA);
            PG8_WAIT_V(8); PG8_WAIT_L(0); PG8_BAR; PG8_MMA(1, 0, At, B0); PG8_MMA(1, 1, At, B1); PG8_BAR; PG8_SCHED;
            PG8_LDB(B0, 1, 0); PG8_LDB(B1, 1, 1); PG8_SCHED; PG8_LDA(At, 1, 0); PG8_STAGE(PG8_SA(0, 1), a2 + hstepA, voffA);
            PG8_WAIT_V(8); PG8_WAIT_L(0); PG8_BAR; PG8_MMA(0, 0, At, B0); PG8_MMA(0, 1, At, B1); PG8_BAR; PG8_SCHED;
            PG8_LDA(At, 1, 1); PG8_STAGE(PG8_SB(1, 0), b3, voffB); PG8_STAGE(PG8_SB(1, 1), b3 + hstepB, voffB); PG8_STAGE(PG8_SA(1, 0), a3, voffA);
            PG8_WAIT_V(8); PG8_WAIT_L(0); PG8_BAR; PG8_MMA(1, 0, At, B0); PG8_MMA(1, 1, At, B1); PG8_BAR; PG8_SCHED;
            } else {
            PG8_LDB(B0, 0, 0); PG8_SCHED; PG8_LDA(At, 0, 0); PG8_STAGE(PG8_SA(1, 1), a1 + hstepA, voffA);
            PG8_WAIT_L(8); PG8_BAR; PG8_WAIT_L(0); PG8_MMA(0, 0, At, B0); PG8_BAR; PG8_SCHED;
            PG8_LDB(B1, 0, 1); PG8_STAGE(PG8_SB(0, 0), b2, voffB);
            PG8_BAR; PG8_WAIT_L(0); PG8_MMA(0, 1, At, B1); PG8_BAR;
            PG8_LDA(At, 0, 1); PG8_STAGE(PG8_SA(0, 0), a2, voffA);
            PG8_BAR; PG8_WAIT_L(0); PG8_MMA(1, 0, At, B0); PG8_BAR; PG8_SCHED;
            PG8_STAGE(PG8_SB(0, 1), b2 + hstepB, voffB);
            PG8_WAIT_V(6); PG8_BAR; PG8_MMA(1, 1, At, B1); PG8_BAR;
            PG8_LDB(B0, 1, 0); PG8_SCHED; PG8_LDA(At, 1, 0); PG8_STAGE(PG8_SA(0, 1), a2 + hstepA, voffA);
            PG8_WAIT_L(8); PG8_BAR; PG8_WAIT_L(0); PG8_MMA(0, 0, At, B0); PG8_BAR; PG8_SCHED;
            PG8_LDB(B1, 1, 1); PG8_STAGE(PG8_SB(1, 0), b3, voffB);
            PG8_BAR; PG8_WAIT_L(0); PG8_MMA(0, 1, At, B1); PG8_BAR;
            PG8_LDA(At, 1, 1); PG8_STAGE(PG8_SA(1, 0), a3, voffA);
            PG8_BAR; PG8_WAIT_L(0); PG8_MMA(1, 0, At, B0); PG8_BAR; PG8_SCHED;
            PG8_STAGE(PG8_SB(1, 1), b3 + hstepB, voffB);
            PG8_WAIT_V(6); PG8_BAR; PG8_MMA(1, 1, At, B1); PG8_BAR;
            }
        }
        if constexpr (ALIGN_EPI) { if (wr == 0) PG8_BAR; }
        E(acc, cur, wr, wc, fr, fq); S.done(cur);
        if (!has_next) break;
#pragma unroll
        for (int a = 0; a < 2; ++a)
#pragma unroll
            for (int b = 0; b < 2; ++b)
#pragma unroll
                for (int m = 0; m < 4; ++m)
#pragma unroll
                    for (int n = 0; n < 2; ++n) acc[a][b][m][n] = zero4;
        cur = nxt; cA = nA; cB = nB; ++ui;
        if constexpr (ALIGN_EPI) { if (wr == 1) PG8_BAR; }
    }
    PG8_WAIT_V(0);
    if constexpr (!ALIGN_EPI) { if (wr == 0) PG8_BAR; }
    PG8_BAR;
#undef PG8_SA
#undef PG8_SB
#undef PG8_STAGE
#undef PG8_LDA
#undef PG8_LDB
#undef PG8_MMA
#undef PG8_WAIT_V
#undef PG8_WAIT_L
#undef PG8_BAR
#undef PG8_SCHED
}
}
using pg8::Unit;
typedef const f32x4 (&AccRef)[2][2][4][2];

struct EpiSwiGLU {
    static constexpr bool PERM = true;
    bf16_t* H;
    __device__ __forceinline__ void operator()(AccRef acc, const Unit& u, int wr, int wc, int fr, int fq) const {
        const int row0 = u.pm * 256 + wr * 64 + fr, col0 = u.pn * 128 + wc * 32 + 8 * fq;
#pragma unroll
        for (int ai = 0; ai < 2; ++ai)
#pragma unroll
            for (int m = 0; m < 4; ++m) {
                const f32x4 g0 = acc[ai][0][m][0], g1 = acc[ai][0][m][1], u0 = acc[ai][1][m][0], u1 = acc[ai][1][m][1];
                u32x4 w;
                w.x = pk2(siluf_(g0[0]) * u0[0], siluf_(g0[1]) * u0[1]); w.y = pk2(siluf_(g0[2]) * u0[2], siluf_(g0[3]) * u0[3]);
                w.z = pk2(siluf_(g1[0]) * u1[0], siluf_(g1[1]) * u1[1]); w.w = pk2(siluf_(g1[2]) * u1[2], siluf_(g1[3]) * u1[3]);
                *(u32x4*)(H + (size_t)(col0 >> 6) * ((size_t)MT * 64) + (size_t)(row0 + ai * 128 + m * 16) * 64 + (col0 & 63)) = w;
            }
    }
};
struct EpiResid {
    static constexpr bool PERM = false;
    const float* xin_p; const float* xin_s; float* xout; float alpha; bool split; float* part;
    __device__ __forceinline__ void operator()(AccRef acc, const Unit& u, int wr, int wc, int fr, int fq) const {
        const int row0 = u.pm * 256 + wr * 64 + fr, col0 = u.pn * 256 + wc * 32 + 4 * fq;
        if (split && u.pm * 256 >= MP) {
            float* pb_ = part + ((size_t)u.sp * MS - MP) * D;
#pragma unroll
            for (int ai = 0; ai < 2; ++ai)
#pragma unroll
                for (int m = 0; m < 4; ++m) { float* o = pb_ + (size_t)(row0 + ai * 128 + m * 16) * D + col0;
#pragma unroll
                    for (int bj = 0; bj < 2; ++bj)
#pragma unroll
                        for (int n = 0; n < 2; ++n) *(f32x4*)(o + bj * 128 + n * 16) = acc[ai][bj][m][n] * alpha; }
            return;
        }
        const float* xin = (u.pm * 256 < MP) ? xin_p : xin_s - (size_t)MP * D;
#pragma unroll
        for (int ai = 0; ai < 2; ++ai) {
            f32x4 b[4][2][2];
#pragma unroll
            for (int m = 0; m < 4; ++m) { const size_t off = (size_t)(row0 + ai * 128 + m * 16) * D + col0;
#pragma unroll
                for (int bj = 0; bj < 2; ++bj)
#pragma unroll
                    for (int n = 0; n < 2; ++n) b[m][bj][n] = *(const f32x4*)(xin + off + bj * 128 + n * 16); }
#pragma unroll
            for (int m = 0; m < 4; ++m) { const size_t off = (size_t)(row0 + ai * 128 + m * 16) * D + col0;
#pragma unroll
                for (int bj = 0; bj < 2; ++bj)
#pragma unroll
                    for (int n = 0; n < 2; ++n) *(f32x4*)(xout + off + bj * 128 + n * 16) = b[m][bj][n] + acc[ai][bj][m][n] * alpha; }
        }
    }
};
struct EpiWin {
    static constexpr bool PERM = true;
    bf16_t* U; float* US; float* fk_p; float* fk_s; float* fv_p; float* fv_s;
    __device__ __forceinline__ void operator()(AccRef acc, const Unit& u, int wr, int wc, int fr, int fq) const {
        const int row0 = u.pm * 256 + wr * 64 + fr, cw = wc * 32 + 8 * fq;
        const int pn = u.pn;
        if (pn < 26) {
            float* fo = nullptr;
            if (pn >= 18) { const bool isv = pn >= 22; const int hc = (pn - (isv ? 22 : 18)) * 256;
                fo = (u.pm * 256 < MP) ? (isv ? fv_p : fk_p) : (isv ? fv_s : fk_s) - (size_t)MP * 1024; fo += hc; }
#pragma unroll
            for (int ai = 0; ai < 2; ++ai)
#pragma unroll
                for (int m = 0; m < 4; ++m) { const int row = row0 + ai * 128 + m * 16;
#pragma unroll
                    for (int bj = 0; bj < 2; ++bj) { const f32x4 v0 = acc[ai][bj][m][0], v1 = acc[ai][bj][m][1];
                        u32x4 w; w.x = pk2(v0[0], v0[1]); w.y = pk2(v0[2], v0[3]); w.z = pk2(v1[0], v1[1]); w.w = pk2(v1[2], v1[3]);
                        *(u32x4*)(U + (size_t)row * LDU + pn * 256 + bj * 128 + cw) = w;
                        if (fo) { float* o = fo + (size_t)row * 1024 + bj * 128 + cw; *(f32x4*)o = v0; *(f32x4*)(o + 4) = v1; } } }
        } else if (pn < 50) {
#pragma unroll
            for (int ai = 0; ai < 2; ++ai)
#pragma unroll
                for (int m = 0; m < 4; ++m) { const int row = row0 + ai * 128 + m * 16;
#pragma unroll
                    for (int bj = 0; bj < 2; ++bj) { const f32x4 v0 = acc[ai][bj][m][0], v1 = acc[ai][bj][m][1];
                        u32x4 w; w.x = pk2(sigmoidf_(v0[0]), sigmoidf_(v0[1])); w.y = pk2(sigmoidf_(v0[2]), sigmoidf_(v0[3]));
                        w.z = pk2(sigmoidf_(v1[0]), sigmoidf_(v1[1])); w.w = pk2(sigmoidf_(v1[2]), sigmoidf_(v1[3]));
                        *(u32x4*)(U + (size_t)row * LDU + pn * 256 + bj * 128 + cw) = w; } }
        } else {
#pragma unroll
            for (int ai = 0; ai < 2; ++ai)
#pragma unroll
                for (int m = 0; m < 4; ++m) { const int row = row0 + ai * 128 + m * 16;
                    float* o = US + (size_t)row * LDUS + cw; *(f32x4*)o = acc[ai][0][m][0]; *(f32x4*)(o + 4) = acc[ai][0][m][1]; }
        }
    }
};
struct EpiUq {
    static constexpr bool PERM = true;
    bf16_t* Q; const f32x2* rope;
    __device__ __forceinline__ void operator()(AccRef acc, const Unit& u, int wr, int wc, int fr, int fq) const {
        const int row0 = u.pm * 256 + wr * 64 + fr;
#pragma unroll
        for (int bj = 0; bj < 2; ++bj) {
            const int c0 = u.pn * 256 + bj * 128 + wc * 32 + 8 * fq, r = c0 % 192;
            const bool isrope = r >= 128; const int j0 = (r - 128) >> 1;
#pragma unroll
            for (int ai = 0; ai < 2; ++ai)
#pragma unroll
                for (int m = 0; m < 4; ++m) { const int row = row0 + ai * 128 + m * 16;
                    f32x4 v0 = acc[ai][bj][m][0], v1 = acc[ai][bj][m][1];
                    if (isrope) { const f32x2* cs = rope + (size_t)pos_of(row) * 32 + j0;
                        const f32x2 a = cs[0], b = cs[1], c = cs[2], d = cs[3];
                        const f32x4 t0 = v0, t1 = v1;
                        v0[0] = t0[0] * a.x - t0[1] * a.y; v0[1] = t0[1] * a.x + t0[0] * a.y; v0[2] = t0[2] * b.x - t0[3] * b.y; v0[3] = t0[3] * b.x + t0[2] * b.y;
                        v1[0] = t1[0] * c.x - t1[1] * c.y; v1[1] = t1[1] * c.x + t1[0] * c.y; v1[2] = t1[2] * d.x - t1[3] * d.y; v1[3] = t1[3] * d.x + t1[2] * d.y; }
                    u32x4 w; w.x = pk2(v0[0], v0[1]); w.y = pk2(v0[2], v0[3]); w.z = pk2(v1[0], v1[1]); w.w = pk2(v1[2], v1[3]);
                    *(u32x4*)(Q + (size_t)row * 1536 + c0) = w; }
        }
    }
};
struct EpiUkv {
    static constexpr bool PERM = true;
    bf16_t* KM; bf16_t* VT;
    __device__ __forceinline__ void operator()(AccRef acc, const Unit& u, int wr, int wc, int fr, int fq) const {
        const int row0 = u.pm * 256 + wr * 64 + fr, h = u.pn, d0 = wc * 32 + 8 * fq;
#pragma unroll
        for (int ai = 0; ai < 2; ++ai)
#pragma unroll
            for (int m = 0; m < 4; ++m) { const int row = row0 + ai * 128 + m * 16;
                { const f32x4 v0 = acc[ai][0][m][0], v1 = acc[ai][0][m][1];
                  u32x4 w; w.x = pk2(v0[0], v0[1]); w.y = pk2(v0[2], v0[3]); w.z = pk2(v1[0], v1[1]); w.w = pk2(v1[2], v1[3]);
                  *(u32x4*)(KM + ((size_t)row * 8 + h) * 192 + d0) = w; }
                { const f32x4 v0 = acc[ai][1][m][0], v1 = acc[ai][1][m][1];
                  bf16_t* vt = VT + (size_t)(h * 128 + d0) * KVROWS + row;
#pragma unroll
                  for (int j = 0; j < 4; ++j) { vt[(size_t)j * KVROWS] = f2bf(v0[j]); vt[(size_t)(j + 4) * KVROWS] = f2bf(v1[j]); } } }
    }
};
template <int BR> struct EpiMerge {
    static constexpr bool PERM = true;
    const bf16_t* U; bf16_t* MG;
    __device__ __forceinline__ void operator()(AccRef acc, const Unit& u, int wr, int wc, int fr, int fq) const {
        const int row0 = u.pm * 256 + wr * 64 + fr, colb = u.pn * 256 + wc * 32 + 8 * fq;
#pragma unroll
        for (int ai = 0; ai < 2; ++ai) {
            u32x4 gt[4][2], od[4][2];
#pragma unroll
            for (int m = 0; m < 4; ++m) { const int row = row0 + ai * 128 + m * 16;
#pragma unroll
                for (int bj = 0; bj < 2; ++bj) { gt[m][bj] = *(const u32x4*)(U + (size_t)row * LDU + UC_GATE + BR * D + colb + bj * 128);
                    if (BR > 0) od[m][bj] = *(const u32x4*)(MG + (size_t)row * D + colb + bj * 128); } }
#pragma unroll
            for (int m = 0; m < 4; ++m) { const int row = row0 + ai * 128 + m * 16;
#pragma unroll
                for (int bj = 0; bj < 2; ++bj) { const u32x4 g = gt[m][bj];
                    f32x4 v0 = acc[ai][bj][m][0], v1 = acc[ai][bj][m][1];
                    v0[0] *= bf_lo(g.x); v0[1] *= bf_hi(g.x); v0[2] *= bf_lo(g.y); v0[3] *= bf_hi(g.y);
                    v1[0] *= bf_lo(g.z); v1[1] *= bf_hi(g.z); v1[2] *= bf_lo(g.w); v1[3] *= bf_hi(g.w);
                    if (BR > 0) { const u32x4 o = od[m][bj];
                        v0[0] += bf_lo(o.x); v0[1] += bf_hi(o.x); v0[2] += bf_lo(o.y); v0[3] += bf_hi(o.y);
                        v1[0] += bf_lo(o.z); v1[1] += bf_hi(o.z); v1[2] += bf_lo(o.w); v1[3] += bf_hi(o.w); }
                    u32x4 w; w.x = pk2(v0[0], v0[1]); w.y = pk2(v0[2], v0[3]); w.z = pk2(v1[0], v1[1]); w.w = pk2(v1[2], v1[3]);
                    *(u32x4*)(MG + (size_t)row * D + colb + bj * 128) = w; } }
        }
    }
};

struct EpiMergeSample {
    static constexpr bool PERM = true;
    const bf16_t* U; bf16_t* MG; float* part; unsigned* cnt; LAS unsigned* flag;
    __device__ __forceinline__ void operator()(AccRef acc, const Unit& u, int wr, int wc, int fr, int fq) const {
        const int br = u.pn >> 3, pn8 = u.pn & 7;
        const int row0 = wr * 64 + fr, colb = pn8 * 256 + wc * 32 + 8 * fq;
        float* pb = part + (size_t)br * MS * D;
#pragma unroll
        for (int ai = 0; ai < 2; ++ai)
#pragma unroll
            for (int m = 0; m < 4; ++m) { const int row = row0 + ai * 128 + m * 16;
#pragma unroll
                for (int bj = 0; bj < 2; ++bj) { const u32x4 g = *(const u32x4*)(U + (size_t)(MP + row) * LDU + UC_GATE + br * D + colb + bj * 128);
                    f32x4 v0 = acc[ai][bj][m][0], v1 = acc[ai][bj][m][1];
                    v0[0] *= bf_lo(g.x); v0[1] *= bf_hi(g.x); v0[2] *= bf_lo(g.y); v0[3] *= bf_hi(g.y);
                    v1[0] *= bf_lo(g.z); v1[1] *= bf_hi(g.z); v1[2] *= bf_lo(g.w); v1[3] *= bf_hi(g.w);
                    unsigned long long* o = (unsigned long long*)(pb + (size_t)row * D + colb + bj * 128);
                    __hip_atomic_store(o + 0, ((unsigned long long)__float_as_uint(v0[1]) << 32) | __float_as_uint(v0[0]), __ATOMIC_RELAXED, __HIP_MEMORY_SCOPE_AGENT);
                    __hip_atomic_store(o + 1, ((unsigned long long)__float_as_uint(v0[3]) << 32) | __float_as_uint(v0[2]), __ATOMIC_RELAXED, __HIP_MEMORY_SCOPE_AGENT);
                    __hip_atomic_store(o + 2, ((unsigned long long)__float_as_uint(v1[1]) << 32) | __float_as_uint(v1[0]), __ATOMIC_RELAXED, __HIP_MEMORY_SCOPE_AGENT);
                    __hip_atomic_store(o + 3, ((unsigned long long)__float_as_uint(v1[3]) << 32) | __float_as_uint(v1[2]), __ATOMIC_RELAXED, __HIP_MEMORY_SCOPE_AGENT); } }
        asm volatile("s_waitcnt vmcnt(0)" ::: "memory");
        __builtin_amdgcn_s_barrier();
        const int t = (wr * 4 + wc) * 64 + fq * 16 + fr;
        if (t == 0) { const unsigned old = __hip_atomic_fetch_add(cnt + 64 * pn8, 1u, __ATOMIC_RELAXED, __HIP_MEMORY_SCOPE_AGENT); *flag = (old == 2u) ? 1u : 0u; }
        asm volatile("s_waitcnt vmcnt(0) lgkmcnt(0)" ::: "memory");
        __builtin_amdgcn_s_barrier();
        asm volatile("" ::: "memory");
        if (*flag != 0u) {
            __builtin_amdgcn_fence(__ATOMIC_ACQUIRE, "agent");
            asm volatile("s_waitcnt vmcnt(0)" ::: "memory");
#pragma unroll 2
            for (int k = 0; k < 16; ++k) { const int e = (k * 512 + t) * 8, r = e >> 8, c = e & 255;
                const float* src = part + (size_t)r * D + pn8 * 256 + c;
                f32x4 a = *(const f32x4*)src, b = *(const f32x4*)(src + 4);
                a = a + *(const f32x4*)(src + (size_t)MS * D) + *(const f32x4*)(src + (size_t)2 * MS * D);
                b = b + *(const f32x4*)(src + (size_t)MS * D + 4) + *(const f32x4*)(src + (size_t)2 * MS * D + 4);
                u32x4 w; w.x = pk2(a[0], a[1]); w.y = pk2(a[2], a[3]); w.z = pk2(b[0], b[1]); w.w = pk2(b[2], b[3]);
                *(u32x4*)(MG + (size_t)(MP + r) * D + pn8 * 256 + c) = w; }
        }
    }
};

struct Frame {
    LAS unsigned char* lds;
    int tid, lane, wave, vcu, G, bx;
    int gw, NGW;
};
__device__ __forceinline__ int lane_now() { unsigned z = 0u; asm volatile("" : "+s"(z)); return (int)__builtin_amdgcn_mbcnt_hi(~0u, __builtin_amdgcn_mbcnt_lo(~0u, z)); }
__device__ __forceinline__ Frame mk_frame(int wave_s) {
    extern __shared__ __attribute__((aligned(16))) unsigned char lds_raw[];
    Frame F; F.lds = (LAS unsigned char*)lds_raw;
    asm volatile("" : "+s"(wave_s)); const int t = wave_s * 64 + lane_now();
    int bx = blockIdx.x, G = gridDim.x; asm volatile("" : "+s"(bx), "+s"(G));
    F.tid = t; F.lane = t & 63; F.wave = __builtin_amdgcn_readfirstlane(t >> 6);
    F.G = G; F.bx = bx; F.vcu = (G % 8 == 0) ? (bx % 8) * (G / 8) + bx / 8 : bx;
    F.gw = F.vcu * 8 + F.wave; F.NGW = G * 8;
    return F;
}

template <int KIND> __device__ __forceinline__ int map_row(int n, float& sc) {
    sc = 1.f;
    if (KIND == 0) return n;
    if (KIND == 1) return 256 * (n >> 7) + (n & 127);
    if (KIND == 2) return 256 * (n >> 7) + 128 + (n & 127);
    if (KIND == 3) {
        if (n < 1024) return n;
        if (n < 1088) return 12800 + (n - 1024);
        if (n < 2112) return UC_Z + (n - 1088);
        if (n < 3648) return UC_XBC + (n - 2112);
        if (n < 3664) return 12864 + (n - 3648);
        if (n < 4688) { sc = FOX_QSCALE; return UC_FQ + (n - 3664); }
        if (n < 5712) return UC_FK + (n - 4688);
        if (n < 6736) return UC_FV + (n - 5712);
        if (n < 6744) return 12880 + (n - 6736);
        return UC_GATE + (n - 6744);
    }
    if (KIND == 4) {
        sc = MLA_QSCALE; const int h = n / 192, r = n % 192;
        if (r < 128) return n;
        const int rr = r - 128; return h * 192 + 128 + 2 * (rr & 31) + (rr >> 5);
    }
    return n;
}
template <int KIND>
__device__ __forceinline__ void cvt_item(const float* W, int N, bf16_t* WT, size_t ldo, size_t coloff, LAS float* scr, int item, int lane, size_t kblk = 0) {
    const int nblk = (N + 31) / 32, kb = item / nblk, nb = item % nblk, k0 = 64 * kb, n0 = 32 * nb;
    const int nn = n0 + (lane & 31); const bool ok = nn < N;
#pragma unroll
    for (int i = 0; i < 32; ++i) { const int kk = 2 * i + (lane >> 5); scr[kk * 33 + (lane & 31)] = ok ? W[(size_t)(k0 + kk) * N + nn] : 0.f; }
    LDS_WAIT(); asm volatile("" ::: "memory");
    const int c = lane & 7;
#pragma unroll
    for (int j = 0; j < 4; ++j) { const int n = (lane >> 3) + 8 * j;
        if (n0 + n < N) { float sc; const int dr = map_row<KIND>(n0 + n, sc); const LAS float* s = scr + (8 * c) * 33 + n;
            u32x4 o; o.x = pk2(s[0 * 33] * sc, s[1 * 33] * sc); o.y = pk2(s[2 * 33] * sc, s[3 * 33] * sc); o.z = pk2(s[4 * 33] * sc, s[5 * 33] * sc); o.w = pk2(s[6 * 33] * sc, s[7 * 33] * sc);
            *(u32x4*)(kblk ? WT + (size_t)kb * kblk + (size_t)dr * 64 + 8 * c : WT + (size_t)dr * ldo + coloff + k0 + 8 * c) = o; } }
    LDS_WAIT(); asm volatile("" ::: "memory");
}

__device__ __forceinline__ void phase_convert(const Params&, const Frame& F0, int layer0) {
    const Frame F = mk_frame(F0.wave);
    const PV p = pv_get(); int layer = layer0; asm volatile("" : "+s"(layer));
    LAS float* scr = (LAS float*)(F.lds + F.wave * 16384);
    unsigned z0_ = 0u; asm volatile("" : "+v"(z0_)); const u32x4 Z4 = {z0_, z0_, z0_, z0_};
    bf16_t* W = (bf16_t*)(p.ws() + WS_W);
    const size_t lFF = (size_t)layer * D * FF;
    constexpr int IT_FF = (D / 64) * (FF / 32), IT_DN = (FF / 64) * (D / 32), IT_IN = (D / 64) * ((IN_COLS + 31) / 32), IT_UQ = 8 * 48, IT_UKV = 8 * 64, IT_BR = 16 * 64, IT_OUT = 32 * 64;
    constexpr int IT_FV = NB * 16 * 32;
    constexpr int NITEMS = 6 * IT_FF + IT_IN + IT_UQ + IT_UKV + 3 * IT_BR + IT_OUT + IT_FV;
    static_assert(IT_FF == IT_DN, "items");
    for (int it = F.gw; it < NITEMS; it += F.NGW) {
        int r = it;
        if (r < IT_FF) { cvt_item<1>(p.in(I_F1G) + lFF, FF, W + W_GU1, D, 0, scr, r, F.lane); continue; } r -= IT_FF;
        if (r < IT_FF) { cvt_item<2>(p.in(I_F1U) + lFF, FF, W + W_GU1, D, 0, scr, r, F.lane); continue; } r -= IT_FF;
        if (r < IT_DN) { cvt_item<0>(p.in(I_F1D) + lFF, D, W + W_D1, FF, 0, scr, r, F.lane, (size_t)D * 64); continue; } r -= IT_DN;
        if (r < IT_FF) { cvt_item<1>(p.in(I_F2G) + lFF, FF, W + W_GU2, D, 0, scr, r, F.lane); continue; } r -= IT_FF;
        if (r < IT_FF) { cvt_item<2>(p.in(I_F2U) + lFF, FF, W + W_GU2, D, 0, scr, r, F.lane); continue; } r -= IT_FF;
        if (r < IT_DN) { cvt_item<0>(p.in(I_F2D) + lFF, D, W + W_D2, FF, 0, scr, r, F.lane, (size_t)D * 64); continue; } r -= IT_DN;
        if (r < IT_IN) { cvt_item<3>(p.in(I_WIN) + (size_t)layer * D * IN_COLS, IN_COLS, W + W_IN, D, 0, scr, r, F.lane); continue; } r -= IT_IN;
        if (r < IT_UQ) { cvt_item<4>(p.in(I_WUQ) + (size_t)layer * 512 * 1536, 1536, W + W_UQ, 512, 0, scr, r, F.lane); continue; } r -= IT_UQ;
        if (r < IT_UKV) { cvt_item<0>(p.in(I_WUKV) + (size_t)layer * 512 * 2048, 2048, W + W_UKV, 512, 0, scr, r, F.lane); continue; } r -= IT_UKV;
        if (r < IT_BR) { cvt_item<0>(p.in(I_BRM) + (size_t)layer * 1024 * D, D, W + W_BR, 1024, 0, scr, r, F.lane); continue; } r -= IT_BR;
        if (r < IT_BR) { cvt_item<0>(p.in(I_BRS) + (size_t)layer * 1024 * D, D, W + W_BR + (size_t)D * 1024, 1024, 0, scr, r, F.lane); continue; } r -= IT_BR;
        if (r < IT_BR) { cvt_item<0>(p.in(I_BRF) + (size_t)layer * 1024 * D, D, W + W_BR + (size_t)2 * D * 1024, 1024, 0, scr, r, F.lane); continue; } r -= IT_BR;
        if (r < IT_OUT) { cvt_item<0>(p.in(I_WOUT) + (size_t)layer * D * D, D, W + W_OUT, D, 0, scr, r, F.lane); continue; } r -= IT_OUT;
        { const int b = r / 512, ri = r % 512;
          cvt_item<0>(p.in(I_CFV) + ((size_t)layer * NB + b) * PAST * 1024, 1024, (bf16_t*)(p.ws() + WS_VTF), KVROWS, (size_t)MP + (size_t)b * KVS, scr, ri, F.lane); }
    }
    const size_t gt = (size_t)F.gw * 64 + F.lane, NT = (size_t)F.NGW * 64;
    {
        u32x4* z = (u32x4*)(W + W_IN + (size_t)IN_COLS * D);
        for (size_t i = gt; i < (size_t)(NWIN - IN_COLS) * D / 8; i += NT) z[i] = Z4;
    }
    {
        const float* src = p.in(I_CCKV) + (size_t)layer * NB * PAST * 512; bf16_t* dst = (bf16_t*)(p.ws() + WS_CKV);
        for (size_t i = gt; i < (size_t)NB * PAST * 512 / 8; i += NT) { const size_t e = i * 8; const int b = (int)(e / (PAST * 512)), rem = (int)(e % (PAST * 512));
            const f32x4 a = *(const f32x4*)(src + e), c = *(const f32x4*)(src + e + 4);
            u32x4 w; w.x = pk2(a[0], a[1]); w.y = pk2(a[2], a[3]); w.z = pk2(c[0], c[1]); w.w = pk2(c[2], c[3]);
            *(u32x4*)(dst + ((size_t)MP + (size_t)b * KVS) * 512 + rem) = w; }
        for (size_t i = gt; i < (size_t)NB * (KVS - KVLEN_S) * 512 / 8; i += NT) { const size_t e = i * 8; const int b = (int)(e / ((KVS - KVLEN_S) * 512)), rem = (int)(e % ((KVS - KVLEN_S) * 512));
            *(u32x4*)(dst + ((size_t)MP + (size_t)b * KVS + KVLEN_S) * 512 + rem) = Z4; }
    }
    {
        const float* src = p.in(I_CFK) + (size_t)layer * NB * PAST * 1024; bf16_t* dst = (bf16_t*)(p.ws() + WS_KFS);
        for (size_t i = gt; i < (size_t)NB * PAST * 1024 / 8; i += NT) { const size_t e = i * 8; const int b = (int)(e / (PAST * 1024)), rem = (int)(e % (PAST * 1024));
            const f32x4 a = *(const f32x4*)(src + e), c = *(const f32x4*)(src + e + 4);
            u32x4 w; w.x = pk2(a[0], a[1]); w.y = pk2(a[2], a[3]); w.z = pk2(c[0], c[1]); w.w = pk2(c[2], c[3]);
            *(u32x4*)(dst + (size_t)b * KVS * 1024 + rem) = w; }
        for (size_t i = gt; i < (size_t)NB * (KVS - KVLEN_S) * 1024 / 8; i += NT) { const size_t e = i * 8; const int b = (int)(e / ((KVS - KVLEN_S) * 1024)), rem = (int)(e % ((KVS - KVLEN_S) * 1024));
            *(u32x4*)(dst + ((size_t)b * KVS + KVLEN_S) * 1024 + rem) = Z4; }
    }
    {
        const float* src = p.in(I_CKPE) + (size_t)layer * NB * PAST * 64; bf16_t* km = (bf16_t*)(p.ws() + WS_KM);
        for (size_t i = gt; i < (size_t)NB * KVS * 32; i += NT) { const int j = (int)(i & 31); const int pr = (int)(i >> 5) % KVS, b = (int)(i >> 5) / KVS;
            unsigned w = 0u;
            if (pr < PAST) { const float* s = src + ((size_t)b * PAST + pr) * 64; w = pk2(s[j], s[32 + j]); }
            if (pr < PAST || pr >= KVLEN_S) { const size_t kr = (size_t)MP + (size_t)b * KVS + pr;
#pragma unroll
                for (int h = 0; h < 8; ++h) *(unsigned*)(km + (kr * 8 + h) * 192 + 128 + 2 * j) = w; } }
        const float* ls = p.in(I_CLOGF) + (size_t)layer * NB * PAST * 8; float* ld = (float*)(p.ws() + WS_LOGF);
        for (size_t i = gt; i < (size_t)NB * KVS * 8; i += NT) { const int hh = (int)(i & 7); const int pr = (int)(i >> 3) % KVS, b = (int)(i >> 3) / KVS;
            if (pr < PAST) ld[((size_t)MP + (size_t)b * KVS + pr) * 8 + hh] = ls[((size_t)b * PAST + pr) * 8 + hh];
            else if (pr >= KVLEN_S) ld[((size_t)MP + (size_t)b * KVS + pr) * 8 + hh] = 0.f; }
        bf16_t* vtf = (bf16_t*)(p.ws() + WS_VTF);
        for (size_t i = gt; i < (size_t)1024 * NB * (KVS - KVLEN_S); i += NT) { const int pc = (int)(i % (KVS - KVLEN_S)); const int b = (int)(i / (KVS - KVLEN_S)) % NB, ch = (int)(i / (KVS - KVLEN_S)) / NB;
            vtf[(size_t)ch * KVROWS + MP + (size_t)b * KVS + KVLEN_S + pc] = 0; }
    }
}

__device__ __forceinline__ void phase_rope_table(const Frame& F0) {
    const Frame F = mk_frame(F0.wave);
    const PV p = pv_get();
    const size_t gt = (size_t)F.gw * 64 + F.lane, NT = (size_t)F.NGW * 64;
    f32x2* rt = (f32x2*)(p.ws() + WS_ROPE);
    for (size_t i = gt; i < (size_t)SEQ * 32; i += NT) { const int j = (int)(i & 31), ps = (int)(i >> 5);
        const float inv = powf(10000.0f, -(float)j / 32.0f); const float ang = (float)ps * inv;
        float sn, cs; sincosf(ang, &sn, &cs); rt[i] = (f32x2){cs, sn}; }
}
__device__ __forceinline__ void phase_norm(const Frame& F, const float* xp, const float* xs, const float* gain, bf16_t* XN, float* copy_s, const float* part) {
    f32x4 g[8];
#pragma unroll
    for (int j = 0; j < 8; ++j) g[j] = *(const f32x4*)(gain + 4 * F.lane + 256 * j);
    for (int m = F.gw; m < MT; m += F.NGW) {
        const float* xr = (m < MP) ? xp + (size_t)m * D : xs + (size_t)(m - MP) * D;
        f32x4 v[8]; float s = 0.f;
#pragma unroll
        for (int j = 0; j < 8; ++j) { v[j] = *(const f32x4*)(xr + 4 * F.lane + 256 * j); s += (v[j][0] * v[j][0] + v[j][1] * v[j][1]) + (v[j][2] * v[j][2] + v[j][3] * v[j][3]); }
        if (m >= MP && (copy_s || part)) {
            if (part) { s = 0.f;
#pragma unroll
                for (int sp = 0; sp < 8; ++sp)
#pragma unroll
                    for (int j = 0; j < 8; ++j) v[j] += *(const f32x4*)(part + ((size_t)sp * MS + (m - MP)) * D + 4 * F.lane + 256 * j);
#pragma unroll
                for (int j = 0; j < 8; ++j) s += (v[j][0] * v[j][0] + v[j][1] * v[j][1]) + (v[j][2] * v[j][2] + v[j][3] * v[j][3]); }
            float* xo = (copy_s ? copy_s : const_cast<float*>(xs)) + (size_t)(m - MP) * D;
#pragma unroll
            for (int j = 0; j < 8; ++j) *(f32x4*)(xo + 4 * F.lane + 256 * j) = v[j]; }
        const float rs = fast_rsqrt(wave_sum(s, F.lane) * (1.0f / D) + EPS);
        bf16_t* o = XN + (size_t)m * D + 4 * F.lane;
#pragma unroll
        for (int j = 0; j < 8; ++j) { u32x2 w; w.x = pk2(v[j][0] * rs * g[j][0], v[j][1] * rs * g[j][1]); w.y = pk2(v[j][2] * rs * g[j][2], v[j][3] * rs * g[j][3]); *(u32x2*)(o + 256 * j) = w; }
    }
}
__device__ __forceinline__ void phase_final_norm(const Frame& F, float* x, const float* gain, const float* part) {
    f32x4 g[8];
#pragma unroll
    for (int j = 0; j < 8; ++j) g[j] = *(const f32x4*)(gain + 4 * F.lane + 256 * j);
    for (int m = F.gw; m < MT; m += F.NGW) {
        float* xr = x + (size_t)m * D;
        f32x4 v[8]; float s = 0.f;
#pragma unroll
        for (int j = 0; j < 8; ++j) v[j] = *(const f32x4*)(xr + 4 * F.lane + 256 * j);
        if (m >= MP) {
#pragma unroll
            for (int sp = 0; sp < 8; ++sp)
#pragma unroll
                for (int j = 0; j < 8; ++j) v[j] += *(const f32x4*)(part + ((size_t)sp * MS + (m - MP)) * D + 4 * F.lane + 256 * j); }
#pragma unroll
        for (int j = 0; j < 8; ++j) s += (v[j][0] * v[j][0] + v[j][1] * v[j][1]) + (v[j][2] * v[j][2] + v[j][3] * v[j][3]);
        const float rs = fast_rsqrt(wave_sum(s, F.lane) * (1.0f / D) + EPS);
#pragma unroll
        for (int j = 0; j < 8; ++j) *(f32x4*)(xr + 4 * F.lane + 256 * j) = v[j] * rs * g[j];
    }
}
__device__ __forceinline__ float softplusf_(float x) {
    if (x > 20.f) return x; const float y = fast_exp(x); return y < 0.03125f ? y * (1.0f + y * (-0.5f + y * (0.33333333f - 0.25f * y))) : fast_log(1.0f + y); }
__device__ __forceinline__ void unpack8(const u32x4 w, float (&v)[8]) {
    v[0] = bf_lo(w.x); v[1] = bf_hi(w.x); v[2] = bf_lo(w.y); v[3] = bf_hi(w.y); v[4] = bf_lo(w.z); v[5] = bf_hi(w.z); v[6] = bf_lo(w.w); v[7] = bf_hi(w.w);
}
__device__ __forceinline__ void phase_t1(const Params&, const Frame& F0, int layer0) {
    const Frame F = mk_frame(F0.wave);
    const PV p = pv_get(); int layer = layer0; asm volatile("" : "+s"(layer));
    bf16_t* U = (bf16_t*)(p.ws() + WS_U); const float* US = (const float*)(p.ws() + WS_US);
    bf16_t* CKV = (bf16_t*)(p.ws() + WS_CKV); bf16_t* KM = (bf16_t*)(p.ws() + WS_KM); bf16_t* KFS = (bf16_t*)(p.ws() + WS_KFS); bf16_t* VTF = (bf16_t*)(p.ws() + WS_VTF);
    float* LOGF = (float*)(p.ws() + WS_LOGF); float* DTB = (float*)(p.ws() + WS_DT); const f32x2* rope = (const f32x2*)(p.ws() + WS_ROPE);
    unsigned* ctl = (unsigned*)(p.ws() + WS_CTL);
    float* o_pckv = p.out() + O_PCKV + (size_t)layer * MP * 512; float* o_sckv = p.out() + O_SCKV + (size_t)layer * MS * 512;
    float* o_pkpe = p.out() + O_PKPE + (size_t)layer * MP * 64; float* o_skpe = p.out() + O_SKPE + (size_t)layer * MS * 64;
    float* o_plf = p.out() + O_PLOGF + (size_t)layer * MP * 8; float* o_slf = p.out() + O_SLOGF + (size_t)layer * MS * 8;
    float* o_pconv = p.out() + O_PCONV + (size_t)layer * 3 * 1536; float* o_sconv = p.out() + O_SCONV + (size_t)layer * NB * 3 * 1536;
    float qg[8], kg[8];
#pragma unroll
    for (int j = 0; j < 8; ++j) { qg[j] = p.in(I_QN)[layer * 512 + 8 * F.lane + j]; kg[j] = p.in(I_KVN)[layer * 512 + 8 * F.lane + j]; }
    const float fb = (F.lane < 8) ? p.in(I_FBF)[layer * 8 + F.lane] : 0.f;
    const float db = (F.lane < 16) ? p.in(I_DTB)[layer * 16 + F.lane] : 0.f;
    for (int m = F.gw; m < MT; m += F.NGW) {
        const int kr = kvrow_of(m), ps = pos_of(m); const bool smp = m >= MP; const int mi = m - MP;
        bf16_t* ur = U + (size_t)m * LDU;
        const float* us = US + (size_t)m * LDUS;
        const u32x4 wq = *(const u32x4*)(ur + UC_QLAT + 8 * F.lane), wc = *(const u32x4*)(ur + UC_CKV + 8 * F.lane);
        const u32x4 fq0 = *(const u32x4*)(ur + UC_FQ + 16 * F.lane), fq1 = *(const u32x4*)(ur + UC_FQ + 16 * F.lane + 8);
        const u32x4 fk0 = *(const u32x4*)(ur + UC_FK + 16 * F.lane), fk1 = *(const u32x4*)(ur + UC_FK + 16 * F.lane + 8);
        float x1 = 0.f, x2 = 0.f; f32x2 cs = {0.f, 0.f};
        if (F.lane < 32) { x1 = us[US_KPE + F.lane]; x2 = us[US_KPE + 32 + F.lane]; cs = rope[(size_t)ps * 32 + F.lane]; }
        const float uff = (F.lane < 8) ? us[US_FF + F.lane] : 0.f, udt = (F.lane < 16) ? us[US_DT + F.lane] : 0.f;
        float vq[8], vc[8]; unpack8(wq, vq); unpack8(wc, vc);
        float sq_ = 0.f, sc_ = 0.f;
#pragma unroll
        for (int j = 0; j < 8; ++j) { sq_ += vq[j] * vq[j]; sc_ += vc[j] * vc[j]; }
        float nq = 0.f, nk = 0.f;
        { float a8[8], b8[8]; unpack8(fq0, a8); unpack8(fq1, b8);
#pragma unroll
          for (int j = 0; j < 8; ++j) nq += a8[j] * a8[j] + b8[j] * b8[j];
          unpack8(fk0, a8); unpack8(fk1, b8);
#pragma unroll
          for (int j = 0; j < 8; ++j) nk += a8[j] * a8[j] + b8[j] * b8[j]; }
#pragma unroll
        for (int o = 1; o < 64; o <<= 1) { const float t0 = shx(sq_, o, F.lane), t1 = shx(sc_, o, F.lane); sq_ += t0; sc_ += t1;
            if (o < 8) { const float t2 = shx(nq, o, F.lane), t3 = shx(nk, o, F.lane); nq += t2; nk += t3; } }
        {
            const float rs = fast_rsqrt(sq_ * (1.0f / 512) + EPS);
            u32x4 w; w.x = pk2(vq[0] * rs * qg[0], vq[1] * rs * qg[1]); w.y = pk2(vq[2] * rs * qg[2], vq[3] * rs * qg[3]); w.z = pk2(vq[4] * rs * qg[4], vq[5] * rs * qg[5]); w.w = pk2(vq[6] * rs * qg[6], vq[7] * rs * qg[7]);
            *(u32x4*)(ur + UC_QLAT + 8 * F.lane) = w;
        }
        {
            const float rs = fast_rsqrt(sc_ * (1.0f / 512) + EPS);
#pragma unroll
            for (int j = 0; j < 8; ++j) vc[j] = vc[j] * rs * kg[j];
            float* o = (smp ? o_sckv + (size_t)mi * 512 : o_pckv + (size_t)m * 512) + 8 * F.lane;
            *(f32x4*)o = (f32x4){vc[0], vc[1], vc[2], vc[3]}; *(f32x4*)(o + 4) = (f32x4){vc[4], vc[5], vc[6], vc[7]};
            u32x4 w; w.x = pk2(vc[0], vc[1]); w.y = pk2(vc[2], vc[3]); w.z = pk2(vc[4], vc[5]); w.w = pk2(vc[6], vc[7]);
            *(u32x4*)(CKV + (size_t)kr * 512 + 8 * F.lane) = w;
        }
        if (F.lane < 32) {
            const float o1 = x1 * cs.x - x2 * cs.y, o2 = x2 * cs.x + x1 * cs.y;
            float* o = smp ? o_skpe + (size_t)mi * 64 : o_pkpe + (size_t)m * 64; o[F.lane] = o1; o[32 + F.lane] = o2;
            const unsigned w = pk2(o1, o2);
#pragma unroll
            for (int h = 0; h < 8; ++h) *(unsigned*)(KM + ((size_t)kr * 8 + h) * 192 + 128 + 2 * F.lane) = w;
        }
        if (F.lane < 8) {
            const float lf = -softplusf_(-(uff + fb));
            (smp ? o_slf + (size_t)mi * 8 : o_plf + (size_t)m * 8)[F.lane] = lf; LOGF[(size_t)kr * 8 + F.lane] = lf;
        }
        if (F.lane < 16) DTB[(size_t)m * 16 + F.lane] = softplusf_(udt + db);
        if (!smp) {
            if ((F.lane & 7) == 0) { const int hh = F.lane >> 3;
                atomicMax(ctl + CW_QN2 + (layer * 64 + (m >> 8)) * 8 + hh, __float_as_uint(nq));
                atomicMax(ctl + CW_KN2 + (layer * 64 + (m >> 8)) * 8 + hh, __float_as_uint(nk)); }
        } else {
            bf16_t* kd = KFS + (size_t)(kr - MP) * 1024 + 16 * F.lane; *(u32x4*)kd = fk0; *(u32x4*)(kd + 8) = fk1;
        }
        {
            int slot = -1; float* od = nullptr;
            if (!smp) { if (m >= MP - 3) { slot = m - (MP - 3); od = o_pconv; } }
            else { const int t = mi & 15; if (t >= 13) { slot = t - 13; od = o_sconv + (size_t)(mi >> 4) * 3 * 1536; } }
            if (slot >= 0) { for (int c = F.lane; c < 1536; c += 64) od[slot * 1536 + c] = bf2f(ur[UC_XBC + c]); }
        }
    }
    {
        bf16_t* XC = (bf16_t*)(p.ws() + WS_XN);
        const float* cw = p.in(I_CW) + (size_t)layer * 4 * 1536; const float* cb = p.in(I_CB) + (size_t)layer * 1536; const float* cst = p.in(I_CONV) + (size_t)layer * NB * 3 * 1536;
        const size_t gt = (size_t)F.gw * 64 + F.lane, NT = (size_t)F.NGW * 64;
        constexpr int STRIP = 25, NSTRIP = (MP + STRIP - 1) / STRIP;
        for (size_t it = gt; it < (size_t)NSTRIP * 192; it += NT) { const int strip = (int)(it / 192), ch0 = (int)(it % 192) * 8; const int r0 = strip * STRIP;
            float wt[4][8], bs[8];
            { const f32x4 b0 = *(const f32x4*)(cb + ch0), b1 = *(const f32x4*)(cb + ch0 + 4); bs[0] = b0[0]; bs[1] = b0[1]; bs[2] = b0[2]; bs[3] = b0[3]; bs[4] = b1[0]; bs[5] = b1[1]; bs[6] = b1[2]; bs[7] = b1[3]; }
#pragma unroll
            for (int k = 0; k < 4; ++k) { const f32x4 w0 = *(const f32x4*)(cw + k * 1536 + ch0), w1 = *(const f32x4*)(cw + k * 1536 + ch0 + 4);
                wt[k][0] = w0[0]; wt[k][1] = w0[1]; wt[k][2] = w0[2]; wt[k][3] = w0[3]; wt[k][4] = w1[0]; wt[k][5] = w1[1]; wt[k][6] = w1[2]; wt[k][7] = w1[3]; }
            const bf16_t* up = U + UC_XBC + ch0;
            u32x4 win[3];
#pragma unroll
            for (int k = 0; k < 3; ++k) { const int rr = r0 - 3 + k; u32x4 z = {0u, 0u, 0u, 0u}; if (rr >= 0) z = *(const u32x4*)(up + (size_t)rr * LDU); win[k] = z; }
#pragma unroll 1
            for (int rb = 0; rb < STRIP; rb += 5) {
                u32x4 nw[5];
#pragma unroll
                for (int e = 0; e < 5; ++e) { const int rr = r0 + rb + e; nw[e] = (rr < MP) ? *(const u32x4*)(up + (size_t)rr * LDU) : (u32x4){0u, 0u, 0u, 0u}; }
#pragma unroll
                for (int e = 0; e < 5; ++e) { const int rr = r0 + rb + e;
                    float x0[8], x1[8], x2[8], x3[8]; unpack8(win[0], x0); unpack8(win[1], x1); unpack8(win[2], x2); unpack8(nw[e], x3);
                    float acc[8];
#pragma unroll
                    for (int j = 0; j < 8; ++j) acc[j] = bs[j] + wt[0][j] * x0[j] + wt[1][j] * x1[j] + wt[2][j] * x2[j] + wt[3][j] * x3[j];
                    u32x4 o; o.x = pk2(siluf_(acc[0]), siluf_(acc[1])); o.y = pk2(siluf_(acc[2]), siluf_(acc[3])); o.z = pk2(siluf_(acc[4]), siluf_(acc[5])); o.w = pk2(siluf_(acc[6]), siluf_(acc[7]));
                    if (rr < MP) *(u32x4*)(XC + (size_t)rr * 1536 + ch0) = o;
                    win[0] = win[1]; win[1] = win[2]; win[2] = nw[e]; }
            }
        }
        for (size_t i = gt; i < (size_t)MS * 192; i += NT) { const int m = MP + (int)(i / 192), ch0 = (int)(i % 192) * 8;
            const int t = (m - MP) & 15;
            float acc[8];
            { const f32x4 b0 = *(const f32x4*)(cb + ch0), b1 = *(const f32x4*)(cb + ch0 + 4); acc[0] = b0[0]; acc[1] = b0[1]; acc[2] = b0[2]; acc[3] = b0[3]; acc[4] = b1[0]; acc[5] = b1[1]; acc[6] = b1[2]; acc[7] = b1[3]; }
#pragma unroll
            for (int k = 0; k < 4; ++k) { const int ii = t - 3 + k; float xv[8];
                if (ii >= 0) unpack8(*(const u32x4*)(U + (size_t)(m - 3 + k) * LDU + UC_XBC + ch0), xv);
                else { const float* sp = cst + ((size_t)((m - MP) >> 4) * 3 + (ii + 3)) * 1536 + ch0; const f32x4 s0 = *(const f32x4*)sp, s1 = *(const f32x4*)(sp + 4);
                    xv[0] = s0[0]; xv[1] = s0[1]; xv[2] = s0[2]; xv[3] = s0[3]; xv[4] = s1[0]; xv[5] = s1[1]; xv[6] = s1[2]; xv[7] = s1[3]; }
                const f32x4 w0 = *(const f32x4*)(cw + k * 1536 + ch0), w1 = *(const f32x4*)(cw + k * 1536 + ch0 + 4);
                acc[0] += w0[0] * xv[0]; acc[1] += w0[1] * xv[1]; acc[2] += w0[2] * xv[2]; acc[3] += w0[3] * xv[3];
                acc[4] += w1[0] * xv[4]; acc[5] += w1[1] * xv[5]; acc[6] += w1[2] * xv[6]; acc[7] += w1[3] * xv[7]; }
            u32x4 o; o.x = pk2(siluf_(acc[0]), siluf_(acc[1])); o.y = pk2(siluf_(acc[2]), siluf_(acc[3])); o.z = pk2(siluf_(acc[4]), siluf_(acc[5])); o.w = pk2(siluf_(acc[6]), siluf_(acc[7]));
            *(u32x4*)(XC + (size_t)m * 1536 + ch0) = o; }
    }
    {
        constexpr int PITCH = 72;
        LAS bf16_t* tile = (LAS bf16_t*)(F.lds + F.wave * (64 * PITCH * 2));
        for (int it = F.gw; it < (MP / 64) * 16; it += F.NGW) {
            const int rt = it >> 4, ct = it & 15, row0 = rt * 64, ch0 = ct * 64;
            u32x4 v[8];
#pragma unroll
            for (int k = 0; k < 8; ++k) { const int r = 8 * k + (F.lane >> 3), c8 = F.lane & 7; v[k] = *(const u32x4*)(U + (size_t)(row0 + r) * LDU + UC_FV + ch0 + 8 * c8); }
#pragma unroll
            for (int k = 0; k < 8; ++k) { const int r = 8 * k + (F.lane >> 3), c8 = F.lane & 7; bf16_t e8[8]; *(u32x4*)e8 = v[k];
#pragma unroll
                for (int e = 0; e < 8; ++e) tile[(8 * c8 + e) * PITCH + r] = e8[e]; }
            LDS_WAIT(); asm volatile("" ::: "memory");
#pragma unroll
            for (int k = 0; k < 8; ++k) { const int ch = 8 * k + (F.lane >> 3), r8 = F.lane & 7; const u32x4 w = *(const LAS u32x4*)(tile + ch * PITCH + 8 * r8);
                *(u32x4*)(VTF + (size_t)(ch0 + ch) * KVROWS + row0 + 8 * r8) = w; }
            LDS_WAIT(); asm volatile("" ::: "memory");
        }
        const size_t gt = (size_t)F.gw * 64 + F.lane, NT = (size_t)F.NGW * 64;
        for (size_t i = gt; i < (size_t)MS * 1024; i += NT) { const int mi = (int)(i >> 10), ch = (int)(i & 1023);
            VTF[(size_t)ch * KVROWS + kvrow_of(MP + mi)] = U[(size_t)(MP + mi) * LDU + UC_FV + ch]; }
    }
}

__device__ __forceinline__ void phase_t2(const Params&, const Frame& F0) {
    const Frame F = mk_frame(F0.wave);
    const PV p = pv_get();
    const float* LOGF = (const float*)(p.ws() + WS_LOGF); float* CUM = (float*)(p.ws() + WS_CUM);
    LAS double* wt = (LAS double*)F.lds;
    for (int job = (F.G == 256) ? (F.bx + 56) % 256 : F.bx; job < 1 + NB; job += F.G) {
        const int base = job == 0 ? 0 : MP + (job - 1) * KVS, n = job == 0 ? MP : KVS;
        const int per = (n + 511) / 512, i0 = F.tid * per, i1 = (i0 + per < n) ? i0 + per : n;
        double s[8];
#pragma unroll
        for (int h = 0; h < 8; ++h) s[h] = 0.0;
        for (int i = i0; i < i1; ++i) { const f32x4 a = *(const f32x4*)(LOGF + (size_t)(base + i) * 8), b = *(const f32x4*)(LOGF + (size_t)(base + i) * 8 + 4);
            s[0] += a[0]; s[1] += a[1]; s[2] += a[2]; s[3] += a[3]; s[4] += b[0]; s[5] += b[1]; s[6] += b[2]; s[7] += b[3]; }
        double pre[8];
#pragma unroll
        for (int h = 0; h < 8; ++h) { double v = s[h];
#pragma unroll
            for (int o = 1; o < 64; o <<= 1) { const long long vb = __builtin_bit_cast(long long, v); const int src = ((F.lane - o) & 63) << 2;
                const unsigned lo_ = (unsigned)__builtin_amdgcn_ds_bpermute(src, (int)(unsigned)vb), hi_ = (unsigned)__builtin_amdgcn_ds_bpermute(src, (int)(unsigned)(vb >> 32));
                const double t = __builtin_bit_cast(double, ((unsigned long long)hi_ << 32) | lo_); if (F.lane >= o) v += t; }
            pre[h] = v - s[h]; if (F.lane == 63) wt[F.wave * 8 + h] = v; }
        __syncthreads();
#pragma unroll
        for (int h = 0; h < 8; ++h) { double off = 0.0; for (int ww = 0; ww < F.wave; ++ww) off += wt[ww * 8 + h]; pre[h] += off; }
        for (int i = i0; i < i1; ++i) { const f32x4 a = *(const f32x4*)(LOGF + (size_t)(base + i) * 8), b = *(const f32x4*)(LOGF + (size_t)(base + i) * 8 + 4);
            pre[0] += a[0]; pre[1] += a[1]; pre[2] += a[2]; pre[3] += a[3]; pre[4] += b[0]; pre[5] += b[1]; pre[6] += b[2]; pre[7] += b[3];
            *(f32x4*)(CUM + (size_t)(base + i) * 8) = (f32x4){(float)pre[0] * LOG2E, (float)pre[1] * LOG2E, (float)pre[2] * LOG2E, (float)pre[3] * LOG2E};
            *(f32x4*)(CUM + (size_t)(base + i) * 8 + 4) = (f32x4){(float)pre[4] * LOG2E, (float)pre[5] * LOG2E, (float)pre[6] * LOG2E, (float)pre[7] * LOG2E}; }
        __syncthreads();
    }
}

#define MFMA32(a, b, c) __builtin_amdgcn_mfma_f32_32x32x16_bf16((a), (b), (c), 0, 0, 0)
__device__ __forceinline__ int crow(int r, int hi) { return (r & 3) + 8 * (r >> 2) + 4 * hi; }
struct AttnSeq {
    const bf16_t* Q; int qs;
    const bf16_t* K; int ks;
    const bf16_t* VT;
    bf16_t* O; int os;
    const float* cq; const float* ck;
};
__device__ __forceinline__ void softmax_tile(f32x16& s0, f32x16& s1, float& m, float& l, f32x16 (&o)[4], bf16x8 (&pa)[4]) {
    float pmax = s0[0];
#pragma unroll
    for (int r = 1; r < 16; ++r) pmax = fmaxf(pmax, s0[r]);
#pragma unroll
    for (int r = 0; r < 16; ++r) pmax = fmaxf(pmax, s1[r]);
    { auto rr = __builtin_amdgcn_permlane32_swap(__float_as_uint(pmax), __float_as_uint(pmax), false, false);
      pmax = fmaxf(__uint_as_float(rr[0]), __uint_as_float(rr[1])); }
    const bool resc = !__all(pmax - m <= 8.0f);
    const float mn = resc ? fmaxf(m, pmax) : m;
    const float alpha = resc ? fast_exp2(m - mn) : 1.0f; m = mn;
    float ps = 0.f;
#pragma unroll
    for (int r = 0; r < 16; ++r) { s0[r] = fast_exp2(s0[r] - mn); ps += s0[r]; }
#pragma unroll
    for (int r = 0; r < 16; ++r) { s1[r] = fast_exp2(s1[r] - mn); ps += s1[r]; }
    { auto rr = __builtin_amdgcn_permlane32_swap(__float_as_uint(ps), __float_as_uint(ps), false, false);
      ps = __uint_as_float(rr[0]) + __uint_as_float(rr[1]); }
    l = l * alpha + ps;
    if (resc) {
#pragma unroll
        for (int d = 0; d < 4; ++d)
#pragma unroll
            for (int r = 0; r < 16; ++r) o[d][r] *= alpha;
    }
#define PK4(P, B_, OUT) do { const unsigned a0 = pk2(P[B_ + 0], P[B_ + 1]), a1 = pk2(P[B_ + 2], P[B_ + 3]), b0 = pk2(P[B_ + 4], P[B_ + 5]), b1 = pk2(P[B_ + 6], P[B_ + 7]); \
        auto r0 = __builtin_amdgcn_permlane32_swap(a0, b0, false, false); auto r1 = __builtin_amdgcn_permlane32_swap(a1, b1, false, false); \
        u32x4 w_ = {r0[0], r1[0], r0[1], r1[1]}; OUT = __builtin_bit_cast(bf16x8, w_); } while (0)
    PK4(s0, 0, pa[0]); PK4(s0, 8, pa[1]); PK4(s1, 0, pa[2]); PK4(s1, 8, pa[3]);
#undef PK4
}
__device__ __forceinline__ void store_o(const f32x16 (&o)[4], float inv, bf16_t* orow, int hi) {
#pragma unroll
    for (int d = 0; d < 4; ++d)
#pragma unroll
        for (int rq = 0; rq < 4; ++rq) { u32x2 w; w.x = pk2(o[d][4 * rq] * inv, o[d][4 * rq + 1] * inv); w.y = pk2(o[d][4 * rq + 2] * inv, o[d][4 * rq + 3] * inv);
            *(u32x2*)(orow + 32 * d + 8 * rq + 4 * hi) = w; }
}

template <int DQK, bool FOX>
__device__ __forceinline__ void attn_prefill_unit(LAS unsigned char* lds, const AttnSeq& a, int qb, int tid0, float bound2 = 0.f) {
    int tid = tid0; asm volatile("" : "+v"(tid));
    constexpr int RB = DQK * 2, CPR = DQK / 8, KBUF = 64 * RB, NKI = DQK / 64, NKS = DQK / 16;
    constexpr int OFF_V = 2 * KBUF, OFF_CK = OFF_V + 2 * 16384, OFF_QR = OFF_CK + 1024;
    constexpr int NQR = NKS;
    static_assert(OFF_QR + 8 * 4096 <= LDSCTL_OFF, "attention LDS map");
    const int w = __builtin_amdgcn_readfirstlane(tid >> 6), lane = tid & 63, c = lane & 31, hi = lane >> 5;
    const int q0w = qb * 256 + 32 * w, qrow = q0w + c;
    const int last_tile = q0w >> 6, ntiles = 4 * qb + 4;
    int jmin = 0;
    if (FOX) {
        LAS int* jm = (LAS int*)(lds + 2 * KBUF + 2 * 16384 + 512);
        if (tid == 0) *jm = ntiles - 1;
        __syncthreads();
        if (tid < ntiles) { const float d = a.cq[(size_t)(qb * 256) * 8] - a.ck[(size_t)(tid * 64 + 63) * 8];
            if (!(d + bound2 < -40.f)) __hip_atomic_fetch_min(jm, tid, __ATOMIC_RELAXED, __HIP_MEMORY_SCOPE_WORKGROUP); }
        __syncthreads();
        jmin = __builtin_amdgcn_readfirstlane(*jm);
    }
    int koff[NKI], voff[2];
#pragma unroll
    for (int i = 0; i < NKI; ++i) { const int s = (i * 8 + w) * 64 + lane, row = s / CPR, cp = s % CPR;
        const int ch = (DQK == 128) ? (cp ^ (row & 15)) : ((cp & ~7) | ((cp & 7) ^ ((row >> 1) & 7)));
        koff[i] = row * a.ks + ch * 8; }
#pragma unroll
    for (int i = 0; i < 2; ++i) { const int s = (i * 8 + w) * 64 + lane, d = s >> 3, cp = s & 7; voff[i] = d * KVROWS + ((cp ^ ((d >> 1) & 7)) * 8); }
    const int krow_b = c * RB;
    const int vsw = (c >> 1) & 7;
    bf16x8 qf[NQR];
    { const bf16_t* qp = a.Q + (size_t)qrow * a.qs + 8 * hi;
#pragma unroll
      for (int ks = 0; ks < NQR; ++ks) qf[ks] = *(const bf16x8*)(qp + 16 * ks);
      if (DQK == 192) {
#pragma unroll
          for (int ks = 8; ks < NKS; ++ks) *(LAS bf16x8*)(lds + OFF_QR + w * 4096 + c * 128 + (((2 * (ks - 8) + hi) ^ vsw) * 16)) = *(const bf16x8*)(qp + 16 * ks); } }
    float cq = 0.f; if (FOX) cq = a.cq[(size_t)qrow * 8];
    f32x16 o[4];
#pragma unroll
    for (int d = 0; d < 4; ++d)
#pragma unroll
        for (int r = 0; r < 16; ++r) o[d][r] = 0.f;
    float m = -1e30f, l = 0.f;
#define ATT_ISSUE(j_, b_) do { const bf16_t* kb_ = a.K + (size_t)(j_) * 64 * a.ks; const bf16_t* vb_ = a.VT + (size_t)(j_) * 64; \
        _Pragma("unroll") for (int i_ = 0; i_ < NKI; ++i_) __builtin_amdgcn_global_load_lds((const unsigned*)(kb_ + koff[i_]), (LAS unsigned*)(lds + (b_) * KBUF + (i_ * 8 + w) * 1024), 16, 0, 0); \
        _Pragma("unroll") for (int i_ = 0; i_ < 2; ++i_) __builtin_amdgcn_global_load_lds((const unsigned*)(vb_ + voff[i_]), (LAS unsigned*)(lds + OFF_V + (b_) * 16384 + (i_ * 8 + w) * 1024), 16, 0, 0); } while (0)
    ATT_ISSUE(jmin, jmin & 1);
    float ckn = 0.f;
    if (FOX && w == 0) { ckn = a.ck[(size_t)(jmin * 64 + lane) * 8]; ((LAS float*)(lds + OFF_CK))[(jmin & 1) * 64 + lane] = ckn; }
    for (int j = jmin; j < ntiles; ++j) {
        const int b = j & 1;
        VM_WAIT();
        __syncthreads();
        if (j + 1 < ntiles) { ATT_ISSUE(j + 1, b ^ 1); if (FOX && w == 0) ckn = a.ck[(size_t)((j + 1) * 64 + lane) * 8]; }
        if (j <= last_tile) {
            const LAS unsigned char* kb = lds + b * KBUF; const LAS unsigned char* vb = lds + OFF_V + b * 16384;
            f32x16 s0, s1;
#pragma unroll
            for (int r = 0; r < 16; ++r) { s0[r] = 0.f; s1[r] = 0.f; }
            constexpr int NB4 = NKS / 4;
            bf16x8 kfa[2][4], kfb[2][4];
#define ATT_LDK(dst, b4) do { _Pragma("unroll") for (int e_ = 0; e_ < 4; ++e_) { const int ks_ = 4 * (b4) + e_, ch_ = 2 * ks_ + hi; \
                const int cp_ = (DQK == 128) ? (ch_ ^ (c & 15)) : ((ch_ & ~7) | ((ch_ & 7) ^ ((c >> 1) & 7))); \
                dst[0][e_] = *(const LAS bf16x8*)(kb + krow_b + cp_ * 16); dst[1][e_] = *(const LAS bf16x8*)(kb + 32 * RB + krow_b + cp_ * 16); } } while (0)
#define ATT_MMK(src, b4) do { _Pragma("unroll") for (int e_ = 0; e_ < 4; ++e_) { const int ks_ = 4 * (b4) + e_; \
                bf16x8 qv_; if (ks_ < NQR) qv_ = qf[ks_ < NQR ? ks_ : 0]; else qv_ = *(const LAS bf16x8*)(lds + OFF_QR + w * 4096 + c * 128 + (((2 * (ks_ - 8) + hi) ^ vsw) * 16)); \
                s0 = MFMA32(src[0][e_], qv_, s0); s1 = MFMA32(src[1][e_], qv_, s1); } } while (0)
            ATT_LDK(kfa, 0);
            __builtin_amdgcn_sched_barrier(0);
            ATT_LDK(kfb, 1);
            __builtin_amdgcn_sched_barrier(0);
            ATT_MMK(kfa, 0);
            __builtin_amdgcn_sched_barrier(0);
            if (NB4 > 2) { ATT_LDK(kfa, 2 < NB4 ? 2 : 0); }
            __builtin_amdgcn_sched_barrier(0);
            ATT_MMK(kfb, 1);
            __builtin_amdgcn_sched_barrier(0);
            if (NB4 > 2) { ATT_MMK(kfa, 2 < NB4 ? 2 : 0); }
            __builtin_amdgcn_sched_barrier(0);
#undef ATT_LDK
#undef ATT_MMK
            if (FOX) {
                const LAS float* ckb = (const LAS float*)(lds + OFF_CK) + b * 64;
#pragma unroll
                for (int r = 0; r < 16; ++r) { s0[r] += cq - ckb[crow(r, hi)]; s1[r] += cq - ckb[32 + crow(r, hi)]; }
                if (j == last_tile) { const int dq = qrow - j * 64;
#pragma unroll
                    for (int r = 0; r < 16; ++r) { if (crow(r, hi) > dq) s0[r] = -__builtin_inff(); if (32 + crow(r, hi) > dq) s1[r] = -__builtin_inff(); } }
            }
            bf16x8 pa[4];
            softmax_tile(s0, s1, m, l, o, pa);
            {
                bf16x8 va[2][4], vb2[2][4];
#define ATT_LDV(dst, k0_) do { _Pragma("unroll") for (int kk_ = 0; kk_ < 2; ++kk_) _Pragma("unroll") for (int d_ = 0; d_ < 4; ++d_) { const int cp_ = (2 * ((k0_) + kk_) + hi) ^ vsw; \
                    dst[kk_][d_] = *(const LAS bf16x8*)(vb + (32 * d_ + c) * 128 + cp_ * 16); } } while (0)
#define ATT_MMV(src, k0_) do { _Pragma("unroll") for (int kk_ = 0; kk_ < 2; ++kk_) _Pragma("unroll") for (int d_ = 0; d_ < 4; ++d_) o[d_] = MFMA32(src[kk_][d_], pa[(k0_) + kk_], o[d_]); } while (0)
                ATT_LDV(va, 0);
                __builtin_amdgcn_sched_barrier(0);
                ATT_LDV(vb2, 2);
                __builtin_amdgcn_sched_barrier(0);
                ATT_MMV(va, 0);
                __builtin_amdgcn_sched_barrier(0);
                ATT_MMV(vb2, 2);
#undef ATT_LDV
#undef ATT_MMV
            }
        }
        if (FOX && w == 0 && j + 1 < ntiles) ((LAS float*)(lds + OFF_CK))[(b ^ 1) * 64 + lane] = ckn;
    }
#undef ATT_ISSUE
    store_o(o, __builtin_amdgcn_rcpf(l), a.O + (size_t)qrow * a.os, hi);
    __syncthreads();
}

template <int DQK, bool FOX>
__device__ __forceinline__ void attn_decode_unit(LAS unsigned char* lds, const AttnSeq& a, int tid0) {
    int tid = tid0; asm volatile("" : "+v"(tid));
    constexpr int NKS = DQK / 16;
    const int w = __builtin_amdgcn_readfirstlane(tid >> 6), lane = tid & 63, c = lane & 31, hi = lane >> 5, t = c & 15;
    bf16x8 qf[NKS];
    { const bf16_t* qp = a.Q + (size_t)t * a.qs + 8 * hi;
#pragma unroll
      for (int ks = 0; ks < NKS; ++ks) qf[ks] = *(const bf16x8*)(qp + 16 * ks); }
    float cq = 0.f; if (FOX) cq = a.cq[(size_t)t * 8];
    f32x16 o[4];
#pragma unroll
    for (int d = 0; d < 4; ++d)
#pragma unroll
        for (int r = 0; r < 16; ++r) o[d][r] = 0.f;
    float m = -1e30f, l = 0.f;
    const int lim = FOX ? PAST + t : KVLEN_S - 1;
    for (int j = w; j < KVS / 64; j += 8) {
        f32x16 s0, s1;
#pragma unroll
        for (int r = 0; r < 16; ++r) { s0[r] = 0.f; s1[r] = 0.f; }
        const bf16_t* kp = a.K + (size_t)(j * 64 + c) * a.ks + 8 * hi;
#pragma unroll
        for (int ks = 0; ks < NKS; ++ks) {
            if ((ks & 3) == 0) __builtin_amdgcn_sched_barrier(0);
            const bf16x8 k0 = *(const bf16x8*)(kp + 16 * ks), k1 = *(const bf16x8*)(kp + (size_t)32 * a.ks + 16 * ks);
            s0 = MFMA32(k0, qf[ks], s0); s1 = MFMA32(k1, qf[ks], s1);
        }
#pragma unroll
        for (int r = 0; r < 16; ++r) { const int k0i = j * 64 + crow(r, hi), k1i = k0i + 32;
            if (FOX) { s0[r] += cq - a.ck[(size_t)k0i * 8]; s1[r] += cq - a.ck[(size_t)k1i * 8]; }
            if (k0i > lim) s0[r] = -__builtin_inff(); if (k1i > lim) s1[r] = -__builtin_inff(); }
        bf16x8 pa[4];
        softmax_tile(s0, s1, m, l, o, pa);
#pragma unroll
        for (int d = 0; d < 4; ++d) {
            __builtin_amdgcn_sched_barrier(0);
#pragma unroll
            for (int ks = 0; ks < 4; ++ks) { const bf16x8 vf = *(const bf16x8*)(a.VT + (size_t)(32 * d + c) * KVROWS + j * 64 + 16 * ks + 8 * hi);
                o[d] = MFMA32(vf, pa[ks], o[d]); } }
    }
    LAS float* Ot = (LAS float*)lds; LAS float* ML = (LAS float*)(lds + 8 * 128 * 16 * 4);
    if (c < 16) {
#pragma unroll
        for (int d = 0; d < 4; ++d)
#pragma unroll
            for (int r = 0; r < 16; ++r) Ot[(w * 128 + 32 * d + crow(r, hi)) * 16 + c] = o[d][r];
        if (hi == 0) { ML[(w * 16 + c) * 2] = m; ML[(w * 16 + c) * 2 + 1] = l; }
    }
    __syncthreads();
    { const int q = tid & 15, dg = tid >> 4;
      float M = -1e30f;
#pragma unroll
      for (int ww = 0; ww < 8; ++ww) M = fmaxf(M, ML[(ww * 16 + q) * 2]);
      float L = 0.f, acc[4] = {0.f, 0.f, 0.f, 0.f};
#pragma unroll
      for (int ww = 0; ww < 8; ++ww) { const float f = fast_exp2(ML[(ww * 16 + q) * 2] - M); L += ML[(ww * 16 + q) * 2 + 1] * f;
#pragma unroll
          for (int e = 0; e < 4; ++e) acc[e] += Ot[(ww * 128 + 4 * dg + e) * 16 + q] * f; }
      const float inv = __builtin_amdgcn_rcpf(L);
      u32x2 wv; wv.x = pk2(acc[0] * inv, acc[1] * inv); wv.y = pk2(acc[2] * inv, acc[3] * inv);
      *(u32x2*)(a.O + (size_t)q * a.os + 4 * dg) = wv; }
    __syncthreads();
}
#define MFMA16(a, b, c) __builtin_amdgcn_mfma_f32_16x16x32_bf16((a), (b), (c), 0, 0, 0)
constexpr int SSD_XP = 72;
constexpr int SSD_BP = 136;
__device__ __forceinline__ void ssd_dt_acs(const Frame& F, const float* DTB, int m0, int L, int g, float a_neg  , LAS float* Dt, LAS float* Ac) {
    { const int l = F.tid >> 3, h = F.tid & 7; Dt[F.tid] = (l < L) ? DTB[(size_t)(m0 + l) * 16 + 8 * g + h] : 0.f; }
    __syncthreads();
    if (F.tid < 8) { float acs = 0.f; for (int l = 0; l < 64; ++l) { acs += Dt[l * 8 + F.tid] * a_neg; Ac[l * 8 + F.tid] = acs; } }
    __syncthreads();
}
__device__ __forceinline__ void phase_s1(const Params&, const Frame& F0, int layer0) {
    const Frame F = mk_frame(F0.wave);
    const PV p = pv_get(); int layer = layer0; asm volatile("" : "+s"(layer));
    const bf16_t* XC = (const bf16_t*)(p.ws() + WS_XN);
    const float* DTB = (const float*)(p.ws() + WS_DT); float* ST = (float*)(p.ws() + WS_ST); float* CDEC = (float*)(p.ws() + WS_CDEC);
    LAS float* Dt = (LAS float*)F.lds; LAS float* Ac = (LAS float*)(F.lds + 2048);
    LAS bf16_t* BT = (LAS bf16_t*)(F.lds + 4096);
    LAS bf16_t* XT = (LAS bf16_t*)(F.lds + 4096 + 128 * SSD_XP * 2) + F.wave * 64 * SSD_XP;
    const int w = F.wave, lane = F.lane, fr = lane & 15, q = lane >> 4;
    for (int unit = (F.G == 256) ? (F.bx + 88) % 256 : F.bx; unit < NCHUNK * 2; unit += F.G) {
        const int ci = unit >> 1, g = unit & 1; const bool smp = ci >= 256; const int L = smp ? 16 : 64; const int m0 = smp ? MP + (ci - 256) * 16 : ci * 64;
        const int head = 8 * g + w;
        const float a_neg = (F.tid < 8) ? -fast_exp(p.in(I_ALOG)[layer * 16 + 8 * g + F.tid]) : 0.f;
        ssd_dt_acs(F, DTB, m0, L, g, a_neg, Dt, Ac);
        const float alast = Ac[63 * 8 + w];
        if (lane == 0) CDEC[ci * 16 + head] = fast_exp(alast);
        for (int idx = F.tid; idx < 64 * 16; idx += 512) { const int l = idx >> 4, n8 = idx & 15; bf16_t v[8];
            if (l < L) *(u32x4*)v = *(const u32x4*)(XC + (size_t)(m0 + l) * 1536 + 1024 + 128 * g + 8 * n8); else *(u32x4*)v = (u32x4){0u, 0u, 0u, 0u};
#pragma unroll
            for (int e = 0; e < 8; ++e) BT[(8 * n8 + e) * SSD_XP + l] = v[e]; }
#pragma unroll
        for (int it = 0; it < 8; ++it) { const int l = 8 * it + (lane >> 3), p8 = lane & 7; float xv[8];
            if (l < L) unpack8(*(const u32x4*)(XC + (size_t)(m0 + l) * 1536 + head * 64 + 8 * p8), xv); else { for (int e = 0; e < 8; ++e) xv[e] = 0.f; }
            const float wgt = fast_exp(alast - Ac[l * 8 + w]) * Dt[l * 8 + w];
#pragma unroll
            for (int e = 0; e < 8; ++e) XT[(8 * p8 + e) * SSD_XP + l] = f2bf(xv[e] * wgt); }
        __syncthreads();
#pragma unroll 1
        for (int nh = 0; nh < 2; ++nh) {
            f32x4 acc[4][4];
#pragma unroll
            for (int nb = 0; nb < 4; ++nb)
#pragma unroll
                for (int pb = 0; pb < 4; ++pb) acc[nb][pb] = (f32x4){0.f, 0.f, 0.f, 0.f};
#pragma unroll
            for (int ks = 0; ks < 2; ++ks) {
                bf16x8 xf[4];
#pragma unroll
                for (int pb = 0; pb < 4; ++pb) xf[pb] = *(const LAS bf16x8*)(XT + (16 * pb + fr) * SSD_XP + 32 * ks + 8 * q);
#pragma unroll
                for (int nb = 0; nb < 4; ++nb) { const bf16x8 bf = *(const LAS bf16x8*)(BT + (64 * nh + 16 * nb + fr) * SSD_XP + 32 * ks + 8 * q);
#pragma unroll
                    for (int pb = 0; pb < 4; ++pb) acc[nb][pb] = MFMA16(bf, xf[pb], acc[nb][pb]); }
            }
            float* so = ST + (size_t)(ci * 16 + head) * 8192;
#pragma unroll
            for (int nb = 0; nb < 4; ++nb)
#pragma unroll
                for (int pb = 0; pb < 4; ++pb) *(f32x4*)(so + (size_t)(16 * pb + fr) * 128 + 64 * nh + 16 * nb + 4 * q) = acc[nb][pb];
        }
        __syncthreads();
    }
}
__device__ __forceinline__ void phase_s2(const Params&, const Frame& F0, int layer0) {
    const Frame F = mk_frame(F0.wave);
    const PV p = pv_get(); int layer = layer0; asm volatile("" : "+s"(layer));
    float* ST = (float*)(p.ws() + WS_ST); const float* CDEC = (const float*)(p.ws() + WS_CDEC);
    float* o_p = p.out() + O_PSSM + (size_t)layer * 131072; float* o_s = p.out() + O_SSSM + (size_t)layer * NB * 131072;
    const float* h0s = p.in(I_SSM) + (size_t)layer * NB * 131072;
    const size_t gt = (size_t)F.bx * 512 + F.tid, NT = (size_t)F.G * 512;
    for (size_t e = gt; e < 131072; e += NT) { const int head = (int)(e >> 13);
        float h = 0.f;
        for (int c0 = 0; c0 < 256; c0 += 32) { float tv[32], dv[32];
#pragma unroll
            for (int i = 0; i < 32; ++i) { tv[i] = ST[(size_t)(c0 + i) * 131072 + e]; dv[i] = CDEC[(c0 + i) * 16 + head]; }
#pragma unroll
            for (int i = 0; i < 32; ++i) { ST[(size_t)(c0 + i) * 131072 + e] = h; h = h * dv[i] + tv[i]; } }
        o_p[e] = h; }
    for (size_t i = gt; i < (size_t)NB * 131072; i += NT) { const int b = (int)(i >> 17); const size_t e = i & 131071; const int head = (int)(e >> 13), ci = 256 + b;
        const float h0 = h0s[i], tv = ST[(size_t)ci * 131072 + e];
        ST[(size_t)ci * 131072 + e] = h0; o_s[i] = h0 * CDEC[ci * 16 + head] + tv; }
}
__device__ __forceinline__ void phase_s3(const Params&, const Frame& F0, int layer0) {
    const Frame F = mk_frame(F0.wave);
    const PV p = pv_get(); int layer = layer0; asm volatile("" : "+s"(layer));
    const bf16_t* XC = (const bf16_t*)(p.ws() + WS_XN); bf16_t* U = (bf16_t*)(p.ws() + WS_U);
    const float* DTB = (const float*)(p.ws() + WS_DT); const float* ST = (const float*)(p.ws() + WS_ST);
    LAS float* Dt = (LAS float*)F.lds; LAS float* Ac = (LAS float*)(F.lds + 2048); LAS float* Rs = (LAS float*)(F.lds + 4096);
    LAS bf16_t* Bs = (LAS bf16_t*)(F.lds + 4608);
    LAS bf16_t* Cs = (LAS bf16_t*)(F.lds + 4608 + 64 * SSD_BP * 2);
    LAS bf16_t* XT = (LAS bf16_t*)(F.lds + 4608 + 2 * 64 * SSD_BP * 2) + F.wave * 64 * SSD_XP;
    const int w = F.wave, lane = F.lane, fr = lane & 15, q = lane >> 4;
    for (int unit = F.bx; unit < NCHUNK * 2; unit += F.G) {
        const int ci = unit >> 1, g = unit & 1; const bool smp = ci >= 256; const int L = smp ? 16 : 64; const int m0 = smp ? MP + (ci - 256) * 16 : ci * 64;
        const int head = 8 * g + w;
        const float a_neg = (F.tid < 8) ? -fast_exp(p.in(I_ALOG)[layer * 16 + 8 * g + F.tid]) : 0.f;
        if (F.tid < 64) Rs[F.tid] = 0.f;
        ssd_dt_acs(F, DTB, m0, L, g, a_neg, Dt, Ac);
        for (int idx = F.tid; idx < 64 * 16; idx += 512) { const int l = idx >> 4, n8 = idx & 15; u32x4 vb = {0u, 0u, 0u, 0u}, vc = {0u, 0u, 0u, 0u};
            if (l < L) { const bf16_t* src = XC + (size_t)(m0 + l) * 1536 + 1024 + 128 * g + 8 * n8; vb = *(const u32x4*)src; vc = *(const u32x4*)(src + 256); }
            *(LAS u32x4*)(Bs + l * SSD_BP + 8 * n8) = vb; *(LAS u32x4*)(Cs + l * SSD_BP + 8 * n8) = vc; }
#pragma unroll
        for (int it = 0; it < 8; ++it) { const int l = 8 * it + (lane >> 3), p8 = lane & 7; bf16_t v[8];
            if (l < L) *(u32x4*)v = *(const u32x4*)(XC + (size_t)(m0 + l) * 1536 + head * 64 + 8 * p8); else *(u32x4*)v = (u32x4){0u, 0u, 0u, 0u};
#pragma unroll
            for (int e = 0; e < 8; ++e) XT[(8 * p8 + e) * SSD_XP + l] = v[e]; }
        __syncthreads();
        f32x4 gt[4][4];
#pragma unroll
        for (int sb = 0; sb < 4; ++sb)
#pragma unroll
            for (int lb = 0; lb < 4; ++lb) gt[sb][lb] = (f32x4){0.f, 0.f, 0.f, 0.f};
#pragma unroll
        for (int ks = 0; ks < 4; ++ks) { bf16x8 cf[4];
#pragma unroll
            for (int lb = 0; lb < 4; ++lb) cf[lb] = *(const LAS bf16x8*)(Cs + (16 * lb + fr) * SSD_BP + 32 * ks + 8 * q);
#pragma unroll
            for (int sb = 0; sb < 4; ++sb) { const bf16x8 bf = *(const LAS bf16x8*)(Bs + (16 * sb + fr) * SSD_BP + 32 * ks + 8 * q);
#pragma unroll
                for (int lb = 0; lb < 4; ++lb) gt[sb][lb] = MFMA16(bf, cf[lb], gt[sb][lb]); } }
        f32x4 acc[4][4];
#pragma unroll
        for (int pb = 0; pb < 4; ++pb)
#pragma unroll
            for (int lb = 0; lb < 4; ++lb) acc[pb][lb] = (f32x4){0.f, 0.f, 0.f, 0.f};
        const float* sth = ST + (size_t)(ci * 16 + head) * 8192;
#pragma unroll
        for (int ks = 0; ks < 4; ++ks) { bf16x8 cf[4];
#pragma unroll
            for (int lb = 0; lb < 4; ++lb) cf[lb] = *(const LAS bf16x8*)(Cs + (16 * lb + fr) * SSD_BP + 32 * ks + 8 * q);
#pragma unroll
            for (int pb = 0; pb < 4; ++pb) { const float* hp = sth + (size_t)(16 * pb + fr) * 128 + 32 * ks + 8 * q; const f32x4 h0 = *(const f32x4*)hp, h1 = *(const f32x4*)(hp + 4);
                u32x4 hw; hw.x = pk2(h0[0], h0[1]); hw.y = pk2(h0[2], h0[3]); hw.z = pk2(h1[0], h1[1]); hw.w = pk2(h1[2], h1[3]);
                const bf16x8 hf = __builtin_bit_cast(bf16x8, hw);
#pragma unroll
                for (int lb = 0; lb < 4; ++lb) acc[pb][lb] = MFMA16(hf, cf[lb], acc[pb][lb]); } }
        float al[4];
#pragma unroll
        for (int lb = 0; lb < 4; ++lb) { al[lb] = Ac[(16 * lb + fr) * 8 + w]; const float el = fast_exp(al[lb]);
#pragma unroll
            for (int pb = 0; pb < 4; ++pb) acc[pb][lb] = acc[pb][lb] * el; }
#pragma unroll
        for (int ks2 = 0; ks2 < 2; ++ks2) {
            float as_[2][4], ds_[2][4];
#pragma unroll
            for (int jh = 0; jh < 2; ++jh)
#pragma unroll
                for (int r = 0; r < 4; ++r) { const int s = 32 * ks2 + 16 * jh + 4 * q + r; as_[jh][r] = Ac[s * 8 + w]; ds_[jh][r] = Dt[s * 8 + w]; }
            bf16x8 mf[4];
#pragma unroll
            for (int lb = 0; lb < 4; ++lb) { const int l = 16 * lb + fr; float mv[8];
#pragma unroll
                for (int jh = 0; jh < 2; ++jh)
#pragma unroll
                    for (int r = 0; r < 4; ++r) { const int s = 32 * ks2 + 16 * jh + 4 * q + r;
                        mv[4 * jh + r] = (s <= l) ? gt[2 * ks2 + jh][lb][r] * fast_exp(al[lb] - as_[jh][r]) * ds_[jh][r] : 0.f; }
                u32x4 mw; mw.x = pk2(mv[0], mv[1]); mw.y = pk2(mv[2], mv[3]); mw.z = pk2(mv[4], mv[5]); mw.w = pk2(mv[6], mv[7]);
                mf[lb] = __builtin_bit_cast(bf16x8, mw); }
#pragma unroll
            for (int pb = 0; pb < 4; ++pb) { const LAS bf16_t* xp = XT + (16 * pb + fr) * SSD_XP + 32 * ks2 + 4 * q;
                const u32x2 x0 = *(const LAS u32x2*)xp, x1 = *(const LAS u32x2*)(xp + 16);
                const u32x4 xw = {x0.x, x0.y, x1.x, x1.y}; const bf16x8 xf = __builtin_bit_cast(bf16x8, xw);
#pragma unroll
                for (int lb = 0; lb < 4; ++lb) acc[pb][lb] = MFMA16(xf, mf[lb], acc[pb][lb]); }
        }
        const float dsk = p.in(I_SD)[layer * 16 + head];
        float sq[4] = {0.f, 0.f, 0.f, 0.f};
#pragma unroll
        for (int lb = 0; lb < 4; ++lb) { const int l = 16 * lb + fr; const bool ok = l < L;
#pragma unroll
            for (int pb = 0; pb < 4; ++pb) { const int pc = 16 * pb + 4 * q;
                u32x2 xw = {0u, 0u}, zw = {0u, 0u};
                if (ok) { xw = *(const u32x2*)(XC + (size_t)(m0 + l) * 1536 + head * 64 + pc); zw = *(const u32x2*)(U + (size_t)(m0 + l) * LDU + UC_Z + head * 64 + pc); }
                f32x4 y = acc[pb][lb];
                y[0] = (y[0] + dsk * bf_lo(xw.x)) * siluf_(bf_lo(zw.x)); y[1] = (y[1] + dsk * bf_hi(xw.x)) * siluf_(bf_hi(zw.x));
                y[2] = (y[2] + dsk * bf_lo(xw.y)) * siluf_(bf_lo(zw.y)); y[3] = (y[3] + dsk * bf_hi(xw.y)) * siluf_(bf_hi(zw.y));
                acc[pb][lb] = y; sq[lb] += (y[0] * y[0] + y[1] * y[1]) + (y[2] * y[2] + y[3] * y[3]); } }
#pragma unroll
        for (int lb = 0; lb < 4; ++lb) { float s = sq[lb]; s += shx(s, 16, F.lane); s += shx(s, 32, F.lane);
            if (q == 0) __hip_atomic_fetch_add(Rs + 16 * lb + fr, s, __ATOMIC_RELAXED, __HIP_MEMORY_SCOPE_WORKGROUP); }
        __syncthreads();
#pragma unroll
        for (int lb = 0; lb < 4; ++lb) { const int l = 16 * lb + fr;
            if (l < L) { const float rs = fast_rsqrt(Rs[l] * (1.0f / 512) + EPS);
#pragma unroll
                for (int pb = 0; pb < 4; ++pb) { const int pc = 16 * pb + 4 * q; const f32x4 gn = *(const f32x4*)(p.in(I_SN) + layer * 1024 + head * 64 + pc); const f32x4 y = acc[pb][lb];
                    u32x2 ow; ow.x = pk2(y[0] * rs * gn[0], y[1] * rs * gn[1]); ow.y = pk2(y[2] * rs * gn[2], y[3] * rs * gn[3]);
                    *(u32x2*)(U + (size_t)(m0 + l) * LDU + UC_OSSD + head * 64 + pc) = ow; } } }
        __syncthreads();
    }
}
#ifndef DUPMASK
#define DUPMASK 0
#endif
__device__ __forceinline__ void phase_attn(const Params&, const Frame& F0, int layer0) {
    const Frame F = mk_frame(F0.wave);
    const PV p = pv_get(); int layer = layer0; asm volatile("" : "+s"(layer));
    bf16_t* U = (bf16_t*)(p.ws() + WS_U); const bf16_t* QM = (const bf16_t*)(p.ws() + WS_QM); const bf16_t* KM = (const bf16_t*)(p.ws() + WS_KM);
    const bf16_t* VTM = (const bf16_t*)(p.ws() + WS_VTM); const bf16_t* KFS = (const bf16_t*)(p.ws() + WS_KFS); const bf16_t* VTF = (const bf16_t*)(p.ws() + WS_VTF);
    const float* CUM = (const float*)(p.ws() + WS_CUM);
    for (int it = F.vcu; it < 256; it += F.G) {
        const int h = it >> 5, pr = it & 31;
        AttnSeq a; a.Q = QM + h * 192; a.qs = 1536; a.K = KM + h * 192; a.ks = 1536; a.VT = VTM + (size_t)h * 128 * KVROWS; a.O = U + UC_OMLA + h * 128; a.os = LDU; a.cq = nullptr; a.ck = nullptr;
#pragma unroll 1
        for (int half = 0; half < 2; ++half) attn_prefill_unit<192, false>(F.lds, a, half ? pr : 63 - pr, F.tid);
    }
#if defined(DUPMASK)
    if ((DUPMASK >> 8) & 1) for (int it = F.vcu; it < 256; it += F.G) {
        const int h = it >> 5, pr = it & 31;
        AttnSeq a; a.Q = QM + h * 192; a.qs = 1536; a.K = KM + h * 192; a.ks = 1536; a.VT = VTM + (size_t)h * 128 * KVROWS; a.O = U + UC_OMLA + h * 128; a.os = LDU; a.cq = nullptr; a.ck = nullptr;
#pragma unroll 1
        for (int half = 0; half < 2; ++half) attn_prefill_unit<192, false>(F.lds, a, half ? pr : 63 - pr, F.tid);
    }
#endif
    for (int it = F.vcu; it < 256; it += F.G) {
        const int h = it >> 5, pr = it & 31;
        AttnSeq a; a.Q = U + UC_FQ + h * 128; a.qs = LDU; a.K = U + UC_FK + h * 128; a.ks = LDU; a.VT = VTF + (size_t)h * 128 * KVROWS; a.O = U + UC_OFOX + h * 128; a.os = LDU; a.cq = CUM + h; a.ck = CUM + h;
        const unsigned* ctl = (const unsigned*)(p.ws() + WS_CTL);
        float kn2; { float v = __uint_as_float(ctl[CW_KN2 + (layer * 64 + F.lane) * 8 + h]);
#pragma unroll
            for (int o = 1; o < 64; o <<= 1) v = fmaxf(v, shx(v, o, F.lane)); kn2 = v; }
#pragma unroll 1
        for (int half = 0; half < 2; ++half) { const int qb = half ? pr : 63 - pr;
            attn_prefill_unit<128, true>(F.lds, a, qb, F.tid, 2.02f * __builtin_amdgcn_sqrtf(__uint_as_float(ctl[CW_QN2 + (layer * 64 + qb) * 8 + h]) * kn2)); }
    }
#if defined(DUPMASK)
    if ((DUPMASK >> 9) & 1) for (int it = F.vcu; it < 256; it += F.G) {
        const int h = it >> 5, pr = it & 31;
        AttnSeq a; a.Q = U + UC_FQ + h * 128; a.qs = LDU; a.K = U + UC_FK + h * 128; a.ks = LDU; a.VT = VTF + (size_t)h * 128 * KVROWS; a.O = (bf16_t*)(p.ws() + WS_ST) + h * 128; a.os = 1024; a.cq = CUM + h; a.ck = CUM + h;
        const unsigned* ctl = (const unsigned*)(p.ws() + WS_CTL);
        float kn2; { float v = __uint_as_float(ctl[CW_KN2 + (layer * 64 + F.lane) * 8 + h]);
#pragma unroll
            for (int o = 1; o < 64; o <<= 1) v = fmaxf(v, shx(v, o, F.lane)); kn2 = v; }
#pragma unroll 1
        for (int half = 0; half < 2; ++half) { const int qb = half ? pr : 63 - pr;
            attn_prefill_unit<128, true>(F.lds, a, qb, F.tid, 2.02f * __builtin_amdgcn_sqrtf(__uint_as_float(ctl[CW_QN2 + (layer * 64 + qb) * 8 + h]) * kn2)); }
    }
#endif
    for (int it = F.vcu; it < 2 * NB * 8; it += F.G) {
        const int kind = it >> 7, s = (it & 127) >> 3, h = it & 7; const size_t q0 = (size_t)MP + 16 * s, k0 = (size_t)MP + (size_t)s * KVS;
        if (kind == 0) { AttnSeq a; a.Q = QM + q0 * 1536 + h * 192; a.qs = 1536; a.K = KM + k0 * 1536 + h * 192; a.ks = 1536; a.VT = VTM + (size_t)h * 128 * KVROWS + k0; a.O = U + q0 * LDU + UC_OMLA + h * 128; a.os = LDU; a.cq = nullptr; a.ck = nullptr;
          attn_decode_unit<192, false>(F.lds, a, F.tid); }
        else { AttnSeq a; a.Q = U + q0 * LDU + UC_FQ + h * 128; a.qs = LDU; a.K = KFS + (size_t)s * KVS * 1024 + h * 128; a.ks = 1024; a.VT = VTF + (size_t)h * 128 * KVROWS + k0; a.O = U + q0 * LDU + UC_OFOX + h * 128; a.os = LDU;
          a.cq = CUM + (k0 + PAST) * 8 + h; a.ck = CUM + k0 * 8 + h;
          attn_decode_unit<128, true>(F.lds, a, F.tid); }
    }
}

#define LAUNDER_P const PV p = pv_get()
#define LAUNDER_PL const PV p = pv_get(); int layer = layer0; asm volatile("" : "+s"(layer))
__device__ __forceinline__ void ph_gateup(const Params&, const Frame& F0, size_t woff) {
    const Frame F = mk_frame(F0.wave);
    LAUNDER_P; bf16_t* W = (bf16_t*)(p.ws() + WS_W); bf16_t* XN = (bf16_t*)(p.ws() + WS_XN); bf16_t* H = (bf16_t*)(p.ws() + WS_U);
    pg8::Gemm g{XN, W + woff, D, D, MT, 2 * FF, D}; pg8::StaticOrder S; S.init(MT, 2 * FF, F.G, F.bx, D); S.nrev = true;
    EpiSwiGLU E{H}; pg8::gemm_phase<EpiSwiGLU, pg8::StaticOrder, true, true>(F.lds, g, S, E, F.wave);
}
__device__ __forceinline__ void ph_down(const Params&, const Frame& F0, size_t woff, bool from_input, bool dummy = false) {
    const Frame F = mk_frame(F0.wave);
    LAUNDER_P; bf16_t* W = (bf16_t*)(p.ws() + WS_W); bf16_t* H = (bf16_t*)(p.ws() + WS_U);
    float* yp = p.out() + O_YP; float* ys = p.out() + O_YS;
    pg8::Gemm g{H, W + woff, 64, 64, MT, D, FF, (size_t)MT * 128, (size_t)D * 128}; pg8::SplitOrder S;
    S.init(MT, D, F.G, F.bx, FF);
    EpiResid E{from_input ? p.in(I_XP) : yp, from_input ? p.in(I_XS) : ys, dummy ? (float*)(p.ws() + WS_ST) : yp, 0.5f, true, (float*)(p.ws() + WS_PART)}; pg8::gemm_phase<EpiResid, pg8::SplitOrder, true, true>(F.lds, g, S, E, F.wave);
}
__device__ __forceinline__ void ph_win(const Params&, const Frame& F0, int layer0) {
    const Frame F = mk_frame(F0.wave);
    LAUNDER_PL; bf16_t* W = (bf16_t*)(p.ws() + WS_W); bf16_t* XN = (bf16_t*)(p.ws() + WS_XN); bf16_t* U = (bf16_t*)(p.ws() + WS_U);
    pg8::Gemm g{XN, W + W_IN, D, D, MT, NWIN, D}; pg8::StaticOrder S; S.init(MT, NWIN, F.G, F.bx, D);
    EpiWin E{U, (float*)(p.ws() + WS_US), p.out() + O_PFK + (size_t)layer * MP * 1024, p.out() + O_SFK + (size_t)layer * MS * 1024,
             p.out() + O_PFV + (size_t)layer * MP * 1024, p.out() + O_SFV + (size_t)layer * MS * 1024};
    pg8::gemm_phase<EpiWin, pg8::StaticOrder, true, true>(F.lds, g, S, E, F.wave);
}
__device__ __forceinline__ void ph_uq(const Params&, const Frame& F0) {
    const Frame F = mk_frame(F0.wave);
    LAUNDER_P; bf16_t* W = (bf16_t*)(p.ws() + WS_W); bf16_t* U = (bf16_t*)(p.ws() + WS_U);
    pg8::Gemm g{U + UC_QLAT, W + W_UQ, LDU, 512, MT, 1536, 512}; pg8::StaticOrder S; S.init(MT, 1536, F.G, F.bx, 512);
    EpiUq E{(bf16_t*)(p.ws() + WS_QM), (const f32x2*)(p.ws() + WS_ROPE)}; pg8::gemm_phase<EpiUq, pg8::StaticOrder, true, true>(F.lds, g, S, E, F.wave);
}
__device__ __forceinline__ void ph_ukv(const Params&, const Frame& F0) {
    const Frame F = mk_frame(F0.wave);
    LAUNDER_P; bf16_t* W = (bf16_t*)(p.ws() + WS_W);
    pg8::Gemm g{(const bf16_t*)(p.ws() + WS_CKV), W + W_UKV, 512, 512, KVROWS, 2048, 512}; pg8::StaticOrder S; S.init(KVROWS, 2048, F.G, (F.G == 256) ? (F.bx + 120) % 256 : F.bx, 512);
    EpiUkv E{(bf16_t*)(p.ws() + WS_KM), (bf16_t*)(p.ws() + WS_VTM)}; pg8::gemm_phase<EpiUkv, pg8::StaticOrder, true, true>(F.lds, g, S, E, F.wave);
}
template <int BR> __device__ __forceinline__ void ph_merge(const Params&, const Frame& F0) {
    const Frame F = mk_frame(F0.wave);
    LAUNDER_P; bf16_t* W = (bf16_t*)(p.ws() + WS_W); bf16_t* U = (bf16_t*)(p.ws() + WS_U); bf16_t* XN = (bf16_t*)(p.ws() + WS_XN);
    constexpr int acol = BR == 0 ? UC_OMLA : (BR == 1 ? UC_OSSD : UC_OFOX);
    pg8::StaticOrder S; S.init(MP, D, F.G, F.bx, 1024, true);
    pg8::Gemm g{U + acol, W + W_BR + (size_t)BR * D * 1024, LDU, 1024, MP, D, 1024}; EpiMerge<BR> E{U, XN}; pg8::gemm_phase<EpiMerge<BR>, pg8::StaticOrder, true, true>(F.lds, g, S, E, F.wave);
}
__device__ __forceinline__ void ph_merge_sample(const Params&, const Frame& F0, int layer0) {
    const Frame F = mk_frame(F0.wave);
    LAUNDER_PL; bf16_t* W = (bf16_t*)(p.ws() + WS_W); bf16_t* U = (bf16_t*)(p.ws() + WS_U); bf16_t* XN = (bf16_t*)(p.ws() + WS_XN);
    pg8::SampleMergeOrder S; S.c = F.bx;
    pg8::Gemm g{U, W + W_BR, LDU, 1024, MT, 3 * D, 1024};
    EpiMergeSample E{U, XN, (float*)(p.ws() + WS_PART), (unsigned*)(p.ws() + WS_CTL) + CW_MGC + layer * 8 * 64, (LAS unsigned*)(F.lds + RING_BYTES)};
    pg8::gemm_phase<EpiMergeSample, pg8::SampleMergeOrder, true, true>(F.lds, g, S, E, F.wave);
}
__device__ __forceinline__ void ph_wout(const Params&, const Frame& F0, bool dummy = false) {
    const Frame F = mk_frame(F0.wave);
    LAUNDER_P; bf16_t* W = (bf16_t*)(p.ws() + WS_W); bf16_t* XN = (bf16_t*)(p.ws() + WS_XN); float* yp = p.out() + O_YP; float* ys = p.out() + O_YS;
    pg8::Gemm g{XN, W + W_OUT, D, D, MT, D, D}; pg8::SplitOrder S; S.init(MT, D, F.G, F.bx, D);
    EpiResid E{yp, ys, dummy ? (float*)(p.ws() + WS_ST) : yp, 1.0f, true, (float*)(p.ws() + WS_PART)}; pg8::gemm_phase<EpiResid, pg8::SplitOrder, true, true>(F.lds, g, S, E, F.wave);
}
__device__ __forceinline__ void ph_norm(const Params&, const Frame& F0, int layer0, int which, bool from_input) {
    const Frame F = mk_frame(F0.wave);
    LAUNDER_PL; float* yp = p.out() + O_YP; float* ys = p.out() + O_YS;
    phase_norm(F, from_input ? p.in(I_XP) : yp, from_input ? p.in(I_XS) : ys, p.in(which) + layer * D, (bf16_t*)(p.ws() + WS_XN), from_input ? ys : nullptr, from_input ? nullptr : (const float*)(p.ws() + WS_PART));
}

constexpr int PH_PER_LAYER = 15, N_PHASES = NL * PH_PER_LAYER + 1;
#ifndef N_LAUNCHES
#define N_LAUNCHES 1
#endif
#ifndef PHMASK
#define PHMASK 0xffff
#endif
#ifndef DUPMASK
#define DUPMASK 0
#endif
#define DUP(k) (((DUPMASK) >> (k)) & 1)

__global__ void __launch_bounds__(512, 2) hybrid_fwd(Params p) {
    extern __shared__ __attribute__((aligned(16))) unsigned char lds_raw[];
    const int wave_k = __builtin_amdgcn_readfirstlane((int)threadIdx.x >> 6);
    const Frame F = mk_frame(wave_k);
    volatile LAS unsigned* MISC = (volatile LAS unsigned*)(F.lds + MISC_OFF);
    for (int u = F.tid; u < (LDS_BYTES - LDSCTL_OFF) / 4; u += 512) ((LAS unsigned*)(F.lds + LDSCTL_OFF))[u] = 0u;
    __syncthreads();
    const PV pk = pv_get();
    unsigned* ctl = (unsigned*)(pk.ws() + WS_CTL);
    const int lo = pk.ph_lo(), hi = pk.ph_hi();
    XcdBarrier bar; bar.bar = ctl + CW_BAR; bar.x = 0; bar.st = nullptr;
    if (hi - lo > 1) bar = xcd_barrier_post(ctl + CW_BAR, MISC + 8, F.tid);
#define IN(k) ((((PHMASK) >> (((k) == NL * PH_PER_LAYER) ? 15 : ((k) % PH_PER_LAYER))) & 1) && lo <= (k) && (k) < hi)
#define SEAM(k) do { if (IN(k) && IN((k) + 1)) xcd_barrier(bar, wave_k); } while (0)
    if (IN(0)) phase_rope_table(F);
#pragma unroll 1
    for (int layer = 0; layer < NL; ++layer) {
        const int pb = layer * PH_PER_LAYER;
        if (IN(pb + 0)) { phase_convert(p, F, layer); if (DUP(0)) phase_convert(p, F, layer); }
        if (IN(pb + 1)) { ph_norm(p, F, layer, I_F1N, layer == 0); if (DUP(1)) ph_norm(p, F, layer, I_F1N, layer == 0); }
        SEAM(pb + 1);
        if (IN(pb + 2)) { ph_gateup(p, F, W_GU1); if (DUP(2)) ph_gateup(p, F, W_GU1); }
        SEAM(pb + 2);
        if (IN(pb + 3)) { if (DUP(3)) ph_down(p, F, W_D1, layer == 0, true); ph_down(p, F, W_D1, layer == 0); }
        SEAM(pb + 3);
        if (IN(pb + 4)) ph_norm(p, F, layer, I_MIXN, false);
        SEAM(pb + 4);
        if (IN(pb + 5)) { ph_win(p, F, layer); if (DUP(5)) ph_win(p, F, layer); }
        SEAM(pb + 5);
        if (IN(pb + 6)) phase_t1(p, F, layer);
        SEAM(pb + 6);
        if (IN(pb + 7)) { phase_t2(p, F); ph_uq(p, F); ph_ukv(p, F); phase_s1(p, F, layer); if (DUP(7)) { ph_uq(p, F); ph_ukv(p, F); } if (DUP(6)) phase_s1(p, F, layer); }
        SEAM(pb + 7);
        if (IN(pb + 8)) { phase_attn(p, F, layer); phase_s2(p, F, layer); }
        SEAM(pb + 8);
        if (IN(pb + 9)) phase_s3(p, F, layer);
        SEAM(pb + 9);
        if (IN(pb + 10)) { ph_merge_sample(p, F, layer); ph_merge<0>(p, F); ph_merge<1>(p, F); ph_merge<2>(p, F); }
        SEAM(pb + 10);
        if (IN(pb + 11)) { if (DUP(11)) ph_wout(p, F, true); ph_wout(p, F); }
        SEAM(pb + 11);
        if (IN(pb + 12)) ph_norm(p, F, layer, I_F2N, false);
        SEAM(pb + 12);
        if (IN(pb + 13)) ph_gateup(p, F, W_GU2);
        SEAM(pb + 13);
        if (IN(pb + 14)) ph_down(p, F, W_D2, false);
        SEAM(pb + 14);
    }
    if (IN(NL * PH_PER_LAYER)) { const PV q = pv_get(); const Frame F2 = mk_frame(wave_k); phase_final_norm(F2, q.out() + O_YP, q.in(I_FN), (const float*)(q.ws() + WS_PART)); }
#undef IN
#undef SEAM
}

extern "C" void kernel_launch(void* const* d_in, const int* in_sizes, int n_in, void* d_out, int out_size, void* d_ws, size_t ws_size, hipStream_t stream) {
    static int grid = 0;
    if (grid == 0) {
        if (n_in != N_IN || (size_t)out_size != O_TOTAL || ws_size < WS_END) { fprintf(stderr, "kernel_launch: unexpected shapes: n_in %d out %d ws %zu (need %zu)\n", n_in, out_size, ws_size, (size_t)WS_END); grid = -1; return; }
        int dev = 0, cus = 0, per_cu = 0;
        if (hipGetDevice(&dev) != hipSuccess || hipDeviceGetAttribute(&cus, hipDeviceAttributeMultiprocessorCount, dev) != hipSuccess) { grid = -1; return; }
        if (hipFuncSetAttribute((const void*)hybrid_fwd, hipFuncAttributeMaxDynamicSharedMemorySize, LDS_BYTES) != hipSuccess) { fprintf(stderr, "kernel_launch: hipFuncSetAttribute failed\n"); grid = -1; return; }
        if (hipOccupancyMaxActiveBlocksPerMultiprocessor(&per_cu, (const void*)hybrid_fwd, 512, LDS_BYTES) != hipSuccess || per_cu < 1) { fprintf(stderr, "kernel_launch: occupancy query says %d\n", per_cu); }
        (void)hipGetLastError();
        grid = cus;
    }
    if (grid < 0) return;
    (void)hipMemsetAsync((char*)d_ws + WS_CTL, 0, CTL_BYTES, stream);
    Params p{};
    for (int i = 0; i < N_IN; ++i) p.in[i] = (const float*)d_in[i];
    p.out = (float*)d_out; p.ws = (unsigned char*)d_ws;
#if defined(PROBE_K)
    p.ph_lo = 0; p.ph_hi = PROBE_K;
    hipLaunchKernelGGL(hybrid_fwd, dim3(grid), dim3(512), LDS_BYTES, stream, p);
    (void)hipMemsetAsync((char*)d_ws + WS_CTL, 0, CTL_BYTES, stream);
    p.ph_lo = 0; p.ph_hi = N_PHASES;
    hipLaunchKernelGGL(hybrid_fwd, dim3(grid), dim3(512), LDS_BYTES, stream, p);
#elif N_LAUNCHES == 1
    p.ph_lo = 0; p.ph_hi = N_PHASES;
    hipLaunchKernelGGL(hybrid_fwd, dim3(grid), dim3(512), LDS_BYTES, stream, p);
#else
    for (int k = 0; k < N_PHASES; ++k) { p.ph_lo = k; p.ph_hi = k + 1; hipLaunchKernelGGL(hybrid_fwd, dim3(grid), dim3(512), LDS_BYTES, stream, p); }
#endif
}
```

```cpp
#include <hip/hip_runtime.h>
#include <cstdio>
#include <cstdint>

#define LAS __attribute__((address_space(3)))
typedef unsigned short bf16_t;
typedef short bf16x8 __attribute__((ext_vector_type(8)));
typedef float f32x4 __attribute__((ext_vector_type(4)));
typedef float f32x2 __attribute__((ext_vector_type(2)));
typedef float f32x16 __attribute__((ext_vector_type(16)));
typedef unsigned u32x4 __attribute__((ext_vector_type(4)));
typedef unsigned u32x2 __attribute__((ext_vector_type(2)));
typedef __bf16 bf2_t __attribute__((ext_vector_type(2)));

constexpr int D = 2048, SEQ = 16384, NB = 16, NS = 16, PAST = 1024, FF = 5504, NL = 2;
constexpr int MP = SEQ, MS = NB * NS, MT = MP + MS;
constexpr int KVS = 1088, KVLEN_S = PAST + NS;
constexpr int KVROWS = MP + NB * KVS;
constexpr int LDU = 12800;
constexpr int IN_COLS = 12888, NWIN = 13056;
constexpr float LOG2E = 1.4426950408889634f;
constexpr float MLA_QSCALE = 0.07216878364870322f * LOG2E;
constexpr float FOX_QSCALE = 0.08838834764831845f * LOG2E;
constexpr float EPS = 1e-6f;
constexpr int UC_QLAT = 0, UC_CKV = 512, UC_Z = 1024, UC_XBC = 2048, UC_FQ = 3584, UC_FK = 4608, UC_FV = 5632, UC_GATE = 6656;
constexpr int UC_OMLA = 0, UC_OSSD = UC_Z, UC_OFOX = UC_FQ;
constexpr int US_KPE = 0, US_DT = 64, US_FF = 80, LDUS = 128;

enum { I_XP = 0, I_XS, I_CCKV, I_CKPE, I_CFK, I_CFV, I_CLOGF, I_SSM, I_CONV, I_F1N, I_F1G, I_F1U, I_F1D, I_MIXN, I_WIN, I_QN, I_WUQ, I_KVN, I_WUKV,
       I_CW, I_CB, I_DTB, I_ALOG, I_SD, I_SN, I_FBF, I_BRM, I_BRS, I_BRF, I_WOUT, I_F2N, I_F2G, I_F2U, I_F2D, I_FN, N_IN };
constexpr size_t O_YP = 0, O_YS = 33554432, O_PCKV = 34078720, O_PKPE = 50855936, O_PFK = 52953088, O_PFV = 86507520, O_PLOGF = 120061952,
                 O_PSSM = 120324096, O_PCONV = 120586240, O_SCKV = 120595456, O_SKPE = 120857600, O_SFK = 120890368, O_SFV = 121414656,
                 O_SLOGF = 121938944, O_SSSM = 121943040, O_SCONV = 126137344, O_TOTAL = 126284800;

constexpr size_t W_GU1 = 0, W_D1 = W_GU1 + (size_t)2 * FF * D, W_IN = W_D1 + (size_t)D * FF, W_UQ = W_IN + (size_t)NWIN * D, W_UKV = W_UQ + (size_t)1536 * 512,
                 W_BR = W_UKV + (size_t)2048 * 512, W_OUT = W_BR + (size_t)3 * 2048 * 1024, W_GU2 = W_OUT + (size_t)D * D, W_D2 = W_GU2 + (size_t)2 * FF * D,
                 W_TOTAL = W_D2 + (size_t)D * FF;

constexpr size_t MiB = 1u << 20;
constexpr size_t al(size_t x) { return (x + MiB - 1) / MiB * MiB; }
constexpr size_t WS_CTL = 0, CTL_BYTES = 1 * MiB;
constexpr size_t WS_ROPE = WS_CTL + CTL_BYTES;
constexpr size_t WS_W = WS_ROPE + al((size_t)SEQ * 32 * 8);
constexpr size_t WS_XN = WS_W + al(W_TOTAL * 2);
constexpr size_t WS_U = WS_XN + al((size_t)MT * D * 2);
constexpr size_t WS_US = WS_U + al((size_t)MT * LDU * 2);
constexpr size_t WS_DT = WS_US + al((size_t)MT * LDUS * 4);
constexpr size_t WS_QM = WS_DT + al((size_t)MT * 16 * 4);
constexpr size_t WS_CKV = WS_QM + al((size_t)MT * 1536 * 2);
constexpr size_t WS_KM = WS_CKV + al((size_t)KVROWS * 512 * 2);
constexpr size_t WS_VTM = WS_KM + al((size_t)KVROWS * 1536 * 2);
constexpr size_t WS_KFS = WS_VTM + al((size_t)1024 * KVROWS * 2);
constexpr size_t WS_VTF = WS_KFS + al((size_t)NB * KVS * 1024 * 2);
constexpr size_t WS_LOGF = WS_VTF + al((size_t)1024 * KVROWS * 2);
constexpr size_t WS_CUM = WS_LOGF + al((size_t)KVROWS * 8 * 4);
constexpr int NCHUNK = 256 + NB;
constexpr size_t WS_ST = WS_CUM + al((size_t)KVROWS * 8 * 4);
constexpr size_t WS_CDEC = WS_ST + al((size_t)NCHUNK * 131072 * 4);
constexpr size_t WS_PART = WS_CDEC + MiB;
constexpr size_t WS_END = WS_PART + al((size_t)8 * MS * D * 4);

constexpr int CW_TMO = 0, CW_BAR = 4096;
constexpr int CW_MGC = 12288;
constexpr int CW_QN2 = 8192, CW_KN2 = CW_QN2 + NL * 64 * 8;

constexpr int RING_BYTES = 131072, LDS_BYTES = 163840, LDSCTL_OFF = LDS_BYTES - 512, MISC_OFF = LDSCTL_OFF + 320;

struct Params {
    const float* in[N_IN];
    float* out;
    unsigned char* ws;
    int ph_lo, ph_hi;
};

typedef const __attribute__((address_space(4))) unsigned char* KA;
struct PV { KA k;
    __device__ __forceinline__ const float* in(int i) const { return *(const float* const __attribute__((address_space(4)))*)(k + 8 * i); }
    __device__ __forceinline__ float* out() const { return *(float* const __attribute__((address_space(4)))*)(k + 8 * N_IN); }
    __device__ __forceinline__ unsigned char* ws() const { return *(unsigned char* const __attribute__((address_space(4)))*)(k + 8 * N_IN + 8); }
    __device__ __forceinline__ int ph_lo() const { return *(const __attribute__((address_space(4))) int*)(k + 8 * N_IN + 16); }
    __device__ __forceinline__ int ph_hi() const { return *(const __attribute__((address_space(4))) int*)(k + 8 * N_IN + 20); }
};
__device__ __forceinline__ PV pv_get() { PV v; v.k = (KA)__builtin_amdgcn_kernarg_segment_ptr(); asm volatile("" : "+s"(v.k)); return v; }
static_assert(sizeof(Params) == 8 * N_IN + 24, "Params layout");

#define LDS_WAIT() asm volatile("s_waitcnt lgkmcnt(0)" ::: "memory")
#define VM_WAIT() asm volatile("s_waitcnt vmcnt(0)" ::: "memory")
__device__ __forceinline__ unsigned pk2(float lo, float hi) { bf2_t v = {(__bf16)lo, (__bf16)hi}; return __builtin_bit_cast(unsigned, v); }
__device__ __forceinline__ float bf_lo(unsigned w) { return __uint_as_float(w << 16); }
__device__ __forceinline__ float bf_hi(unsigned w) { return __uint_as_float(w & 0xffff0000u); }
__device__ __forceinline__ float bf2f(bf16_t b) { return __uint_as_float((unsigned)b << 16); }
__device__ __forceinline__ bf16_t f2bf(float f) { return (bf16_t)(pk2(f, 0.f) & 0xffffu); }
__device__ __forceinline__ float shx(float v, int o, int lane) { return __int_as_float(__builtin_amdgcn_ds_bpermute((lane ^ o) << 2, __float_as_int(v))); }
__device__ __forceinline__ float wave_sum(float v, int lane) {
#pragma unroll
    for (int o = 1; o < 64; o <<= 1) v += shx(v, o, lane);
    return v;
}
__device__ __forceinline__ float fast_exp2(float x) { return __builtin_amdgcn_exp2f(x); }
__device__ __forceinline__ float fast_exp(float x) { return __builtin_amdgcn_exp2f(x * LOG2E); }
__device__ __forceinline__ float fast_rsqrt(float x) { return __builtin_amdgcn_rsqf(x); }
__device__ __forceinline__ float fast_log(float x) { return __builtin_amdgcn_logf(x) * 0.6931471805599453f; }
__device__ __forceinline__ float sigmoidf_(float x) { return __builtin_amdgcn_rcpf(1.f + fast_exp2(-x * LOG2E)); }
__device__ __forceinline__ float siluf_(float x) { return x * sigmoidf_(x); }
__device__ __forceinline__ int kvrow_of(int m) { return m < MP ? m : MP + ((m - MP) >> 4) * KVS + PAST + ((m - MP) & 15); }
__device__ __forceinline__ int pos_of(int m) { return m < MP ? m : PAST + ((m - MP) & 15); }

#define XB_TMO      128
#define XB_XCNT(j)  (256  + 64 * (j))
#define XB_XSUB(j)  (1280 + 64 * (j))
#define XB_XGEN(j)  (2304 + 64 * (j))
#define XB_TOP      3328
#define XB_TOPGEN   3392
#define XCD_BAR_WORDS 3456
#define XB_SPIN_CAP (1u << 22)
__device__ __forceinline__ unsigned xb_ld(unsigned* p)              { return __hip_atomic_load(p, __ATOMIC_RELAXED, __HIP_MEMORY_SCOPE_AGENT); }
__device__ __forceinline__ unsigned xb_add(unsigned* p, unsigned v) { return __hip_atomic_fetch_add(p, v, __ATOMIC_RELAXED, __HIP_MEMORY_SCOPE_AGENT); }
__device__ __forceinline__ unsigned xb_xcc_id() { return (unsigned)__builtin_amdgcn_s_getreg((3 << 11) | 20) & 0xFu; }
#define XB_SPIN(cond, bar) do { unsigned _sp = 0; while (cond) { __builtin_amdgcn_s_sleep(1); \
    if ((++_sp & 255u) == 0u) { if (xb_ld(&(bar)[XB_TMO])) break; if (_sp > XB_SPIN_CAP) { atomicAdd(&(bar)[XB_TMO], 1u); break; } } } } while (0)
struct XcdBarrier { unsigned* bar; unsigned x; volatile LAS unsigned* st; };
__device__ __forceinline__ XcdBarrier xcd_barrier_post(unsigned* bar, volatile LAS unsigned* st, int tid) {
    XcdBarrier b; b.bar = bar; b.x = xb_xcc_id(); b.st = st;
    if (tid == 0) (void)xb_add(&bar[XB_XCNT(b.x)], 1u);
    return b;
}
__device__ __forceinline__ void xcd_barrier_complete(unsigned* bar, unsigned x, unsigned& nloc, unsigned& nx) {
    const unsigned G = gridDim.x * gridDim.y * gridDim.z;
    unsigned sum, cnt, mine, sp = 0u;
    for (;;) {
        sum = 0u; cnt = 0u; mine = 0u;
#pragma unroll
        for (unsigned j = 0; j < 16; ++j) { const unsigned c = xb_ld(&bar[XB_XCNT(j)]); sum += c; cnt += (c > 0u) ? 1u : 0u; mine = (j == x) ? c : mine; }
        if (sum == G) break;
        __builtin_amdgcn_s_sleep(1);
        if ((++sp & 255u) == 0u) { if (xb_ld(&bar[XB_TMO])) break; if (sp > XB_SPIN_CAP) { atomicAdd(&bar[XB_TMO], 1u); break; } }
    }
    nloc = mine > 0u ? mine : 1u; nx = cnt > 0u ? cnt : 1u;
}
__device__ __forceinline__ void xcd_barrier(const XcdBarrier& b, int wave_s) {
    asm volatile("s_waitcnt vmcnt(0)" ::: "memory");
    __syncthreads();
    int tid_b; { unsigned z_ = 0u; asm volatile("" : "+s"(z_)); tid_b = wave_s * 64 + (int)__builtin_amdgcn_mbcnt_hi(~0u, __builtin_amdgcn_mbcnt_lo(~0u, z_)); }
    if (tid_b == 0) {
        unsigned* bar = b.bar; asm volatile("" : "+s"(bar));
        __builtin_amdgcn_s_waitcnt(0);
        unsigned nloc = b.st[0], nx = b.st[1];
        if (nloc == 0u) { xcd_barrier_complete(bar, b.x, nloc, nx); b.st[0] = nloc; b.st[1] = nx; }
        const unsigned old = xb_add(&bar[XB_XSUB(b.x)], 1u);
        const unsigned gen = old / nloc;
        if (old + 1u == (gen + 1u) * nloc) {
            __builtin_amdgcn_fence(__ATOMIC_RELEASE, "agent");
            asm volatile("s_waitcnt vmcnt(0)" ::: "memory");
            const unsigned og = xb_add(&bar[XB_TOP], 1u);
            const unsigned tg = og / nx;
            if (og + 1u == (tg + 1u) * nx) xb_add(&bar[XB_TOPGEN], 1u);
            else XB_SPIN(xb_ld(&bar[XB_TOPGEN]) == tg, bar);
            __builtin_amdgcn_fence(__ATOMIC_ACQUIRE, "agent");
            xb_add(&bar[XB_XGEN(b.x)], 1u);
            asm volatile("s_waitcnt vmcnt(0)" ::: "memory");
        } else {
            XB_SPIN(xb_ld(&bar[XB_XGEN(b.x)]) == gen, bar);
            __builtin_amdgcn_fence(__ATOMIC_ACQUIRE, "agent");
            asm volatile("s_waitcnt vmcnt(0)" ::: "memory");
        }
    }
    __syncthreads();
}

namespace pg8 {
constexpr int BM = 256, BK = 64, HALF = 128, HTB = HALF * BK * 2, STAGE_BYTES = 8 * HTB, NXCD = 8, WGM = 8;
__host__ __device__ __forceinline__ int lds_byte(int r, int c) { const int st = (r >> 4) * 2 + (c >> 5), rr = r & 15, cc = c & 31, ob = rr * 64 + cc * 2; return st * 1024 + (ob ^ (((ob >> 9) & 1) << 5)); }
__host__ __device__ __forceinline__ void stage_rc(int b, int& R, int& C) { const int st = b / 1024, sb = b % 1024, swz = sb ^ (((sb >> 9) & 1) << 5); R = (st >> 1) * 16 + swz / 64; C = (st & 1) * 32 + (swz % 64) / 2; }
__host__ __device__ __forceinline__ int perm32(int rho) { const int n = rho >> 4, i = rho & 15; return 8 * (i >> 2) + 4 * n + (i & 3); }
struct Unit { int pm, pn, k0, nt, sp; };
struct Gemm { const bf16_t* A; const bf16_t* Bt; int lda, ldb, M, N, K; size_t ksA = 128, ksB = 128; };
struct StaticOrder {
    int nM, nN, nwg, G, c, ntK; bool nfast; bool nrev = false;
    __host__ __device__ __forceinline__ void init(int M, int N, int G_, int c_, int K_ = 0, bool nfast_ = false) { nM = M / BM; nN = N / BM; nwg = nM * nN; G = G_; c = c_; ntK = K_ / BK; nfast = nfast_; }
    __host__ __device__ __forceinline__ bool next(int i, Unit& u) const {
        const long L = (long)i * G + c; if (L >= nwg) return false;
        int wgid = (int)L; { const int q = nwg / NXCD, r = nwg % NXCD, xcd = wgid % NXCD, off = wgid / NXCD; wgid = (xcd < r ? xcd * (q + 1) : r * (q + 1) + (xcd - r) * q) + off; }
        const int nig = WGM * nN, gid = wgid / nig, fm = gid * WGM, gsz = (nM - fm) < WGM ? (nM - fm) : WGM;
        const int ig = wgid % nig;
        u.pm = nfast ? fm + ig / nN : fm + (ig % gsz); u.pn = nfast ? ig % nN : ig / gsz; if (nrev) u.pn = nN - 1 - u.pn; u.k0 = 0; u.nt = ntK; u.sp = 0; return true;
    }
    __device__ __forceinline__ void a_ready(const Unit&) const {}
    __device__ __forceinline__ void done(const Unit&) const {}
    __device__ __forceinline__ size_t a_extra(const Unit&) const { return 0; }
};
struct SplitOrder : StaticOrder {
    __host__ __device__ __forceinline__ void init(int M, int N, int G_, int c_, int K_) { StaticOrder::init(M - BM, N, G_, c_, K_, true); }
    __host__ __device__ __forceinline__ bool next(int i, Unit& u) const {
        const long L = (long)i * G + c;
        const bool reg = L < nwg; const int idx = (int)(L - nwg);
        const int ns = 8;
        if (!reg && idx >= nN * ns) return false;
        Unit a; a.pm = 0; a.pn = 0; a.k0 = 0; a.nt = ntK; a.sp = 0;
        if (reg) { Unit t; StaticOrder::next(i, t); a.pm = t.pm; a.pn = t.pn; }
        const int sp = idx / nN;
        const int base = (ntK / ns) & ~1, extra = (ntK - ns * base) / 2;
        const int s_nt = base + (sp < extra ? 2 : 0), s_k0 = base * sp + 2 * (sp < extra ? sp : extra);
        u.pm = reg ? a.pm : nM; u.pn = reg ? a.pn : idx % nN; u.k0 = reg ? 0 : s_k0; u.nt = reg ? ntK : s_nt; u.sp = reg ? 0 : sp;
        return true;
    }
};
struct SampleMergeOrder {
    int c;
    __host__ __device__ __forceinline__ bool next(int i, Unit& u) const {
        if (i != 0 || c >= 24) return false;
        u.pm = MP / BM; u.pn = c; u.k0 = 0; u.nt = 16; u.sp = 0; return true;
    }
    __device__ __forceinline__ void a_ready(const Unit&) const {}
    __device__ __forceinline__ void done(const Unit&) const {}
    __device__ __forceinline__ size_t a_extra(const Unit& u) const { const int br = u.pn >> 3; return (size_t)(br == 0 ? UC_OMLA : (br == 1 ? UC_OSSD : UC_OFOX)) * 2; }
};
template <class Epi, class Sched, bool ALIGN_EPI = false, bool SP2 = false>
__device__ __forceinline__ void gemm_phase(LAS unsigned char* lds, const Gemm g, const Sched& S, const Epi& E, int wave_s) {
    int tid_; { unsigned z_ = 0u; asm volatile("" : "+s"(z_)); tid_ = wave_s * 64 + (int)__builtin_amdgcn_mbcnt_hi(~0u, __builtin_amdgcn_mbcnt_lo(~0u, z_)); }
    const int tid = tid_, wid = __builtin_amdgcn_readfirstlane(tid >> 6), lane = tid & 63, wr = wid >> 2, wc = wid & 3, fr = lane & 15, fq = lane >> 4;
    unsigned voffA[2], voffB[2];
#pragma unroll
    for (int i = 0; i < 2; ++i) { int R, C; stage_rc(tid * 16 + i * 8192, R, C); const int Rb = Epi::PERM ? ((R & ~31) + perm32(R & 31)) : R;
        voffA[i] = (unsigned)(R * g.lda + C) * 2u; voffB[i] = (unsigned)(Rb * g.ldb + C) * 2u; }
    const size_t kstepA = g.ksA, kstepB = g.ksB;
    const size_t hstepA = (size_t)HALF * g.lda * 2, hstepB = (size_t)HALF * g.ldb * 2;
    const size_t tstepA = 2 * hstepA, tstepB = 2 * hstepB;
    const unsigned ldsw = (unsigned)wid * 1024u;
    const int aoff = lds_byte(wr * 64 + fr, fq * 8), boff = lds_byte(wc * 32 + fr, fq * 8);
#define PG8_SA(b, h) (((b) * 2 + (h)) * HTB)
#define PG8_SB(b, h) ((4 + (b) * 2 + (h)) * HTB)
#define PG8_STAGE(bufoff, gbase, voff) do { _Pragma("unroll") for (int _i = 0; _i < 2; ++_i) \
        __builtin_amdgcn_global_load_lds((const unsigned*)((const char*)(gbase) + (voff)[_i]), (LAS unsigned*)(lds + (bufoff) + ldsw + _i * 8192), 16, 0, 0); } while (0)
#define PG8_LDA(dst, b, h) do { _Pragma("unroll") for (int m = 0; m < 4; ++m) _Pragma("unroll") for (int k = 0; k < 2; ++k) dst[m][k] = *(const LAS bf16x8*)(lds + PG8_SA(b, h) + aoff + m * 2048 + k * 1024); } while (0)
#define PG8_LDB(dst, b, h) do { _Pragma("unroll") for (int n = 0; n < 2; ++n) _Pragma("unroll") for (int k = 0; k < 2; ++k) dst[n][k] = *(const LAS bf16x8*)(lds + PG8_SB(b, h) + boff + n * 2048 + k * 1024); } while (0)
#define PG8_MMA(ai, bj, At, Bt) do { __builtin_amdgcn_s_setprio(1); _Pragma("unroll") for (int m = 0; m < 4; ++m) _Pragma("unroll") for (int n = 0; n < 2; ++n) _Pragma("unroll") for (int k = 0; k < 2; ++k) \
        acc[ai][bj][m][n] = __builtin_amdgcn_mfma_f32_16x16x32_bf16(Bt[n][k], At[m][k], acc[ai][bj][m][n], 0, 0, 0); __builtin_amdgcn_s_setprio(0); } while (0)
#define PG8_WAIT_V(n) asm volatile("s_waitcnt vmcnt(" #n ")" ::: "memory")
#define PG8_WAIT_L(n) asm volatile("s_waitcnt lgkmcnt(" #n ")" ::: "memory")
#define PG8_BAR __builtin_amdgcn_s_barrier()
#define PG8_SCHED __builtin_amdgcn_sched_barrier(0)
    Unit cur, nxt; int ui = 0;
    if (!S.next(0, cur)) return;
    float zf_ = 0.f; asm volatile("" : "+v"(zf_));
    const f32x4 zero4 = {zf_, zf_, zf_, zf_};
    f32x4 acc[2][2][4][2];
#pragma unroll
    for (int a = 0; a < 2; ++a)
#pragma unroll
        for (int b = 0; b < 2; ++b)
#pragma unroll
            for (int m = 0; m < 4; ++m)
#pragma unroll
                for (int n = 0; n < 2; ++n) acc[a][b][m][n] = zero4;
    bf16x8 At[4][2], B0[2][2], B1[2][2];
    const char* cA = (const char*)g.A + (size_t)cur.pm * tstepA + (size_t)cur.k0 * kstepA + S.a_extra(cur); const char* cB = (const char*)g.Bt + (size_t)cur.pn * tstepB + (size_t)cur.k0 * kstepB;
    S.a_ready(cur);
    if constexpr (SP2) {
        PG8_STAGE(PG8_SB(0, 0), cB, voffB); PG8_STAGE(PG8_SB(0, 1), cB + hstepB, voffB); PG8_STAGE(PG8_SA(0, 0), cA, voffA); PG8_STAGE(PG8_SA(0, 1), cA + hstepA, voffA);
        if (wr == 1) PG8_BAR;
        PG8_WAIT_V(2); PG8_BAR;
        PG8_STAGE(PG8_SB(1, 0), cB + kstepB, voffB); PG8_STAGE(PG8_SA(1, 0), cA + kstepA, voffA); PG8_STAGE(PG8_SB(1, 1), cB + hstepB + kstepB, voffB);
        PG8_WAIT_V(6); PG8_BAR;
    } else {
        PG8_STAGE(PG8_SB(0, 0), cB, voffB); PG8_STAGE(PG8_SA(0, 0), cA, voffA); PG8_STAGE(PG8_SB(0, 1), cB + hstepB, voffB); PG8_STAGE(PG8_SA(0, 1), cA + hstepA, voffA);
        if (wr == 1) PG8_BAR;
        PG8_WAIT_V(4); PG8_BAR;
        PG8_STAGE(PG8_SB(1, 0), cB + kstepB, voffB); PG8_STAGE(PG8_SA(1, 0), cA + kstepA, voffA); PG8_STAGE(PG8_SB(1, 1), cB + hstepB + kstepB, voffB);
        PG8_WAIT_V(6); PG8_BAR;
    }
    for (;;) {
        const bool has_next = S.next(ui + 1, nxt);
        const char* nA = has_next ? (const char*)g.A + (size_t)nxt.pm * tstepA + (size_t)nxt.k0 * kstepA + S.a_extra(nxt) : cA; const char* nB = has_next ? (const char*)g.Bt + (size_t)nxt.pn * tstepB + (size_t)nxt.k0 * kstepB : cB;
        const int nt = cur.nt;
        for (int t = 0; t < nt; t += 2) {
            const bool last = (t == nt - 2);
            const char* a1 = cA + (size_t)(t + 1) * kstepA;
            const char* a2 = last ? nA : cA + (size_t)(t + 2) * kstepA; const char* b2 = last ? nB : cB + (size_t)(t + 2) * kstepB;
            const char* a3 = a2 + kstepA; const char* b3 = b2 + kstepB;
            if (last && has_next) S.a_ready(nxt);
            if constexpr (SP2) {
            PG8_LDB(B0, 0, 0); PG8_LDB(B1, 0, 1); PG8_SCHED; PG8_LDA(At, 0, 0); PG8_STAGE(PG8_SA(1, 1), a1 + hstepA, voffA);
            PG8_WAIT_V(8); PG8_WAIT_L(0); PG8_BAR; PG8_MMA(0, 0, At, B0); PG8_MMA(0, 1, At, B1); PG8_BAR; PG8_SCHED;
            PG8_LDA(At, 0, 1); PG8_STAGE(PG8_SB(0, 0), b2, voffB); PG8_STAGE(PG8_SB(0, 1), b2 + hstepB, voffB); PG8_STAGE(PG8_SA(0, 0), a2, voffA);
            PG8_WAIT_V(8); PG8_WAIT_L(0); PG8_BAR; PG8_MMA(1, 0, At, B0); PG8_MMA(1, 1, At, B1); PG8_BAR; PG8_SCHED;
            PG8_LDB(B0, 1, 0); PG8_LDB(B1, 1, 1); PG8_SCHED; PG8_LDA(At, 1, 0); PG8_STAGE(PG8_SA(0, 1), a2 + hstepA, voffA);
            PG8_WAIT_V(8); PG8_WAIT_L(0); PG8_BAR; PG8_MMA(0, 0, At, B0); PG8_MMA(0, 1, At, B1); PG8_BAR; PG8_SCHED;
            PG8_LDA(At, 1, 1); PG8_STAGE(PG8_SB(1, 0), b3, voffB); PG8_STAGE(PG8_SB(1, 1), b3 + hstepB, voffB); PG8_STAGE(PG8_SA(1, 0), a3, voffA);
            PG8_WAIT_V(8); PG8_WAIT_L(0); PG8_BAR; PG8_MMA(1, 0, At, B0); PG8_MMA(1, 1, At, B1); PG8_BAR; PG8_SCHED;
            } else {
            PG8_LDB(B0, 0, 0); PG8_SCHED; PG8_LDA(At, 0, 0); PG8_STAGE(PG8_SA(1, 1), a1 + hstepA, voffA);
            PG8_WAIT_L(8); PG8_BAR; PG8_WAIT_L(0); PG8_MMA(0, 0, At, B0); PG8_BAR; PG8_SCHED;
            PG8_LDB(B1, 0, 1); PG8_STAGE(PG8_SB(0, 0), b2, voffB);
            PG8_BAR; PG8_WAIT_L(0); PG8_MMA(0, 1, At, B1); PG8_BAR;
            PG8_LDA(At, 0, 1); PG8_STAGE(PG8_SA(0, 0), a2, voffA);
            PG8_BAR; PG8_WAIT_L(0); PG8_MMA(1, 0, At, B0); PG8_BAR; PG8_SCHED;
            PG8_STAGE(PG8_SB(0, 1), b2 + hstepB, voffB);
            PG8_WAIT_V(6); PG8_BAR; PG8_MMA(1, 1, At, B1); PG8_BAR;
            PG8_LDB(B0, 1, 0); PG8_SCHED; PG8_LDA(At, 1, 0); PG8_STAGE(PG8_SA(0, 1), a2 + hstepA, voffA);
            PG8_WAIT_L(8); PG8_BAR; PG8_WAIT_L(0); PG8_MMA(0, 0, At, B0); PG8_BAR; PG8_SCHED;
            PG8_LDB(B1, 1, 1); PG8_STAGE(PG8_SB(1, 0), b3, voffB);
            PG8_BAR; PG8_WAIT_L(0); PG8_MMA(0, 1, At, B1); PG8_BAR;
            PG8_LDA(At, 1, 1); PG8_STAGE(PG8_SA(1, 0), a3, voffA);
            PG8_BAR; PG8_WAIT_L(0); PG8_MMA(1, 0, At, B0); PG8_BAR; PG8_SCHED;
            PG8_STAGE(PG8_SB(1, 1), b3 + hstepB, voffB);
            PG8_WAIT_V(6); PG8_BAR; PG8_MMA(1, 1, At, B1); PG8_BAR;
            }
        }
        if constexpr (ALIGN_EPI) { if (wr == 0) PG8_BAR; }
        E(acc, cur, wr, wc, fr, fq); S.done(cur);
        if (!has_next) break;
#pragma unroll
        for (int a = 0; a < 2; ++a)
#pragma unroll
            for (int b = 0; b < 2; ++b)
#pragma unroll
                for (int m = 0; m < 4; ++m)
#pragma unroll
                    for (int n = 0; n < 2; ++n) acc[a][b][m][n] = zero4;
        cur = nxt; cA = nA; cB = nB; ++ui;
        if constexpr (ALIGN_EPI) { if (wr == 1) PG8_BAR; }
    }
    PG8_WAIT_V(0);
    if constexpr (!ALIGN_EPI) { if (wr == 0) PG8_BAR; }
    PG8_BAR;
#undef PG8_SA
#undef PG8_SB
#undef PG8_STAGE
#undef PG8_LDA
#undef PG8_LDB
#undef PG8_MMA
#undef PG8_WAIT_V
#undef PG8_WAIT_L
#undef PG8_BAR
#undef PG8_SCHED
}
}
using pg8::Unit;
typedef const f32x4 (&AccRef)[2][2][4][2];

struct EpiSwiGLU {
    static constexpr bool PERM = true;
    bf16_t* H;
    __device__ __forceinline__ void operator()(AccRef acc, const Unit& u, int wr, int wc, int fr, int fq) const {
        const int row0 = u.pm * 256 + wr * 64 + fr, col0 = u.pn * 128 + wc * 32 + 8 * fq;
#pragma unroll
        for (int ai = 0; ai < 2; ++ai)
#pragma unroll
            for (int m = 0; m < 4; ++m) {
                const f32x4 g0 = acc[ai][0][m][0], g1 = acc[ai][0][m][1], u0 = acc[ai][1][m][0], u1 = acc[ai][1][m][1];
                u32x4 w;
                w.x = pk2(siluf_(g0[0]) * u0[0], siluf_(g0[1]) * u0[1]); w.y = pk2(siluf_(g0[2]) * u0[2], siluf_(g0[3]) * u0[3]);
                w.z = pk2(siluf_(g1[0]) * u1[0], siluf_(g1[1]) * u1[1]); w.w = pk2(siluf_(g1[2]) * u1[2], siluf_(g1[3]) * u1[3]);
                *(u32x4*)(H + (size_t)(col0 >> 6) * ((size_t)MT * 64) + (size_t)(row0 + ai * 128 + m * 16) * 64 + (col0 & 63)) = w;
            }
    }
};
struct EpiResid {
    static constexpr bool PERM = false;
    const float* xin_p; const float* xin_s; float* xout; float alpha; bool split; float* part;
    __device__ __forceinline__ void operator()(AccRef acc, const Unit& u, int wr, int wc, int fr, int fq) const {
        const int row0 = u.pm * 256 + wr * 64 + fr, col0 = u.pn * 256 + wc * 32 + 4 * fq;
        if (split && u.pm * 256 >= MP) {
            float* pb_ = part + ((size_t)u.sp * MS - MP) * D;
#pragma unroll
            for (int ai = 0; ai < 2; ++ai)
#pragma unroll
                for (int m = 0; m < 4; ++m) { float* o = pb_ + (size_t)(row0 + ai * 128 + m * 16) * D + col0;
#pragma unroll
                    for (int bj = 0; bj < 2; ++bj)
#pragma unroll
                        for (int n = 0; n < 2; ++n) *(f32x4*)(o + bj * 128 + n * 16) = acc[ai][bj][m][n] * alpha; }
            return;
        }
        const float* xin = (u.pm * 256 < MP) ? xin_p : xin_s - (size_t)MP * D;
#pragma unroll
        for (int ai = 0; ai < 2; ++ai) {
            f32x4 b[4][2][2];
#pragma unroll
            for (int m = 0; m < 4; ++m) { const size_t off = (size_t)(row0 + ai * 128 + m * 16) * D + col0;
#pragma unroll
                for (int bj = 0; bj < 2; ++bj)
#pragma unroll
                    for (int n = 0; n < 2; ++n) b[m][bj][n] = *(const f32x4*)(xin + off + bj * 128 + n * 16); }
#pragma unroll
            for (int m = 0; m < 4; ++m) { const size_t off = (size_t)(row0 + ai * 128 + m * 16) * D + col0;
#pragma unroll
                for (int bj = 0; bj < 2; ++bj)
#pragma unroll
                    for (int n = 0; n < 2; ++n) *(f32x4*)(xout + off + bj * 128 + n * 16) = b[m][bj][n] + acc[ai][bj][m][n] * alpha; }
        }
    }
};
struct EpiWin {
    static constexpr bool PERM = true;
    bf16_t* U; float* US; float* fk_p; float* fk_s; float* fv_p; float* fv_s;
    __device__ __forceinline__ void operator()(AccRef acc, const Unit& u, int wr, int wc, int fr, int fq) const {
        const int row0 = u.pm * 256 + wr * 64 + fr, cw = wc * 32 + 8 * fq;
        const int pn = u.pn;
        if (pn < 26) {
            float* fo = nullptr;
            if (pn >= 18) { const bool isv = pn >= 22; const int hc = (pn - (isv ? 22 : 18)) * 256;
                fo = (u.pm * 256 < MP) ? (isv ? fv_p : fk_p) : (isv ? fv_s : fk_s) - (size_t)MP * 1024; fo += hc; }
#pragma unroll
            for (int ai = 0; ai < 2; ++ai)
#pragma unroll
                for (int m = 0; m < 4; ++m) { const int row = row0 + ai * 128 + m * 16;
#pragma unroll
                    for (int bj = 0; bj < 2; ++bj) { const f32x4 v0 = acc[ai][bj][m][0], v1 = acc[ai][bj][m][1];
                        u32x4 w; w.x = pk2(v0[0], v0[1]); w.y = pk2(v0[2], v0[3]); w.z = pk2(v1[0], v1[1]); w.w = pk2(v1[2], v1[3]);
                        *(u32x4*)(U + (size_t)row * LDU + pn * 256 + bj * 128 + cw) = w;
                        if (fo) { float* o = fo + (size_t)row * 1024 + bj * 128 + cw; *(f32x4*)o = v0; *(f32x4*)(o + 4) = v1; } } }
        } else if (pn < 50) {
#pragma unroll
            for (int ai = 0; ai < 2; ++ai)
#pragma unroll
                for (int m = 0; m < 4; ++m) { const int row = row0 + ai * 128 + m * 16;
#pragma unroll
                    for (int bj = 0; bj < 2; ++bj) { const f32x4 v0 = acc[ai][bj][m][0], v1 = acc[ai][bj][m][1];
                        u32x4 w; w.x = pk2(sigmoidf_(v0[0]), sigmoidf_(v0[1])); w.y = pk2(sigmoidf_(v0[2]), sigmoidf_(v0[3]));
                        w.z = pk2(sigmoidf_(v1[0]), sigmoidf_(v1[1])); w.w = pk2(sigmoidf_(v1[2]), sigmoidf_(v1[3]));
                        *(u32x4*)(U + (size_t)row * LDU + pn * 256 + bj * 128 + cw) = w; } }
        } else {
#pragma unroll
            for (int ai = 0; ai < 2; ++ai)
#pragma unroll
                for (int m = 0; m < 4; ++m) { const int row = row0 + ai * 128 + m * 16;
                    float* o = US + (size_t)row * LDUS + cw; *(f32x4*)o = acc[ai][0][m][0]; *(f32x4*)(o + 4) = acc[ai][0][m][1]; }
        }
    }
};
struct EpiUq {
    static constexpr bool PERM = true;
    bf16_t* Q; const f32x2* rope;
    __device__ __forceinline__ void operator()(AccRef acc, const Unit& u, int wr, int wc, int fr, int fq) const {
        const int row0 = u.pm * 256 + wr * 64 + fr;
#pragma unroll
        for (int bj = 0; bj < 2; ++bj) {
            const int c0 = u.pn * 256 + bj * 128 + wc * 32 + 8 * fq, r = c0 % 192;
            const bool isrope = r >= 128; const int j0 = (r - 128) >> 1;
#pragma unroll
            for (int ai = 0; ai < 2; ++ai)
#pragma unroll
                for (int m = 0; m < 4; ++m) { const int row = row0 + ai * 128 + m * 16;
                    f32x4 v0 = acc[ai][bj][m][0], v1 = acc[ai][bj][m][1];
                    if (isrope) { const f32x2* cs = rope + (size_t)pos_of(row) * 32 + j0;
                        const f32x2 a = cs[0], b = cs[1], c = cs[2], d = cs[3];
                        const f32x4 t0 = v0, t1 = v1;
                        v0[0] = t0[0] * a.x - t0[1] * a.y; v0[1] = t0[1] * a.x + t0[0] * a.y; v0[2] = t0[2] * b.x - t0[3] * b.y; v0[3] = t0[3] * b.x + t0[2] * b.y;
                        v1[0] = t1[0] * c.x - t1[1] * c.y; v1[1] = t1[1] * c.x + t1[0] * c.y; v1[2] = t1[2] * d.x - t1[3] * d.y; v1[3] = t1[3] * d.x + t1[2] * d.y; }
                    u32x4 w; w.x = pk2(v0[0], v0[1]); w.y = pk2(v0[2], v0[3]); w.z = pk2(v1[0], v1[1]); w.w = pk2(v1[2], v1[3]);
                    *(u32x4*)(Q + (size_t)row * 1536 + c0) = w; }
        }
    }
};
struct EpiUkv {
    static constexpr bool PERM = true;
    bf16_t* KM; bf16_t* VT;
    __device__ __forceinline__ void operator()(AccRef acc, const Unit& u, int wr, int wc, int fr, int fq) const {
        const int row0 = u.pm * 256 + wr * 64 + fr, h = u.pn, d0 = wc * 32 + 8 * fq;
#pragma unroll
        for (int ai = 0; ai < 2; ++ai)
#pragma unroll
            for (int m = 0; m < 4; ++m) { const int row = row0 + ai * 128 + m * 16;
                { const f32x4 v0 = acc[ai][0][m][0], v1 = acc[ai][0][m][1];
                  u32x4 w; w.x = pk2(v0[0], v0[1]); w.y = pk2(v0[2], v0[3]); w.z = pk2(v1[0], v1[1]); w.w = pk2(v1[2], v1[3]);
                  *(u32x4*)(KM + ((size_t)row * 8 + h) * 192 + d0) = w; }
                { const f32x4 v0 = acc[ai][1][m][0], v1 = acc[ai][1][m][1];
                  bf16_t* vt = VT + (size_t)(h * 128 + d0) * KVROWS + row;
#pragma unroll
                  for (int j = 0; j < 4; ++j) { vt[(size_t)j * KVROWS] = f2bf(v0[j]); vt[(size_t)(j + 4) * KVROWS] = f2bf(v1[j]); } } }
    }
};
template <int BR> struct EpiMerge {
    static constexpr bool PERM = true;
    const bf16_t* U; bf16_t* MG;
    __device__ __forceinline__ void operator()(AccRef acc, const Unit& u, int wr, int wc, int fr, int fq) const {
        const int row0 = u.pm * 256 + wr * 64 + fr, colb = u.pn * 256 + wc * 32 + 8 * fq;
#pragma unroll
        for (int ai = 0; ai < 2; ++ai) {
            u32x4 gt[4][2], od[4][2];
#pragma unroll
            for (int m = 0; m < 4; ++m) { const int row = row0 + ai * 128 + m * 16;
#pragma unroll
                for (int bj = 0; bj < 2; ++bj) { gt[m][bj] = *(const u32x4*)(U + (size_t)row * LDU + UC_GATE + BR * D + colb + bj * 128);
                    if (BR > 0) od[m][bj] = *(const u32x4*)(MG + (size_t)row * D + colb + bj * 128); } }
#pragma unroll
            for (int m = 0; m < 4; ++m) { const int row = row0 + ai * 128 + m * 16;
#pragma unroll
                for (int bj = 0; bj < 2; ++bj) { const u32x4 g = gt[m][bj];
                    f32x4 v0 = acc[ai][bj][m][0], v1 = acc[ai][bj][m][1];
                    v0[0] *= bf_lo(g.x); v0[1] *= bf_hi(g.x); v0[2] *= bf_lo(g.y); v0[3] *= bf_hi(g.y);
                    v1[0] *= bf_lo(g.z); v1[1] *= bf_hi(g.z); v1[2] *= bf_lo(g.w); v1[3] *= bf_hi(g.w);
                    if (BR > 0) { const u32x4 o = od[m][bj];
                        v0[0] += bf_lo(o.x); v0[1] += bf_hi(o.x); v0[2] += bf_lo(o.y); v0[3] += bf_hi(o.y);
                        v1[0] += bf_lo(o.z); v1[1] += bf_hi(o.z); v1[2] += bf_lo(o.w); v1[3] += bf_hi(o.w); }
                    u32x4 w; w.x = pk2(v0[0], v0[1]); w.y = pk2(v0[2], v0[3]); w.z = pk2(v1[0], v1[1]); w.w = pk2(v1[2], v1[3]);
                    *(u32x4*)(MG + (size_t)row * D + colb + bj * 128) = w; } }
        }
    }
};

struct EpiMergeSample {
    static constexpr bool PERM = true;
    const bf16_t* U; bf16_t* MG; float* part; unsigned* cnt; LAS unsigned* flag;
    __device__ __forceinline__ void operator()(AccRef acc, const Unit& u, int wr, int wc, int fr, int fq) const {
        const int br = u.pn >> 3, pn8 = u.pn & 7;
        const int row0 = wr * 64 + fr, colb = pn8 * 256 + wc * 32 + 8 * fq;
        float* pb = part + (size_t)br * MS * D;
#pragma unroll
        for (int ai = 0; ai < 2; ++ai)
#pragma unroll
            for (int m = 0; m < 4; ++m) { const int row = row0 + ai * 128 + m * 16;
#pragma unroll
                for (int bj = 0; bj < 2; ++bj) { const u32x4 g = *(const u32x4*)(U + (size_t)(MP + row) * LDU + UC_GATE + br * D + colb + bj * 128);
                    f32x4 v0 = acc[ai][bj][m][0], v1 = acc[ai][bj][m][1];
                    v0[0] *= bf_lo(g.x); v0[1] *= bf_hi(g.x); v0[2] *= bf_lo(g.y); v0[3] *= bf_hi(g.y);
                    v1[0] *= bf_lo(g.z); v1[1] *= bf_hi(g.z); v1[2] *= bf_lo(g.w); v1[3] *= bf_hi(g.w);
                    unsigned long long* o = (unsigned long long*)(pb + (size_t)row * D + colb + bj * 128);
                    __hip_atomic_store(o + 0, ((unsigned long long)__float_as_uint(v0[1]) << 32) | __float_as_uint(v0[0]), __ATOMIC_RELAXED, __HIP_MEMORY_SCOPE_AGENT);
                    __hip_atomic_store(o + 1, ((unsigned long long)__float_as_uint(v0[3]) << 32) | __float_as_uint(v0[2]), __ATOMIC_RELAXED, __HIP_MEMORY_SCOPE_AGENT);
                    __hip_atomic_store(o + 2, ((unsigned long long)__float_as_uint(v1[1]) << 32) | __float_as_uint(v1[0]), __ATOMIC_RELAXED, __HIP_MEMORY_SCOPE_AGENT);
                    __hip_atomic_store(o + 3, ((unsigned long long)__float_as_uint(v1[3]) << 32) | __float_as_uint(v1[2]), __ATOMIC_RELAXED, __HIP_MEMORY_SCOPE_AGENT); } }
        asm volatile("s_waitcnt vmcnt(0)" ::: "memory");
        __builtin_amdgcn_s_barrier();
        const int t = (wr * 4 + wc) * 64 + fq * 16 + fr;
        if (t == 0) { const unsigned old = __hip_atomic_fetch_add(cnt + 64 * pn8, 1u, __ATOMIC_RELAXED, __HIP_MEMORY_SCOPE_AGENT); *flag = (old == 2u) ? 1u : 0u; }
        asm volatile("s_waitcnt vmcnt(0) lgkmcnt(0)" ::: "memory");
        __builtin_amdgcn_s_barrier();
        asm volatile("" ::: "memory");
        if (*flag != 0u) {
            __builtin_amdgcn_fence(__ATOMIC_ACQUIRE, "agent");
            asm volatile("s_waitcnt vmcnt(0)" ::: "memory");
#pragma unroll 2
            for (int k = 0; k < 16; ++k) { const int e = (k * 512 + t) * 8, r = e >> 8, c = e & 255;
                const float* src = part + (size_t)r * D + pn8 * 256 + c;
                f32x4 a = *(const f32x4*)src, b = *(const f32x4*)(src + 4);
                a = a + *(const f32x4*)(src + (size_t)MS * D) + *(const f32x4*)(src + (size_t)2 * MS * D);
                b = b + *(const f32x4*)(src + (size_t)MS * D + 4) + *(const f32x4*)(src + (size_t)2 * MS * D + 4);
                u32x4 w; w.x = pk2(a[0], a[1]); w.y = pk2(a[2], a[3]); w.z = pk2(b[0], b[1]); w.w = pk2(b[2], b[3]);
                *(u32x4*)(MG + (size_t)(MP + r) * D + pn8 * 256 + c) = w; }
        }
    }
};

struct Frame {
    LAS unsigned char* lds;
    int tid, lane, wave, vcu, G, bx;
    int gw, NGW;
};
__device__ __forceinline__ int lane_now() { unsigned z = 0u; asm volatile("" : "+s"(z)); return (int)__builtin_amdgcn_mbcnt_hi(~0u, __builtin_amdgcn_mbcnt_lo(~0u, z)); }
__device__ __forceinline__ Frame mk_frame(int wave_s) {
    extern __shared__ __attribute__((aligned(16))) unsigned char lds_raw[];
    Frame F; F.lds = (LAS unsigned char*)lds_raw;
    asm volatile("" : "+s"(wave_s)); const int t = wave_s * 64 + lane_now();
    int bx = blockIdx.x, G = gridDim.x; asm volatile("" : "+s"(bx), "+s"(G));
    F.tid = t; F.lane = t & 63; F.wave = __builtin_amdgcn_readfirstlane(t >> 6);
    F.G = G; F.bx = bx; F.vcu = (G % 8 == 0) ? (bx % 8) * (G / 8) + bx / 8 : bx;
    F.gw = F.vcu * 8 + F.wave; F.NGW = G * 8;
    return F;
}

template <int KIND> __device__ __forceinline__ int map_row(int n, float& sc) {
    sc = 1.f;
    if (KIND == 0) return n;
    if (KIND == 1) return 256 * (n >> 7) + (n & 127);
    if (KIND == 2) return 256 * (n >> 7) + 128 + (n & 127);
    if (KIND == 3) {
        if (n < 1024) return n;
        if (n < 1088) return 12800 + (n - 1024);
        if (n < 2112) return UC_Z + (n - 1088);
        if (n < 3648) return UC_XBC + (n - 2112);
        if (n < 3664) return 12864 + (n - 3648);
        if (n < 4688) { sc = FOX_QSCALE; return UC_FQ + (n - 3664); }
        if (n < 5712) return UC_FK + (n - 4688);
        if (n < 6736) return UC_FV + (n - 5712);
        if (n < 6744) return 12880 + (n - 6736);
        return UC_GATE + (n - 6744);
    }
    if (KIND == 4) {
        sc = MLA_QSCALE; const int h = n / 192, r = n % 192;
        if (r < 128) return n;
        const int rr = r - 128; return h * 192 + 128 + 2 * (rr & 31) + (rr >> 5);
    }
    return n;
}
template <int KIND>
__device__ __forceinline__ void cvt_item(const float* W, int N, bf16_t* WT, size_t ldo, size_t coloff, LAS float* scr, int item, int lane, size_t kblk = 0) {
    const int nblk = (N + 31) / 32, kb = item / nblk, nb = item % nblk, k0 = 64 * kb, n0 = 32 * nb;
    const int nn = n0 + (lane & 31); const bool ok = nn < N;
#pragma unroll
    for (int i = 0; i < 32; ++i) { const int kk = 2 * i + (lane >> 5); scr[kk * 33 + (lane & 31)] = ok ? W[(size_t)(k0 + kk) * N + nn] : 0.f; }
    LDS_WAIT(); asm volatile("" ::: "memory");
    const int c = lane & 7;
#pragma unroll
    for (int j = 0; j < 4; ++j) { const int n = (lane >> 3) + 8 * j;
        if (n0 + n < N) { float sc; const int dr = map_row<KIND>(n0 + n, sc); const LAS float* s = scr + (8 * c) * 33 + n;
            u32x4 o; o.x = pk2(s[0 * 33] * sc, s[1 * 33] * sc); o.y = pk2(s[2 * 33] * sc, s[3 * 33] * sc); o.z = pk2(s[4 * 33] * sc, s[5 * 33] * sc); o.w = pk2(s[6 * 33] * sc, s[7 * 33] * sc);
            *(u32x4*)(kblk ? WT + (size_t)kb * kblk + (size_t)dr * 64 + 8 * c : WT + (size_t)dr * ldo + coloff + k0 + 8 * c) = o; } }
    LDS_WAIT(); asm volatile("" ::: "memory");
}

__device__ __forceinline__ void phase_convert(const Params&, const Frame& F0, int layer0) {
    const Frame F = mk_frame(F0.wave);
    const PV p = pv_get(); int layer = layer0; asm volatile("" : "+s"(layer));
    LAS float* scr = (LAS float*)(F.lds + F.wave * 16384);
    unsigned z0_ = 0u; asm volatile("" : "+v"(z0_)); const u32x4 Z4 = {z0_, z0_, z0_, z0_};
    bf16_t* W = (bf16_t*)(p.ws() + WS_W);
    const size_t lFF = (size_t)layer * D * FF;
    constexpr int IT_FF = (D / 64) * (FF / 32), IT_DN = (FF / 64) * (D / 32), IT_IN = (D / 64) * ((IN_COLS + 31) / 32), IT_UQ = 8 * 48, IT_UKV = 8 * 64, IT_BR = 16 * 64, IT_OUT = 32 * 64;
    constexpr int IT_FV = NB * 16 * 32;
    constexpr int NITEMS = 6 * IT_FF + IT_IN + IT_UQ + IT_UKV + 3 * IT_BR + IT_OUT + IT_FV;
    static_assert(IT_FF == IT_DN, "items");
    for (int it = F.gw; it < NITEMS; it += F.NGW) {
        int r = it;
        if (r < IT_FF) { cvt_item<1>(p.in(I_F1G) + lFF, FF, W + W_GU1, D, 0, scr, r, F.lane, (size_t)2 * FF * 64); continue; } r -= IT_FF;
        if (r < IT_FF) { cvt_item<2>(p.in(I_F1U) + lFF, FF, W + W_GU1, D, 0, scr, r, F.lane, (size_t)2 * FF * 64); continue; } r -= IT_FF;
        if (r < IT_DN) { cvt_item<0>(p.in(I_F1D) + lFF, D, W + W_D1, FF, 0, scr, r, F.lane, (size_t)D * 64); continue; } r -= IT_DN;
        if (r < IT_FF) { cvt_item<1>(p.in(I_F2G) + lFF, FF, W + W_GU2, D, 0, scr, r, F.lane, (size_t)2 * FF * 64); continue; } r -= IT_FF;
        if (r < IT_FF) { cvt_item<2>(p.in(I_F2U) + lFF, FF, W + W_GU2, D, 0, scr, r, F.lane, (size_t)2 * FF * 64); continue; } r -= IT_FF;
        if (r < IT_DN) { cvt_item<0>(p.in(I_F2D) + lFF, D, W + W_D2, FF, 0, scr, r, F.lane, (size_t)D * 64); continue; } r -= IT_DN;
        if (r < IT_IN) { cvt_item<3>(p.in(I_WIN) + (size_t)layer * D * IN_COLS, IN_COLS, W + W_IN, D, 0, scr, r, F.lane, (size_t)NWIN * 64); continue; } r -= IT_IN;
        if (r < IT_UQ) { cvt_item<4>(p.in(I_WUQ) + (size_t)layer * 512 * 1536, 1536, W + W_UQ, 512, 0, scr, r, F.lane); continue; } r -= IT_UQ;
        if (r < IT_UKV) { cvt_item<0>(p.in(I_WUKV) + (size_t)layer * 512 * 2048, 2048, W + W_UKV, 512, 0, scr, r, F.lane); continue; } r -= IT_UKV;
        if (r < IT_BR) { cvt_item<0>(p.in(I_BRM) + (size_t)layer * 1024 * D, D, W + W_BR, 1024, 0, scr, r, F.lane); continue; } r -= IT_BR;
        if (r < IT_BR) { cvt_item<0>(p.in(I_BRS) + (size_t)layer * 1024 * D, D, W + W_BR + (size_t)D * 1024, 1024, 0, scr, r, F.lane); continue; } r -= IT_BR;
        if (r < IT_BR) { cvt_item<0>(p.in(I_BRF) + (size_t)layer * 1024 * D, D, W + W_BR + (size_t)2 * D * 1024, 1024, 0, scr, r, F.lane); continue; } r -= IT_BR;
        if (r < IT_OUT) { cvt_item<0>(p.in(I_WOUT) + (size_t)layer * D * D, D, W + W_OUT, D, 0, scr, r, F.lane); continue; } r -= IT_OUT;
        { const int b = r / 512, ri = r % 512;
          cvt_item<0>(p.in(I_CFV) + ((size_t)layer * NB + b) * PAST * 1024, 1024, (bf16_t*)(p.ws() + WS_VTF), KVROWS, (size_t)MP + (size_t)b * KVS, scr, ri, F.lane); }
    }
    const size_t gt = (size_t)F.gw * 64 + F.lane, NT = (size_t)F.NGW * 64;
    {
        constexpr int PADE = (NWIN - IN_COLS) * 64 / 8;
        for (size_t i = gt; i < (size_t)PADE * (D / 64); i += NT) { const int kb = (int)(i / PADE), rem = (int)(i % PADE);
            *(u32x4*)(W + W_IN + (size_t)kb * ((size_t)NWIN * 64) + (size_t)IN_COLS * 64 + (size_t)rem * 8) = Z4; }
    }
    {
        const float* src = p.in(I_CCKV) + (size_t)layer * NB * PAST * 512; bf16_t* dst = (bf16_t*)(p.ws() + WS_CKV);
        for (size_t i = gt; i < (size_t)NB * PAST * 512 / 8; i += NT) { const size_t e = i * 8; const int b = (int)(e / (PAST * 512)), rem = (int)(e % (PAST * 512));
            const f32x4 a = *(const f32x4*)(src + e), c = *(const f32x4*)(src + e + 4);
            u32x4 w; w.x = pk2(a[0], a[1]); w.y = pk2(a[2], a[3]); w.z = pk2(c[0], c[1]); w.w = pk2(c[2], c[3]);
            *(u32x4*)(dst + ((size_t)MP + (size_t)b * KVS) * 512 + rem) = w; }
        for (size_t i = gt; i < (size_t)NB * (KVS - KVLEN_S) * 512 / 8; i += NT) { const size_t e = i * 8; const int b = (int)(e / ((KVS - KVLEN_S) * 512)), rem = (int)(e % ((KVS - KVLEN_S) * 512));
            *(u32x4*)(dst + ((size_t)MP + (size_t)b * KVS + KVLEN_S) * 512 + rem) = Z4; }
    }
    {
        const float* src = p.in(I_CFK) + (size_t)layer * NB * PAST * 1024; bf16_t* dst = (bf16_t*)(p.ws() + WS_KFS);
        for (size_t i = gt; i < (size_t)NB * PAST * 1024 / 8; i += NT) { const size_t e = i * 8; const int b = (int)(e / (PAST * 1024)), rem = (int)(e % (PAST * 1024));
            const f32x4 a = *(const f32x4*)(src + e), c = *(const f32x4*)(src + e + 4);
            u32x4 w; w.x = pk2(a[0], a[1]); w.y = pk2(a[2], a[3]); w.z = pk2(c[0], c[1]); w.w = pk2(c[2], c[3]);
            *(u32x4*)(dst + (size_t)b * KVS * 1024 + rem) = w; }
        for (size_t i = gt; i < (size_t)NB * (KVS - KVLEN_S) * 1024 / 8; i += NT) { const size_t e = i * 8; const int b = (int)(e / ((KVS - KVLEN_S) * 1024)), rem = (int)(e % ((KVS - KVLEN_S) * 1024));
            *(u32x4*)(dst + ((size_t)b * KVS + KVLEN_S) * 1024 + rem) = Z4; }
    }
    {
        const float* src = p.in(I_CKPE) + (size_t)layer * NB * PAST * 64; bf16_t* km = (bf16_t*)(p.ws() + WS_KM);
        for (size_t i = gt; i < (size_t)NB * KVS * 32; i += NT) { const int j = (int)(i & 31); const int pr = (int)(i >> 5) % KVS, b = (int)(i >> 5) / KVS;
            unsigned w = 0u;
            if (pr < PAST) { const float* s = src + ((size_t)b * PAST + pr) * 64; w = pk2(s[j], s[32 + j]); }
            if (pr < PAST || pr >= KVLEN_S) { const size_t kr = (size_t)MP + (size_t)b * KVS + pr;
#pragma unroll
                for (int h = 0; h < 8; ++h) *(unsigned*)(km + (kr * 8 + h) * 192 + 128 + 2 * j) = w; } }
        const float* ls = p.in(I_CLOGF) + (size_t)layer * NB * PAST * 8; float* ld = (float*)(p.ws() + WS_LOGF);
        for (size_t i = gt; i < (size_t)NB * KVS * 8; i += NT) { const int hh = (int)(i & 7); const int pr = (int)(i >> 3) % KVS, b = (int)(i >> 3) / KVS;
            if (pr < PAST) ld[((size_t)MP + (size_t)b * KVS + pr) * 8 + hh] = ls[((size_t)b * PAST + pr) * 8 + hh];
            else if (pr >= KVLEN_S) ld[((size_t)MP + (size_t)b * KVS + pr) * 8 + hh] = 0.f; }
        bf16_t* vtf = (bf16_t*)(p.ws() + WS_VTF);
        for (size_t i = gt; i < (size_t)1024 * NB * (KVS - KVLEN_S); i += NT) { const int pc = (int)(i % (KVS - KVLEN_S)); const int b = (int)(i / (KVS - KVLEN_S)) % NB, ch = (int)(i / (KVS - KVLEN_S)) / NB;
            vtf[(size_t)ch * KVROWS + MP + (size_t)b * KVS + KVLEN_S + pc] = 0; }
    }
}

__device__ __forceinline__ void phase_rope_table(const Frame& F0) {
    const Frame F = mk_frame(F0.wave);
    const PV p = pv_get();
    const size_t gt = (size_t)F.gw * 64 + F.lane, NT = (size_t)F.NGW * 64;
    f32x2* rt = (f32x2*)(p.ws() + WS_ROPE);
    for (size_t i = gt; i < (size_t)SEQ * 32; i += NT) { const int j = (int)(i & 31), ps = (int)(i >> 5);
        const float inv = powf(10000.0f, -(float)j / 32.0f); const float ang = (float)ps * inv;
        float sn, cs; sincosf(ang, &sn, &cs); rt[i] = (f32x2){cs, sn}; }
}
__device__ __forceinline__ void phase_norm(const Frame& F, const float* xp, const float* xs, const float* gain, bf16_t* XN, float* copy_s, const float* part) {
    f32x4 g[8];
#pragma unroll
    for (int j = 0; j < 8; ++j) g[j] = *(const f32x4*)(gain + 4 * F.lane + 256 * j);
    for (int m = F.gw; m < MT; m += F.NGW) {
        const float* xr = (m < MP) ? xp + (size_t)m * D : xs + (size_t)(m - MP) * D;
        f32x4 v[8]; float s = 0.f;
#pragma unroll
        for (int j = 0; j < 8; ++j) { v[j] = *(const f32x4*)(xr + 4 * F.lane + 256 * j); s += (v[j][0] * v[j][0] + v[j][1] * v[j][1]) + (v[j][2] * v[j][2] + v[j][3] * v[j][3]); }
        if (m >= MP && (copy_s || part)) {
            if (part) { s = 0.f;
#pragma unroll
                for (int sp = 0; sp < 8; ++sp)
#pragma unroll
                    for (int j = 0; j < 8; ++j) v[j] += *(const f32x4*)(part + ((size_t)sp * MS + (m - MP)) * D + 4 * F.lane + 256 * j);
#pragma unroll
                for (int j = 0; j < 8; ++j) s += (v[j][0] * v[j][0] + v[j][1] * v[j][1]) + (v[j][2] * v[j][2] + v[j][3] * v[j][3]); }
            float* xo = (copy_s ? copy_s : const_cast<float*>(xs)) + (size_t)(m - MP) * D;
#pragma unroll
            for (int j = 0; j < 8; ++j) *(f32x4*)(xo + 4 * F.lane + 256 * j) = v[j]; }
        const float rs = fast_rsqrt(wave_sum(s, F.lane) * (1.0f / D) + EPS);
        bf16_t* o = XN + (size_t)(F.lane >> 4) * ((size_t)MT * 64) + (size_t)m * 64 + 4 * (F.lane & 15);
#pragma unroll
        for (int j = 0; j < 8; ++j) { u32x2 w; w.x = pk2(v[j][0] * rs * g[j][0], v[j][1] * rs * g[j][1]); w.y = pk2(v[j][2] * rs * g[j][2], v[j][3] * rs * g[j][3]); *(u32x2*)(o + (size_t)(4 * j) * ((size_t)MT * 64)) = w; }
    }
}
__device__ __forceinline__ void phase_final_norm(const Frame& F, float* x, const float* gain, const float* part) {
    f32x4 g[8];
#pragma unroll
    for (int j = 0; j < 8; ++j) g[j] = *(const f32x4*)(gain + 4 * F.lane + 256 * j);
    for (int m = F.gw; m < MT; m += F.NGW) {
        float* xr = x + (size_t)m * D;
        f32x4 v[8]; float s = 0.f;
#pragma unroll
        for (int j = 0; j < 8; ++j) v[j] = *(const f32x4*)(xr + 4 * F.lane + 256 * j);
        if (m >= MP) {
#pragma unroll
            for (int sp = 0; sp < 8; ++sp)
#pragma unroll
                for (int j = 0; j < 8; ++j) v[j] += *(const f32x4*)(part + ((size_t)sp * MS + (m - MP)) * D + 4 * F.lane + 256 * j); }
#pragma unroll
        for (int j = 0; j < 8; ++j) s += (v[j][0] * v[j][0] + v[j][1] * v[j][1]) + (v[j][2] * v[j][2] + v[j][3] * v[j][3]);
        const float rs = fast_rsqrt(wave_sum(s, F.lane) * (1.0f / D) + EPS);
#pragma unroll
        for (int j = 0; j < 8; ++j) *(f32x4*)(xr + 4 * F.lane + 256 * j) = v[j] * rs * g[j];
    }
}
__device__ __forceinline__ float softplusf_(float x) {
    if (x > 20.f) return x; const float y = fast_exp(x); return y < 0.03125f ? y * (1.0f + y * (-0.5f + y * (0.33333333f - 0.25f * y))) : fast_log(1.0f + y); }
__device__ __forceinline__ void unpack8(const u32x4 w, float (&v)[8]) {
    v[0] = bf_lo(w.x); v[1] = bf_hi(w.x); v[2] = bf_lo(w.y); v[3] = bf_hi(w.y); v[4] = bf_lo(w.z); v[5] = bf_hi(w.z); v[6] = bf_lo(w.w); v[7] = bf_hi(w.w);
}
__device__ __forceinline__ void phase_t1(const Params&, const Frame& F0, int layer0) {
    const Frame F = mk_frame(F0.wave);
    const PV p = pv_get(); int layer = layer0; asm volatile("" : "+s"(layer));
    bf16_t* U = (bf16_t*)(p.ws() + WS_U); const float* US = (const float*)(p.ws() + WS_US);
    bf16_t* CKV = (bf16_t*)(p.ws() + WS_CKV); bf16_t* KM = (bf16_t*)(p.ws() + WS_KM); bf16_t* KFS = (bf16_t*)(p.ws() + WS_KFS); bf16_t* VTF = (bf16_t*)(p.ws() + WS_VTF);
    float* LOGF = (float*)(p.ws() + WS_LOGF); float* DTB = (float*)(p.ws() + WS_DT); const f32x2* rope = (const f32x2*)(p.ws() + WS_ROPE);
    unsigned* ctl = (unsigned*)(p.ws() + WS_CTL);
    float* o_pckv = p.out() + O_PCKV + (size_t)layer * MP * 512; float* o_sckv = p.out() + O_SCKV + (size_t)layer * MS * 512;
    float* o_pkpe = p.out() + O_PKPE + (size_t)layer * MP * 64; float* o_skpe = p.out() + O_SKPE + (size_t)layer * MS * 64;
    float* o_plf = p.out() + O_PLOGF + (size_t)layer * MP * 8; float* o_slf = p.out() + O_SLOGF + (size_t)layer * MS * 8;
    float* o_pconv = p.out() + O_PCONV + (size_t)layer * 3 * 1536; float* o_sconv = p.out() + O_SCONV + (size_t)layer * NB * 3 * 1536;
    float qg[8], kg[8];
#pragma unroll
    for (int j = 0; j < 8; ++j) { qg[j] = p.in(I_QN)[layer * 512 + 8 * F.lane + j]; kg[j] = p.in(I_KVN)[layer * 512 + 8 * F.lane + j]; }
    const float fb = (F.lane < 8) ? p.in(I_FBF)[layer * 8 + F.lane] : 0.f;
    const float db = (F.lane < 16) ? p.in(I_DTB)[layer * 16 + F.lane] : 0.f;
    for (int m = F.gw; m < MT; m += F.NGW) {
        const int kr = kvrow_of(m), ps = pos_of(m); const bool smp = m >= MP; const int mi = m - MP;
        bf16_t* ur = U + (size_t)m * LDU;
        const float* us = US + (size_t)m * LDUS;
        const u32x4 wq = *(const u32x4*)(ur + UC_QLAT + 8 * F.lane), wc = *(const u32x4*)(ur + UC_CKV + 8 * F.lane);
        const u32x4 fq0 = *(const u32x4*)(ur + UC_FQ + 16 * F.lane), fq1 = *(const u32x4*)(ur + UC_FQ + 16 * F.lane + 8);
        const u32x4 fk0 = *(const u32x4*)(ur + UC_FK + 16 * F.lane), fk1 = *(const u32x4*)(ur + UC_FK + 16 * F.lane + 8);
        float x1 = 0.f, x2 = 0.f; f32x2 cs = {0.f, 0.f};
        if (F.lane < 32) { x1 = us[US_KPE + F.lane]; x2 = us[US_KPE + 32 + F.lane]; cs = rope[(size_t)ps * 32 + F.lane]; }
        const float uff = (F.lane < 8) ? us[US_FF + F.lane] : 0.f, udt = (F.lane < 16) ? us[US_DT + F.lane] : 0.f;
        float vq[8], vc[8]; unpack8(wq, vq); unpack8(wc, vc);
        float sq_ = 0.f, sc_ = 0.f;
#pragma unroll
        for (int j = 0; j < 8; ++j) { sq_ += vq[j] * vq[j]; sc_ += vc[j] * vc[j]; }
        float nq = 0.f, nk = 0.f;
        { float a8[8], b8[8]; unpack8(fq0, a8); unpack8(fq1, b8);
#pragma unroll
          for (int j = 0; j < 8; ++j) nq += a8[j] * a8[j] + b8[j] * b8[j];
          unpack8(fk0, a8); unpack8(fk1, b8);
#pragma unroll
          for (int j = 0; j < 8; ++j) nk += a8[j] * a8[j] + b8[j] * b8[j]; }
#pragma unroll
        for (int o = 1; o < 64; o <<= 1) { const float t0 = shx(sq_, o, F.lane), t1 = shx(sc_, o, F.lane); sq_ += t0; sc_ += t1;
            if (o < 8) { const float t2 = shx(nq, o, F.lane), t3 = shx(nk, o, F.lane); nq += t2; nk += t3; } }
        {
            const float rs = fast_rsqrt(sq_ * (1.0f / 512) + EPS);
            u32x4 w; w.x = pk2(vq[0] * rs * qg[0], vq[1] * rs * qg[1]); w.y = pk2(vq[2] * rs * qg[2], vq[3] * rs * qg[3]); w.z = pk2(vq[4] * rs * qg[4], vq[5] * rs * qg[5]); w.w = pk2(vq[6] * rs * qg[6], vq[7] * rs * qg[7]);
            *(u32x4*)(ur + UC_QLAT + 8 * F.lane) = w;
        }
        {
            const float rs = fast_rsqrt(sc_ * (1.0f / 512) + EPS);
#pragma unroll
            for (int j = 0; j < 8; ++j) vc[j] = vc[j] * rs * kg[j];
            float* o = (smp ? o_sckv + (size_t)mi * 512 : o_pckv + (size_t)m * 512) + 8 * F.lane;
            *(f32x4*)o = (f32x4){vc[0], vc[1], vc[2], vc[3]}; *(f32x4*)(o + 4) = (f32x4){vc[4], vc[5], vc[6], vc[7]};
            u32x4 w; w.x = pk2(vc[0], vc[1]); w.y = pk2(vc[2], vc[3]); w.z = pk2(vc[4], vc[5]); w.w = pk2(vc[6], vc[7]);
            *(u32x4*)(CKV + (size_t)kr * 512 + 8 * F.lane) = w;
        }
        if (F.lane < 32) {
            const float o1 = x1 * cs.x - x2 * cs.y, o2 = x2 * cs.x + x1 * cs.y;
            float* o = smp ? o_skpe + (size_t)mi * 64 : o_pkpe + (size_t)m * 64; o[F.lane] = o1; o[32 + F.lane] = o2;
            const unsigned w = pk2(o1, o2);
#pragma unroll
            for (int h = 0; h < 8; ++h) *(unsigned*)(KM + ((size_t)kr * 8 + h) * 192 + 128 + 2 * F.lane) = w;
        }
        if (F.lane < 8) {
            const float lf = -softplusf_(-(uff + fb));
            (smp ? o_slf + (size_t)mi * 8 : o_plf + (size_t)m * 8)[F.lane] = lf; LOGF[(size_t)kr * 8 + F.lane] = lf;
        }
        if (F.lane < 16) DTB[(size_t)m * 16 + F.lane] = softplusf_(udt + db);
        if (!smp) {
            if ((F.lane & 7) == 0) { const int hh = F.lane >> 3;
                atomicMax(ctl + CW_QN2 + (layer * 64 + (m >> 8)) * 8 + hh, __float_as_uint(nq));
                atomicMax(ctl + CW_KN2 + (layer * 64 + (m >> 8)) * 8 + hh, __float_as_uint(nk)); }
        } else {
            bf16_t* kd = KFS + (size_t)(kr - MP) * 1024 + 16 * F.lane; *(u32x4*)kd = fk0; *(u32x4*)(kd + 8) = fk1;
        }
        {
            int slot = -1; float* od = nullptr;
            if (!smp) { if (m >= MP - 3) { slot = m - (MP - 3); od = o_pconv; } }
            else { const int t = mi & 15; if (t >= 13) { slot = t - 13; od = o_sconv + (size_t)(mi >> 4) * 3 * 1536; } }
            if (slot >= 0) { for (int c = F.lane; c < 1536; c += 64) od[slot * 1536 + c] = bf2f(ur[UC_XBC + c]); }
        }
    }
    {
        bf16_t* XC = (bf16_t*)(p.ws() + WS_XN);
        const float* cw = p.in(I_CW) + (size_t)layer * 4 * 1536; const float* cb = p.in(I_CB) + (size_t)layer * 1536; const float* cst = p.in(I_CONV) + (size_t)layer * NB * 3 * 1536;
        const size_t gt = (size_t)F.gw * 64 + F.lane, NT = (size_t)F.NGW * 64;
        constexpr int STRIP = 25, NSTRIP = (MP + STRIP - 1) / STRIP;
        for (size_t it = gt; it < (size_t)NSTRIP * 192; it += NT) { const int strip = (int)(it / 192), ch0 = (int)(it % 192) * 8; const int r0 = strip * STRIP;
            float wt[4][8], bs[8];
            { const f32x4 b0 = *(const f32x4*)(cb + ch0), b1 = *(const f32x4*)(cb + ch0 + 4); bs[0] = b0[0]; bs[1] = b0[1]; bs[2] = b0[2]; bs[3] = b0[3]; bs[4] = b1[0]; bs[5] = b1[1]; bs[6] = b1[2]; bs[7] = b1[3]; }
#pragma unroll
            for (int k = 0; k < 4; ++k) { const f32x4 w0 = *(const f32x4*)(cw + k * 1536 + ch0), w1 = *(const f32x4*)(cw + k * 1536 + ch0 + 4);
                wt[k][0] = w0[0]; wt[k][1] = w0[1]; wt[k][2] = w0[2]; wt[k][3] = w0[3]; wt[k][4] = w1[0]; wt[k][5] = w1[1]; wt[k][6] = w1[2]; wt[k][7] = w1[3]; }
            const bf16_t* up = U + UC_XBC + ch0;
            u32x4 win[3];
#pragma unroll
            for (int k = 0; k < 3; ++k) { const int rr = r0 - 3 + k; u32x4 z = {0u, 0u, 0u, 0u}; if (rr >= 0) z = *(const u32x4*)(up + (size_t)rr * LDU); win[k] = z; }
#pragma unroll 1
            for (int rb = 0; rb < STRIP; rb += 5) {
                u32x4 nw[5];
#pragma unroll
                for (int e = 0; e < 5; ++e) { const int rr = r0 + rb + e; nw[e] = (rr < MP) ? *(const u32x4*)(up + (size_t)rr * LDU) : (u32x4){0u, 0u, 0u, 0u}; }
#pragma unroll
                for (int e = 0; e < 5; ++e) { const int rr = r0 + rb + e;
                    float x0[8], x1[8], x2[8], x3[8]; unpack8(win[0], x0); unpack8(win[1], x1); unpack8(win[2], x2); unpack8(nw[e], x3);
                    float acc[8];
#pragma unroll
                    for (int j = 0; j < 8; ++j) acc[j] = bs[j] + wt[0][j] * x0[j] + wt[1][j] * x1[j] + wt[2][j] * x2[j] + wt[3][j] * x3[j];
                    u32x4 o; o.x = pk2(siluf_(acc[0]), siluf_(acc[1])); o.y = pk2(siluf_(acc[2]), siluf_(acc[3])); o.z = pk2(siluf_(acc[4]), siluf_(acc[5])); o.w = pk2(siluf_(acc[6]), siluf_(acc[7]));
                    if (rr < MP) *(u32x4*)(XC + (size_t)rr * 1536 + ch0) = o;
                    win[0] = win[1]; win[1] = win[2]; win[2] = nw[e]; }
            }
        }
        for (size_t i = gt; i < (size_t)MS * 192; i += NT) { const int m = MP + (int)(i / 192), ch0 = (int)(i % 192) * 8;
            const int t = (m - MP) & 15;
            float acc[8];
            { const f32x4 b0 = *(const f32x4*)(cb + ch0), b1 = *(const f32x4*)(cb + ch0 + 4); acc[0] = b0[0]; acc[1] = b0[1]; acc[2] = b0[2]; acc[3] = b0[3]; acc[4] = b1[0]; acc[5] = b1[1]; acc[6] = b1[2]; acc[7] = b1[3]; }
#pragma unroll
            for (int k = 0; k < 4; ++k) { const int ii = t - 3 + k; float xv[8];
                if (ii >= 0) unpack8(*(const u32x4*)(U + (size_t)(m - 3 + k) * LDU + UC_XBC + ch0), xv);
                else { const float* sp = cst + ((size_t)((m - MP) >> 4) * 3 + (ii + 3)) * 1536 + ch0; const f32x4 s0 = *(const f32x4*)sp, s1 = *(const f32x4*)(sp + 4);
                    xv[0] = s0[0]; xv[1] = s0[1]; xv[2] = s0[2]; xv[3] = s0[3]; xv[4] = s1[0]; xv[5] = s1[1]; xv[6] = s1[2]; xv[7] = s1[3]; }
                const f32x4 w0 = *(const f32x4*)(cw + k * 1536 + ch0), w1 = *(const f32x4*)(cw + k * 1536 + ch0 + 4);
                acc[0] += w0[0] * xv[0]; acc[1] += w0[1] * xv[1]; acc[2] += w0[2] * xv[2]; acc[3] += w0[3] * xv[3];
                acc[4] += w1[0] * xv[4]; acc[5] += w1[1] * xv[5]; acc[6] += w1[2] * xv[6]; acc[7] += w1[3] * xv[7]; }
            u32x4 o; o.x = pk2(siluf_(acc[0]), siluf_(acc[1])); o.y = pk2(siluf_(acc[2]), siluf_(acc[3])); o.z = pk2(siluf_(acc[4]), siluf_(acc[5])); o.w = pk2(siluf_(acc[6]), siluf_(acc[7]));
            *(u32x4*)(XC + (size_t)m * 1536 + ch0) = o; }
    }
    {
        constexpr int PITCH = 72;
        LAS bf16_t* tile = (LAS bf16_t*)(F.lds + F.wave * (64 * PITCH * 2));
        for (int it = F.gw; it < (MP / 64) * 16; it += F.NGW) {
            const int rt = it >> 4, ct = it & 15, row0 = rt * 64, ch0 = ct * 64;
            u32x4 v[8];
#pragma unroll
            for (int k = 0; k < 8; ++k) { const int r = 8 * k + (F.lane >> 3), c8 = F.lane & 7; v[k] = *(const u32x4*)(U + (size_t)(row0 + r) * LDU + UC_FV + ch0 + 8 * c8); }
#pragma unroll
            for (int k = 0; k < 8; ++k) { const int r = 8 * k + (F.lane >> 3), c8 = F.lane & 7; bf16_t e8[8]; *(u32x4*)e8 = v[k];
#pragma unroll
                for (int e = 0; e < 8; ++e) tile[(8 * c8 + e) * PITCH + r] = e8[e]; }
            LDS_WAIT(); asm volatile("" ::: "memory");
#pragma unroll
            for (int k = 0; k < 8; ++k) { const int ch = 8 * k + (F.lane >> 3), r8 = F.lane & 7; const u32x4 w = *(const LAS u32x4*)(tile + ch * PITCH + 8 * r8);
                *(u32x4*)(VTF + (size_t)(ch0 + ch) * KVROWS + row0 + 8 * r8) = w; }
            LDS_WAIT(); asm volatile("" ::: "memory");
        }
        const size_t gt = (size_t)F.gw * 64 + F.lane, NT = (size_t)F.NGW * 64;
        for (size_t i = gt; i < (size_t)MS * 1024; i += NT) { const int mi = (int)(i >> 10), ch = (int)(i & 1023);
            VTF[(size_t)ch * KVROWS + kvrow_of(MP + mi)] = U[(size_t)(MP + mi) * LDU + UC_FV + ch]; }
    }
}

__device__ __forceinline__ void phase_t2(const Params&, const Frame& F0) {
    const Frame F = mk_frame(F0.wave);
    const PV p = pv_get();
    const float* LOGF = (const float*)(p.ws() + WS_LOGF); float* CUM = (float*)(p.ws() + WS_CUM);
    LAS double* wt = (LAS double*)F.lds;
    for (int job = (F.G == 256) ? (F.bx + 56) % 256 : F.bx; job < 1 + NB; job += F.G) {
        const int base = job == 0 ? 0 : MP + (job - 1) * KVS, n = job == 0 ? MP : KVS;
        const int per = (n + 511) / 512, i0 = F.tid * per, i1 = (i0 + per < n) ? i0 + per : n;
        double s[8];
#pragma unroll
        for (int h = 0; h < 8; ++h) s[h] = 0.0;
        for (int i = i0; i < i1; ++i) { const f32x4 a = *(const f32x4*)(LOGF + (size_t)(base + i) * 8), b = *(const f32x4*)(LOGF + (size_t)(base + i) * 8 + 4);
            s[0] += a[0]; s[1] += a[1]; s[2] += a[2]; s[3] += a[3]; s[4] += b[0]; s[5] += b[1]; s[6] += b[2]; s[7] += b[3]; }
        double pre[8];
#pragma unroll
        for (int h = 0; h < 8; ++h) { double v = s[h];
#pragma unroll
            for (int o = 1; o < 64; o <<= 1) { const long long vb = __builtin_bit_cast(long long, v); const int src = ((F.lane - o) & 63) << 2;
                const unsigned lo_ = (unsigned)__builtin_amdgcn_ds_bpermute(src, (int)(unsigned)vb), hi_ = (unsigned)__builtin_amdgcn_ds_bpermute(src, (int)(unsigned)(vb >> 32));
                const double t = __builtin_bit_cast(double, ((unsigned long long)hi_ << 32) | lo_); if (F.lane >= o) v += t; }
            pre[h] = v - s[h]; if (F.lane == 63) wt[F.wave * 8 + h] = v; }
        __syncthreads();
#pragma unroll
        for (int h = 0; h < 8; ++h) { double off = 0.0; for (int ww = 0; ww < F.wave; ++ww) off += wt[ww * 8 + h]; pre[h] += off; }
        for (int i = i0; i < i1; ++i) { const f32x4 a = *(const f32x4*)(LOGF + (size_t)(base + i) * 8), b = *(const f32x4*)(LOGF + (size_t)(base + i) * 8 + 4);
            pre[0] += a[0]; pre[1] += a[1]; pre[2] += a[2]; pre[3] += a[3]; pre[4] += b[0]; pre[5] += b[1]; pre[6] += b[2]; pre[7] += b[3];
            *(f32x4*)(CUM + (size_t)(base + i) * 8) = (f32x4){(float)pre[0] * LOG2E, (float)pre[1] * LOG2E, (float)pre[2] * LOG2E, (float)pre[3] * LOG2E};
            *(f32x4*)(CUM + (size_t)(base + i) * 8 + 4) = (f32x4){(float)pre[4] * LOG2E, (float)pre[5] * LOG2E, (float)pre[6] * LOG2E, (float)pre[7] * LOG2E}; }
        __syncthreads();
    }
}

#define MFMA32(a, b, c) __builtin_amdgcn_mfma_f32_32x32x16_bf16((a), (b), (c), 0, 0, 0)
__device__ __forceinline__ int crow(int r, int hi) { return (r & 3) + 8 * (r >> 2) + 4 * hi; }
struct AttnSeq {
    const bf16_t* Q; int qs;
    const bf16_t* K; int ks;
    const bf16_t* VT;
    bf16_t* O; int os;
    const float* cq; const float* ck;
};
__device__ __forceinline__ void softmax_tile(f32x16& s0, f32x16& s1, float& m, float& l, f32x16 (&o)[4], bf16x8 (&pa)[4]) {
    float pmax = s0[0];
#pragma unroll
    for (int r = 1; r < 16; ++r) pmax = fmaxf(pmax, s0[r]);
#pragma unroll
    for (int r = 0; r < 16; ++r) pmax = fmaxf(pmax, s1[r]);
    { auto rr = __builtin_amdgcn_permlane32_swap(__float_as_uint(pmax), __float_as_uint(pmax), false, false);
      pmax = fmaxf(__uint_as_float(rr[0]), __uint_as_float(rr[1])); }
    const bool resc = !__all(pmax - m <= 8.0f);
    const float mn = resc ? fmaxf(m, pmax) : m;
    const float alpha = resc ? fast_exp2(m - mn) : 1.0f; m = mn;
    float ps = 0.f;
#pragma unroll
    for (int r = 0; r < 16; ++r) { s0[r] = fast_exp2(s0[r] - mn); ps += s0[r]; }
#pragma unroll
    for (int r = 0; r < 16; ++r) { s1[r] = fast_exp2(s1[r] - mn); ps += s1[r]; }
    { auto rr = __builtin_amdgcn_permlane32_swap(__float_as_uint(ps), __float_as_uint(ps), false, false);
      ps = __uint_as_float(rr[0]) + __uint_as_float(rr[1]); }
    l = l * alpha + ps;
    if (resc) {
#pragma unroll
        for (int d = 0; d < 4; ++d)
#pragma unroll
            for (int r = 0; r < 16; ++r) o[d][r] *= alpha;
    }
#define PK4(P, B_, OUT) do { const unsigned a0 = pk2(P[B_ + 0], P[B_ + 1]), a1 = pk2(P[B_ + 2], P[B_ + 3]), b0 = pk2(P[B_ + 4], P[B_ + 5]), b1 = pk2(P[B_ + 6], P[B_ + 7]); \
        auto r0 = __builtin_amdgcn_permlane32_swap(a0, b0, false, false); auto r1 = __builtin_amdgcn_permlane32_swap(a1, b1, false, false); \
        u32x4 w_ = {r0[0], r1[0], r0[1], r1[1]}; OUT = __builtin_bit_cast(bf16x8, w_); } while (0)
    PK4(s0, 0, pa[0]); PK4(s0, 8, pa[1]); PK4(s1, 0, pa[2]); PK4(s1, 8, pa[3]);
#undef PK4
}
__device__ __forceinline__ void store_o(const f32x16 (&o)[4], float inv, bf16_t* orow, int hi) {
#pragma unroll
    for (int d = 0; d < 4; ++d)
#pragma unroll
        for (int rq = 0; rq < 4; ++rq) { u32x2 w; w.x = pk2(o[d][4 * rq] * inv, o[d][4 * rq + 1] * inv); w.y = pk2(o[d][4 * rq + 2] * inv, o[d][4 * rq + 3] * inv);
            *(u32x2*)(orow + 32 * d + 8 * rq + 4 * hi) = w; }
}

template <int DQK, bool FOX>
__device__ __forceinline__ void attn_prefill_unit(LAS unsigned char* lds, const AttnSeq& a, int qb, int tid0, float bound2 = 0.f) {
    int tid = tid0; asm volatile("" : "+v"(tid));
    constexpr int RB = DQK * 2, CPR = DQK / 8, KBUF = 64 * RB, NKI = DQK / 64, NKS = DQK / 16;
    constexpr int OFF_V = 2 * KBUF, OFF_CK = OFF_V + 2 * 16384, OFF_QR = OFF_CK + 1024;
    constexpr int NQR = NKS;
    static_assert(OFF_QR + 8 * 4096 <= LDSCTL_OFF, "attention LDS map");
    const int w = __builtin_amdgcn_readfirstlane(tid >> 6), lane = tid & 63, c = lane & 31, hi = lane >> 5;
    const int q0w = qb * 256 + 32 * w, qrow = q0w + c;
    const int last_tile = q0w >> 6, ntiles = 4 * qb + 4;
    int jmin = 0;
    if (FOX) {
        LAS int* jm = (LAS int*)(lds + 2 * KBUF + 2 * 16384 + 512);
        if (tid == 0) *jm = ntiles - 1;
        __syncthreads();
        if (tid < ntiles) { const float d = a.cq[(size_t)(qb * 256) * 8] - a.ck[(size_t)(tid * 64 + 63) * 8];
            if (!(d + bound2 < -40.f)) __hip_atomic_fetch_min(jm, tid, __ATOMIC_RELAXED, __HIP_MEMORY_SCOPE_WORKGROUP); }
        __syncthreads();
        jmin = __builtin_amdgcn_readfirstlane(*jm);
    }
    int koff[NKI], voff[2];
#pragma unroll
    for (int i = 0; i < NKI; ++i) { const int s = (i * 8 + w) * 64 + lane, row = s / CPR, cp = s % CPR;
        const int ch = (DQK == 128) ? (cp ^ (row & 15)) : ((cp & ~7) | ((cp & 7) ^ ((row >> 1) & 7)));
        koff[i] = row * a.ks + ch * 8; }
#pragma unroll
    for (int i = 0; i < 2; ++i) { const int s = (i * 8 + w) * 64 + lane, d = s >> 3, cp = s & 7; voff[i] = d * KVROWS + ((cp ^ ((d >> 1) & 7)) * 8); }
    const int krow_b = c * RB;
    const int vsw = (c >> 1) & 7;
    bf16x8 qf[NQR];
    { const bf16_t* qp = a.Q + (size_t)qrow * a.qs + 8 * hi;
#pragma unroll
      for (int ks = 0; ks < NQR; ++ks) qf[ks] = *(const bf16x8*)(qp + 16 * ks);
      if (DQK == 192) {
#pragma unroll
          for (int ks = 8; ks < NKS; ++ks) *(LAS bf16x8*)(lds + OFF_QR + w * 4096 + c * 128 + (((2 * (ks - 8) + hi) ^ vsw) * 16)) = *(const bf16x8*)(qp + 16 * ks); } }
    float cq = 0.f; if (FOX) cq = a.cq[(size_t)qrow * 8];
    f32x16 o[4];
#pragma unroll
    for (int d = 0; d < 4; ++d)
#pragma unroll
        for (int r = 0; r < 16; ++r) o[d][r] = 0.f;
    float m = -1e30f, l = 0.f;
#define ATT_ISSUE(j_, b_) do { const bf16_t* kb_ = a.K + (size_t)(j_) * 64 * a.ks; const bf16_t* vb_ = a.VT + (size_t)(j_) * 64; \
        _Pragma("unroll") for (int i_ = 0; i_ < NKI; ++i_) __builtin_amdgcn_global_load_lds((const unsigned*)(kb_ + koff[i_]), (LAS unsigned*)(lds + (b_) * KBUF + (i_ * 8 + w) * 1024), 16, 0, 0); \
        _Pragma("unroll") for (int i_ = 0; i_ < 2; ++i_) __builtin_amdgcn_global_load_lds((const unsigned*)(vb_ + voff[i_]), (LAS unsigned*)(lds + OFF_V + (b_) * 16384 + (i_ * 8 + w) * 1024), 16, 0, 0); } while (0)
    ATT_ISSUE(jmin, jmin & 1);
    float ckn = 0.f;
    if (FOX && w == 0) { ckn = a.ck[(size_t)(jmin * 64 + lane) * 8]; ((LAS float*)(lds + OFF_CK))[(jmin & 1) * 64 + lane] = ckn; }
    for (int j = jmin; j < ntiles; ++j) {
        const int b = j & 1;
        VM_WAIT();
        __syncthreads();
        if (j + 1 < ntiles) { ATT_ISSUE(j + 1, b ^ 1); if (FOX && w == 0) ckn = a.ck[(size_t)((j + 1) * 64 + lane) * 8]; }
        if (j <= last_tile) {
            const LAS unsigned char* kb = lds + b * KBUF; const LAS unsigned char* vb = lds + OFF_V + b * 16384;
            f32x16 s0, s1;
#pragma unroll
            for (int r = 0; r < 16; ++r) { s0[r] = 0.f; s1[r] = 0.f; }
            constexpr int NB4 = NKS / 4;
            bf16x8 kfa[2][4], kfb[2][4];
#define ATT_LDK(dst, b4) do { _Pragma("unroll") for (int e_ = 0; e_ < 4; ++e_) { const int ks_ = 4 * (b4) + e_, ch_ = 2 * ks_ + hi; \
                const int cp_ = (DQK == 128) ? (ch_ ^ (c & 15)) : ((ch_ & ~7) | ((ch_ & 7) ^ ((c >> 1) & 7))); \
                dst[0][e_] = *(const LAS bf16x8*)(kb + krow_b + cp_ * 16); dst[1][e_] = *(const LAS bf16x8*)(kb + 32 * RB + krow_b + cp_ * 16); } } while (0)
#define ATT_MMK(src, b4) do { _Pragma("unroll") for (int e_ = 0; e_ < 4; ++e_) { const int ks_ = 4 * (b4) + e_; \
                bf16x8 qv_; if (ks_ < NQR) qv_ = qf[ks_ < NQR ? ks_ : 0]; else qv_ = *(const LAS bf16x8*)(lds + OFF_QR + w * 4096 + c * 128 + (((2 * (ks_ - 8) + hi) ^ vsw) * 16)); \
                s0 = MFMA32(src[0][e_], qv_, s0); s1 = MFMA32(src[1][e_], qv_, s1); } } while (0)
            ATT_LDK(kfa, 0);
            __builtin_amdgcn_sched_barrier(0);
            ATT_LDK(kfb, 1);
            __builtin_amdgcn_sched_barrier(0);
            ATT_MMK(kfa, 0);
            __builtin_amdgcn_sched_barrier(0);
            if (NB4 > 2) { ATT_LDK(kfa, 2 < NB4 ? 2 : 0); }
            __builtin_amdgcn_sched_barrier(0);
            ATT_MMK(kfb, 1);
            __builtin_amdgcn_sched_barrier(0);
            if (NB4 > 2) { ATT_MMK(kfa, 2 < NB4 ? 2 : 0); }
            __builtin_amdgcn_sched_barrier(0);
#undef ATT_LDK
#undef ATT_MMK
            if (FOX) {
                const LAS float* ckb = (const LAS float*)(lds + OFF_CK) + b * 64;
#pragma unroll
                for (int r = 0; r < 16; ++r) { s0[r] += cq - ckb[crow(r, hi)]; s1[r] += cq - ckb[32 + crow(r, hi)]; }
                if (j == last_tile) { const int dq = qrow - j * 64;
#pragma unroll
                    for (int r = 0; r < 16; ++r) { if (crow(r, hi) > dq) s0[r] = -__builtin_inff(); if (32 + crow(r, hi) > dq) s1[r] = -__builtin_inff(); } }
            }
            bf16x8 pa[4];
            softmax_tile(s0, s1, m, l, o, pa);
            {
                bf16x8 va[2][4], vb2[2][4];
#define ATT_LDV(dst, k0_) do { _Pragma("unroll") for (int kk_ = 0; kk_ < 2; ++kk_) _Pragma("unroll") for (int d_ = 0; d_ < 4; ++d_) { const int cp_ = (2 * ((k0_) + kk_) + hi) ^ vsw; \
                    dst[kk_][d_] = *(const LAS bf16x8*)(vb + (32 * d_ + c) * 128 + cp_ * 16); } } while (0)
#define ATT_MMV(src, k0_) do { _Pragma("unroll") for (int kk_ = 0; kk_ < 2; ++kk_) _Pragma("unroll") for (int d_ = 0; d_ < 4; ++d_) o[d_] = MFMA32(src[kk_][d_], pa[(k0_) + kk_], o[d_]); } while (0)
                ATT_LDV(va, 0);
                __builtin_amdgcn_sched_barrier(0);
                ATT_LDV(vb2, 2);
                __builtin_amdgcn_sched_barrier(0);
                ATT_MMV(va, 0);
                __builtin_amdgcn_sched_barrier(0);
                ATT_MMV(vb2, 2);
#undef ATT_LDV
#undef ATT_MMV
            }
        }
        if (FOX && w == 0 && j + 1 < ntiles) ((LAS float*)(lds + OFF_CK))[(b ^ 1) * 64 + lane] = ckn;
    }
#undef ATT_ISSUE
    store_o(o, __builtin_amdgcn_rcpf(l), a.O + (size_t)qrow * a.os, hi);
    __syncthreads();
}

template <int DQK, bool FOX>
__device__ __forceinline__ void attn_decode_unit(LAS unsigned char* lds, const AttnSeq& a, int tid0) {
    int tid = tid0; asm volatile("" : "+v"(tid));
    constexpr int NKS = DQK / 16;
    const int w = __builtin_amdgcn_readfirstlane(tid >> 6), lane = tid & 63, c = lane & 31, hi = lane >> 5, t = c & 15;
    bf16x8 qf[NKS];
    { const bf16_t* qp = a.Q + (size_t)t * a.qs + 8 * hi;
#pragma unroll
      for (int ks = 0; ks < NKS; ++ks) qf[ks] = *(const bf16x8*)(qp + 16 * ks); }
    float cq = 0.f; if (FOX) cq = a.cq[(size_t)t * 8];
    f32x16 o[4];
#pragma unroll
    for (int d = 0; d < 4; ++d)
#pragma unroll
        for (int r = 0; r < 16; ++r) o[d][r] = 0.f;
    float m = -1e30f, l = 0.f;
    const int lim = FOX ? PAST + t : KVLEN_S - 1;
    for (int j = w; j < KVS / 64; j += 8) {
        f32x16 s0, s1;
#pragma unroll
        for (int r = 0; r < 16; ++r) { s0[r] = 0.f; s1[r] = 0.f; }
        const bf16_t* kp = a.K + (size_t)(j * 64 + c) * a.ks + 8 * hi;
#pragma unroll
        for (int ks = 0; ks < NKS; ++ks) {
            if ((ks & 3) == 0) __builtin_amdgcn_sched_barrier(0);
            const bf16x8 k0 = *(const bf16x8*)(kp + 16 * ks), k1 = *(const bf16x8*)(kp + (size_t)32 * a.ks + 16 * ks);
            s0 = MFMA32(k0, qf[ks], s0); s1 = MFMA32(k1, qf[ks], s1);
        }
#pragma unroll
        for (int r = 0; r < 16; ++r) { const int k0i = j * 64 + crow(r, hi), k1i = k0i + 32;
            if (FOX) { s0[r] += cq - a.ck[(size_t)k0i * 8]; s1[r] += cq - a.ck[(size_t)k1i * 8]; }
            if (k0i > lim) s0[r] = -__builtin_inff(); if (k1i > lim) s1[r] = -__builtin_inff(); }
        bf16x8 pa[4];
        softmax_tile(s0, s1, m, l, o, pa);
#pragma unroll
        for (int d = 0; d < 4; ++d) {
            __builtin_amdgcn_sched_barrier(0);
#pragma unroll
            for (int ks = 0; ks < 4; ++ks) { const bf16x8 vf = *(const bf16x8*)(a.VT + (size_t)(32 * d + c) * KVROWS + j * 64 + 16 * ks + 8 * hi);
                o[d] = MFMA32(vf, pa[ks], o[d]); } }
    }
    LAS float* Ot = (LAS float*)lds; LAS float* ML = (LAS float*)(lds + 8 * 128 * 16 * 4);
    if (c < 16) {
#pragma unroll
        for (int d = 0; d < 4; ++d)
#pragma unroll
            for (int r = 0; r < 16; ++r) Ot[(w * 128 + 32 * d + crow(r, hi)) * 16 + c] = o[d][r];
        if (hi == 0) { ML[(w * 16 + c) * 2] = m; ML[(w * 16 + c) * 2 + 1] = l; }
    }
    __syncthreads();
    { const int q = tid & 15, dg = tid >> 4;
      float M = -1e30f;
#pragma unroll
      for (int ww = 0; ww < 8; ++ww) M = fmaxf(M, ML[(ww * 16 + q) * 2]);
      float L = 0.f, acc[4] = {0.f, 0.f, 0.f, 0.f};
#pragma unroll
      for (int ww = 0; ww < 8; ++ww) { const float f = fast_exp2(ML[(ww * 16 + q) * 2] - M); L += ML[(ww * 16 + q) * 2 + 1] * f;
#pragma unroll
          for (int e = 0; e < 4; ++e) acc[e] += Ot[(ww * 128 + 4 * dg + e) * 16 + q] * f; }
      const float inv = __builtin_amdgcn_rcpf(L);
      u32x2 wv; wv.x = pk2(acc[0] * inv, acc[1] * inv); wv.y = pk2(acc[2] * inv, acc[3] * inv);
      *(u32x2*)(a.O + (size_t)q * a.os + 4 * dg) = wv; }
    __syncthreads();
}
#define MFMA16(a, b, c) __builtin_amdgcn_mfma_f32_16x16x32_bf16((a), (b), (c), 0, 0, 0)
constexpr int SSD_XP = 72;
constexpr int SSD_BP = 136;
__device__ __forceinline__ void ssd_dt_acs(const Frame& F, const float* DTB, int m0, int L, int g, float a_neg  , LAS float* Dt, LAS float* Ac) {
    { const int l = F.tid >> 3, h = F.tid & 7; Dt[F.tid] = (l < L) ? DTB[(size_t)(m0 + l) * 16 + 8 * g + h] : 0.f; }
    __syncthreads();
    if (F.tid < 8) { float acs = 0.f; for (int l = 0; l < 64; ++l) { acs += Dt[l * 8 + F.tid] * a_neg; Ac[l * 8 + F.tid] = acs; } }
    __syncthreads();
}
__device__ __forceinline__ void phase_s1(const Params&, const Frame& F0, int layer0) {
    const Frame F = mk_frame(F0.wave);
    const PV p = pv_get(); int layer = layer0; asm volatile("" : "+s"(layer));
    const bf16_t* XC = (const bf16_t*)(p.ws() + WS_XN);
    const float* DTB = (const float*)(p.ws() + WS_DT); float* ST = (float*)(p.ws() + WS_ST); float* CDEC = (float*)(p.ws() + WS_CDEC);
    LAS float* Dt = (LAS float*)F.lds; LAS float* Ac = (LAS float*)(F.lds + 2048);
    LAS bf16_t* BT = (LAS bf16_t*)(F.lds + 4096);
    LAS bf16_t* XT = (LAS bf16_t*)(F.lds + 4096 + 128 * SSD_XP * 2) + F.wave * 64 * SSD_XP;
    const int w = F.wave, lane = F.lane, fr = lane & 15, q = lane >> 4;
    for (int unit = (F.G == 256) ? (F.bx + 88) % 256 : F.bx; unit < NCHUNK * 2; unit += F.G) {
        const int ci = unit >> 1, g = unit & 1; const bool smp = ci >= 256; const int L = smp ? 16 : 64; const int m0 = smp ? MP + (ci - 256) * 16 : ci * 64;
        const int head = 8 * g + w;
        const float a_neg = (F.tid < 8) ? -fast_exp(p.in(I_ALOG)[layer * 16 + 8 * g + F.tid]) : 0.f;
        ssd_dt_acs(F, DTB, m0, L, g, a_neg, Dt, Ac);
        const float alast = Ac[63 * 8 + w];
        if (lane == 0) CDEC[ci * 16 + head] = fast_exp(alast);
        for (int idx = F.tid; idx < 64 * 16; idx += 512) { const int l = idx >> 4, n8 = idx & 15; bf16_t v[8];
            if (l < L) *(u32x4*)v = *(const u32x4*)(XC + (size_t)(m0 + l) * 1536 + 1024 + 128 * g + 8 * n8); else *(u32x4*)v = (u32x4){0u, 0u, 0u, 0u};
#pragma unroll
            for (int e = 0; e < 8; ++e) BT[(8 * n8 + e) * SSD_XP + l] = v[e]; }
#pragma unroll
        for (int it = 0; it < 8; ++it) { const int l = 8 * it + (lane >> 3), p8 = lane & 7; float xv[8];
            if (l < L) unpack8(*(const u32x4*)(XC + (size_t)(m0 + l) * 1536 + head * 64 + 8 * p8), xv); else { for (int e = 0; e < 8; ++e) xv[e] = 0.f; }
            const float wgt = fast_exp(alast - Ac[l * 8 + w]) * Dt[l * 8 + w];
#pragma unroll
            for (int e = 0; e < 8; ++e) XT[(8 * p8 + e) * SSD_XP + l] = f2bf(xv[e] * wgt); }
        __syncthreads();
#pragma unroll 1
        for (int nh = 0; nh < 2; ++nh) {
            f32x4 acc[4][4];
#pragma unroll
            for (int nb = 0; nb < 4; ++nb)
#pragma unroll
                for (int pb = 0; pb < 4; ++pb) acc[nb][pb] = (f32x4){0.f, 0.f, 0.f, 0.f};
#pragma unroll
            for (int ks = 0; ks < 2; ++ks) {
                bf16x8 xf[4];
#pragma unroll
                for (int pb = 0; pb < 4; ++pb) xf[pb] = *(const LAS bf16x8*)(XT + (16 * pb + fr) * SSD_XP + 32 * ks + 8 * q);
#pragma unroll
                for (int nb = 0; nb < 4; ++nb) { const bf16x8 bf = *(const LAS bf16x8*)(BT + (64 * nh + 16 * nb + fr) * SSD_XP + 32 * ks + 8 * q);
#pragma unroll
                    for (int pb = 0; pb < 4; ++pb) acc[nb][pb] = MFMA16(bf, xf[pb], acc[nb][pb]); }
            }
            float* so = ST + (size_t)(ci * 16 + head) * 8192;
#pragma unroll
            for (int nb = 0; nb < 4; ++nb)
#pragma unroll
                for (int pb = 0; pb < 4; ++pb) *(f32x4*)(so + (size_t)(16 * pb + fr) * 128 + 64 * nh + 16 * nb + 4 * q) = acc[nb][pb];
        }
        __syncthreads();
    }
}
__device__ __forceinline__ void phase_s2(const Params&, const Frame& F0, int layer0) {
    const Frame F = mk_frame(F0.wave);
    const PV p = pv_get(); int layer = layer0; asm volatile("" : "+s"(layer));
    float* ST = (float*)(p.ws() + WS_ST); const float* CDEC = (const float*)(p.ws() + WS_CDEC);
    float* o_p = p.out() + O_PSSM + (size_t)layer * 131072; float* o_s = p.out() + O_SSSM + (size_t)layer * NB * 131072;
    const float* h0s = p.in(I_SSM) + (size_t)layer * NB * 131072;
    const size_t gt = (size_t)F.bx * 512 + F.tid, NT = (size_t)F.G * 512;
    for (size_t e = gt; e < 131072; e += NT) { const int head = (int)(e >> 13);
        float h = 0.f;
        for (int c0 = 0; c0 < 256; c0 += 32) { float tv[32], dv[32];
#pragma unroll
            for (int i = 0; i < 32; ++i) { tv[i] = ST[(size_t)(c0 + i) * 131072 + e]; dv[i] = CDEC[(c0 + i) * 16 + head]; }
#pragma unroll
            for (int i = 0; i < 32; ++i) { ST[(size_t)(c0 + i) * 131072 + e] = h; h = h * dv[i] + tv[i]; } }
        o_p[e] = h; }
    for (size_t i = gt; i < (size_t)NB * 131072; i += NT) { const int b = (int)(i >> 17); const size_t e = i & 131071; const int head = (int)(e >> 13), ci = 256 + b;
        const float h0 = h0s[i], tv = ST[(size_t)ci * 131072 + e];
        ST[(size_t)ci * 131072 + e] = h0; o_s[i] = h0 * CDEC[ci * 16 + head] + tv; }
}
__device__ __forceinline__ void phase_s3(const Params&, const Frame& F0, int layer0) {
    const Frame F = mk_frame(F0.wave);
    const PV p = pv_get(); int layer = layer0; asm volatile("" : "+s"(layer));
    const bf16_t* XC = (const bf16_t*)(p.ws() + WS_XN); bf16_t* U = (bf16_t*)(p.ws() + WS_U);
    const float* DTB = (const float*)(p.ws() + WS_DT); const float* ST = (const float*)(p.ws() + WS_ST);
    LAS float* Dt = (LAS float*)F.lds; LAS float* Ac = (LAS float*)(F.lds + 2048); LAS float* Rs = (LAS float*)(F.lds + 4096);
    LAS bf16_t* Bs = (LAS bf16_t*)(F.lds + 4608);
    LAS bf16_t* Cs = (LAS bf16_t*)(F.lds + 4608 + 64 * SSD_BP * 2);
    LAS bf16_t* XT = (LAS bf16_t*)(F.lds + 4608 + 2 * 64 * SSD_BP * 2) + F.wave * 64 * SSD_XP;
    const int w = F.wave, lane = F.lane, fr = lane & 15, q = lane >> 4;
    for (int unit = F.bx; unit < NCHUNK * 2; unit += F.G) {
        const int ci = unit >> 1, g = unit & 1; const bool smp = ci >= 256; const int L = smp ? 16 : 64; const int m0 = smp ? MP + (ci - 256) * 16 : ci * 64;
        const int head = 8 * g + w;
        const float a_neg = (F.tid < 8) ? -fast_exp(p.in(I_ALOG)[layer * 16 + 8 * g + F.tid]) : 0.f;
        if (F.tid < 64) Rs[F.tid] = 0.f;
        ssd_dt_acs(F, DTB, m0, L, g, a_neg, Dt, Ac);
        for (int idx = F.tid; idx < 64 * 16; idx += 512) { const int l = idx >> 4, n8 = idx & 15; u32x4 vb = {0u, 0u, 0u, 0u}, vc = {0u, 0u, 0u, 0u};
            if (l < L) { const bf16_t* src = XC + (size_t)(m0 + l) * 1536 + 1024 + 128 * g + 8 * n8; vb = *(const u32x4*)src; vc = *(const u32x4*)(src + 256); }
            *(LAS u32x4*)(Bs + l * SSD_BP + 8 * n8) = vb; *(LAS u32x4*)(Cs + l * SSD_BP + 8 * n8) = vc; }
#pragma unroll
        for (int it = 0; it < 8; ++it) { const int l = 8 * it + (lane >> 3), p8 = lane & 7; bf16_t v[8];
            if (l < L) *(u32x4*)v = *(const u32x4*)(XC + (size_t)(m0 + l) * 1536 + head * 64 + 8 * p8); else *(u32x4*)v = (u32x4){0u, 0u, 0u, 0u};
#pragma unroll
            for (int e = 0; e < 8; ++e) XT[(8 * p8 + e) * SSD_XP + l] = v[e]; }
        __syncthreads();
        f32x4 gt[4][4];
#pragma unroll
        for (int sb = 0; sb < 4; ++sb)
#pragma unroll
            for (int lb = 0; lb < 4; ++lb) gt[sb][lb] = (f32x4){0.f, 0.f, 0.f, 0.f};
#pragma unroll
        for (int ks = 0; ks < 4; ++ks) { bf16x8 cf[4];
#pragma unroll
            for (int lb = 0; lb < 4; ++lb) cf[lb] = *(const LAS bf16x8*)(Cs + (16 * lb + fr) * SSD_BP + 32 * ks + 8 * q);
#pragma unroll
            for (int sb = 0; sb < 4; ++sb) { const bf16x8 bf = *(const LAS bf16x8*)(Bs + (16 * sb + fr) * SSD_BP + 32 * ks + 8 * q);
#pragma unroll
                for (int lb = 0; lb < 4; ++lb) gt[sb][lb] = MFMA16(bf, cf[lb], gt[sb][lb]); } }
        f32x4 acc[4][4];
#pragma unroll
        for (int pb = 0; pb < 4; ++pb)
#pragma unroll
            for (int lb = 0; lb < 4; ++lb) acc[pb][lb] = (f32x4){0.f, 0.f, 0.f, 0.f};
        const float* sth = ST + (size_t)(ci * 16 + head) * 8192;
#pragma unroll
        for (int ks = 0; ks < 4; ++ks) { bf16x8 cf[4];
#pragma unroll
            for (int lb = 0; lb < 4; ++lb) cf[lb] = *(const LAS bf16x8*)(Cs + (16 * lb + fr) * SSD_BP + 32 * ks + 8 * q);
#pragma unroll
            for (int pb = 0; pb < 4; ++pb) { const float* hp = sth + (size_t)(16 * pb + fr) * 128 + 32 * ks + 8 * q; const f32x4 h0 = *(const f32x4*)hp, h1 = *(const f32x4*)(hp + 4);
                u32x4 hw; hw.x = pk2(h0[0], h0[1]); hw.y = pk2(h0[2], h0[3]); hw.z = pk2(h1[0], h1[1]); hw.w = pk2(h1[2], h1[3]);
                const bf16x8 hf = __builtin_bit_cast(bf16x8, hw);
#pragma unroll
                for (int lb = 0; lb < 4; ++lb) acc[pb][lb] = MFMA16(hf, cf[lb], acc[pb][lb]); } }
        float al[4];
#pragma unroll
        for (int lb = 0; lb < 4; ++lb) { al[lb] = Ac[(16 * lb + fr) * 8 + w]; const float el = fast_exp(al[lb]);
#pragma unroll
            for (int pb = 0; pb < 4; ++pb) acc[pb][lb] = acc[pb][lb] * el; }
#pragma unroll
        for (int ks2 = 0; ks2 < 2; ++ks2) {
            float as_[2][4], ds_[2][4];
#pragma unroll
            for (int jh = 0; jh < 2; ++jh)
#pragma unroll
                for (int r = 0; r < 4; ++r) { const int s = 32 * ks2 + 16 * jh + 4 * q + r; as_[jh][r] = Ac[s * 8 + w]; ds_[jh][r] = Dt[s * 8 + w]; }
            bf16x8 mf[4];
#pragma unroll
            for (int lb = 0; lb < 4; ++lb) { const int l = 16 * lb + fr; float mv[8];
#pragma unroll
                for (int jh = 0; jh < 2; ++jh)
#pragma unroll
                    for (int r = 0; r < 4; ++r) { const int s = 32 * ks2 + 16 * jh + 4 * q + r;
                        mv[4 * jh + r] = (s <= l) ? gt[2 * ks2 + jh][lb][r] * fast_exp(al[lb] - as_[jh][r]) * ds_[jh][r] : 0.f; }
                u32x4 mw; mw.x = pk2(mv[0], mv[1]); mw.y = pk2(mv[2], mv[3]); mw.z = pk2(mv[4], mv[5]); mw.w = pk2(mv[6], mv[7]);
                mf[lb] = __builtin_bit_cast(bf16x8, mw); }
#pragma unroll
            for (int pb = 0; pb < 4; ++pb) { const LAS bf16_t* xp = XT + (16 * pb + fr) * SSD_XP + 32 * ks2 + 4 * q;
                const u32x2 x0 = *(const LAS u32x2*)xp, x1 = *(const LAS u32x2*)(xp + 16);
                const u32x4 xw = {x0.x, x0.y, x1.x, x1.y}; const bf16x8 xf = __builtin_bit_cast(bf16x8, xw);
#pragma unroll
                for (int lb = 0; lb < 4; ++lb) acc[pb][lb] = MFMA16(xf, mf[lb], acc[pb][lb]); }
        }
        const float dsk = p.in(I_SD)[layer * 16 + head];
        float sq[4] = {0.f, 0.f, 0.f, 0.f};
#pragma unroll
        for (int lb = 0; lb < 4; ++lb) { const int l = 16 * lb + fr; const bool ok = l < L;
#pragma unroll
            for (int pb = 0; pb < 4; ++pb) { const int pc = 16 * pb + 4 * q;
                u32x2 xw = {0u, 0u}, zw = {0u, 0u};
                if (ok) { xw = *(const u32x2*)(XC + (size_t)(m0 + l) * 1536 + head * 64 + pc); zw = *(const u32x2*)(U + (size_t)(m0 + l) * LDU + UC_Z + head * 64 + pc); }
                f32x4 y = acc[pb][lb];
                y[0] = (y[0] + dsk * bf_lo(xw.x)) * siluf_(bf_lo(zw.x)); y[1] = (y[1] + dsk * bf_hi(xw.x)) * siluf_(bf_hi(zw.x));
                y[2] = (y[2] + dsk * bf_lo(xw.y)) * siluf_(bf_lo(zw.y)); y[3] = (y[3] + dsk * bf_hi(xw.y)) * siluf_(bf_hi(zw.y));
                acc[pb][lb] = y; sq[lb] += (y[0] * y[0] + y[1] * y[1]) + (y[2] * y[2] + y[3] * y[3]); } }
#pragma unroll
        for (int lb = 0; lb < 4; ++lb) { float s = sq[lb]; s += shx(s, 16, F.lane); s += shx(s, 32, F.lane);
            if (q == 0) __hip_atomic_fetch_add(Rs + 16 * lb + fr, s, __ATOMIC_RELAXED, __HIP_MEMORY_SCOPE_WORKGROUP); }
        __syncthreads();
#pragma unroll
        for (int lb = 0; lb < 4; ++lb) { const int l = 16 * lb + fr;
            if (l < L) { const float rs = fast_rsqrt(Rs[l] * (1.0f / 512) + EPS);
#pragma unroll
                for (int pb = 0; pb < 4; ++pb) { const int pc = 16 * pb + 4 * q; const f32x4 gn = *(const f32x4*)(p.in(I_SN) + layer * 1024 + head * 64 + pc); const f32x4 y = acc[pb][lb];
                    u32x2 ow; ow.x = pk2(y[0] * rs * gn[0], y[1] * rs * gn[1]); ow.y = pk2(y[2] * rs * gn[2], y[3] * rs * gn[3]);
                    *(u32x2*)(U + (size_t)(m0 + l) * LDU + UC_OSSD + head * 64 + pc) = ow; } } }
        __syncthreads();
    }
}
#ifndef DUPMASK
#define DUPMASK 0
#endif
__device__ __forceinline__ void phase_attn(const Params&, const Frame& F0, int layer0) {
    const Frame F = mk_frame(F0.wave);
    const PV p = pv_get(); int layer = layer0; asm volatile("" : "+s"(layer));
    bf16_t* U = (bf16_t*)(p.ws() + WS_U); const bf16_t* QM = (const bf16_t*)(p.ws() + WS_QM); const bf16_t* KM = (const bf16_t*)(p.ws() + WS_KM);
    const bf16_t* VTM = (const bf16_t*)(p.ws() + WS_VTM); const bf16_t* KFS = (const bf16_t*)(p.ws() + WS_KFS); const bf16_t* VTF = (const bf16_t*)(p.ws() + WS_VTF);
    const float* CUM = (const float*)(p.ws() + WS_CUM);
    for (int it = F.vcu; it < 256; it += F.G) {
        const int h = it >> 5, pr = it & 31;
        AttnSeq a; a.Q = QM + h * 192; a.qs = 1536; a.K = KM + h * 192; a.ks = 1536; a.VT = VTM + (size_t)h * 128 * KVROWS; a.O = U + UC_OMLA + h * 128; a.os = LDU; a.cq = nullptr; a.ck = nullptr;
#pragma unroll 1
        for (int half = 0; half < 2; ++half) attn_prefill_unit<192, false>(F.lds, a, half ? pr : 63 - pr, F.tid);
    }
#if defined(DUPMASK)
    if ((DUPMASK >> 8) & 1) for (int it = F.vcu; it < 256; it += F.G) {
        const int h = it >> 5, pr = it & 31;
        AttnSeq a; a.Q = QM + h * 192; a.qs = 1536; a.K = KM + h * 192; a.ks = 1536; a.VT = VTM + (size_t)h * 128 * KVROWS; a.O = U + UC_OMLA + h * 128; a.os = LDU; a.cq = nullptr; a.ck = nullptr;
#pragma unroll 1
        for (int half = 0; half < 2; ++half) attn_prefill_unit<192, false>(F.lds, a, half ? pr : 63 - pr, F.tid);
    }
#endif
    for (int it = F.vcu; it < 256; it += F.G) {
        const int h = it >> 5, pr = it & 31;
        AttnSeq a; a.Q = U + UC_FQ + h * 128; a.qs = LDU; a.K = U + UC_FK + h * 128; a.ks = LDU; a.VT = VTF + (size_t)h * 128 * KVROWS; a.O = U + UC_OFOX + h * 128; a.os = LDU; a.cq = CUM + h; a.ck = CUM + h;
        const unsigned* ctl = (const unsigned*)(p.ws() + WS_CTL);
        float kn2; { float v = __uint_as_float(ctl[CW_KN2 + (layer * 64 + F.lane) * 8 + h]);
#pragma unroll
            for (int o = 1; o < 64; o <<= 1) v = fmaxf(v, shx(v, o, F.lane)); kn2 = v; }
#pragma unroll 1
        for (int half = 0; half < 2; ++half) { const int qb = half ? pr : 63 - pr;
            attn_prefill_unit<128, true>(F.lds, a, qb, F.tid, 2.02f * __builtin_amdgcn_sqrtf(__uint_as_float(ctl[CW_QN2 + (layer * 64 + qb) * 8 + h]) * kn2)); }
    }
#if defined(DUPMASK)
    if ((DUPMASK >> 9) & 1) for (int it = F.vcu; it < 256; it += F.G) {
        const int h = it >> 5, pr = it & 31;
        AttnSeq a; a.Q = U + UC_FQ + h * 128; a.qs = LDU; a.K = U + UC_FK + h * 128; a.ks = LDU; a.VT = VTF + (size_t)h * 128 * KVROWS; a.O = (bf16_t*)(p.ws() + WS_ST) + h * 128; a.os = 1024; a.cq = CUM + h; a.ck = CUM + h;
        const unsigned* ctl = (const unsigned*)(p.ws() + WS_CTL);
        float kn2; { float v = __uint_as_float(ctl[CW_KN2 + (layer * 64 + F.lane) * 8 + h]);
#pragma unroll
            for (int o = 1; o < 64; o <<= 1) v = fmaxf(v, shx(v, o, F.lane)); kn2 = v; }
#pragma unroll 1
        for (int half = 0; half < 2; ++half) { const int qb = half ? pr : 63 - pr;
            attn_prefill_unit<128, true>(F.lds, a, qb, F.tid, 2.02f * __builtin_amdgcn_sqrtf(__uint_as_float(ctl[CW_QN2 + (layer * 64 + qb) * 8 + h]) * kn2)); }
    }
#endif
    for (int it = F.vcu; it < 2 * NB * 8; it += F.G) {
        const int kind = it >> 7, s = (it & 127) >> 3, h = it & 7; const size_t q0 = (size_t)MP + 16 * s, k0 = (size_t)MP + (size_t)s * KVS;
        if (kind == 0) { AttnSeq a; a.Q = QM + q0 * 1536 + h * 192; a.qs = 1536; a.K = KM + k0 * 1536 + h * 192; a.ks = 1536; a.VT = VTM + (size_t)h * 128 * KVROWS + k0; a.O = U + q0 * LDU + UC_OMLA + h * 128; a.os = LDU; a.cq = nullptr; a.ck = nullptr;
          attn_decode_unit<192, false>(F.lds, a, F.tid); }
        else { AttnSeq a; a.Q = U + q0 * LDU + UC_FQ + h * 128; a.qs = LDU; a.K = KFS + (size_t)s * KVS * 1024 + h * 128; a.ks = 1024; a.VT = VTF + (size_t)h * 128 * KVROWS + k0; a.O = U + q0 * LDU + UC_OFOX + h * 128; a.os = LDU;
          a.cq = CUM + (k0 + PAST) * 8 + h; a.ck = CUM + k0 * 8 + h;
          attn_decode_unit<128, true>(F.lds, a, F.tid); }
    }
}

#define LAUNDER_P const PV p = pv_get()
#define LAUNDER_PL const PV p = pv_get(); int layer = layer0; asm volatile("" : "+s"(layer))
__device__ __forceinline__ void ph_gateup(const Params&, const Frame& F0, size_t woff) {
    const Frame F = mk_frame(F0.wave);
    LAUNDER_P; bf16_t* W = (bf16_t*)(p.ws() + WS_W); bf16_t* XN = (bf16_t*)(p.ws() + WS_XN); bf16_t* H = (bf16_t*)(p.ws() + WS_U);
    pg8::Gemm g{XN, W + woff, 64, 64, MT, 2 * FF, D, (size_t)MT * 128, (size_t)2 * FF * 128}; pg8::StaticOrder S; S.init(MT, 2 * FF, F.G, F.bx, D); S.nrev = true;
    EpiSwiGLU E{H}; pg8::gemm_phase<EpiSwiGLU, pg8::StaticOrder, true, true>(F.lds, g, S, E, F.wave);
}
__device__ __forceinline__ void ph_down(const Params&, const Frame& F0, size_t woff, bool from_input, bool dummy = false) {
    const Frame F = mk_frame(F0.wave);
    LAUNDER_P; bf16_t* W = (bf16_t*)(p.ws() + WS_W); bf16_t* H = (bf16_t*)(p.ws() + WS_U);
    float* yp = p.out() + O_YP; float* ys = p.out() + O_YS;
    pg8::Gemm g{H, W + woff, 64, 64, MT, D, FF, (size_t)MT * 128, (size_t)D * 128}; pg8::SplitOrder S;
    S.init(MT, D, F.G, F.bx, FF);
    EpiResid E{from_input ? p.in(I_XP) : yp, from_input ? p.in(I_XS) : ys, dummy ? (float*)(p.ws() + WS_ST) : yp, 0.5f, true, (float*)(p.ws() + WS_PART)}; pg8::gemm_phase<EpiResid, pg8::SplitOrder, true, true>(F.lds, g, S, E, F.wave);
}
__device__ __forceinline__ void ph_win(const Params&, const Frame& F0, int layer0) {
    const Frame F = mk_frame(F0.wave);
    LAUNDER_PL; bf16_t* W = (bf16_t*)(p.ws() + WS_W); bf16_t* XN = (bf16_t*)(p.ws() + WS_XN); bf16_t* U = (bf16_t*)(p.ws() + WS_U);
    pg8::Gemm g{XN, W + W_IN, 64, 64, MT, NWIN, D, (size_t)MT * 128, (size_t)NWIN * 128}; pg8::StaticOrder S; S.init(MT, NWIN, F.G, F.bx, D);
    EpiWin E{U, (float*)(p.ws() + WS_US), p.out() + O_PFK + (size_t)layer * MP * 1024, p.out() + O_SFK + (size_t)layer * MS * 1024,
             p.out() + O_PFV + (size_t)layer * MP * 1024, p.out() + O_SFV + (size_t)layer * MS * 1024};
    pg8::gemm_phase<EpiWin, pg8::StaticOrder, true, true>(F.lds, g, S, E, F.wave);
}
__device__ __forceinline__ void ph_uq(const Params&, const Frame& F0) {
    const Frame F = mk_frame(F0.wave);
    LAUNDER_P; bf16_t* W = (bf16_t*)(p.ws() + WS_W); bf16_t* U = (bf16_t*)(p.ws() + WS_U);
    pg8::Gemm g{U + UC_QLAT, W + W_UQ, LDU, 512, MT, 1536, 512}; pg8::StaticOrder S; S.init(MT, 1536, F.G, F.bx, 512);
    EpiUq E{(bf16_t*)(p.ws() + WS_QM), (const f32x2*)(p.ws() + WS_ROPE)}; pg8::gemm_phase<EpiUq, pg8::StaticOrder, true, true>(F.lds, g, S, E, F.wave);
}
__device__ __forceinline__ void ph_ukv(const Params&, const Frame& F0) {
    const Frame F = mk_frame(F0.wave);
    LAUNDER_P; bf16_t* W = (bf16_t*)(p.ws() + WS_W);
    pg8::Gemm g{(const bf16_t*)(p.ws() + WS_CKV), W + W_UKV, 512, 512, KVROWS, 2048, 512}; pg8::StaticOrder S; S.init(KVROWS, 2048, F.G, (F.G == 256) ? (F.bx + 120) % 256 : F.bx, 512);
    EpiUkv E{(bf16_t*)(p.ws() + WS_KM), (bf16_t*)(p.ws() + WS_VTM)}; pg8::gemm_phase<EpiUkv, pg8::StaticOrder, true, true>(F.lds, g, S, E, F.wave);
}
template <int BR> __device__ __forceinline__ void ph_merge(const Params&, const Frame& F0) {
    const Frame F = mk_frame(F0.wave);
    LAUNDER_P; bf16_t* W = (bf16_t*)(p.ws() + WS_W); bf16_t* U = (bf16_t*)(p.ws() + WS_U); bf16_t* XN = (bf16_t*)(p.ws() + WS_XN);
    constexpr int acol = BR == 0 ? UC_OMLA : (BR == 1 ? UC_OSSD : UC_OFOX);
    pg8::StaticOrder S; S.init(MP, D, F.G, F.bx, 1024, true);
    pg8::Gemm g{U + acol, W + W_BR + (size_t)BR * D * 1024, LDU, 1024, MP, D, 1024}; EpiMerge<BR> E{U, XN}; pg8::gemm_phase<EpiMerge<BR>, pg8::StaticOrder, true, true>(F.lds, g, S, E, F.wave);
}
__device__ __forceinline__ void ph_merge_sample(const Params&, const Frame& F0, int layer0) {
    const Frame F = mk_frame(F0.wave);
    LAUNDER_PL; bf16_t* W = (bf16_t*)(p.ws() + WS_W); bf16_t* U = (bf16_t*)(p.ws() + WS_U); bf16_t* XN = (bf16_t*)(p.ws() + WS_XN);
    pg8::SampleMergeOrder S; S.c = F.bx;
    pg8::Gemm g{U, W + W_BR, LDU, 1024, MT, 3 * D, 1024};
    EpiMergeSample E{U, XN, (float*)(p.ws() + WS_PART), (unsigned*)(p.ws() + WS_CTL) + CW_MGC + layer * 8 * 64, (LAS unsigned*)(F.lds + RING_BYTES)};
    pg8::gemm_phase<EpiMergeSample, pg8::SampleMergeOrder, true, true>(F.lds, g, S, E, F.wave);
}
__device__ __forceinline__ void ph_wout(const Params&, const Frame& F0, bool dummy = false) {
    const Frame F = mk_frame(F0.wave);
    LAUNDER_P; bf16_t* W = (bf16_t*)(p.ws() + WS_W); bf16_t* XN = (bf16_t*)(p.ws() + WS_XN); float* yp = p.out() + O_YP; float* ys = p.out() + O_YS;
    pg8::Gemm g{XN, W + W_OUT, D, D, MT, D, D}; pg8::SplitOrder S; S.init(MT, D, F.G, F.bx, D);
    EpiResid E{yp, ys, dummy ? (float*)(p.ws() + WS_ST) : yp, 1.0f, true, (float*)(p.ws() + WS_PART)}; pg8::gemm_phase<EpiResid, pg8::SplitOrder, true, true>(F.lds, g, S, E, F.wave);
}
__device__ __forceinline__ void ph_norm(const Params&, const Frame& F0, int layer0, int which, bool from_input) {
    const Frame F = mk_frame(F0.wave);
    LAUNDER_PL; float* yp = p.out() + O_YP; float* ys = p.out() + O_YS;
    phase_norm(F, from_input ? p.in(I_XP) : yp, from_input ? p.in(I_XS) : ys, p.in(which) + layer * D, (bf16_t*)(p.ws() + WS_XN), from_input ? ys : nullptr, from_input ? nullptr : (const float*)(p.ws() + WS_PART));
}

constexpr int PH_PER_LAYER = 15, N_PHASES = NL * PH_PER_LAYER + 1;
#ifndef N_LAUNCHES
#define N_LAUNCHES 1
#endif
#ifndef PHMASK
#define PHMASK 0xffff
#endif
#ifndef DUPMASK
#define DUPMASK 0
#endif
#define DUP(k) (((DUPMASK) >> (k)) & 1)

__global__ void __launch_bounds__(512, 2) hybrid_fwd(Params p) {
    extern __shared__ __attribute__((aligned(16))) unsigned char lds_raw[];
    const int wave_k = __builtin_amdgcn_readfirstlane((int)threadIdx.x >> 6);
    const Frame F = mk_frame(wave_k);
    volatile LAS unsigned* MISC = (volatile LAS unsigned*)(F.lds + MISC_OFF);
    for (int u = F.tid; u < (LDS_BYTES - LDSCTL_OFF) / 4; u += 512) ((LAS unsigned*)(F.lds + LDSCTL_OFF))[u] = 0u;
    __syncthreads();
    const PV pk = pv_get();
    unsigned* ctl = (unsigned*)(pk.ws() + WS_CTL);
    const int lo = pk.ph_lo(), hi = pk.ph_hi();
    XcdBarrier bar; bar.bar = ctl + CW_BAR; bar.x = 0; bar.st = nullptr;
    if (hi - lo > 1) bar = xcd_barrier_post(ctl + CW_BAR, MISC + 8, F.tid);
#define IN(k) ((((PHMASK) >> (((k) == NL * PH_PER_LAYER) ? 15 : ((k) % PH_PER_LAYER))) & 1) && lo <= (k) && (k) < hi)
#define SEAM(k) do { if (IN(k) && IN((k) + 1)) xcd_barrier(bar, wave_k); } while (0)
    if (IN(0)) phase_rope_table(F);
#pragma unroll 1
    for (int layer = 0; layer < NL; ++layer) {
        const int pb = layer * PH_PER_LAYER;
        if (IN(pb + 0)) { phase_convert(p, F, layer); if (DUP(0)) phase_convert(p, F, layer); }
        if (IN(pb + 1)) { ph_norm(p, F, layer, I_F1N, layer == 0); if (DUP(1)) ph_norm(p, F, layer, I_F1N, layer == 0); }
        SEAM(pb + 1);
        if (IN(pb + 2)) { ph_gateup(p, F, W_GU1); if (DUP(2)) ph_gateup(p, F, W_GU1); }
        SEAM(pb + 2);
        if (IN(pb + 3)) { if (DUP(3)) ph_down(p, F, W_D1, layer == 0, true); ph_down(p, F, W_D1, layer == 0); }
        SEAM(pb + 3);
        if (IN(pb + 4)) ph_norm(p, F, layer, I_MIXN, false);
        SEAM(pb + 4);
        if (IN(pb + 5)) { ph_win(p, F, layer); if (DUP(5)) ph_win(p, F, layer); }
        SEAM(pb + 5);
        if (IN(pb + 6)) phase_t1(p, F, layer);
        SEAM(pb + 6);
        if (IN(pb + 7)) { phase_t2(p, F); ph_uq(p, F); ph_ukv(p, F); phase_s1(p, F, layer); if (DUP(7)) { ph_uq(p, F); ph_ukv(p, F); } if (DUP(6)) phase_s1(p, F, layer); }
        SEAM(pb + 7);
        if (IN(pb + 8)) { phase_attn(p, F, layer); phase_s2(p, F, layer); }
        SEAM(pb + 8);
        if (IN(pb + 9)) phase_s3(p, F, layer);
        SEAM(pb + 9);
        if (IN(pb + 10)) { ph_merge_sample(p, F, layer); ph_merge<0>(p, F); ph_merge<1>(p, F); ph_merge<2>(p, F); }
        SEAM(pb + 10);
        if (IN(pb + 11)) { if (DUP(11)) ph_wout(p, F, true); ph_wout(p, F); }
        SEAM(pb + 11);
        if (IN(pb + 12)) ph_norm(p, F, layer, I_F2N, false);
        SEAM(pb + 12);
        if (IN(pb + 13)) ph_gateup(p, F, W_GU2);
        SEAM(pb + 13);
        if (IN(pb + 14)) ph_down(p, F, W_D2, false);
        SEAM(pb + 14);
    }
    if (IN(NL * PH_PER_LAYER)) { const PV q = pv_get(); const Frame F2 = mk_frame(wave_k); phase_final_norm(F2, q.out() + O_YP, q.in(I_FN), (const float*)(q.ws() + WS_PART)); }
#undef IN
#undef SEAM
}

extern "C" void kernel_launch(void* const* d_in, const int* in_sizes, int n_in, void* d_out, int out_size, void* d_ws, size_t ws_size, hipStream_t stream) {
    static int grid = 0;
    if (grid == 0) {
        if (n_in != N_IN || (size_t)out_size != O_TOTAL || ws_size < WS_END) { fprintf(stderr, "kernel_launch: unexpected shapes: n_in %d out %d ws %zu (need %zu)\n", n_in, out_size, ws_size, (size_t)WS_END); grid = -1; return; }
        int dev = 0, cus = 0, per_cu = 0;
        if (hipGetDevice(&dev) != hipSuccess || hipDeviceGetAttribute(&cus, hipDeviceAttributeMultiprocessorCount, dev) != hipSuccess) { grid = -1; return; }
        if (hipFuncSetAttribute((const void*)hybrid_fwd, hipFuncAttributeMaxDynamicSharedMemorySize, LDS_BYTES) != hipSuccess) { fprintf(stderr, "kernel_launch: hipFuncSetAttribute failed\n"); grid = -1; return; }
        if (hipOccupancyMaxActiveBlocksPerMultiprocessor(&per_cu, (const void*)hybrid_fwd, 512, LDS_BYTES) != hipSuccess || per_cu < 1) { fprintf(stderr, "kernel_launch: occupancy query says %d\n", per_cu); }
        (void)hipGetLastError();
        grid = cus;
    }
    if (grid < 0) return;
    (void)hipMemsetAsync((char*)d_ws + WS_CTL, 0, CTL_BYTES, stream);
    Params p{};
    for (int i = 0; i < N_IN; ++i) p.in[i] = (const float*)d_in[i];
    p.out = (float*)d_out; p.ws = (unsigned char*)d_ws;
#if defined(PROBE_K)
    p.ph_lo = 0; p.ph_hi = PROBE_K;
    hipLaunchKernelGGL(hybrid_fwd, dim3(grid), dim3(512), LDS_BYTES, stream, p);
    (void)hipMemsetAsync((char*)d_ws + WS_CTL, 0, CTL_BYTES, stream);
    p.ph_lo = 0; p.ph_hi = N_PHASES;
    hipLaunchKernelGGL(hybrid_fwd, dim3(grid), dim3(512), LDS_BYTES, stream, p);
#elif N_LAUNCHES == 1
    p.ph_lo = 0; p.ph_hi = N_PHASES;
    hipLaunchKernelGGL(hybrid_fwd, dim3(grid), dim3(512), LDS_BYTES, stream, p);
#else
    for (int k = 0; k < N_PHASES; ++k) { p.ph_lo = k; p.ph_hi = k + 1; hipLaunchKernelGGL(hybrid_fwd, dim3(grid), dim3(512), LDS_BYTES, stream, p); }
#endif
}
```

```cpp
#include <hip/hip_runtime.h>
#include <cstdio>
#include <cstdint>

#define LAS __attribute__((address_space(3)))
typedef unsigned short bf16_t;
typedef short bf16x8 __attribute__((ext_vector_type(8)));
typedef float f32x4 __attribute__((ext_vector_type(4)));
typedef float f32x2 __attribute__((ext_vector_type(2)));
typedef float f32x16 __attribute__((ext_vector_type(16)));
typedef unsigned u32x4 __attribute__((ext_vector_type(4)));
typedef unsigned u32x2 __attribute__((ext_vector_type(2)));
typedef __bf16 bf2_t __attribute__((ext_vector_type(2)));

constexpr int D = 2048, SEQ = 16384, NB = 16, NS = 16, PAST = 1024, FF = 5504, NL = 2;
constexpr int MP = SEQ, MS = NB * NS, MT = MP + MS;
constexpr int KVS = 1088, KVLEN_S = PAST + NS;
constexpr int KVROWS = MP + NB * KVS;
constexpr int LDU = 12800;
constexpr int IN_COLS = 12888, NWIN = 13056;
constexpr float LOG2E = 1.4426950408889634f;
constexpr float MLA_QSCALE = 0.07216878364870322f * LOG2E;
constexpr float FOX_QSCALE = 0.08838834764831845f * LOG2E;
constexpr float EPS = 1e-6f;
constexpr int UC_QLAT = 0, UC_CKV = 512, UC_Z = 1024, UC_XBC = 2048, UC_FQ = 3584, UC_FK = 4608, UC_FV = 5632, UC_GATE = 6656;
constexpr int UC_OMLA = 0, UC_OSSD = UC_Z, UC_OFOX = UC_FQ;
constexpr int US_KPE = 0, US_DT = 64, US_FF = 80, LDUS = 128;

enum { I_XP = 0, I_XS, I_CCKV, I_CKPE, I_CFK, I_CFV, I_CLOGF, I_SSM, I_CONV, I_F1N, I_F1G, I_F1U, I_F1D, I_MIXN, I_WIN, I_QN, I_WUQ, I_KVN, I_WUKV,
       I_CW, I_CB, I_DTB, I_ALOG, I_SD, I_SN, I_FBF, I_BRM, I_BRS, I_BRF, I_WOUT, I_F2N, I_F2G, I_F2U, I_F2D, I_FN, N_IN };
constexpr size_t O_YP = 0, O_YS = 33554432, O_PCKV = 34078720, O_PKPE = 50855936, O_PFK = 52953088, O_PFV = 86507520, O_PLOGF = 120061952,
                 O_PSSM = 120324096, O_PCONV = 120586240, O_SCKV = 120595456, O_SKPE = 120857600, O_SFK = 120890368, O_SFV = 121414656,
                 O_SLOGF = 121938944, O_SSSM = 121943040, O_SCONV = 126137344, O_TOTAL = 126284800;

constexpr size_t W_GU1 = 0, W_D1 = W_GU1 + (size_t)2 * FF * D, W_IN = W_D1 + (size_t)D * FF, W_UQ = W_IN + (size_t)NWIN * D, W_UKV = W_UQ + (size_t)1536 * 512,
                 W_BR = W_UKV + (size_t)2048 * 512, W_OUT = W_BR + (size_t)3 * 2048 * 1024, W_GU2 = W_OUT + (size_t)D * D, W_D2 = W_GU2 + (size_t)2 * FF * D,
                 W_TOTAL = W_D2 + (size_t)D * FF;

constexpr size_t MiB = 1u << 20;
constexpr size_t al(size_t x) { return (x + MiB - 1) / MiB * MiB; }
constexpr size_t WS_CTL = 0, CTL_BYTES = 1 * MiB;
constexpr size_t WS_ROPE = WS_CTL + CTL_BYTES;
constexpr size_t WS_W = WS_ROPE + al((size_t)SEQ * 32 * 8);
constexpr size_t WS_XN = WS_W + al(W_TOTAL * 2);
constexpr size_t WS_U = WS_XN + al((size_t)MT * D * 2);
constexpr size_t WS_US = WS_U + al((size_t)MT * LDU * 2);
constexpr size_t WS_DT = WS_US + al((size_t)MT * LDUS * 4);
constexpr size_t WS_QM = WS_DT + al((size_t)MT * 16 * 4);
constexpr size_t WS_CKV = WS_QM + al((size_t)MT * 1536 * 2);
constexpr size_t WS_KM = WS_CKV + al((size_t)KVROWS * 512 * 2);
constexpr size_t WS_VTM = WS_KM + al((size_t)KVROWS * 1536 * 2);
constexpr size_t WS_KFS = WS_VTM + al((size_t)1024 * KVROWS * 2);
constexpr size_t WS_VTF = WS_KFS + al((size_t)NB * KVS * 1024 * 2);
constexpr size_t WS_LOGF = WS_VTF + al((size_t)1024 * KVROWS * 2);
constexpr size_t WS_CUM = WS_LOGF + al((size_t)KVROWS * 8 * 4);
constexpr int NCHUNK = 256 + NB;
constexpr size_t WS_ST = WS_CUM + al((size_t)KVROWS * 8 * 4);
constexpr size_t WS_CDEC = WS_ST + al((size_t)NCHUNK * 131072 * 4);
constexpr size_t WS_PART = WS_CDEC + MiB;
constexpr size_t WS_XB = WS_PART + al((size_t)8 * MS * D * 4);
constexpr size_t WS_END = WS_XB + al((size_t)MP * D * 2);

constexpr int CW_TMO = 0, CW_BAR = 4096;
constexpr int CW_MGC = 12288;
constexpr int CW_QN2 = 8192, CW_KN2 = CW_QN2 + NL * 64 * 8;

constexpr int RING_BYTES = 131072, LDS_BYTES = 163840, LDSCTL_OFF = LDS_BYTES - 512, MISC_OFF = LDSCTL_OFF + 320;

struct Params {
    const float* in[N_IN];
    float* out;
    unsigned char* ws;
    int ph_lo, ph_hi;
};

typedef const __attribute__((address_space(4))) unsigned char* KA;
struct PV { KA k;
    __device__ __forceinline__ const float* in(int i) const { return *(const float* const __attribute__((address_space(4)))*)(k + 8 * i); }
    __device__ __forceinline__ float* out() const { return *(float* const __attribute__((address_space(4)))*)(k + 8 * N_IN); }
    __device__ __forceinline__ unsigned char* ws() const { return *(unsigned char* const __attribute__((address_space(4)))*)(k + 8 * N_IN + 8); }
    __device__ __forceinline__ int ph_lo() const { return *(const __attribute__((address_space(4))) int*)(k + 8 * N_IN + 16); }
    __device__ __forceinline__ int ph_hi() const { return *(const __attribute__((address_space(4))) int*)(k + 8 * N_IN + 20); }
};
__device__ __forceinline__ PV pv_get() { PV v; v.k = (KA)__builtin_amdgcn_kernarg_segment_ptr(); asm volatile("" : "+s"(v.k)); return v; }
static_assert(sizeof(Params) == 8 * N_IN + 24, "Params layout");

#define LDS_WAIT() asm volatile("s_waitcnt lgkmcnt(0)" ::: "memory")
#define VM_WAIT() asm volatile("s_waitcnt vmcnt(0)" ::: "memory")
__device__ __forceinline__ unsigned pk2(float lo, float hi) { bf2_t v = {(__bf16)lo, (__bf16)hi}; return __builtin_bit_cast(unsigned, v); }
__device__ __forceinline__ float bf_lo(unsigned w) { return __uint_as_float(w << 16); }
__device__ __forceinline__ float bf_hi(unsigned w) { return __uint_as_float(w & 0xffff0000u); }
__device__ __forceinline__ float bf2f(bf16_t b) { return __uint_as_float((unsigned)b << 16); }
__device__ __forceinline__ bf16_t f2bf(float f) { return (bf16_t)(pk2(f, 0.f) & 0xffffu); }
__device__ __forceinline__ float shx(float v, int o, int lane) { return __int_as_float(__builtin_amdgcn_ds_bpermute((lane ^ o) << 2, __float_as_int(v))); }
__device__ __forceinline__ float wave_sum(float v, int lane) {
#pragma unroll
    for (int o = 1; o < 64; o <<= 1) v += shx(v, o, lane);
    return v;
}
__device__ __forceinline__ float fast_exp2(float x) { return __builtin_amdgcn_exp2f(x); }
__device__ __forceinline__ float fast_exp(float x) { return __builtin_amdgcn_exp2f(x * LOG2E); }
__device__ __forceinline__ float fast_rsqrt(float x) { return __builtin_amdgcn_rsqf(x); }
__device__ __forceinline__ float fast_log(float x) { return __builtin_amdgcn_logf(x) * 0.6931471805599453f; }
__device__ __forceinline__ float sigmoidf_(float x) { return __builtin_amdgcn_rcpf(1.f + fast_exp2(-x * LOG2E)); }
__device__ __forceinline__ float siluf_(float x) { return x * sigmoidf_(x); }
__device__ __forceinline__ int kvrow_of(int m) { return m < MP ? m : MP + ((m - MP) >> 4) * KVS + PAST + ((m - MP) & 15); }
__device__ __forceinline__ int pos_of(int m) { return m < MP ? m : PAST + ((m - MP) & 15); }

#define XB_TMO      128
#define XB_XCNT(j)  (256  + 64 * (j))
#define XB_XSUB(j)  (1280 + 64 * (j))
#define XB_XGEN(j)  (2304 + 64 * (j))
#define XB_TOP      3328
#define XB_TOPGEN   3392
#define XCD_BAR_WORDS 3456
#define XB_SPIN_CAP (1u << 22)
__device__ __forceinline__ unsigned xb_ld(unsigned* p)              { return __hip_atomic_load(p, __ATOMIC_RELAXED, __HIP_MEMORY_SCOPE_AGENT); }
__device__ __forceinline__ unsigned xb_add(unsigned* p, unsigned v) { return __hip_atomic_fetch_add(p, v, __ATOMIC_RELAXED, __HIP_MEMORY_SCOPE_AGENT); }
__device__ __forceinline__ unsigned xb_xcc_id() { return (unsigned)__builtin_amdgcn_s_getreg((3 << 11) | 20) & 0xFu; }
#define XB_SPIN(cond, bar) do { unsigned _sp = 0; while (cond) { __builtin_amdgcn_s_sleep(1); \
    if ((++_sp & 255u) == 0u) { if (xb_ld(&(bar)[XB_TMO])) break; if (_sp > XB_SPIN_CAP) { atomicAdd(&(bar)[XB_TMO], 1u); break; } } } } while (0)
struct XcdBarrier { unsigned* bar; unsigned x; volatile LAS unsigned* st; };
__device__ __forceinline__ XcdBarrier xcd_barrier_post(unsigned* bar, volatile LAS unsigned* st, int tid) {
    XcdBarrier b; b.bar = bar; b.x = xb_xcc_id(); b.st = st;
    if (tid == 0) (void)xb_add(&bar[XB_XCNT(b.x)], 1u);
    return b;
}
__device__ __forceinline__ void xcd_barrier_complete(unsigned* bar, unsigned x, unsigned& nloc, unsigned& nx) {
    const unsigned G = gridDim.x * gridDim.y * gridDim.z;
    unsigned sum, cnt, mine, sp = 0u;
    for (;;) {
        sum = 0u; cnt = 0u; mine = 0u;
#pragma unroll
        for (unsigned j = 0; j < 16; ++j) { const unsigned c = xb_ld(&bar[XB_XCNT(j)]); sum += c; cnt += (c > 0u) ? 1u : 0u; mine = (j == x) ? c : mine; }
        if (sum == G) break;
        __builtin_amdgcn_s_sleep(1);
        if ((++sp & 255u) == 0u) { if (xb_ld(&bar[XB_TMO])) break; if (sp > XB_SPIN_CAP) { atomicAdd(&bar[XB_TMO], 1u); break; } }
    }
    nloc = mine > 0u ? mine : 1u; nx = cnt > 0u ? cnt : 1u;
}
__device__ __forceinline__ void xcd_barrier(const XcdBarrier& b, int wave_s) {
    asm volatile("s_waitcnt vmcnt(0)" ::: "memory");
    __syncthreads();
    int tid_b; { unsigned z_ = 0u; asm volatile("" : "+s"(z_)); tid_b = wave_s * 64 + (int)__builtin_amdgcn_mbcnt_hi(~0u, __builtin_amdgcn_mbcnt_lo(~0u, z_)); }
    if (tid_b == 0) {
        unsigned* bar = b.bar; asm volatile("" : "+s"(bar));
        __builtin_amdgcn_s_waitcnt(0);
        unsigned nloc = b.st[0], nx = b.st[1];
        if (nloc == 0u) { xcd_barrier_complete(bar, b.x, nloc, nx); b.st[0] = nloc; b.st[1] = nx; }
        const unsigned old = xb_add(&bar[XB_XSUB(b.x)], 1u);
        const unsigned gen = old / nloc;
        if (old + 1u == (gen + 1u) * nloc) {
            __builtin_amdgcn_fence(__ATOMIC_RELEASE, "agent");
            asm volatile("s_waitcnt vmcnt(0)" ::: "memory");
            const unsigned og = xb_add(&bar[XB_TOP], 1u);
            const unsigned tg = og / nx;
            if (og + 1u == (tg + 1u) * nx) xb_add(&bar[XB_TOPGEN], 1u);
            else XB_SPIN(xb_ld(&bar[XB_TOPGEN]) == tg, bar);
            __builtin_amdgcn_fence(__ATOMIC_ACQUIRE, "agent");
            xb_add(&bar[XB_XGEN(b.x)], 1u);
            asm volatile("s_waitcnt vmcnt(0)" ::: "memory");
        } else {
            XB_SPIN(xb_ld(&bar[XB_XGEN(b.x)]) == gen, bar);
            __builtin_amdgcn_fence(__ATOMIC_ACQUIRE, "agent");
            asm volatile("s_waitcnt vmcnt(0)" ::: "memory");
        }
    }
    __syncthreads();
}

namespace pg8 {
constexpr int BM = 256, BK = 64, HALF = 128, HTB = HALF * BK * 2, STAGE_BYTES = 8 * HTB, NXCD = 8, WGM = 8;
__host__ __device__ __forceinline__ int lds_byte(int r, int c) { const int st = (r >> 4) * 2 + (c >> 5), rr = r & 15, cc = c & 31, ob = rr * 64 + cc * 2; return st * 1024 + (ob ^ (((ob >> 9) & 1) << 5)); }
__host__ __device__ __forceinline__ void stage_rc(int b, int& R, int& C) { const int st = b / 1024, sb = b % 1024, swz = sb ^ (((sb >> 9) & 1) << 5); R = (st >> 1) * 16 + swz / 64; C = (st & 1) * 32 + (swz % 64) / 2; }
__host__ __device__ __forceinline__ int perm32(int rho) { const int n = rho >> 4, i = rho & 15; return 8 * (i >> 2) + 4 * n + (i & 3); }
struct Unit { int pm, pn, k0, nt, sp; };
struct Gemm { const bf16_t* A; const bf16_t* Bt; int lda, ldb, M, N, K; size_t ksA = 128, ksB = 128; };
struct StaticOrder {
    int nM, nN, nwg, G, c, ntK; bool nfast; bool nrev = false;
    __host__ __device__ __forceinline__ void init(int M, int N, int G_, int c_, int K_ = 0, bool nfast_ = false) { nM = M / BM; nN = N / BM; nwg = nM * nN; G = G_; c = c_; ntK = K_ / BK; nfast = nfast_; }
    __host__ __device__ __forceinline__ bool next(int i, Unit& u) const {
        const long L = (long)i * G + c; if (L >= nwg) return false;
        int wgid = (int)L; { const int q = nwg / NXCD, r = nwg % NXCD, xcd = wgid % NXCD, off = wgid / NXCD; wgid = (xcd < r ? xcd * (q + 1) : r * (q + 1) + (xcd - r) * q) + off; }
        const int nig = WGM * nN, gid = wgid / nig, fm = gid * WGM, gsz = (nM - fm) < WGM ? (nM - fm) : WGM;
        const int ig = wgid % nig;
        u.pm = nfast ? fm + ig / nN : fm + (ig % gsz); u.pn = nfast ? ig % nN : ig / gsz; if (nrev) u.pn = nN - 1 - u.pn; u.k0 = 0; u.nt = ntK; u.sp = 0; return true;
    }
    __device__ __forceinline__ void a_ready(const Unit&) const {}
    __device__ __forceinline__ void done(const Unit&) const {}
    __device__ __forceinline__ size_t a_extra(const Unit&) const { return 0; }
};
struct SplitOrder : StaticOrder {
    __host__ __device__ __forceinline__ void init(int M, int N, int G_, int c_, int K_) { StaticOrder::init(M - BM, N, G_, c_, K_, true); }
    __host__ __device__ __forceinline__ bool next(int i, Unit& u) const {
        const long L = (long)i * G + c;
        const bool reg = L < nwg; const int idx = (int)(L - nwg);
        const int ns = 8;
        if (!reg && idx >= nN * ns) return false;
        Unit a; a.pm = 0; a.pn = 0; a.k0 = 0; a.nt = ntK; a.sp = 0;
        if (reg) { Unit t; StaticOrder::next(i, t); a.pm = t.pm; a.pn = t.pn; }
        const int sp = idx / nN;
        const int base = (ntK / ns) & ~1, extra = (ntK - ns * base) / 2;
        const int s_nt = base + (sp < extra ? 2 : 0), s_k0 = base * sp + 2 * (sp < extra ? sp : extra);
        u.pm = reg ? a.pm : nM; u.pn = reg ? a.pn : idx % nN; u.k0 = reg ? 0 : s_k0; u.nt = reg ? ntK : s_nt; u.sp = reg ? 0 : sp;
        return true;
    }
};
struct SampleMergeOrder {
    int c;
    __host__ __device__ __forceinline__ bool next(int i, Unit& u) const {
        if (i != 0 || c >= 24) return false;
        u.pm = MP / BM; u.pn = c; u.k0 = 0; u.nt = 16; u.sp = 0; return true;
    }
    __device__ __forceinline__ void a_ready(const Unit&) const {}
    __device__ __forceinline__ void done(const Unit&) const {}
    __device__ __forceinline__ size_t a_extra(const Unit& u) const { const int br = u.pn >> 3; return (size_t)(br == 0 ? UC_OMLA : (br == 1 ? UC_OSSD : UC_OFOX)) * 2; }
};
template <class Epi, class Sched, bool ALIGN_EPI = false, bool SP2 = false>
__device__ __forceinline__ void gemm_phase(LAS unsigned char* lds, const Gemm g, const Sched& S, const Epi& E, int wave_s) {
    int tid_; { unsigned z_ = 0u; asm volatile("" : "+s"(z_)); tid_ = wave_s * 64 + (int)__builtin_amdgcn_mbcnt_hi(~0u, __builtin_amdgcn_mbcnt_lo(~0u, z_)); }
    const int tid = tid_, wid = __builtin_amdgcn_readfirstlane(tid >> 6), lane = tid & 63, wr = wid >> 2, wc = wid & 3, fr = lane & 15, fq = lane >> 4;
    unsigned voffA[2], voffB[2];
#pragma unroll
    for (int i = 0; i < 2; ++i) { int R, C; stage_rc(tid * 16 + i * 8192, R, C); const int Rb = Epi::PERM ? ((R & ~31) + perm32(R & 31)) : R;
        voffA[i] = (unsigned)(R * g.lda + C) * 2u; voffB[i] = (unsigned)(Rb * g.ldb + C) * 2u; }
    const size_t kstepA = g.ksA, kstepB = g.ksB;
    const size_t hstepA = (size_t)HALF * g.lda * 2, hstepB = (size_t)HALF * g.ldb * 2;
    const size_t tstepA = 2 * hstepA, tstepB = 2 * hstepB;
    const unsigned ldsw = (unsigned)wid * 1024u;
    const int aoff = lds_byte(wr * 64 + fr, fq * 8), boff = lds_byte(wc * 32 + fr, fq * 8);
#define PG8_SA(b, h) (((b) * 2 + (h)) * HTB)
#define PG8_SB(b, h) ((4 + (b) * 2 + (h)) * HTB)
#define PG8_STAGE(bufoff, gbase, voff) do { _Pragma("unroll") for (int _i = 0; _i < 2; ++_i) \
        __builtin_amdgcn_global_load_lds((const unsigned*)((const char*)(gbase) + (voff)[_i]), (LAS unsigned*)(lds + (bufoff) + ldsw + _i * 8192), 16, 0, 0); } while (0)
#define PG8_LDA(dst, b, h) do { _Pragma("unroll") for (int m = 0; m < 4; ++m) _Pragma("unroll") for (int k = 0; k < 2; ++k) dst[m][k] = *(const LAS bf16x8*)(lds + PG8_SA(b, h) + aoff + m * 2048 + k * 1024); } while (0)
#define PG8_LDB(dst, b, h) do { _Pragma("unroll") for (int n = 0; n < 2; ++n) _Pragma("unroll") for (int k = 0; k < 2; ++k) dst[n][k] = *(const LAS bf16x8*)(lds + PG8_SB(b, h) + boff + n * 2048 + k * 1024); } while (0)
#define PG8_MMA(ai, bj, At, Bt) do { __builtin_amdgcn_s_setprio(1); _Pragma("unroll") for (int m = 0; m < 4; ++m) _Pragma("unroll") for (int n = 0; n < 2; ++n) _Pragma("unroll") for (int k = 0; k < 2; ++k) \
        acc[ai][bj][m][n] = __builtin_amdgcn_mfma_f32_16x16x32_bf16(Bt[n][k], At[m][k], acc[ai][bj][m][n], 0, 0, 0); __builtin_amdgcn_s_setprio(0); } while (0)
#define PG8_WAIT_V(n) asm volatile("s_waitcnt vmcnt(" #n ")" ::: "memory")
#define PG8_WAIT_L(n) asm volatile("s_waitcnt lgkmcnt(" #n ")" ::: "memory")
#define PG8_BAR __builtin_amdgcn_s_barrier()
#define PG8_SCHED __builtin_amdgcn_sched_barrier(0)
    Unit cur, nxt; int ui = 0;
    if (!S.next(0, cur)) return;
    float zf_ = 0.f; asm volatile("" : "+v"(zf_));
    const f32x4 zero4 = {zf_, zf_, zf_, zf_};
    f32x4 acc[2][2][4][2];
#pragma unroll
    for (int a = 0; a < 2; ++a)
#pragma unroll
        for (int b = 0; b < 2; ++b)
#pragma unroll
            for (int m = 0; m < 4; ++m)
#pragma unroll
                for (int n = 0; n < 2; ++n) acc[a][b][m][n] = zero4;
    bf16x8 At[4][2], B0[2][2], B1[2][2];
    const char* cA = (const char*)g.A + (size_t)cur.pm * tstepA + (size_t)cur.k0 * kstepA + S.a_extra(cur); const char* cB = (const char*)g.Bt + (size_t)cur.pn * tstepB + (size_t)cur.k0 * kstepB;
    S.a_ready(cur);
    if constexpr (SP2) {
        PG8_STAGE(PG8_SB(0, 0), cB, voffB); PG8_STAGE(PG8_SB(0, 1), cB + hstepB, voffB); PG8_STAGE(PG8_SA(0, 0), cA, voffA); PG8_STAGE(PG8_SA(0, 1), cA + hstepA, voffA);
        if (wr == 1) PG8_BAR;
        PG8_WAIT_V(2); PG8_BAR;
        PG8_STAGE(PG8_SB(1, 0), cB + kstepB, voffB); PG8_STAGE(PG8_SA(1, 0), cA + kstepA, voffA); PG8_STAGE(PG8_SB(1, 1), cB + hstepB + kstepB, voffB);
        PG8_WAIT_V(6); PG8_BAR;
    } else {
        PG8_STAGE(PG8_SB(0, 0), cB, voffB); PG8_STAGE(PG8_SA(0, 0), cA, voffA); PG8_STAGE(PG8_SB(0, 1), cB + hstepB, voffB); PG8_STAGE(PG8_SA(0, 1), cA + hstepA, voffA);
        if (wr == 1) PG8_BAR;
        PG8_WAIT_V(4); PG8_BAR;
        PG8_STAGE(PG8_SB(1, 0), cB + kstepB, voffB); PG8_STAGE(PG8_SA(1, 0), cA + kstepA, voffA); PG8_STAGE(PG8_SB(1, 1), cB + hstepB + kstepB, voffB);
        PG8_WAIT_V(6); PG8_BAR;
    }
    for (;;) {
        const bool has_next = S.next(ui + 1, nxt);
        const char* nA = has_next ? (const char*)g.A + (size_t)nxt.pm * tstepA + (size_t)nxt.k0 * kstepA + S.a_extra(nxt) : cA; const char* nB = has_next ? (const char*)g.Bt + (size_t)nxt.pn * tstepB + (size_t)nxt.k0 * kstepB : cB;
        const int nt = cur.nt;
        for (int t = 0; t < nt; t += 2) {
            const bool last = (t == nt - 2);
            const char* a1 = cA + (size_t)(t + 1) * kstepA;
            const char* a2 = last ? nA : cA + (size_t)(t + 2) * kstepA; const char* b2 = last ? nB : cB + (size_t)(t + 2) * kstepB;
            const char* a3 = a2 + kstepA; const char* b3 = b2 + kstepB;
            if (last && has_next) S.a_ready(nxt);
            if constexpr (SP2) {
            PG8_LDB(B0, 0, 0); PG8_LDB(B1, 0, 1); PG8_SCHED; PG8_LDA(At, 0, 0); PG8_STAGE(PG8_SA(1, 1), a1 + hstepA, voffA);
            PG8_WAIT_V(8); PG8_WAIT_L(0); PG8_BAR; PG8_MMA(0, 0, At, B0); PG8_MMA(0, 1, At, B1); PG8_BAR; PG8_SCHED;
            PG8_LDA(At, 0, 1); PG8_STAGE(PG8_SB(0, 0), b2, voffB); PG8_STAGE(PG8_SB(0, 1), b2 + hstepB, voffB); PG8_STAGE(PG8_SA(0, 0), a2, voffA);
            PG8_WAIT_V(8); PG8_WAIT_L(0); PG8_BAR; PG8_MMA(1, 0, At, B0); PG8_MMA(1, 1, At, B1); PG8_BAR; PG8_SCHED;
            PG8_LDB(B0, 1, 0); PG8_LDB(B1, 1, 1); PG8_SCHED; PG8_LDA(At, 1, 0); PG8_STAGE(PG8_SA(0, 1), a2 + hstepA, voffA);
            PG8_WAIT_V(8); PG8_WAIT_L(0); PG8_BAR; PG8_MMA(0, 0, At, B0); PG8_MMA(0, 1, At, B1); PG8_BAR; PG8_SCHED;
            PG8_LDA(At, 1, 1); PG8_STAGE(PG8_SB(1, 0), b3, voffB); PG8_STAGE(PG8_SB(1, 1), b3 + hstepB, voffB); PG8_STAGE(PG8_SA(1, 0), a3, voffA);
            PG8_WAIT_V(8); PG8_WAIT_L(0); PG8_BAR; PG8_MMA(1, 0, At, B0); PG8_MMA(1, 1, At, B1); PG8_BAR; PG8_SCHED;
            } else {
            PG8_LDB(B0, 0, 0); PG8_SCHED; PG8_LDA(At, 0, 0); PG8_STAGE(PG8_SA(1, 1), a1 + hstepA, voffA);
            PG8_WAIT_L(8); PG8_BAR; PG8_WAIT_L(0); PG8_MMA(0, 0, At, B0); PG8_BAR; PG8_SCHED;
            PG8_LDB(B1, 0, 1); PG8_STAGE(PG8_SB(0, 0), b2, voffB);
            PG8_BAR; PG8_WAIT_L(0); PG8_MMA(0, 1, At, B1); PG8_BAR;
            PG8_LDA(At, 0, 1); PG8_STAGE(PG8_SA(0, 0), a2, voffA);
            PG8_BAR; PG8_WAIT_L(0); PG8_MMA(1, 0, At, B0); PG8_BAR; PG8_SCHED;
            PG8_STAGE(PG8_SB(0, 1), b2 + hstepB, voffB);
            PG8_WAIT_V(6); PG8_BAR; PG8_MMA(1, 1, At, B1); PG8_BAR;
            PG8_LDB(B0, 1, 0); PG8_SCHED; PG8_LDA(At, 1, 0); PG8_STAGE(PG8_SA(0, 1), a2 + hstepA, voffA);
            PG8_WAIT_L(8); PG8_BAR; PG8_WAIT_L(0); PG8_MMA(0, 0, At, B0); PG8_BAR; PG8_SCHED;
            PG8_LDB(B1, 1, 1); PG8_STAGE(PG8_SB(1, 0), b3, voffB);
            PG8_BAR; PG8_WAIT_L(0); PG8_MMA(0, 1, At, B1); PG8_BAR;
            PG8_LDA(At, 1, 1); PG8_STAGE(PG8_SA(1, 0), a3, voffA);
            PG8_BAR; PG8_WAIT_L(0); PG8_MMA(1, 0, At, B0); PG8_BAR; PG8_SCHED;
            PG8_STAGE(PG8_SB(1, 1), b3 + hstepB, voffB);
            PG8_WAIT_V(6); PG8_BAR; PG8_MMA(1, 1, At, B1); PG8_BAR;
            }
        }
        if constexpr (ALIGN_EPI) { if (wr == 0) PG8_BAR; }
        E(acc, cur, wr, wc, fr, fq); S.done(cur);
        if (!has_next) break;
#pragma unroll
        for (int a = 0; a < 2; ++a)
#pragma unroll
            for (int b = 0; b < 2; ++b)
#pragma unroll
                for (int m = 0; m < 4; ++m)
#pragma unroll
                    for (int n = 0; n < 2; ++n) acc[a][b][m][n] = zero4;
        cur = nxt; cA = nA; cB = nB; ++ui;
        if constexpr (ALIGN_EPI) { if (wr == 1) PG8_BAR; }
    }
    PG8_WAIT_V(0);
    if constexpr (!ALIGN_EPI) { if (wr == 0) PG8_BAR; }
    PG8_BAR;
#undef PG8_SA
#undef PG8_SB
#undef PG8_STAGE
#undef PG8_LDA
#undef PG8_LDB
#undef PG8_MMA
#undef PG8_WAIT_V
#undef PG8_WAIT_L
#undef PG8_BAR
#undef PG8_SCHED
}
}
using pg8::Unit;
typedef const f32x4 (&AccRef)[2][2][4][2];

struct EpiSwiGLU {
    static constexpr bool PERM = true;
    bf16_t* H;
    __device__ __forceinline__ void operator()(AccRef acc, const Unit& u, int wr, int wc, int fr, int fq) const {
        const int row0 = u.pm * 256 + wr * 64 + fr, col0 = u.pn * 128 + wc * 32 + 8 * fq;
#pragma unroll
        for (int ai = 0; ai < 2; ++ai)
#pragma unroll
            for (int m = 0; m < 4; ++m) {
                const f32x4 g0 = acc[ai][0][m][0], g1 = acc[ai][0][m][1], u0 = acc[ai][1][m][0], u1 = acc[ai][1][m][1];
                u32x4 w;
                w.x = pk2(siluf_(g0[0]) * u0[0], siluf_(g0[1]) * u0[1]); w.y = pk2(siluf_(g0[2]) * u0[2], siluf_(g0[3]) * u0[3]);
                w.z = pk2(siluf_(g1[0]) * u1[0], siluf_(g1[1]) * u1[1]); w.w = pk2(siluf_(g1[2]) * u1[2], siluf_(g1[3]) * u1[3]);
                *(u32x4*)(H + (size_t)(col0 >> 6) * ((size_t)MT * 64) + (size_t)(row0 + ai * 128 + m * 16) * 64 + (col0 & 63)) = w;
            }
    }
};
struct EpiResid {
    static constexpr bool PERM = true;
    const float* xin_f; bf16_t* xb; float alpha; float* part;
    __device__ __forceinline__ void operator()(AccRef acc, const Unit& u, int wr, int wc, int fr, int fq) const {
        const int row0 = u.pm * 256 + wr * 64 + fr, col0 = u.pn * 256 + wc * 32 + 8 * fq;
        if (u.pm * 256 >= MP) {
            float* pb_ = part + ((size_t)u.sp * MS - MP) * D;
#pragma unroll
            for (int ai = 0; ai < 2; ++ai)
#pragma unroll
                for (int m = 0; m < 4; ++m) { float* o = pb_ + (size_t)(row0 + ai * 128 + m * 16) * D + col0;
#pragma unroll
                    for (int bj = 0; bj < 2; ++bj)
#pragma unroll
                        for (int n = 0; n < 2; ++n) *(f32x4*)(o + bj * 128 + n * 4) = acc[ai][bj][m][n] * alpha; }
            return;
        }
        if (xin_f) {
#pragma unroll
            for (int ai = 0; ai < 2; ++ai) {
                f32x4 b[4][2][2];
#pragma unroll
                for (int m = 0; m < 4; ++m) { const size_t off = (size_t)(row0 + ai * 128 + m * 16) * D + col0;
#pragma unroll
                    for (int bj = 0; bj < 2; ++bj)
#pragma unroll
                        for (int n = 0; n < 2; ++n) b[m][bj][n] = *(const f32x4*)(xin_f + off + bj * 128 + n * 4); }
#pragma unroll
                for (int m = 0; m < 4; ++m) { const size_t off = (size_t)(row0 + ai * 128 + m * 16) * D + col0;
#pragma unroll
                    for (int bj = 0; bj < 2; ++bj) { const f32x4 a0 = b[m][bj][0] + acc[ai][bj][m][0] * alpha, a1 = b[m][bj][1] + acc[ai][bj][m][1] * alpha;
                        u32x4 w; w.x = pk2(a0[0], a0[1]); w.y = pk2(a0[2], a0[3]); w.z = pk2(a1[0], a1[1]); w.w = pk2(a1[2], a1[3]);
                        *(u32x4*)(xb + off + bj * 128) = w; } }
            }
        } else {
#pragma unroll
            for (int ai = 0; ai < 2; ++ai) {
                u32x4 b[4][2];
#pragma unroll
                for (int m = 0; m < 4; ++m) { const size_t off = (size_t)(row0 + ai * 128 + m * 16) * D + col0;
#pragma unroll
                    for (int bj = 0; bj < 2; ++bj) b[m][bj] = *(const u32x4*)(xb + off + bj * 128); }
#pragma unroll
                for (int m = 0; m < 4; ++m) { const size_t off = (size_t)(row0 + ai * 128 + m * 16) * D + col0;
#pragma unroll
                    for (int bj = 0; bj < 2; ++bj) { const u32x4 x = b[m][bj];
                        const f32x4 x0 = {bf_lo(x.x), bf_hi(x.x), bf_lo(x.y), bf_hi(x.y)}, x1 = {bf_lo(x.z), bf_hi(x.z), bf_lo(x.w), bf_hi(x.w)};
                        const f32x4 a0 = x0 + acc[ai][bj][m][0] * alpha, a1 = x1 + acc[ai][bj][m][1] * alpha;
                        u32x4 w; w.x = pk2(a0[0], a0[1]); w.y = pk2(a0[2], a0[3]); w.z = pk2(a1[0], a1[1]); w.w = pk2(a1[2], a1[3]);
                        *(u32x4*)(xb + off + bj * 128) = w; } }
            }
        }
    }
};
struct EpiWin {
    static constexpr bool PERM = true;
    bf16_t* U; float* US; float* fk_p; float* fk_s; float* fv_p; float* fv_s;
    __device__ __forceinline__ void operator()(AccRef acc, const Unit& u, int wr, int wc, int fr, int fq) const {
        const int row0 = u.pm * 256 + wr * 64 + fr, cw = wc * 32 + 8 * fq;
        const int pn = u.pn;
        if (pn < 26) {
            float* fo = nullptr;
            if (pn >= 18) { const bool isv = pn >= 22; const int hc = (pn - (isv ? 22 : 18)) * 256;
                fo = (u.pm * 256 < MP) ? (isv ? fv_p : fk_p) : (isv ? fv_s : fk_s) - (size_t)MP * 1024; fo += hc; }
#pragma unroll
            for (int ai = 0; ai < 2; ++ai)
#pragma unroll
                for (int m = 0; m < 4; ++m) { const int row = row0 + ai * 128 + m * 16;
#pragma unroll
                    for (int bj = 0; bj < 2; ++bj) { const f32x4 v0 = acc[ai][bj][m][0], v1 = acc[ai][bj][m][1];
                        u32x4 w; w.x = pk2(v0[0], v0[1]); w.y = pk2(v0[2], v0[3]); w.z = pk2(v1[0], v1[1]); w.w = pk2(v1[2], v1[3]);
                        *(u32x4*)(U + (size_t)row * LDU + pn * 256 + bj * 128 + cw) = w;
                        if (fo) { float* o = fo + (size_t)row * 1024 + bj * 128 + cw; *(f32x4*)o = v0; *(f32x4*)(o + 4) = v1; } } }
        } else if (pn < 50) {
#pragma unroll
            for (int ai = 0; ai < 2; ++ai)
#pragma unroll
                for (int m = 0; m < 4; ++m) { const int row = row0 + ai * 128 + m * 16;
#pragma unroll
                    for (int bj = 0; bj < 2; ++bj) { const f32x4 v0 = acc[ai][bj][m][0], v1 = acc[ai][bj][m][1];
                        u32x4 w; w.x = pk2(sigmoidf_(v0[0]), sigmoidf_(v0[1])); w.y = pk2(sigmoidf_(v0[2]), sigmoidf_(v0[3]));
                        w.z = pk2(sigmoidf_(v1[0]), sigmoidf_(v1[1])); w.w = pk2(sigmoidf_(v1[2]), sigmoidf_(v1[3]));
                        *(u32x4*)(U + (size_t)row * LDU + pn * 256 + bj * 128 + cw) = w; } }
        } else {
#pragma unroll
            for (int ai = 0; ai < 2; ++ai)
#pragma unroll
                for (int m = 0; m < 4; ++m) { const int row = row0 + ai * 128 + m * 16;
                    float* o = US + (size_t)row * LDUS + cw; *(f32x4*)o = acc[ai][0][m][0]; *(f32x4*)(o + 4) = acc[ai][0][m][1]; }
        }
    }
};
struct EpiUq {
    static constexpr bool PERM = true;
    bf16_t* Q; const f32x2* rope;
    __device__ __forceinline__ void operator()(AccRef acc, const Unit& u, int wr, int wc, int fr, int fq) const {
        const int row0 = u.pm * 256 + wr * 64 + fr;
#pragma unroll
        for (int bj = 0; bj < 2; ++bj) {
            const int c0 = u.pn * 256 + bj * 128 + wc * 32 + 8 * fq, r = c0 % 192;
            const bool isrope = r >= 128; const int j0 = (r - 128) >> 1;
#pragma unroll
            for (int ai = 0; ai < 2; ++ai)
#pragma unroll
                for (int m = 0; m < 4; ++m) { const int row = row0 + ai * 128 + m * 16;
                    f32x4 v0 = acc[ai][bj][m][0], v1 = acc[ai][bj][m][1];
                    if (isrope) { const f32x2* cs = rope + (size_t)pos_of(row) * 32 + j0;
                        const f32x2 a = cs[0], b = cs[1], c = cs[2], d = cs[3];
                        const f32x4 t0 = v0, t1 = v1;
                        v0[0] = t0[0] * a.x - t0[1] * a.y; v0[1] = t0[1] * a.x + t0[0] * a.y; v0[2] = t0[2] * b.x - t0[3] * b.y; v0[3] = t0[3] * b.x + t0[2] * b.y;
                        v1[0] = t1[0] * c.x - t1[1] * c.y; v1[1] = t1[1] * c.x + t1[0] * c.y; v1[2] = t1[2] * d.x - t1[3] * d.y; v1[3] = t1[3] * d.x + t1[2] * d.y; }
                    u32x4 w; w.x = pk2(v0[0], v0[1]); w.y = pk2(v0[2], v0[3]); w.z = pk2(v1[0], v1[1]); w.w = pk2(v1[2], v1[3]);
                    *(u32x4*)(Q + (size_t)row * 1536 + c0) = w; }
        }
    }
};
struct EpiUkv {
    static constexpr bool PERM = true;
    bf16_t* KM; bf16_t* VT;
    __device__ __forceinline__ void operator()(AccRef acc, const Unit& u, int wr, int wc, int fr, int fq) const {
        const int row0 = u.pm * 256 + wr * 64 + fr, h = u.pn, d0 = wc * 32 + 8 * fq;
#pragma unroll
        for (int ai = 0; ai < 2; ++ai)
#pragma unroll
            for (int m = 0; m < 4; ++m) { const int row = row0 + ai * 128 + m * 16;
                { const f32x4 v0 = acc[ai][0][m][0], v1 = acc[ai][0][m][1];
                  u32x4 w; w.x = pk2(v0[0], v0[1]); w.y = pk2(v0[2], v0[3]); w.z = pk2(v1[0], v1[1]); w.w = pk2(v1[2], v1[3]);
                  *(u32x4*)(KM + ((size_t)row * 8 + h) * 192 + d0) = w; }
                { const f32x4 v0 = acc[ai][1][m][0], v1 = acc[ai][1][m][1];
                  bf16_t* vt = VT + (size_t)(h * 128 + d0) * KVROWS + row;
#pragma unroll
                  for (int j = 0; j < 4; ++j) { vt[(size_t)j * KVROWS] = f2bf(v0[j]); vt[(size_t)(j + 4) * KVROWS] = f2bf(v1[j]); } } }
    }
};
template <int BR> struct EpiMerge {
    static constexpr bool PERM = true;
    const bf16_t* U; bf16_t* MG;
    __device__ __forceinline__ void operator()(AccRef acc, const Unit& u, int wr, int wc, int fr, int fq) const {
        const int row0 = u.pm * 256 + wr * 64 + fr, colb = u.pn * 256 + wc * 32 + 8 * fq;
#pragma unroll
        for (int ai = 0; ai < 2; ++ai) {
            u32x4 gt[4][2], od[4][2];
#pragma unroll
            for (int m = 0; m < 4; ++m) { const int row = row0 + ai * 128 + m * 16;
#pragma unroll
                for (int bj = 0; bj < 2; ++bj) { gt[m][bj] = *(const u32x4*)(U + (size_t)row * LDU + UC_GATE + BR * D + colb + bj * 128);
                    if (BR > 0) od[m][bj] = *(const u32x4*)(MG + (size_t)row * D + colb + bj * 128); } }
#pragma unroll
            for (int m = 0; m < 4; ++m) { const int row = row0 + ai * 128 + m * 16;
#pragma unroll
                for (int bj = 0; bj < 2; ++bj) { const u32x4 g = gt[m][bj];
                    f32x4 v0 = acc[ai][bj][m][0], v1 = acc[ai][bj][m][1];
                    v0[0] *= bf_lo(g.x); v0[1] *= bf_hi(g.x); v0[2] *= bf_lo(g.y); v0[3] *= bf_hi(g.y);
                    v1[0] *= bf_lo(g.z); v1[1] *= bf_hi(g.z); v1[2] *= bf_lo(g.w); v1[3] *= bf_hi(g.w);
                    if (BR > 0) { const u32x4 o = od[m][bj];
                        v0[0] += bf_lo(o.x); v0[1] += bf_hi(o.x); v0[2] += bf_lo(o.y); v0[3] += bf_hi(o.y);
                        v1[0] += bf_lo(o.z); v1[1] += bf_hi(o.z); v1[2] += bf_lo(o.w); v1[3] += bf_hi(o.w); }
                    u32x4 w; w.x = pk2(v0[0], v0[1]); w.y = pk2(v0[2], v0[3]); w.z = pk2(v1[0], v1[1]); w.w = pk2(v1[2], v1[3]);
                    *(u32x4*)(MG + (size_t)row * D + colb + bj * 128) = w; } }
        }
    }
};

struct EpiMergeSample {
    static constexpr bool PERM = true;
    const bf16_t* U; bf16_t* MG; float* part; unsigned* cnt; LAS unsigned* flag;
    __device__ __forceinline__ void operator()(AccRef acc, const Unit& u, int wr, int wc, int fr, int fq) const {
        const int br = u.pn >> 3, pn8 = u.pn & 7;
        const int row0 = wr * 64 + fr, colb = pn8 * 256 + wc * 32 + 8 * fq;
        float* pb = part + (size_t)br * MS * D;
#pragma unroll
        for (int ai = 0; ai < 2; ++ai)
#pragma unroll
            for (int m = 0; m < 4; ++m) { const int row = row0 + ai * 128 + m * 16;
#pragma unroll
                for (int bj = 0; bj < 2; ++bj) { const u32x4 g = *(const u32x4*)(U + (size_t)(MP + row) * LDU + UC_GATE + br * D + colb + bj * 128);
                    f32x4 v0 = acc[ai][bj][m][0], v1 = acc[ai][bj][m][1];
                    v0[0] *= bf_lo(g.x); v0[1] *= bf_hi(g.x); v0[2] *= bf_lo(g.y); v0[3] *= bf_hi(g.y);
                    v1[0] *= bf_lo(g.z); v1[1] *= bf_hi(g.z); v1[2] *= bf_lo(g.w); v1[3] *= bf_hi(g.w);
                    unsigned long long* o = (unsigned long long*)(pb + (size_t)row * D + colb + bj * 128);
                    __hip_atomic_store(o + 0, ((unsigned long long)__float_as_uint(v0[1]) << 32) | __float_as_uint(v0[0]), __ATOMIC_RELAXED, __HIP_MEMORY_SCOPE_AGENT);
                    __hip_atomic_store(o + 1, ((unsigned long long)__float_as_uint(v0[3]) << 32) | __float_as_uint(v0[2]), __ATOMIC_RELAXED, __HIP_MEMORY_SCOPE_AGENT);
                    __hip_atomic_store(o + 2, ((unsigned long long)__float_as_uint(v1[1]) << 32) | __float_as_uint(v1[0]), __ATOMIC_RELAXED, __HIP_MEMORY_SCOPE_AGENT);
                    __hip_atomic_store(o + 3, ((unsigned long long)__float_as_uint(v1[3]) << 32) | __float_as_uint(v1[2]), __ATOMIC_RELAXED, __HIP_MEMORY_SCOPE_AGENT); } }
        asm volatile("s_waitcnt vmcnt(0)" ::: "memory");
        __builtin_amdgcn_s_barrier();
        const int t = (wr * 4 + wc) * 64 + fq * 16 + fr;
        if (t == 0) { const unsigned old = __hip_atomic_fetch_add(cnt + 64 * pn8, 1u, __ATOMIC_RELAXED, __HIP_MEMORY_SCOPE_AGENT); *flag = (old == 2u) ? 1u : 0u; }
        asm volatile("s_waitcnt vmcnt(0) lgkmcnt(0)" ::: "memory");
        __builtin_amdgcn_s_barrier();
        asm volatile("" ::: "memory");
        if (*flag != 0u) {
            __builtin_amdgcn_fence(__ATOMIC_ACQUIRE, "agent");
            asm volatile("s_waitcnt vmcnt(0)" ::: "memory");
#pragma unroll 2
            for (int k = 0; k < 16; ++k) { const int e = (k * 512 + t) * 8, r = e >> 8, c = e & 255;
                const float* src = part + (size_t)r * D + pn8 * 256 + c;
                f32x4 a = *(const f32x4*)src, b = *(const f32x4*)(src + 4);
                a = a + *(const f32x4*)(src + (size_t)MS * D) + *(const f32x4*)(src + (size_t)2 * MS * D);
                b = b + *(const f32x4*)(src + (size_t)MS * D + 4) + *(const f32x4*)(src + (size_t)2 * MS * D + 4);
                u32x4 w; w.x = pk2(a[0], a[1]); w.y = pk2(a[2], a[3]); w.z = pk2(b[0], b[1]); w.w = pk2(b[2], b[3]);
                *(u32x4*)(MG + (size_t)(MP + r) * D + pn8 * 256 + c) = w; }
        }
    }
};

struct Frame {
    LAS unsigned char* lds;
    int tid, lane, wave, vcu, G, bx;
    int gw, NGW;
};
__device__ __forceinline__ int lane_now() { unsigned z = 0u; asm volatile("" : "+s"(z)); return (int)__builtin_amdgcn_mbcnt_hi(~0u, __builtin_amdgcn_mbcnt_lo(~0u, z)); }
__device__ __forceinline__ Frame mk_frame(int wave_s) {
    extern __shared__ __attribute__((aligned(16))) unsigned char lds_raw[];
    Frame F; F.lds = (LAS unsigned char*)lds_raw;
    asm volatile("" : "+s"(wave_s)); const int t = wave_s * 64 + lane_now();
    int bx = blockIdx.x, G = gridDim.x; asm volatile("" : "+s"(bx), "+s"(G));
    F.tid = t; F.lane = t & 63; F.wave = __builtin_amdgcn_readfirstlane(t >> 6);
    F.G = G; F.bx = bx; F.vcu = (G % 8 == 0) ? (bx % 8) * (G / 8) + bx / 8 : bx;
    F.gw = F.vcu * 8 + F.wave; F.NGW = G * 8;
    return F;
}

template <int KIND> __device__ __forceinline__ int map_row(int n, float& sc) {
    sc = 1.f;
    if (KIND == 0) return n;
    if (KIND == 1) return 256 * (n >> 7) + (n & 127);
    if (KIND == 2) return 256 * (n >> 7) + 128 + (n & 127);
    if (KIND == 3) {
        if (n < 1024) return n;
        if (n < 1088) return 12800 + (n - 1024);
        if (n < 2112) return UC_Z + (n - 1088);
        if (n < 3648) return UC_XBC + (n - 2112);
        if (n < 3664) return 12864 + (n - 3648);
        if (n < 4688) { sc = FOX_QSCALE; return UC_FQ + (n - 3664); }
        if (n < 5712) return UC_FK + (n - 4688);
        if (n < 6736) return UC_FV + (n - 5712);
        if (n < 6744) return 12880 + (n - 6736);
        return UC_GATE + (n - 6744);
    }
    if (KIND == 4) {
        sc = MLA_QSCALE; const int h = n / 192, r = n % 192;
        if (r < 128) return n;
        const int rr = r - 128; return h * 192 + 128 + 2 * (rr & 31) + (rr >> 5);
    }
    return n;
}
template <int KIND>
__device__ __forceinline__ void cvt_item(const float* W, int N, bf16_t* WT, size_t ldo, size_t coloff, LAS float* scr, int item, int lane, size_t kblk = 0) {
    const int nblk = (N + 31) / 32, kb = item / nblk, nb = item % nblk, k0 = 64 * kb, n0 = 32 * nb;
    const int nn = n0 + (lane & 31); const bool ok = nn < N;
#pragma unroll
    for (int i = 0; i < 32; ++i) { const int kk = 2 * i + (lane >> 5); scr[kk * 33 + (lane & 31)] = ok ? W[(size_t)(k0 + kk) * N + nn] : 0.f; }
    LDS_WAIT(); asm volatile("" ::: "memory");
    const int c = lane & 7;
#pragma unroll
    for (int j = 0; j < 4; ++j) { const int n = (lane >> 3) + 8 * j;
        if (n0 + n < N) { float sc; const int dr = map_row<KIND>(n0 + n, sc); const LAS float* s = scr + (8 * c) * 33 + n;
            u32x4 o; o.x = pk2(s[0 * 33] * sc, s[1 * 33] * sc); o.y = pk2(s[2 * 33] * sc, s[3 * 33] * sc); o.z = pk2(s[4 * 33] * sc, s[5 * 33] * sc); o.w = pk2(s[6 * 33] * sc, s[7 * 33] * sc);
            *(u32x4*)(kblk ? WT + (size_t)kb * kblk + (size_t)dr * 64 + 8 * c : WT + (size_t)dr * ldo + coloff + k0 + 8 * c) = o; } }
    LDS_WAIT(); asm volatile("" ::: "memory");
}

__device__ __forceinline__ void phase_convert(const Params&, const Frame& F0, int layer0) {
    const Frame F = mk_frame(F0.wave);
    const PV p = pv_get(); int layer = layer0; asm volatile("" : "+s"(layer));
    LAS float* scr = (LAS float*)(F.lds + F.wave * 16384);
    unsigned z0_ = 0u; asm volatile("" : "+v"(z0_)); const u32x4 Z4 = {z0_, z0_, z0_, z0_};
    bf16_t* W = (bf16_t*)(p.ws() + WS_W);
    const size_t lFF = (size_t)layer * D * FF;
    constexpr int IT_FF = (D / 64) * (FF / 32), IT_DN = (FF / 64) * (D / 32), IT_IN = (D / 64) * ((IN_COLS + 31) / 32), IT_UQ = 8 * 48, IT_UKV = 8 * 64, IT_BR = 16 * 64, IT_OUT = 32 * 64;
    constexpr int IT_FV = NB * 16 * 32;
    constexpr int NITEMS = 6 * IT_FF + IT_IN + IT_UQ + IT_UKV + 3 * IT_BR + IT_OUT + IT_FV;
    static_assert(IT_FF == IT_DN, "items");
    for (int it = F.gw; it < NITEMS; it += F.NGW) {
        int r = it;
        if (r < IT_FF) { cvt_item<1>(p.in(I_F1G) + lFF, FF, W + W_GU1, D, 0, scr, r, F.lane, (size_t)2 * FF * 64); continue; } r -= IT_FF;
        if (r < IT_FF) { cvt_item<2>(p.in(I_F1U) + lFF, FF, W + W_GU1, D, 0, scr, r, F.lane, (size_t)2 * FF * 64); continue; } r -= IT_FF;
        if (r < IT_DN) { cvt_item<0>(p.in(I_F1D) + lFF, D, W + W_D1, FF, 0, scr, r, F.lane, (size_t)D * 64); continue; } r -= IT_DN;
        if (r < IT_FF) { cvt_item<1>(p.in(I_F2G) + lFF, FF, W + W_GU2, D, 0, scr, r, F.lane, (size_t)2 * FF * 64); continue; } r -= IT_FF;
        if (r < IT_FF) { cvt_item<2>(p.in(I_F2U) + lFF, FF, W + W_GU2, D, 0, scr, r, F.lane, (size_t)2 * FF * 64); continue; } r -= IT_FF;
        if (r < IT_DN) { cvt_item<0>(p.in(I_F2D) + lFF, D, W + W_D2, FF, 0, scr, r, F.lane, (size_t)D * 64); continue; } r -= IT_DN;
        if (r < IT_IN) { cvt_item<3>(p.in(I_WIN) + (size_t)layer * D * IN_COLS, IN_COLS, W + W_IN, D, 0, scr, r, F.lane, (size_t)NWIN * 64); continue; } r -= IT_IN;
        if (r < IT_UQ) { cvt_item<4>(p.in(I_WUQ) + (size_t)layer * 512 * 1536, 1536, W + W_UQ, 512, 0, scr, r, F.lane); continue; } r -= IT_UQ;
        if (r < IT_UKV) { cvt_item<0>(p.in(I_WUKV) + (size_t)layer * 512 * 2048, 2048, W + W_UKV, 512, 0, scr, r, F.lane); continue; } r -= IT_UKV;
        if (r < IT_BR) { cvt_item<0>(p.in(I_BRM) + (size_t)layer * 1024 * D, D, W + W_BR, 1024, 0, scr, r, F.lane); continue; } r -= IT_BR;
        if (r < IT_BR) { cvt_item<0>(p.in(I_BRS) + (size_t)layer * 1024 * D, D, W + W_BR + (size_t)D * 1024, 1024, 0, scr, r, F.lane); continue; } r -= IT_BR;
        if (r < IT_BR) { cvt_item<0>(p.in(I_BRF) + (size_t)layer * 1024 * D, D, W + W_BR + (size_t)2 * D * 1024, 1024, 0, scr, r, F.lane); continue; } r -= IT_BR;
        if (r < IT_OUT) { cvt_item<0>(p.in(I_WOUT) + (size_t)layer * D * D, D, W + W_OUT, D, 0, scr, r, F.lane); continue; } r -= IT_OUT;
        { const int b = r / 512, ri = r % 512;
          cvt_item<0>(p.in(I_CFV) + ((size_t)layer * NB + b) * PAST * 1024, 1024, (bf16_t*)(p.ws() + WS_VTF), KVROWS, (size_t)MP + (size_t)b * KVS, scr, ri, F.lane); }
    }
    const size_t gt = (size_t)F.gw * 64 + F.lane, NT = (size_t)F.NGW * 64;
    {
        constexpr int PADE = (NWIN - IN_COLS) * 64 / 8;
        for (size_t i = gt; i < (size_t)PADE * (D / 64); i += NT) { const int kb = (int)(i / PADE), rem = (int)(i % PADE);
            *(u32x4*)(W + W_IN + (size_t)kb * ((size_t)NWIN * 64) + (size_t)IN_COLS * 64 + (size_t)rem * 8) = Z4; }
    }
    {
        const float* src = p.in(I_CCKV) + (size_t)layer * NB * PAST * 512; bf16_t* dst = (bf16_t*)(p.ws() + WS_CKV);
        for (size_t i = gt; i < (size_t)NB * PAST * 512 / 8; i += NT) { const size_t e = i * 8; const int b = (int)(e / (PAST * 512)), rem = (int)(e % (PAST * 512));
            const f32x4 a = *(const f32x4*)(src + e), c = *(const f32x4*)(src + e + 4);
            u32x4 w; w.x = pk2(a[0], a[1]); w.y = pk2(a[2], a[3]); w.z = pk2(c[0], c[1]); w.w = pk2(c[2], c[3]);
            *(u32x4*)(dst + ((size_t)MP + (size_t)b * KVS) * 512 + rem) = w; }
        for (size_t i = gt; i < (size_t)NB * (KVS - KVLEN_S) * 512 / 8; i += NT) { const size_t e = i * 8; const int b = (int)(e / ((KVS - KVLEN_S) * 512)), rem = (int)(e % ((KVS - KVLEN_S) * 512));
            *(u32x4*)(dst + ((size_t)MP + (size_t)b * KVS + KVLEN_S) * 512 + rem) = Z4; }
    }
    {
        const float* src = p.in(I_CFK) + (size_t)layer * NB * PAST * 1024; bf16_t* dst = (bf16_t*)(p.ws() + WS_KFS);
        for (size_t i = gt; i < (size_t)NB * PAST * 1024 / 8; i += NT) { const size_t e = i * 8; const int b = (int)(e / (PAST * 1024)), rem = (int)(e % (PAST * 1024));
            const f32x4 a = *(const f32x4*)(src + e), c = *(const f32x4*)(src + e + 4);
            u32x4 w; w.x = pk2(a[0], a[1]); w.y = pk2(a[2], a[3]); w.z = pk2(c[0], c[1]); w.w = pk2(c[2], c[3]);
            *(u32x4*)(dst + (size_t)b * KVS * 1024 + rem) = w; }
        for (size_t i = gt; i < (size_t)NB * (KVS - KVLEN_S) * 1024 / 8; i += NT) { const size_t e = i * 8; const int b = (int)(e / ((KVS - KVLEN_S) * 1024)), rem = (int)(e % ((KVS - KVLEN_S) * 1024));
            *(u32x4*)(dst + ((size_t)b * KVS + KVLEN_S) * 1024 + rem) = Z4; }
    }
    {
        const float* src = p.in(I_CKPE) + (size_t)layer * NB * PAST * 64; bf16_t* km = (bf16_t*)(p.ws() + WS_KM);
        for (size_t i = gt; i < (size_t)NB * KVS * 32; i += NT) { const int j = (int)(i & 31); const int pr = (int)(i >> 5) % KVS, b = (int)(i >> 5) / KVS;
            unsigned w = 0u;
            if (pr < PAST) { const float* s = src + ((size_t)b * PAST + pr) * 64; w = pk2(s[j], s[32 + j]); }
            if (pr < PAST || pr >= KVLEN_S) { const size_t kr = (size_t)MP + (size_t)b * KVS + pr;
#pragma unroll
                for (int h = 0; h < 8; ++h) *(unsigned*)(km + (kr * 8 + h) * 192 + 128 + 2 * j) = w; } }
        const float* ls = p.in(I_CLOGF) + (size_t)layer * NB * PAST * 8; float* ld = (float*)(p.ws() + WS_LOGF);
        for (size_t i = gt; i < (size_t)NB * KVS * 8; i += NT) { const int hh = (int)(i & 7); const int pr = (int)(i >> 3) % KVS, b = (int)(i >> 3) / KVS;
            if (pr < PAST) ld[((size_t)MP + (size_t)b * KVS + pr) * 8 + hh] = ls[((size_t)b * PAST + pr) * 8 + hh];
            else if (pr >= KVLEN_S) ld[((size_t)MP + (size_t)b * KVS + pr) * 8 + hh] = 0.f; }
        bf16_t* vtf = (bf16_t*)(p.ws() + WS_VTF);
        for (size_t i = gt; i < (size_t)1024 * NB * (KVS - KVLEN_S); i += NT) { const int pc = (int)(i % (KVS - KVLEN_S)); const int b = (int)(i / (KVS - KVLEN_S)) % NB, ch = (int)(i / (KVS - KVLEN_S)) / NB;
            vtf[(size_t)ch * KVROWS + MP + (size_t)b * KVS + KVLEN_S + pc] = 0; }
    }
}

__device__ __forceinline__ void phase_rope_table(const Frame& F0) {
    const Frame F = mk_frame(F0.wave);
    const PV p = pv_get();
    const size_t gt = (size_t)F.gw * 64 + F.lane, NT = (size_t)F.NGW * 64;
    f32x2* rt = (f32x2*)(p.ws() + WS_ROPE);
    for (size_t i = gt; i < (size_t)SEQ * 32; i += NT) { const int j = (int)(i & 31), ps = (int)(i >> 5);
        const float inv = powf(10000.0f, -(float)j / 32.0f); const float ang = (float)ps * inv;
        float sn, cs; sincosf(ang, &sn, &cs); rt[i] = (f32x2){cs, sn}; }
}
__device__ __forceinline__ void phase_norm(const Frame& F, const float* xp, const bf16_t* xb, const float* xs, const float* gain, bf16_t* XN, float* copy_s, const float* part) {
    f32x4 g[8];
#pragma unroll
    for (int j = 0; j < 8; ++j) g[j] = *(const f32x4*)(gain + 4 * F.lane + 256 * j);
    for (int m = F.gw; m < MT; m += F.NGW) {
        f32x4 v[8]; float s = 0.f;
        if (m < MP && !xp) { const bf16_t* xr = xb + (size_t)m * D + 4 * F.lane;
#pragma unroll
            for (int j = 0; j < 8; ++j) { const u32x2 w = *(const u32x2*)(xr + 256 * j); v[j] = (f32x4){bf_lo(w.x), bf_hi(w.x), bf_lo(w.y), bf_hi(w.y)}; }
        } else { const float* xr = (m < MP) ? xp + (size_t)m * D : xs + (size_t)(m - MP) * D;
#pragma unroll
            for (int j = 0; j < 8; ++j) v[j] = *(const f32x4*)(xr + 4 * F.lane + 256 * j); }
#pragma unroll
        for (int j = 0; j < 8; ++j) s += (v[j][0] * v[j][0] + v[j][1] * v[j][1]) + (v[j][2] * v[j][2] + v[j][3] * v[j][3]);
        if (m >= MP && (copy_s || part)) {
            if (part) { s = 0.f;
#pragma unroll
                for (int sp = 0; sp < 8; ++sp)
#pragma unroll
                    for (int j = 0; j < 8; ++j) v[j] += *(const f32x4*)(part + ((size_t)sp * MS + (m - MP)) * D + 4 * F.lane + 256 * j);
#pragma unroll
                for (int j = 0; j < 8; ++j) s += (v[j][0] * v[j][0] + v[j][1] * v[j][1]) + (v[j][2] * v[j][2] + v[j][3] * v[j][3]); }
            float* xo = (copy_s ? copy_s : const_cast<float*>(xs)) + (size_t)(m - MP) * D;
#pragma unroll
            for (int j = 0; j < 8; ++j) *(f32x4*)(xo + 4 * F.lane + 256 * j) = v[j]; }
        const float rs = fast_rsqrt(wave_sum(s, F.lane) * (1.0f / D) + EPS);
        bf16_t* o = XN + (size_t)(F.lane >> 4) * ((size_t)MT * 64) + (size_t)m * 64 + 4 * (F.lane & 15);
#pragma unroll
        for (int j = 0; j < 8; ++j) { u32x2 w; w.x = pk2(v[j][0] * rs * g[j][0], v[j][1] * rs * g[j][1]); w.y = pk2(v[j][2] * rs * g[j][2], v[j][3] * rs * g[j][3]); *(u32x2*)(o + (size_t)(4 * j) * ((size_t)MT * 64)) = w; }
    }
}
__device__ __forceinline__ void phase_final_norm(const Frame& F, float* x, const bf16_t* xb, const float* gain, const float* part) {
    f32x4 g[8];
#pragma unroll
    for (int j = 0; j < 8; ++j) g[j] = *(const f32x4*)(gain + 4 * F.lane + 256 * j);
    for (int m = F.gw; m < MT; m += F.NGW) {
        float* xr = x + (size_t)m * D;
        f32x4 v[8]; float s = 0.f;
        if (m < MP) { const bf16_t* xq = xb + (size_t)m * D + 4 * F.lane;
#pragma unroll
            for (int j = 0; j < 8; ++j) { const u32x2 w = *(const u32x2*)(xq + 256 * j); v[j] = (f32x4){bf_lo(w.x), bf_hi(w.x), bf_lo(w.y), bf_hi(w.y)}; }
        } else {
#pragma unroll
            for (int j = 0; j < 8; ++j) v[j] = *(const f32x4*)(xr + 4 * F.lane + 256 * j); }
        if (m >= MP) {
#pragma unroll
            for (int sp = 0; sp < 8; ++sp)
#pragma unroll
                for (int j = 0; j < 8; ++j) v[j] += *(const f32x4*)(part + ((size_t)sp * MS + (m - MP)) * D + 4 * F.lane + 256 * j); }
#pragma unroll
        for (int j = 0; j < 8; ++j) s += (v[j][0] * v[j][0] + v[j][1] * v[j][1]) + (v[j][2] * v[j][2] + v[j][3] * v[j][3]);
        const float rs = fast_rsqrt(wave_sum(s, F.lane) * (1.0f / D) + EPS);
#pragma unroll
        for (int j = 0; j < 8; ++j) *(f32x4*)(xr + 4 * F.lane + 256 * j) = v[j] * rs * g[j];
    }
}
__device__ __forceinline__ float softplusf_(float x) {
    if (x > 20.f) return x; const float y = fast_exp(x); return y < 0.03125f ? y * (1.0f + y * (-0.5f + y * (0.33333333f - 0.25f * y))) : fast_log(1.0f + y); }
__device__ __forceinline__ void unpack8(const u32x4 w, float (&v)[8]) {
    v[0] = bf_lo(w.x); v[1] = bf_hi(w.x); v[2] = bf_lo(w.y); v[3] = bf_hi(w.y); v[4] = bf_lo(w.z); v[5] = bf_hi(w.z); v[6] = bf_lo(w.w); v[7] = bf_hi(w.w);
}
__device__ __forceinline__ void phase_t1(const Params&, const Frame& F0, int layer0) {
    const Frame F = mk_frame(F0.wave);
    const PV p = pv_get(); int layer = layer0; asm volatile("" : "+s"(layer));
    bf16_t* U = (bf16_t*)(p.ws() + WS_U); const float* US = (const float*)(p.ws() + WS_US);
    bf16_t* CKV = (bf16_t*)(p.ws() + WS_CKV); bf16_t* KM = (bf16_t*)(p.ws() + WS_KM); bf16_t* KFS = (bf16_t*)(p.ws() + WS_KFS); bf16_t* VTF = (bf16_t*)(p.ws() + WS_VTF);
    float* LOGF = (float*)(p.ws() + WS_LOGF); float* DTB = (float*)(p.ws() + WS_DT); const f32x2* rope = (const f32x2*)(p.ws() + WS_ROPE);
    unsigned* ctl = (unsigned*)(p.ws() + WS_CTL);
    float* o_pckv = p.out() + O_PCKV + (size_t)layer * MP * 512; float* o_sckv = p.out() + O_SCKV + (size_t)layer * MS * 512;
    float* o_pkpe = p.out() + O_PKPE + (size_t)layer * MP * 64; float* o_skpe = p.out() + O_SKPE + (size_t)layer * MS * 64;
    float* o_plf = p.out() + O_PLOGF + (size_t)layer * MP * 8; float* o_slf = p.out() + O_SLOGF + (size_t)layer * MS * 8;
    float* o_pconv = p.out() + O_PCONV + (size_t)layer * 3 * 1536; float* o_sconv = p.out() + O_SCONV + (size_t)layer * NB * 3 * 1536;
    float qg[8], kg[8];
#pragma unroll
    for (int j = 0; j < 8; ++j) { qg[j] = p.in(I_QN)[layer * 512 + 8 * F.lane + j]; kg[j] = p.in(I_KVN)[layer * 512 + 8 * F.lane + j]; }
    const float fb = (F.lane < 8) ? p.in(I_FBF)[layer * 8 + F.lane] : 0.f;
    const float db = (F.lane < 16) ? p.in(I_DTB)[layer * 16 + F.lane] : 0.f;
    for (int m = F.gw; m < MT; m += F.NGW) {
        const int kr = kvrow_of(m), ps = pos_of(m); const bool smp = m >= MP; const int mi = m - MP;
        bf16_t* ur = U + (size_t)m * LDU;
        const float* us = US + (size_t)m * LDUS;
        const u32x4 wq = *(const u32x4*)(ur + UC_QLAT + 8 * F.lane), wc = *(const u32x4*)(ur + UC_CKV + 8 * F.lane);
        const u32x4 fq0 = *(const u32x4*)(ur + UC_FQ + 16 * F.lane), fq1 = *(const u32x4*)(ur + UC_FQ + 16 * F.lane + 8);
        const u32x4 fk0 = *(const u32x4*)(ur + UC_FK + 16 * F.lane), fk1 = *(const u32x4*)(ur + UC_FK + 16 * F.lane + 8);
        float x1 = 0.f, x2 = 0.f; f32x2 cs = {0.f, 0.f};
        if (F.lane < 32) { x1 = us[US_KPE + F.lane]; x2 = us[US_KPE + 32 + F.lane]; cs = rope[(size_t)ps * 32 + F.lane]; }
        const float uff = (F.lane < 8) ? us[US_FF + F.lane] : 0.f, udt = (F.lane < 16) ? us[US_DT + F.lane] : 0.f;
        float vq[8], vc[8]; unpack8(wq, vq); unpack8(wc, vc);
        float sq_ = 0.f, sc_ = 0.f;
#pragma unroll
        for (int j = 0; j < 8; ++j) { sq_ += vq[j] * vq[j]; sc_ += vc[j] * vc[j]; }
        float nq = 0.f, nk = 0.f;
        { float a8[8], b8[8]; unpack8(fq0, a8); unpack8(fq1, b8);
#pragma unroll
          for (int j = 0; j < 8; ++j) nq += a8[j] * a8[j] + b8[j] * b8[j];
          unpack8(fk0, a8); unpack8(fk1, b8);
#pragma unroll
          for (int j = 0; j < 8; ++j) nk += a8[j] * a8[j] + b8[j] * b8[j]; }
#pragma unroll
        for (int o = 1; o < 64; o <<= 1) { const float t0 = shx(sq_, o, F.lane), t1 = shx(sc_, o, F.lane); sq_ += t0; sc_ += t1;
            if (o < 8) { const float t2 = shx(nq, o, F.lane), t3 = shx(nk, o, F.lane); nq += t2; nk += t3; } }
        {
            const float rs = fast_rsqrt(sq_ * (1.0f / 512) + EPS);
            u32x4 w; w.x = pk2(vq[0] * rs * qg[0], vq[1] * rs * qg[1]); w.y = pk2(vq[2] * rs * qg[2], vq[3] * rs * qg[3]); w.z = pk2(vq[4] * rs * qg[4], vq[5] * rs * qg[5]); w.w = pk2(vq[6] * rs * qg[6], vq[7] * rs * qg[7]);
            *(u32x4*)(ur + UC_QLAT + 8 * F.lane) = w;
        }
        {
            const float rs = fast_rsqrt(sc_ * (1.0f / 512) + EPS);
#pragma unroll
            for (int j = 0; j < 8; ++j) vc[j] = vc[j] * rs * kg[j];
            float* o = (smp ? o_sckv + (size_t)mi * 512 : o_pckv + (size_t)m * 512) + 8 * F.lane;
            *(f32x4*)o = (f32x4){vc[0], vc[1], vc[2], vc[3]}; *(f32x4*)(o + 4) = (f32x4){vc[4], vc[5], vc[6], vc[7]};
            u32x4 w; w.x = pk2(vc[0], vc[1]); w.y = pk2(vc[2], vc[3]); w.z = pk2(vc[4], vc[5]); w.w = pk2(vc[6], vc[7]);
            *(u32x4*)(CKV + (size_t)kr * 512 + 8 * F.lane) = w;
        }
        if (F.lane < 32) {
            const float o1 = x1 * cs.x - x2 * cs.y, o2 = x2 * cs.x + x1 * cs.y;
            float* o = smp ? o_skpe + (size_t)mi * 64 : o_pkpe + (size_t)m * 64; o[F.lane] = o1; o[32 + F.lane] = o2;
            const unsigned w = pk2(o1, o2);
#pragma unroll
            for (int h = 0; h < 8; ++h) *(unsigned*)(KM + ((size_t)kr * 8 + h) * 192 + 128 + 2 * F.lane) = w;
        }
        if (F.lane < 8) {
            const float lf = -softplusf_(-(uff + fb));
            (smp ? o_slf + (size_t)mi * 8 : o_plf + (size_t)m * 8)[F.lane] = lf; LOGF[(size_t)kr * 8 + F.lane] = lf;
        }
        if (F.lane < 16) DTB[(size_t)m * 16 + F.lane] = softplusf_(udt + db);
        if (!smp) {
            if ((F.lane & 7) == 0) { const int hh = F.lane >> 3;
                atomicMax(ctl + CW_QN2 + (layer * 64 + (m >> 8)) * 8 + hh, __float_as_uint(nq));
                atomicMax(ctl + CW_KN2 + (layer * 64 + (m >> 8)) * 8 + hh, __float_as_uint(nk)); }
        } else {
            bf16_t* kd = KFS + (size_t)(kr - MP) * 1024 + 16 * F.lane; *(u32x4*)kd = fk0; *(u32x4*)(kd + 8) = fk1;
        }
        {
            int slot = -1; float* od = nullptr;
            if (!smp) { if (m >= MP - 3) { slot = m - (MP - 3); od = o_pconv; } }
            else { const int t = mi & 15; if (t >= 13) { slot = t - 13; od = o_sconv + (size_t)(mi >> 4) * 3 * 1536; } }
            if (slot >= 0) { for (int c = F.lane; c < 1536; c += 64) od[slot * 1536 + c] = bf2f(ur[UC_XBC + c]); }
        }
    }
    {
        bf16_t* XC = (bf16_t*)(p.ws() + WS_XN);
        const float* cw = p.in(I_CW) + (size_t)layer * 4 * 1536; const float* cb = p.in(I_CB) + (size_t)layer * 1536; const float* cst = p.in(I_CONV) + (size_t)layer * NB * 3 * 1536;
        const size_t gt = (size_t)F.gw * 64 + F.lane, NT = (size_t)F.NGW * 64;
        constexpr int STRIP = 25, NSTRIP = (MP + STRIP - 1) / STRIP;
        for (size_t it = gt; it < (size_t)NSTRIP * 192; it += NT) { const int strip = (int)(it / 192), ch0 = (int)(it % 192) * 8; const int r0 = strip * STRIP;
            float wt[4][8], bs[8];
            { const f32x4 b0 = *(const f32x4*)(cb + ch0), b1 = *(const f32x4*)(cb + ch0 + 4); bs[0] = b0[0]; bs[1] = b0[1]; bs[2] = b0[2]; bs[3] = b0[3]; bs[4] = b1[0]; bs[5] = b1[1]; bs[6] = b1[2]; bs[7] = b1[3]; }
#pragma unroll
            for (int k = 0; k < 4; ++k) { const f32x4 w0 = *(const f32x4*)(cw + k * 1536 + ch0), w1 = *(const f32x4*)(cw + k * 1536 + ch0 + 4);
                wt[k][0] = w0[0]; wt[k][1] = w0[1]; wt[k][2] = w0[2]; wt[k][3] = w0[3]; wt[k][4] = w1[0]; wt[k][5] = w1[1]; wt[k][6] = w1[2]; wt[k][7] = w1[3]; }
            const bf16_t* up = U + UC_XBC + ch0;
            u32x4 win[3];
#pragma unroll
            for (int k = 0; k < 3; ++k) { const int rr = r0 - 3 + k; u32x4 z = {0u, 0u, 0u, 0u}; if (rr >= 0) z = *(const u32x4*)(up + (size_t)rr * LDU); win[k] = z; }
#pragma unroll 1
            for (int rb = 0; rb < STRIP; rb += 5) {
                u32x4 nw[5];
#pragma unroll
                for (int e = 0; e < 5; ++e) { const int rr = r0 + rb + e; nw[e] = (rr < MP) ? *(const u32x4*)(up + (size_t)rr * LDU) : (u32x4){0u, 0u, 0u, 0u}; }
#pragma unroll
                for (int e = 0; e < 5; ++e) { const int rr = r0 + rb + e;
                    float x0[8], x1[8], x2[8], x3[8]; unpack8(win[0], x0); unpack8(win[1], x1); unpack8(win[2], x2); unpack8(nw[e], x3);
                    float acc[8];
#pragma unroll
                    for (int j = 0; j < 8; ++j) acc[j] = bs[j] + wt[0][j] * x0[j] + wt[1][j] * x1[j] + wt[2][j] * x2[j] + wt[3][j] * x3[j];
                    u32x4 o; o.x = pk2(siluf_(acc[0]), siluf_(acc[1])); o.y = pk2(siluf_(acc[2]), siluf_(acc[3])); o.z = pk2(siluf_(acc[4]), siluf_(acc[5])); o.w = pk2(siluf_(acc[6]), siluf_(acc[7]));
                    if (rr < MP) *(u32x4*)(XC + (size_t)rr * 1536 + ch0) = o;
                    win[0] = win[1]; win[1] = win[2]; win[2] = nw[e]; }
            }
        }
        for (size_t i = gt; i < (size_t)MS * 192; i += NT) { const int m = MP + (int)(i / 192), ch0 = (int)(i % 192) * 8;
            const int t = (m - MP) & 15;
            float acc[8];
            { const f32x4 b0 = *(const f32x4*)(cb + ch0), b1 = *(const f32x4*)(cb + ch0 + 4); acc[0] = b0[0]; acc[1] = b0[1]; acc[2] = b0[2]; acc[3] = b0[3]; acc[4] = b1[0]; acc[5] = b1[1]; acc[6] = b1[2]; acc[7] = b1[3]; }
#pragma unroll
            for (int k = 0; k < 4; ++k) { const int ii = t - 3 + k; float xv[8];
                if (ii >= 0) unpack8(*(const u32x4*)(U + (size_t)(m - 3 + k) * LDU + UC_XBC + ch0), xv);
                else { const float* sp = cst + ((size_t)((m - MP) >> 4) * 3 + (ii + 3)) * 1536 + ch0; const f32x4 s0 = *(const f32x4*)sp, s1 = *(const f32x4*)(sp + 4);
                    xv[0] = s0[0]; xv[1] = s0[1]; xv[2] = s0[2]; xv[3] = s0[3]; xv[4] = s1[0]; xv[5] = s1[1]; xv[6] = s1[2]; xv[7] = s1[3]; }
                const f32x4 w0 = *(const f32x4*)(cw + k * 1536 + ch0), w1 = *(const f32x4*)(cw + k * 1536 + ch0 + 4);
                acc[0] += w0[0] * xv[0]; acc[1] += w0[1] * xv[1]; acc[2] += w0[2] * xv[2]; acc[3] += w0[3] * xv[3];
                acc[4] += w1[0] * xv[4]; acc[5] += w1[1] * xv[5]; acc[6] += w1[2] * xv[6]; acc[7] += w1[3] * xv[7]; }
            u32x4 o; o.x = pk2(siluf_(acc[0]), siluf_(acc[1])); o.y = pk2(siluf_(acc[2]), siluf_(acc[3])); o.z = pk2(siluf_(acc[4]), siluf_(acc[5])); o.w = pk2(siluf_(acc[6]), siluf_(acc[7]));
            *(u32x4*)(XC + (size_t)m * 1536 + ch0) = o; }
    }
    {
        constexpr int PITCH = 72;
        LAS bf16_t* tile = (LAS bf16_t*)(F.lds + F.wave * (64 * PITCH * 2));
        for (int it = F.gw; it < (MP / 64) * 16; it += F.NGW) {
            const int rt = it >> 4, ct = it & 15, row0 = rt * 64, ch0 = ct * 64;
            u32x4 v[8];
#pragma unroll
            for (int k = 0; k < 8; ++k) { const int r = 8 * k + (F.lane >> 3), c8 = F.lane & 7; v[k] = *(const u32x4*)(U + (size_t)(row0 + r) * LDU + UC_FV + ch0 + 8 * c8); }
#pragma unroll
            for (int k = 0; k < 8; ++k) { const int r = 8 * k + (F.lane >> 3), c8 = F.lane & 7; bf16_t e8[8]; *(u32x4*)e8 = v[k];
#pragma unroll
                for (int e = 0; e < 8; ++e) tile[(8 * c8 + e) * PITCH + r] = e8[e]; }
            LDS_WAIT(); asm volatile("" ::: "memory");
#pragma unroll
            for (int k = 0; k < 8; ++k) { const int ch = 8 * k + (F.lane >> 3), r8 = F.lane & 7; const u32x4 w = *(const LAS u32x4*)(tile + ch * PITCH + 8 * r8);
                *(u32x4*)(VTF + (size_t)(ch0 + ch) * KVROWS + row0 + 8 * r8) = w; }
            LDS_WAIT(); asm volatile("" ::: "memory");
        }
        const size_t gt = (size_t)F.gw * 64 + F.lane, NT = (size_t)F.NGW * 64;
        for (size_t i = gt; i < (size_t)MS * 1024; i += NT) { const int mi = (int)(i >> 10), ch = (int)(i & 1023);
            VTF[(size_t)ch * KVROWS + kvrow_of(MP + mi)] = U[(size_t)(MP + mi) * LDU + UC_FV + ch]; }
    }
}

__device__ __forceinline__ void phase_t2(const Params&, const Frame& F0) {
    const Frame F = mk_frame(F0.wave);
    const PV p = pv_get();
    const float* LOGF = (const float*)(p.ws() + WS_LOGF); float* CUM = (float*)(p.ws() + WS_CUM);
    LAS double* wt = (LAS double*)F.lds;
    for (int job = (F.G == 256) ? (F.bx + 56) % 256 : F.bx; job < 1 + NB; job += F.G) {
        const int base = job == 0 ? 0 : MP + (job - 1) * KVS, n = job == 0 ? MP : KVS;
        const int per = (n + 511) / 512, i0 = F.tid * per, i1 = (i0 + per < n) ? i0 + per : n;
        double s[8];
#pragma unroll
        for (int h = 0; h < 8; ++h) s[h] = 0.0;
        for (int i = i0; i < i1; ++i) { const f32x4 a = *(const f32x4*)(LOGF + (size_t)(base + i) * 8), b = *(const f32x4*)(LOGF + (size_t)(base + i) * 8 + 4);
            s[0] += a[0]; s[1] += a[1]; s[2] += a[2]; s[3] += a[3]; s[4] += b[0]; s[5] += b[1]; s[6] += b[2]; s[7] += b[3]; }
        double pre[8];
#pragma unroll
        for (int h = 0; h < 8; ++h) { double v = s[h];
#pragma unroll
            for (int o = 1; o < 64; o <<= 1) { const long long vb = __builtin_bit_cast(long long, v); const int src = ((F.lane - o) & 63) << 2;
                const unsigned lo_ = (unsigned)__builtin_amdgcn_ds_bpermute(src, (int)(unsigned)vb), hi_ = (unsigned)__builtin_amdgcn_ds_bpermute(src, (int)(unsigned)(vb >> 32));
                const double t = __builtin_bit_cast(double, ((unsigned long long)hi_ << 32) | lo_); if (F.lane >= o) v += t; }
            pre[h] = v - s[h]; if (F.lane == 63) wt[F.wave * 8 + h] = v; }
        __syncthreads();
#pragma unroll
        for (int h = 0; h < 8; ++h) { double off = 0.0; for (int ww = 0; ww < F.wave; ++ww) off += wt[ww * 8 + h]; pre[h] += off; }
        for (int i = i0; i < i1; ++i) { const f32x4 a = *(const f32x4*)(LOGF + (size_t)(base + i) * 8), b = *(const f32x4*)(LOGF + (size_t)(base + i) * 8 + 4);
            pre[0] += a[0]; pre[1] += a[1]; pre[2] += a[2]; pre[3] += a[3]; pre[4] += b[0]; pre[5] += b[1]; pre[6] += b[2]; pre[7] += b[3];
            *(f32x4*)(CUM + (size_t)(base + i) * 8) = (f32x4){(float)pre[0] * LOG2E, (float)pre[1] * LOG2E, (float)pre[2] * LOG2E, (float)pre[3] * LOG2E};
            *(f32x4*)(CUM + (size_t)(base + i) * 8 + 4) = (f32x4){(float)pre[4] * LOG2E, (float)pre[5] * LOG2E, (float)pre[6] * LOG2E, (float)pre[7] * LOG2E}; }
        __syncthreads();
    }
}

#define MFMA32(a, b, c) __builtin_amdgcn_mfma_f32_32x32x16_bf16((a), (b), (c), 0, 0, 0)
__device__ __forceinline__ int crow(int r, int hi) { return (r & 3) + 8 * (r >> 2) + 4 * hi; }
struct AttnSeq {
    const bf16_t* Q; int qs;
    const bf16_t* K; int ks;
    const bf16_t* VT;
    bf16_t* O; int os;
    const float* cq; const float* ck;
};
__device__ __forceinline__ void softmax_tile(f32x16& s0, f32x16& s1, float& m, float& l, f32x16 (&o)[4], bf16x8 (&pa)[4]) {
    float pmax = s0[0];
#pragma unroll
    for (int r = 1; r < 16; ++r) pmax = fmaxf(pmax, s0[r]);
#pragma unroll
    for (int r = 0; r < 16; ++r) pmax = fmaxf(pmax, s1[r]);
    { auto rr = __builtin_amdgcn_permlane32_swap(__float_as_uint(pmax), __float_as_uint(pmax), false, false);
      pmax = fmaxf(__uint_as_float(rr[0]), __uint_as_float(rr[1])); }
    const bool resc = !__all(pmax - m <= 8.0f);
    const float mn = resc ? fmaxf(m, pmax) : m;
    const float alpha = resc ? fast_exp2(m - mn) : 1.0f; m = mn;
    float ps = 0.f;
#pragma unroll
    for (int r = 0; r < 16; ++r) { s0[r] = fast_exp2(s0[r] - mn); ps += s0[r]; }
#pragma unroll
    for (int r = 0; r < 16; ++r) { s1[r] = fast_exp2(s1[r] - mn); ps += s1[r]; }
    { auto rr = __builtin_amdgcn_permlane32_swap(__float_as_uint(ps), __float_as_uint(ps), false, false);
      ps = __uint_as_float(rr[0]) + __uint_as_float(rr[1]); }
    l = l * alpha + ps;
    if (resc) {
#pragma unroll
        for (int d = 0; d < 4; ++d)
#pragma unroll
            for (int r = 0; r < 16; ++r) o[d][r] *= alpha;
    }
#define PK4(P, B_, OUT) do { const unsigned a0 = pk2(P[B_ + 0], P[B_ + 1]), a1 = pk2(P[B_ + 2], P[B_ + 3]), b0 = pk2(P[B_ + 4], P[B_ + 5]), b1 = pk2(P[B_ + 6], P[B_ + 7]); \
        auto r0 = __builtin_amdgcn_permlane32_swap(a0, b0, false, false); auto r1 = __builtin_amdgcn_permlane32_swap(a1, b1, false, false); \
        u32x4 w_ = {r0[0], r1[0], r0[1], r1[1]}; OUT = __builtin_bit_cast(bf16x8, w_); } while (0)
    PK4(s0, 0, pa[0]); PK4(s0, 8, pa[1]); PK4(s1, 0, pa[2]); PK4(s1, 8, pa[3]);
#undef PK4
}
__device__ __forceinline__ void store_o(const f32x16 (&o)[4], float inv, bf16_t* orow, int hi) {
#pragma unroll
    for (int d = 0; d < 4; ++d)
#pragma unroll
        for (int rq = 0; rq < 4; ++rq) { u32x2 w; w.x = pk2(o[d][4 * rq] * inv, o[d][4 * rq + 1] * inv); w.y = pk2(o[d][4 * rq + 2] * inv, o[d][4 * rq + 3] * inv);
            *(u32x2*)(orow + 32 * d + 8 * rq + 4 * hi) = w; }
}

template <int DQK, bool FOX>
__device__ __forceinline__ void attn_prefill_unit(LAS unsigned char* lds, const AttnSeq& a, int qb, int tid0, float bound2 = 0.f) {
    int tid = tid0; asm volatile("" : "+v"(tid));
    constexpr int RB = DQK * 2, CPR = DQK / 8, KBUF = 64 * RB, NKI = DQK / 64, NKS = DQK / 16;
    constexpr int OFF_V = 2 * KBUF, OFF_CK = OFF_V + 2 * 16384, OFF_QR = OFF_CK + 1024;
    constexpr int NQR = NKS;
    static_assert(OFF_QR + 8 * 4096 <= LDSCTL_OFF, "attention LDS map");
    const int w = __builtin_amdgcn_readfirstlane(tid >> 6), lane = tid & 63, c = lane & 31, hi = lane >> 5;
    const int q0w = qb * 256 + 32 * w, qrow = q0w + c;
    const int last_tile = q0w >> 6, ntiles = 4 * qb + 4;
    int jmin = 0;
    if (FOX) {
        LAS int* jm = (LAS int*)(lds + 2 * KBUF + 2 * 16384 + 512);
        if (tid == 0) *jm = ntiles - 1;
        __syncthreads();
        if (tid < ntiles) { const float d = a.cq[(size_t)(qb * 256) * 8] - a.ck[(size_t)(tid * 64 + 63) * 8];
            if (!(d + bound2 < -40.f)) __hip_atomic_fetch_min(jm, tid, __ATOMIC_RELAXED, __HIP_MEMORY_SCOPE_WORKGROUP); }
        __syncthreads();
        jmin = __builtin_amdgcn_readfirstlane(*jm);
    }
    int koff[NKI], voff[2];
#pragma unroll
    for (int i = 0; i < NKI; ++i) { const int s = (i * 8 + w) * 64 + lane, row = s / CPR, cp = s % CPR;
        const int ch = (DQK == 128) ? (cp ^ (row & 15)) : ((cp & ~7) | ((cp & 7) ^ ((row >> 1) & 7)));
        koff[i] = row * a.ks + ch * 8; }
#pragma unroll
    for (int i = 0; i < 2; ++i) { const int s = (i * 8 + w) * 64 + lane, d = s >> 3, cp = s & 7; voff[i] = d * KVROWS + ((cp ^ ((d >> 1) & 7)) * 8); }
    const int krow_b = c * RB;
    const int vsw = (c >> 1) & 7;
    bf16x8 qf[NQR];
    { const bf16_t* qp = a.Q + (size_t)qrow * a.qs + 8 * hi;
#pragma unroll
      for (int ks = 0; ks < NQR; ++ks) qf[ks] = *(const bf16x8*)(qp + 16 * ks);
      if (DQK == 192) {
#pragma unroll
          for (int ks = 8; ks < NKS; ++ks) *(LAS bf16x8*)(lds + OFF_QR + w * 4096 + c * 128 + (((2 * (ks - 8) + hi) ^ vsw) * 16)) = *(const bf16x8*)(qp + 16 * ks); } }
    float cq = 0.f; if (FOX) cq = a.cq[(size_t)qrow * 8];
    f32x16 o[4];
#pragma unroll
    for (int d = 0; d < 4; ++d)
#pragma unroll
        for (int r = 0; r < 16; ++r) o[d][r] = 0.f;
    float m = -1e30f, l = 0.f;
#define ATT_ISSUE(j_, b_) do { const bf16_t* kb_ = a.K + (size_t)(j_) * 64 * a.ks; const bf16_t* vb_ = a.VT + (size_t)(j_) * 64; \
        _Pragma("unroll") for (int i_ = 0; i_ < NKI; ++i_) __builtin_amdgcn_global_load_lds((const unsigned*)(kb_ + koff[i_]), (LAS unsigned*)(lds + (b_) * KBUF + (i_ * 8 + w) * 1024), 16, 0, 0); \
        _Pragma("unroll") for (int i_ = 0; i_ < 2; ++i_) __builtin_amdgcn_global_load_lds((const unsigned*)(vb_ + voff[i_]), (LAS unsigned*)(lds + OFF_V + (b_) * 16384 + (i_ * 8 + w) * 1024), 16, 0, 0); } while (0)
    ATT_ISSUE(jmin, jmin & 1);
    float ckn = 0.f;
    if (FOX && w == 0) { ckn = a.ck[(size_t)(jmin * 64 + lane) * 8]; ((LAS float*)(lds + OFF_CK))[(jmin & 1) * 64 + lane] = ckn; }
    for (int j = jmin; j < ntiles; ++j) {
        const int b = j & 1;
        VM_WAIT();
        __syncthreads();
        if (j + 1 < ntiles) { ATT_ISSUE(j + 1, b ^ 1); if (FOX && w == 0) ckn = a.ck[(size_t)((j + 1) * 64 + lane) * 8]; }
        if (j <= last_tile) {
            const LAS unsigned char* kb = lds + b * KBUF; const LAS unsigned char* vb = lds + OFF_V + b * 16384;
            f32x16 s0, s1;
#pragma unroll
            for (int r = 0; r < 16; ++r) { s0[r] = 0.f; s1[r] = 0.f; }
            constexpr int NB4 = NKS / 4;
            bf16x8 kfa[2][4], kfb[2][4];
#define ATT_LDK(dst, b4) do { _Pragma("unroll") for (int e_ = 0; e_ < 4; ++e_) { const int ks_ = 4 * (b4) + e_, ch_ = 2 * ks_ + hi; \
                const int cp_ = (DQK == 128) ? (ch_ ^ (c & 15)) : ((ch_ & ~7) | ((ch_ & 7) ^ ((c >> 1) & 7))); \
                dst[0][e_] = *(const LAS bf16x8*)(kb + krow_b + cp_ * 16); dst[1][e_] = *(const LAS bf16x8*)(kb + 32 * RB + krow_b + cp_ * 16); } } while (0)
#define ATT_MMK(src, b4) do { _Pragma("unroll") for (int e_ = 0; e_ < 4; ++e_) { const int ks_ = 4 * (b4) + e_; \
                bf16x8 qv_; if (ks_ < NQR) qv_ = qf[ks_ < NQR ? ks_ : 0]; else qv_ = *(const LAS bf16x8*)(lds + OFF_QR + w * 4096 + c * 128 + (((2 * (ks_ - 8) + hi) ^ vsw) * 16)); \
                s0 = MFMA32(src[0][e_], qv_, s0); s1 = MFMA32(src[1][e_], qv_, s1); } } while (0)
            ATT_LDK(kfa, 0);
            __builtin_amdgcn_sched_barrier(0);
            ATT_LDK(kfb, 1);
            __builtin_amdgcn_sched_barrier(0);
            ATT_MMK(kfa, 0);
            __builtin_amdgcn_sched_barrier(0);
            if (NB4 > 2) { ATT_LDK(kfa, 2 < NB4 ? 2 : 0); }
            __builtin_amdgcn_sched_barrier(0);
            ATT_MMK(kfb, 1);
            __builtin_amdgcn_sched_barrier(0);
            if (NB4 > 2) { ATT_MMK(kfa, 2 < NB4 ? 2 : 0); }
            __builtin_amdgcn_sched_barrier(0);
#undef ATT_LDK
#undef ATT_MMK
            if (FOX) {
                const LAS float* ckb = (const LAS float*)(lds + OFF_CK) + b * 64;
#pragma unroll
                for (int r = 0; r < 16; ++r) { s0[r] += cq - ckb[crow(r, hi)]; s1[r] += cq - ckb[32 + crow(r, hi)]; }
                if (j == last_tile) { const int dq = qrow - j * 64;
#pragma unroll
                    for (int r = 0; r < 16; ++r) { if (crow(r, hi) > dq) s0[r] = -__builtin_inff(); if (32 + crow(r, hi) > dq) s1[r] = -__builtin_inff(); } }
            }
            bf16x8 pa[4];
            softmax_tile(s0, s1, m, l, o, pa);
            {
                bf16x8 va[2][4], vb2[2][4];
#define ATT_LDV(dst, k0_) do { _Pragma("unroll") for (int kk_ = 0; kk_ < 2; ++kk_) _Pragma("unroll") for (int d_ = 0; d_ < 4; ++d_) { const int cp_ = (2 * ((k0_) + kk_) + hi) ^ vsw; \
                    dst[kk_][d_] = *(const LAS bf16x8*)(vb + (32 * d_ + c) * 128 + cp_ * 16); } } while (0)
#define ATT_MMV(src, k0_) do { _Pragma("unroll") for (int kk_ = 0; kk_ < 2; ++kk_) _Pragma("unroll") for (int d_ = 0; d_ < 4; ++d_) o[d_] = MFMA32(src[kk_][d_], pa[(k0_) + kk_], o[d_]); } while (0)
                ATT_LDV(va, 0);
                __builtin_amdgcn_sched_barrier(0);
                ATT_LDV(vb2, 2);
                __builtin_amdgcn_sched_barrier(0);
                ATT_MMV(va, 0);
                __builtin_amdgcn_sched_barrier(0);
                ATT_MMV(vb2, 2);
#undef ATT_LDV
#undef ATT_MMV
            }
        }
        if (FOX && w == 0 && j + 1 < ntiles) ((LAS float*)(lds + OFF_CK))[(b ^ 1) * 64 + lane] = ckn;
    }
#undef ATT_ISSUE
    store_o(o, __builtin_amdgcn_rcpf(l), a.O + (size_t)qrow * a.os, hi);
    __syncthreads();
}

template <int DQK, bool FOX>
__device__ __forceinline__ void attn_decode_unit(LAS unsigned char* lds, const AttnSeq& a, int tid0) {
    int tid = tid0; asm volatile("" : "+v"(tid));
    constexpr int NKS = DQK / 16;
    const int w = __builtin_amdgcn_readfirstlane(tid >> 6), lane = tid & 63, c = lane & 31, hi = lane >> 5, t = c & 15;
    bf16x8 qf[NKS];
    { const bf16_t* qp = a.Q + (size_t)t * a.qs + 8 * hi;
#pragma unroll
      for (int ks = 0; ks < NKS; ++ks) qf[ks] = *(const bf16x8*)(qp + 16 * ks); }
    float cq = 0.f; if (FOX) cq = a.cq[(size_t)t * 8];
    f32x16 o[4];
#pragma unroll
    for (int d = 0; d < 4; ++d)
#pragma unroll
        for (int r = 0; r < 16; ++r) o[d][r] = 0.f;
    float m = -1e30f, l = 0.f;
    const int lim = FOX ? PAST + t : KVLEN_S - 1;
    for (int j = w; j < KVS / 64; j += 8) {
        f32x16 s0, s1;
#pragma unroll
        for (int r = 0; r < 16; ++r) { s0[r] = 0.f; s1[r] = 0.f; }
        const bf16_t* kp = a.K + (size_t)(j * 64 + c) * a.ks + 8 * hi;
#pragma unroll
        for (int ks = 0; ks < NKS; ++ks) {
            if ((ks & 3) == 0) __builtin_amdgcn_sched_barrier(0);
            const bf16x8 k0 = *(const bf16x8*)(kp + 16 * ks), k1 = *(const bf16x8*)(kp + (size_t)32 * a.ks + 16 * ks);
            s0 = MFMA32(k0, qf[ks], s0); s1 = MFMA32(k1, qf[ks], s1);
        }
#pragma unroll
        for (int r = 0; r < 16; ++r) { const int k0i = j * 64 + crow(r, hi), k1i = k0i + 32;
            if (FOX) { s0[r] += cq - a.ck[(size_t)k0i * 8]; s1[r] += cq - a.ck[(size_t)k1i * 8]; }
            if (k0i > lim) s0[r] = -__builtin_inff(); if (k1i > lim) s1[r] = -__builtin_inff(); }
        bf16x8 pa[4];
        softmax_tile(s0, s1, m, l, o, pa);
#pragma unroll
        for (int d = 0; d < 4; ++d) {
            __builtin_amdgcn_sched_barrier(0);
#pragma unroll
            for (int ks = 0; ks < 4; ++ks) { const bf16x8 vf = *(const bf16x8*)(a.VT + (size_t)(32 * d + c) * KVROWS + j * 64 + 16 * ks + 8 * hi);
                o[d] = MFMA32(vf, pa[ks], o[d]); } }
    }
    LAS float* Ot = (LAS float*)lds; LAS float* ML = (LAS float*)(lds + 8 * 128 * 16 * 4);
    if (c < 16) {
#pragma unroll
        for (int d = 0; d < 4; ++d)
#pragma unroll
            for (int r = 0; r < 16; ++r) Ot[(w * 128 + 32 * d + crow(r, hi)) * 16 + c] = o[d][r];
        if (hi == 0) { ML[(w * 16 + c) * 2] = m; ML[(w * 16 + c) * 2 + 1] = l; }
    }
    __syncthreads();
    { const int q = tid & 15, dg = tid >> 4;
      float M = -1e30f;
#pragma unroll
      for (int ww = 0; ww < 8; ++ww) M = fmaxf(M, ML[(ww * 16 + q) * 2]);
      float L = 0.f, acc[4] = {0.f, 0.f, 0.f, 0.f};
#pragma unroll
      for (int ww = 0; ww < 8; ++ww) { const float f = fast_exp2(ML[(ww * 16 + q) * 2] - M); L += ML[(ww * 16 + q) * 2 + 1] * f;
#pragma unroll
          for (int e = 0; e < 4; ++e) acc[e] += Ot[(ww * 128 + 4 * dg + e) * 16 + q] * f; }
      const float inv = __builtin_amdgcn_rcpf(L);
      u32x2 wv; wv.x = pk2(acc[0] * inv, acc[1] * inv); wv.y = pk2(acc[2] * inv, acc[3] * inv);
      *(u32x2*)(a.O + (size_t)q * a.os + 4 * dg) = wv; }
    __syncthreads();
}
#define MFMA16(a, b, c) __builtin_amdgcn_mfma_f32_16x16x32_bf16((a), (b), (c), 0, 0, 0)
constexpr int SSD_XP = 72;
constexpr int SSD_BP = 136;
__device__ __forceinline__ void ssd_dt_acs(const Frame& F, const float* DTB, int m0, int L, int g, float a_neg  , LAS float* Dt, LAS float* Ac) {
    { const int l = F.tid >> 3, h = F.tid & 7; Dt[F.tid] = (l < L) ? DTB[(size_t)(m0 + l) * 16 + 8 * g + h] : 0.f; }
    __syncthreads();
    if (F.tid < 8) { float acs = 0.f; for (int l = 0; l < 64; ++l) { acs += Dt[l * 8 + F.tid] * a_neg; Ac[l * 8 + F.tid] = acs; } }
    __syncthreads();
}
__device__ __forceinline__ void phase_s1(const Params&, const Frame& F0, int layer0) {
    const Frame F = mk_frame(F0.wave);
    const PV p = pv_get(); int layer = layer0; asm volatile("" : "+s"(layer));
    const bf16_t* XC = (const bf16_t*)(p.ws() + WS_XN);
    const float* DTB = (const float*)(p.ws() + WS_DT); float* ST = (float*)(p.ws() + WS_ST); float* CDEC = (float*)(p.ws() + WS_CDEC);
    LAS float* Dt = (LAS float*)F.lds; LAS float* Ac = (LAS float*)(F.lds + 2048);
    LAS bf16_t* BT = (LAS bf16_t*)(F.lds + 4096);
    LAS bf16_t* XT = (LAS bf16_t*)(F.lds + 4096 + 128 * SSD_XP * 2) + F.wave * 64 * SSD_XP;
    const int w = F.wave, lane = F.lane, fr = lane & 15, q = lane >> 4;
    for (int unit = (F.G == 256) ? (F.bx + 88) % 256 : F.bx; unit < NCHUNK * 2; unit += F.G) {
        const int ci = unit >> 1, g = unit & 1; const bool smp = ci >= 256; const int L = smp ? 16 : 64; const int m0 = smp ? MP + (ci - 256) * 16 : ci * 64;
        const int head = 8 * g + w;
        const float a_neg = (F.tid < 8) ? -fast_exp(p.in(I_ALOG)[layer * 16 + 8 * g + F.tid]) : 0.f;
        ssd_dt_acs(F, DTB, m0, L, g, a_neg, Dt, Ac);
        const float alast = Ac[63 * 8 + w];
        if (lane == 0) CDEC[ci * 16 + head] = fast_exp(alast);
        for (int idx = F.tid; idx < 64 * 16; idx += 512) { const int l = idx >> 4, n8 = idx & 15; bf16_t v[8];
            if (l < L) *(u32x4*)v = *(const u32x4*)(XC + (size_t)(m0 + l) * 1536 + 1024 + 128 * g + 8 * n8); else *(u32x4*)v = (u32x4){0u, 0u, 0u, 0u};
#pragma unroll
            for (int e = 0; e < 8; ++e) BT[(8 * n8 + e) * SSD_XP + l] = v[e]; }
#pragma unroll
        for (int it = 0; it < 8; ++it) { const int l = 8 * it + (lane >> 3), p8 = lane & 7; float xv[8];
            if (l < L) unpack8(*(const u32x4*)(XC + (size_t)(m0 + l) * 1536 + head * 64 + 8 * p8), xv); else { for (int e = 0; e < 8; ++e) xv[e] = 0.f; }
            const float wgt = fast_exp(alast - Ac[l * 8 + w]) * Dt[l * 8 + w];
#pragma unroll
            for (int e = 0; e < 8; ++e) XT[(8 * p8 + e) * SSD_XP + l] = f2bf(xv[e] * wgt); }
        __syncthreads();
#pragma unroll 1
        for (int nh = 0; nh < 2; ++nh) {
            f32x4 acc[4][4];
#pragma unroll
            for (int nb = 0; nb < 4; ++nb)
#pragma unroll
                for (int pb = 0; pb < 4; ++pb) acc[nb][pb] = (f32x4){0.f, 0.f, 0.f, 0.f};
#pragma unroll
            for (int ks = 0; ks < 2; ++ks) {
                bf16x8 xf[4];
#pragma unroll
                for (int pb = 0; pb < 4; ++pb) xf[pb] = *(const LAS bf16x8*)(XT + (16 * pb + fr) * SSD_XP + 32 * ks + 8 * q);
#pragma unroll
                for (int nb = 0; nb < 4; ++nb) { const bf16x8 bf = *(const LAS bf16x8*)(BT + (64 * nh + 16 * nb + fr) * SSD_XP + 32 * ks + 8 * q);
#pragma unroll
                    for (int pb = 0; pb < 4; ++pb) acc[nb][pb] = MFMA16(bf, xf[pb], acc[nb][pb]); }
            }
            float* so = ST + (size_t)(ci * 16 + head) * 8192;
#pragma unroll
            for (int nb = 0; nb < 4; ++nb)
#pragma unroll
                for (int pb = 0; pb < 4; ++pb) *(f32x4*)(so + (size_t)(16 * pb + fr) * 128 + 64 * nh + 16 * nb + 4 * q) = acc[nb][pb];
        }
        __syncthreads();
    }
}
__device__ __forceinline__ void phase_s2(const Params&, const Frame& F0, int layer0) {
    const Frame F = mk_frame(F0.wave);
    const PV p = pv_get(); int layer = layer0; asm volatile("" : "+s"(layer));
    float* ST = (float*)(p.ws() + WS_ST); const float* CDEC = (const float*)(p.ws() + WS_CDEC);
    float* o_p = p.out() + O_PSSM + (size_t)layer * 131072; float* o_s = p.out() + O_SSSM + (size_t)layer * NB * 131072;
    const float* h0s = p.in(I_SSM) + (size_t)layer * NB * 131072;
    const size_t gt = (size_t)F.bx * 512 + F.tid, NT = (size_t)F.G * 512;
    for (size_t e = gt; e < 131072; e += NT) { const int head = (int)(e >> 13);
        float h = 0.f;
        for (int c0 = 0; c0 < 256; c0 += 32) { float tv[32], dv[32];
#pragma unroll
            for (int i = 0; i < 32; ++i) { tv[i] = ST[(size_t)(c0 + i) * 131072 + e]; dv[i] = CDEC[(c0 + i) * 16 + head]; }
#pragma unroll
            for (int i = 0; i < 32; ++i) { ST[(size_t)(c0 + i) * 131072 + e] = h; h = h * dv[i] + tv[i]; } }
        o_p[e] = h; }
    for (size_t i = gt; i < (size_t)NB * 131072; i += NT) { const int b = (int)(i >> 17); const size_t e = i & 131071; const int head = (int)(e >> 13), ci = 256 + b;
        const float h0 = h0s[i], tv = ST[(size_t)ci * 131072 + e];
        ST[(size_t)ci * 131072 + e] = h0; o_s[i] = h0 * CDEC[ci * 16 + head] + tv; }
}
__device__ __forceinline__ void phase_s3(const Params&, const Frame& F0, int layer0) {
    const Frame F = mk_frame(F0.wave);
    const PV p = pv_get(); int layer = layer0; asm volatile("" : "+s"(layer));
    const bf16_t* XC = (const bf16_t*)(p.ws() + WS_XN); bf16_t* U = (bf16_t*)(p.ws() + WS_U);
    const float* DTB = (const float*)(p.ws() + WS_DT); const float* ST = (const float*)(p.ws() + WS_ST);
    LAS float* Dt = (LAS float*)F.lds; LAS float* Ac = (LAS float*)(F.lds + 2048); LAS float* Rs = (LAS float*)(F.lds + 4096);
    LAS bf16_t* Bs = (LAS bf16_t*)(F.lds + 4608);
    LAS bf16_t* Cs = (LAS bf16_t*)(F.lds + 4608 + 64 * SSD_BP * 2);
    LAS bf16_t* XT = (LAS bf16_t*)(F.lds + 4608 + 2 * 64 * SSD_BP * 2) + F.wave * 64 * SSD_XP;
    const int w = F.wave, lane = F.lane, fr = lane & 15, q = lane >> 4;
    for (int unit = F.bx; unit < NCHUNK * 2; unit += F.G) {
        const int ci = unit >> 1, g = unit & 1; const bool smp = ci >= 256; const int L = smp ? 16 : 64; const int m0 = smp ? MP + (ci - 256) * 16 : ci * 64;
        const int head = 8 * g + w;
        const float a_neg = (F.tid < 8) ? -fast_exp(p.in(I_ALOG)[layer * 16 + 8 * g + F.tid]) : 0.f;
        if (F.tid < 64) Rs[F.tid] = 0.f;
        ssd_dt_acs(F, DTB, m0, L, g, a_neg, Dt, Ac);
        for (int idx = F.tid; idx < 64 * 16; idx += 512) { const int l = idx >> 4, n8 = idx & 15; u32x4 vb = {0u, 0u, 0u, 0u}, vc = {0u, 0u, 0u, 0u};
            if (l < L) { const bf16_t* src = XC + (size_t)(m0 + l) * 1536 + 1024 + 128 * g + 8 * n8; vb = *(const u32x4*)src; vc = *(const u32x4*)(src + 256); }
            *(LAS u32x4*)(Bs + l * SSD_BP + 8 * n8) = vb; *(LAS u32x4*)(Cs + l * SSD_BP + 8 * n8) = vc; }
#pragma unroll
        for (int it = 0; it < 8; ++it) { const int l = 8 * it + (lane >> 3), p8 = lane & 7; bf16_t v[8];
            if (l < L) *(u32x4*)v = *(const u32x4*)(XC + (size_t)(m0 + l) * 1536 + head * 64 + 8 * p8); else *(u32x4*)v = (u32x4){0u, 0u, 0u, 0u};
#pragma unroll
            for (int e = 0; e < 8; ++e) XT[(8 * p8 + e) * SSD_XP + l] = v[e]; }
        __syncthreads();
        f32x4 gt[4][4];
#pragma unroll
        for (int sb = 0; sb < 4; ++sb)
#pragma unroll
            for (int lb = 0; lb < 4; ++lb) gt[sb][lb] = (f32x4){0.f, 0.f, 0.f, 0.f};
#pragma unroll
        for (int ks = 0; ks < 4; ++ks) { bf16x8 cf[4];
#pragma unroll
            for (int lb = 0; lb < 4; ++lb) cf[lb] = *(const LAS bf16x8*)(Cs + (16 * lb + fr) * SSD_BP + 32 * ks + 8 * q);
#pragma unroll
            for (int sb = 0; sb < 4; ++sb) { const bf16x8 bf = *(const LAS bf16x8*)(Bs + (16 * sb + fr) * SSD_BP + 32 * ks + 8 * q);
#pragma unroll
                for (int lb = 0; lb < 4; ++lb) gt[sb][lb] = MFMA16(bf, cf[lb], gt[sb][lb]); } }
        f32x4 acc[4][4];
#pragma unroll
        for (int pb = 0; pb < 4; ++pb)
#pragma unroll
            for (int lb = 0; lb < 4; ++lb) acc[pb][lb] = (f32x4){0.f, 0.f, 0.f, 0.f};
        const float* sth = ST + (size_t)(ci * 16 + head) * 8192;
#pragma unroll
        for (int ks = 0; ks < 4; ++ks) { bf16x8 cf[4];
#pragma unroll
            for (int lb = 0; lb < 4; ++lb) cf[lb] = *(const LAS bf16x8*)(Cs + (16 * lb + fr) * SSD_BP + 32 * ks + 8 * q);
#pragma unroll
            for (int pb = 0; pb < 4; ++pb) { const float* hp = sth + (size_t)(16 * pb + fr) * 128 + 32 * ks + 8 * q; const f32x4 h0 = *(const f32x4*)hp, h1 = *(const f32x4*)(hp + 4);
                u32x4 hw; hw.x = pk2(h0[0], h0[1]); hw.y = pk2(h0[2], h0[3]); hw.z = pk2(h1[0], h1[1]); hw.w = pk2(h1[2], h1[3]);
                const bf16x8 hf = __builtin_bit_cast(bf16x8, hw);
#pragma unroll
                for (int lb = 0; lb < 4; ++lb) acc[pb][lb] = MFMA16(hf, cf[lb], acc[pb][lb]); } }
        float al[4];
#pragma unroll
        for (int lb = 0; lb < 4; ++lb) { al[lb] = Ac[(16 * lb + fr) * 8 + w]; const float el = fast_exp(al[lb]);
#pragma unroll
            for (int pb = 0; pb < 4; ++pb) acc[pb][lb] = acc[pb][lb] * el; }
#pragma unroll
        for (int ks2 = 0; ks2 < 2; ++ks2) {
            float as_[2][4], ds_[2][4];
#pragma unroll
            for (int jh = 0; jh < 2; ++jh)
#pragma unroll
                for (int r = 0; r < 4; ++r) { const int s = 32 * ks2 + 16 * jh + 4 * q + r; as_[jh][r] = Ac[s * 8 + w]; ds_[jh][r] = Dt[s * 8 + w]; }
            bf16x8 mf[4];
#pragma unroll
            for (int lb = 0; lb < 4; ++lb) { const int l = 16 * lb + fr; float mv[8];
#pragma unroll
                for (int jh = 0; jh < 2; ++jh)
#pragma unroll
                    for (int r = 0; r < 4; ++r) { const int s = 32 * ks2 + 16 * jh + 4 * q + r;
                        mv[4 * jh + r] = (s <= l) ? gt[2 * ks2 + jh][lb][r] * fast_exp(al[lb] - as_[jh][r]) * ds_[jh][r] : 0.f; }
                u32x4 mw; mw.x = pk2(mv[0], mv[1]); mw.y = pk2(mv[2], mv[3]); mw.z = pk2(mv[4], mv[5]); mw.w = pk2(mv[6], mv[7]);
                mf[lb] = __builtin_bit_cast(bf16x8, mw); }
#pragma unroll
            for (int pb = 0; pb < 4; ++pb) { const LAS bf16_t* xp = XT + (16 * pb + fr) * SSD_XP + 32 * ks2 + 4 * q;
                const u32x2 x0 = *(const LAS u32x2*)xp, x1 = *(const LAS u32x2*)(xp + 16);
                const u32x4 xw = {x0.x, x0.y, x1.x, x1.y}; const bf16x8 xf = __builtin_bit_cast(bf16x8, xw);
#pragma unroll
                for (int lb = 0; lb < 4; ++lb) acc[pb][lb] = MFMA16(xf, mf[lb], acc[pb][lb]); }
        }
        const float dsk = p.in(I_SD)[layer * 16 + head];
        float sq[4] = {0.f, 0.f, 0.f, 0.f};
#pragma unroll
        for (int lb = 0; lb < 4; ++lb) { const int l = 16 * lb + fr; const bool ok = l < L;
#pragma unroll
            for (int pb = 0; pb < 4; ++pb) { const int pc = 16 * pb + 4 * q;
                u32x2 xw = {0u, 0u}, zw = {0u, 0u};
                if (ok) { xw = *(const u32x2*)(XC + (size_t)(m0 + l) * 1536 + head * 64 + pc); zw = *(const u32x2*)(U + (size_t)(m0 + l) * LDU + UC_Z + head * 64 + pc); }
                f32x4 y = acc[pb][lb];
                y[0] = (y[0] + dsk * bf_lo(xw.x)) * siluf_(bf_lo(zw.x)); y[1] = (y[1] + dsk * bf_hi(xw.x)) * siluf_(bf_hi(zw.x));
                y[2] = (y[2] + dsk * bf_lo(xw.y)) * siluf_(bf_lo(zw.y)); y[3] = (y[3] + dsk * bf_hi(xw.y)) * siluf_(bf_hi(zw.y));
                acc[pb][lb] = y; sq[lb] += (y[0] * y[0] + y[1] * y[1]) + (y[2] * y[2] + y[3] * y[3]); } }
#pragma unroll
        for (int lb = 0; lb < 4; ++lb) { float s = sq[lb]; s += shx(s, 16, F.lane); s += shx(s, 32, F.lane);
            if (q == 0) __hip_atomic_fetch_add(Rs + 16 * lb + fr, s, __ATOMIC_RELAXED, __HIP_MEMORY_SCOPE_WORKGROUP); }
        __syncthreads();
#pragma unroll
        for (int lb = 0; lb < 4; ++lb) { const int l = 16 * lb + fr;
            if (l < L) { const float rs = fast_rsqrt(Rs[l] * (1.0f / 512) + EPS);
#pragma unroll
                for (int pb = 0; pb < 4; ++pb) { const int pc = 16 * pb + 4 * q; const f32x4 gn = *(const f32x4*)(p.in(I_SN) + layer * 1024 + head * 64 + pc); const f32x4 y = acc[pb][lb];
                    u32x2 ow; ow.x = pk2(y[0] * rs * gn[0], y[1] * rs * gn[1]); ow.y = pk2(y[2] * rs * gn[2], y[3] * rs * gn[3]);
                    *(u32x2*)(U + (size_t)(m0 + l) * LDU + UC_OSSD + head * 64 + pc) = ow; } } }
        __syncthreads();
    }
}
#ifndef DUPMASK
#define DUPMASK 0
#endif
__device__ __forceinline__ void phase_attn(const Params&, const Frame& F0, int layer0) {
    const Frame F = mk_frame(F0.wave);
    const PV p = pv_get(); int layer = layer0; asm volatile("" : "+s"(layer));
    bf16_t* U = (bf16_t*)(p.ws() + WS_U); const bf16_t* QM = (const bf16_t*)(p.ws() + WS_QM); const bf16_t* KM = (const bf16_t*)(p.ws() + WS_KM);
    const bf16_t* VTM = (const bf16_t*)(p.ws() + WS_VTM); const bf16_t* KFS = (const bf16_t*)(p.ws() + WS_KFS); const bf16_t* VTF = (const bf16_t*)(p.ws() + WS_VTF);
    const float* CUM = (const float*)(p.ws() + WS_CUM);
    for (int it = F.vcu; it < 256; it += F.G) {
        const int h = it >> 5, pr = it & 31;
        AttnSeq a; a.Q = QM + h * 192; a.qs = 1536; a.K = KM + h * 192; a.ks = 1536; a.VT = VTM + (size_t)h * 128 * KVROWS; a.O = U + UC_OMLA + h * 128; a.os = LDU; a.cq = nullptr; a.ck = nullptr;
#pragma unroll 1
        for (int half = 0; half < 2; ++half) attn_prefill_unit<192, false>(F.lds, a, half ? pr : 63 - pr, F.tid);
    }
#if defined(DUPMASK)
    if ((DUPMASK >> 8) & 1) for (int it = F.vcu; it < 256; it += F.G) {
        const int h = it >> 5, pr = it & 31;
        AttnSeq a; a.Q = QM + h * 192; a.qs = 1536; a.K = KM + h * 192; a.ks = 1536; a.VT = VTM + (size_t)h * 128 * KVROWS; a.O = U + UC_OMLA + h * 128; a.os = LDU; a.cq = nullptr; a.ck = nullptr;
#pragma unroll 1
        for (int half = 0; half < 2; ++half) attn_prefill_unit<192, false>(F.lds, a, half ? pr : 63 - pr, F.tid);
    }
#endif
    for (int it = F.vcu; it < 256; it += F.G) {
        const int h = it >> 5, pr = it & 31;
        AttnSeq a; a.Q = U + UC_FQ + h * 128; a.qs = LDU; a.K = U + UC_FK + h * 128; a.ks = LDU; a.VT = VTF + (size_t)h * 128 * KVROWS; a.O = U + UC_OFOX + h * 128; a.os = LDU; a.cq = CUM + h; a.ck = CUM + h;
        const unsigned* ctl = (const unsigned*)(p.ws() + WS_CTL);
        float kn2; { float v = __uint_as_float(ctl[CW_KN2 + (layer * 64 + F.lane) * 8 + h]);
#pragma unroll
            for (int o = 1; o < 64; o <<= 1) v = fmaxf(v, shx(v, o, F.lane)); kn2 = v; }
#pragma unroll 1
        for (int half = 0; half < 2; ++half) { const int qb = half ? pr : 63 - pr;
            attn_prefill_unit<128, true>(F.lds, a, qb, F.tid, 2.02f * __builtin_amdgcn_sqrtf(__uint_as_float(ctl[CW_QN2 + (layer * 64 + qb) * 8 + h]) * kn2)); }
    }
#if defined(DUPMASK)
    if ((DUPMASK >> 9) & 1) for (int it = F.vcu; it < 256; it += F.G) {
        const int h = it >> 5, pr = it & 31;
        AttnSeq a; a.Q = U + UC_FQ + h * 128; a.qs = LDU; a.K = U + UC_FK + h * 128; a.ks = LDU; a.VT = VTF + (size_t)h * 128 * KVROWS; a.O = (bf16_t*)(p.ws() + WS_ST) + h * 128; a.os = 1024; a.cq = CUM + h; a.ck = CUM + h;
        const unsigned* ctl = (const unsigned*)(p.ws() + WS_CTL);
        float kn2; { float v = __uint_as_float(ctl[CW_KN2 + (layer * 64 + F.lane) * 8 + h]);
#pragma unroll
            for (int o = 1; o < 64; o <<= 1) v = fmaxf(v, shx(v, o, F.lane)); kn2 = v; }
#pragma unroll 1
        for (int half = 0; half < 2; ++half) { const int qb = half ? pr : 63 - pr;
            attn_prefill_unit<128, true>(F.lds, a, qb, F.tid, 2.02f * __builtin_amdgcn_sqrtf(__uint_as_float(ctl[CW_QN2 + (layer * 64 + qb) * 8 + h]) * kn2)); }
    }
#endif
    for (int it = F.vcu; it < 2 * NB * 8; it += F.G) {
        const int kind = it >> 7, s = (it & 127) >> 3, h = it & 7; const size_t q0 = (size_t)MP + 16 * s, k0 = (size_t)MP + (size_t)s * KVS;
        if (kind == 0) { AttnSeq a; a.Q = QM + q0 * 1536 + h * 192; a.qs = 1536; a.K = KM + k0 * 1536 + h * 192; a.ks = 1536; a.VT = VTM + (size_t)h * 128 * KVROWS + k0; a.O = U + q0 * LDU + UC_OMLA + h * 128; a.os = LDU; a.cq = nullptr; a.ck = nullptr;
          attn_decode_unit<192, false>(F.lds, a, F.tid); }
        else { AttnSeq a; a.Q = U + q0 * LDU + UC_FQ + h * 128; a.qs = LDU; a.K = KFS + (size_t)s * KVS * 1024 + h * 128; a.ks = 1024; a.VT = VTF + (size_t)h * 128 * KVROWS + k0; a.O = U + q0 * LDU + UC_OFOX + h * 128; a.os = LDU;
          a.cq = CUM + (k0 + PAST) * 8 + h; a.ck = CUM + k0 * 8 + h;
          attn_decode_unit<128, true>(F.lds, a, F.tid); }
    }
}

#define LAUNDER_P const PV p = pv_get()
#define LAUNDER_PL const PV p = pv_get(); int layer = layer0; asm volatile("" : "+s"(layer))
__device__ __forceinline__ void ph_gateup(const Params&, const Frame& F0, size_t woff) {
    const Frame F = mk_frame(F0.wave);
    LAUNDER_P; bf16_t* W = (bf16_t*)(p.ws() + WS_W); bf16_t* XN = (bf16_t*)(p.ws() + WS_XN); bf16_t* H = (bf16_t*)(p.ws() + WS_U);
    pg8::Gemm g{XN, W + woff, 64, 64, MT, 2 * FF, D, (size_t)MT * 128, (size_t)2 * FF * 128}; pg8::StaticOrder S; S.init(MT, 2 * FF, F.G, F.bx, D); S.nrev = true;
    EpiSwiGLU E{H}; pg8::gemm_phase<EpiSwiGLU, pg8::StaticOrder, true, true>(F.lds, g, S, E, F.wave);
}
__device__ __forceinline__ void ph_down(const Params&, const Frame& F0, size_t woff, bool from_input, bool dummy = false) {
    const Frame F = mk_frame(F0.wave);
    LAUNDER_P; bf16_t* W = (bf16_t*)(p.ws() + WS_W); bf16_t* H = (bf16_t*)(p.ws() + WS_U);
    pg8::Gemm g{H, W + woff, 64, 64, MT, D, FF, (size_t)MT * 128, (size_t)D * 128}; pg8::SplitOrder S;
    S.init(MT, D, F.G, F.bx, FF);
    EpiResid E{from_input ? p.in(I_XP) : nullptr, (bf16_t*)(p.ws() + (dummy ? WS_ST : WS_XB)), 0.5f, (float*)(p.ws() + WS_PART)}; pg8::gemm_phase<EpiResid, pg8::SplitOrder, true, true>(F.lds, g, S, E, F.wave);
}
__device__ __forceinline__ void ph_win(const Params&, const Frame& F0, int layer0) {
    const Frame F = mk_frame(F0.wave);
    LAUNDER_PL; bf16_t* W = (bf16_t*)(p.ws() + WS_W); bf16_t* XN = (bf16_t*)(p.ws() + WS_XN); bf16_t* U = (bf16_t*)(p.ws() + WS_U);
    pg8::Gemm g{XN, W + W_IN, 64, 64, MT, NWIN, D, (size_t)MT * 128, (size_t)NWIN * 128}; pg8::StaticOrder S; S.init(MT, NWIN, F.G, F.bx, D);
    EpiWin E{U, (float*)(p.ws() + WS_US), p.out() + O_PFK + (size_t)layer * MP * 1024, p.out() + O_SFK + (size_t)layer * MS * 1024,
             p.out() + O_PFV + (size_t)layer * MP * 1024, p.out() + O_SFV + (size_t)layer * MS * 1024};
    pg8::gemm_phase<EpiWin, pg8::StaticOrder, true, true>(F.lds, g, S, E, F.wave);
}
__device__ __forceinline__ void ph_uq(const Params&, const Frame& F0) {
    const Frame F = mk_frame(F0.wave);
    LAUNDER_P; bf16_t* W = (bf16_t*)(p.ws() + WS_W); bf16_t* U = (bf16_t*)(p.ws() + WS_U);
    pg8::Gemm g{U + UC_QLAT, W + W_UQ, LDU, 512, MT, 1536, 512}; pg8::StaticOrder S; S.init(MT, 1536, F.G, F.bx, 512);
    EpiUq E{(bf16_t*)(p.ws() + WS_QM), (const f32x2*)(p.ws() + WS_ROPE)}; pg8::gemm_phase<EpiUq, pg8::StaticOrder, true, true>(F.lds, g, S, E, F.wave);
}
__device__ __forceinline__ void ph_ukv(const Params&, const Frame& F0) {
    const Frame F = mk_frame(F0.wave);
    LAUNDER_P; bf16_t* W = (bf16_t*)(p.ws() + WS_W);
    pg8::Gemm g{(const bf16_t*)(p.ws() + WS_CKV), W + W_UKV, 512, 512, KVROWS, 2048, 512}; pg8::StaticOrder S; S.init(KVROWS, 2048, F.G, (F.G == 256) ? (F.bx + 120) % 256 : F.bx, 512);
    EpiUkv E{(bf16_t*)(p.ws() + WS_KM), (bf16_t*)(p.ws() + WS_VTM)}; pg8::gemm_phase<EpiUkv, pg8::StaticOrder, true, true>(F.lds, g, S, E, F.wave);
}
template <int BR> __device__ __forceinline__ void ph_merge(const Params&, const Frame& F0) {
    const Frame F = mk_frame(F0.wave);
    LAUNDER_P; bf16_t* W = (bf16_t*)(p.ws() + WS_W); bf16_t* U = (bf16_t*)(p.ws() + WS_U); bf16_t* XN = (bf16_t*)(p.ws() + WS_XN);
    constexpr int acol = BR == 0 ? UC_OMLA : (BR == 1 ? UC_OSSD : UC_OFOX);
    pg8::StaticOrder S; S.init(MP, D, F.G, F.bx, 1024, true);
    pg8::Gemm g{U + acol, W + W_BR + (size_t)BR * D * 1024, LDU, 1024, MP, D, 1024}; EpiMerge<BR> E{U, XN}; pg8::gemm_phase<EpiMerge<BR>, pg8::StaticOrder, true, true>(F.lds, g, S, E, F.wave);
}
__device__ __forceinline__ void ph_merge_sample(const Params&, const Frame& F0, int layer0) {
    const Frame F = mk_frame(F0.wave);
    LAUNDER_PL; bf16_t* W = (bf16_t*)(p.ws() + WS_W); bf16_t* U = (bf16_t*)(p.ws() + WS_U); bf16_t* XN = (bf16_t*)(p.ws() + WS_XN);
    pg8::SampleMergeOrder S; S.c = F.bx;
    pg8::Gemm g{U, W + W_BR, LDU, 1024, MT, 3 * D, 1024};
    EpiMergeSample E{U, XN, (float*)(p.ws() + WS_PART), (unsigned*)(p.ws() + WS_CTL) + CW_MGC + layer * 8 * 64, (LAS unsigned*)(F.lds + RING_BYTES)};
    pg8::gemm_phase<EpiMergeSample, pg8::SampleMergeOrder, true, true>(F.lds, g, S, E, F.wave);
}
__device__ __forceinline__ void ph_wout(const Params&, const Frame& F0, bool dummy = false) {
    const Frame F = mk_frame(F0.wave);
    LAUNDER_P; bf16_t* W = (bf16_t*)(p.ws() + WS_W); bf16_t* XN = (bf16_t*)(p.ws() + WS_XN);
    pg8::Gemm g{XN, W + W_OUT, D, D, MT, D, D}; pg8::SplitOrder S; S.init(MT, D, F.G, F.bx, D);
    EpiResid E{nullptr, (bf16_t*)(p.ws() + (dummy ? WS_ST : WS_XB)), 1.0f, (float*)(p.ws() + WS_PART)}; pg8::gemm_phase<EpiResid, pg8::SplitOrder, true, true>(F.lds, g, S, E, F.wave);
}
__device__ __forceinline__ void ph_norm(const Params&, const Frame& F0, int layer0, int which, bool from_input) {
    const Frame F = mk_frame(F0.wave);
    LAUNDER_PL; float* ys = p.out() + O_YS;
    phase_norm(F, from_input ? p.in(I_XP) : nullptr, (const bf16_t*)(p.ws() + WS_XB), from_input ? p.in(I_XS) : ys, p.in(which) + layer * D, (bf16_t*)(p.ws() + WS_XN), from_input ? ys : nullptr, from_input ? nullptr : (const float*)(p.ws() + WS_PART));
}

constexpr int PH_PER_LAYER = 15, N_PHASES = NL * PH_PER_LAYER + 1;
#ifndef N_LAUNCHES
#define N_LAUNCHES 1
#endif
#ifndef PHMASK
#define PHMASK 0xffff
#endif
#ifndef DUPMASK
#define DUPMASK 0
#endif
#define DUP(k) (((DUPMASK) >> (k)) & 1)

__global__ void __launch_bounds__(512, 2) hybrid_fwd(Params p) {
    extern __shared__ __attribute__((aligned(16))) unsigned char lds_raw[];
    const int wave_k = __builtin_amdgcn_readfirstlane((int)threadIdx.x >> 6);
    const Frame F = mk_frame(wave_k);
    volatile LAS unsigned* MISC = (volatile LAS unsigned*)(F.lds + MISC_OFF);
    for (int u = F.tid; u < (LDS_BYTES - LDSCTL_OFF) / 4; u += 512) ((LAS unsigned*)(F.lds + LDSCTL_OFF))[u] = 0u;
    __syncthreads();
    const PV pk = pv_get();
    unsigned* ctl = (unsigned*)(pk.ws() + WS_CTL);
    const int lo = pk.ph_lo(), hi = pk.ph_hi();
    XcdBarrier bar; bar.bar = ctl + CW_BAR; bar.x = 0; bar.st = nullptr;
    if (hi - lo > 1) bar = xcd_barrier_post(ctl + CW_BAR, MISC + 8, F.tid);
#define IN(k) ((((PHMASK) >> (((k) == NL * PH_PER_LAYER) ? 15 : ((k) % PH_PER_LAYER))) & 1) && lo <= (k) && (k) < hi)
#define SEAM(k) do { if (IN(k) && IN((k) + 1)) xcd_barrier(bar, wave_k); } while (0)
    if (IN(0)) phase_rope_table(F);
#pragma unroll 1
    for (int layer = 0; layer < NL; ++layer) {
        const int pb = layer * PH_PER_LAYER;
        if (IN(pb + 0)) { phase_convert(p, F, layer); if (DUP(0)) phase_convert(p, F, layer); }
        if (IN(pb + 1)) { ph_norm(p, F, layer, I_F1N, layer == 0); if (DUP(1)) ph_norm(p, F, layer, I_F1N, layer == 0); }
        SEAM(pb + 1);
        if (IN(pb + 2)) { ph_gateup(p, F, W_GU1); if (DUP(2)) ph_gateup(p, F, W_GU1); }
        SEAM(pb + 2);
        if (IN(pb + 3)) { if (DUP(3)) ph_down(p, F, W_D1, layer == 0, true); ph_down(p, F, W_D1, layer == 0); }
        SEAM(pb + 3);
        if (IN(pb + 4)) ph_norm(p, F, layer, I_MIXN, false);
        SEAM(pb + 4);
        if (IN(pb + 5)) { ph_win(p, F, layer); if (DUP(5)) ph_win(p, F, layer); }
        SEAM(pb + 5);
        if (IN(pb + 6)) phase_t1(p, F, layer);
        SEAM(pb + 6);
        if (IN(pb + 7)) { phase_t2(p, F); ph_uq(p, F); ph_ukv(p, F); phase_s1(p, F, layer); if (DUP(7)) { ph_uq(p, F); ph_ukv(p, F); } if (DUP(6)) phase_s1(p, F, layer); }
        SEAM(pb + 7);
        if (IN(pb + 8)) { phase_attn(p, F, layer); phase_s2(p, F, layer); }
        SEAM(pb + 8);
        if (IN(pb + 9)) phase_s3(p, F, layer);
        SEAM(pb + 9);
        if (IN(pb + 10)) { ph_merge_sample(p, F, layer); ph_merge<0>(p, F); ph_merge<1>(p, F); ph_merge<2>(p, F); }
        SEAM(pb + 10);
        if (IN(pb + 11)) { if (DUP(11)) ph_wout(p, F, true); ph_wout(p, F); }
        SEAM(pb + 11);
        if (IN(pb + 12)) ph_norm(p, F, layer, I_F2N, false);
        SEAM(pb + 12);
        if (IN(pb + 13)) ph_gateup(p, F, W_GU2);
        SEAM(pb + 13);
        if (IN(pb + 14)) ph_down(p, F, W_D2, false);
        SEAM(pb + 14);
    }
    if (IN(NL * PH_PER_LAYER)) { const PV q = pv_get(); const Frame F2 = mk_frame(wave_k); phase_final_norm(F2, q.out() + O_YP, (const bf16_t*)(q.ws() + WS_XB), q.in(I_FN), (const float*)(q.ws() + WS_PART)); }
#undef IN
#undef SEAM
}

extern "C" void kernel_launch(void* const* d_in, const int* in_sizes, int n_in, void* d_out, int out_size, void* d_ws, size_t ws_size, hipStream_t stream) {
    static int grid = 0;
    if (grid == 0) {
        if (n_in != N_IN || (size_t)out_size != O_TOTAL || ws_size < WS_END) { fprintf(stderr, "kernel_launch: unexpected shapes: n_in %d out %d ws %zu (need %zu)\n", n_in, out_size, ws_size, (size_t)WS_END); grid = -1; return; }
        int dev = 0, cus = 0, per_cu = 0;
        if (hipGetDevice(&dev) != hipSuccess || hipDeviceGetAttribute(&cus, hipDeviceAttributeMultiprocessorCount, dev) != hipSuccess) { grid = -1; return; }
        if (hipFuncSetAttribute((const void*)hybrid_fwd, hipFuncAttributeMaxDynamicSharedMemorySize, LDS_BYTES) != hipSuccess) { fprintf(stderr, "kernel_launch: hipFuncSetAttribute failed\n"); grid = -1; return; }
        if (hipOccupancyMaxActiveBlocksPerMultiprocessor(&per_cu, (const void*)hybrid_fwd, 512, LDS_BYTES) != hipSuccess || per_cu < 1) { fprintf(stderr, "kernel_launch: occupancy query says %d\n", per_cu); }
        (void)hipGetLastError();
        grid = cus;
    }
    if (grid < 0) return;
    (void)hipMemsetAsync((char*)d_ws + WS_CTL, 0, CTL_BYTES, stream);
    Params p{};
    for (int i = 0; i < N_IN; ++i) p.in[i] = (const float*)d_in[i];
    p.out = (float*)d_out; p.ws = (unsigned char*)d_ws;
#if defined(PROBE_K)
    p.ph_lo = 0; p.ph_hi = PROBE_K;
    hipLaunchKernelGGL(hybrid_fwd, dim3(grid), dim3(512), LDS_BYTES, stream, p);
    (void)hipMemsetAsync((char*)d_ws + WS_CTL, 0, CTL_BYTES, stream);
    p.ph_lo = 0; p.ph_hi = N_PHASES;
    hipLaunchKernelGGL(hybrid_fwd, dim3(grid), dim3(512), LDS_BYTES, stream, p);
#elif N_LAUNCHES == 1
    p.ph_lo = 0; p.ph_hi = N_PHASES;
    hipLaunchKernelGGL(hybrid_fwd, dim3(grid), dim3(512), LDS_BYTES, stream, p);
#else
    for (int k = 0; k < N_PHASES; ++k) { p.ph_lo = k; p.ph_hi = k + 1; hipLaunchKernelGGL(hybrid_fwd, dim3(grid), dim3(512), LDS_BYTES, stream, p); }
#endif
}
```

```cpp
#include <hip/hip_runtime.h>
#include <cstdio>
#include <cstdint>

#define LAS __attribute__((address_space(3)))
typedef unsigned short bf16_t;
typedef short bf16x8 __attribute__((ext_vector_type(8)));
typedef float f32x4 __attribute__((ext_vector_type(4)));
typedef float f32x2 __attribute__((ext_vector_type(2)));
typedef float f32x16 __attribute__((ext_vector_type(16)));
typedef unsigned u32x4 __attribute__((ext_vector_type(4)));
typedef unsigned u32x2 __attribute__((ext_vector_type(2)));
typedef __bf16 bf2_t __attribute__((ext_vector_type(2)));

constexpr int D = 2048, SEQ = 16384, NB = 16, NS = 16, PAST = 1024, FF = 5504, NL = 2;
constexpr int MP = SEQ, MS = NB * NS, MT = MP + MS;
constexpr int KVS = 1088, KVLEN_S = PAST + NS;
constexpr int KVROWS = MP + NB * KVS;
constexpr int LDU = 12800;
constexpr int IN_COLS = 12888, NWIN = 13056;
constexpr float LOG2E = 1.4426950408889634f;
constexpr float MLA_QSCALE = 0.07216878364870322f * LOG2E;
constexpr float FOX_QSCALE = 0.08838834764831845f * LOG2E;
constexpr float EPS = 1e-6f;
constexpr int UC_QLAT = 0, UC_CKV = 512, UC_Z = 1024, UC_XBC = 2048, UC_FQ = 3584, UC_FK = 4608, UC_FV = 5632, UC_GATE = 6656;
constexpr int UC_OMLA = 0, UC_OSSD = UC_Z, UC_OFOX = UC_FQ;
constexpr int US_KPE = 0, US_DT = 64, US_FF = 80, LDUS = 128;

enum { I_XP = 0, I_XS, I_CCKV, I_CKPE, I_CFK, I_CFV, I_CLOGF, I_SSM, I_CONV, I_F1N, I_F1G, I_F1U, I_F1D, I_MIXN, I_WIN, I_QN, I_WUQ, I_KVN, I_WUKV,
       I_CW, I_CB, I_DTB, I_ALOG, I_SD, I_SN, I_FBF, I_BRM, I_BRS, I_BRF, I_WOUT, I_F2N, I_F2G, I_F2U, I_F2D, I_FN, N_IN };
constexpr size_t O_YP = 0, O_YS = 33554432, O_PCKV = 34078720, O_PKPE = 50855936, O_PFK = 52953088, O_PFV = 86507520, O_PLOGF = 120061952,
                 O_PSSM = 120324096, O_PCONV = 120586240, O_SCKV = 120595456, O_SKPE = 120857600, O_SFK = 120890368, O_SFV = 121414656,
                 O_SLOGF = 121938944, O_SSSM = 121943040, O_SCONV = 126137344, O_TOTAL = 126284800;

constexpr size_t W_GU1 = 0, W_D1 = W_GU1 + (size_t)2 * FF * D, W_IN = W_D1 + (size_t)D * FF, W_UQ = W_IN + (size_t)NWIN * D, W_UKV = W_UQ + (size_t)1536 * 512,
                 W_BR = W_UKV + (size_t)2048 * 512, W_OUT = W_BR + (size_t)3 * 2048 * 1024, W_GU2 = W_OUT + (size_t)D * D, W_D2 = W_GU2 + (size_t)2 * FF * D,
                 W_TOTAL = W_D2 + (size_t)D * FF;

constexpr size_t MiB = 1u << 20;
constexpr size_t al(size_t x) { return (x + MiB - 1) / MiB * MiB; }
constexpr size_t WS_CTL = 0, CTL_BYTES = 1 * MiB;
constexpr size_t WS_ROPE = WS_CTL + CTL_BYTES;
constexpr size_t WS_W = WS_ROPE + al((size_t)SEQ * 32 * 8);
constexpr size_t WS_HB = WS_W;
constexpr size_t WS_XN = WS_W + al(W_TOTAL * 2);
constexpr size_t WS_U = WS_XN + al((size_t)MT * D * 2);
constexpr size_t WS_US = WS_U + al((size_t)MT * LDU * 2);
constexpr size_t WS_DT = WS_US + al((size_t)MT * LDUS * 4);
constexpr size_t WS_QM = WS_DT + al((size_t)MT * 16 * 4);
constexpr size_t WS_CKV = WS_QM + al((size_t)MT * 1536 * 2);
constexpr size_t WS_KM = WS_CKV + al((size_t)KVROWS * 512 * 2);
constexpr size_t WS_VTM = WS_KM + al((size_t)KVROWS * 1536 * 2);
constexpr size_t WS_KFS = WS_VTM + al((size_t)1024 * KVROWS * 2);
constexpr size_t WS_VTF = WS_KFS + al((size_t)NB * KVS * 1024 * 2);
constexpr size_t WS_LOGF = WS_VTF + al((size_t)1024 * KVROWS * 2);
constexpr size_t WS_CUM = WS_LOGF + al((size_t)KVROWS * 8 * 4);
constexpr int NCHUNK = 256 + NB;
constexpr size_t WS_ST = WS_CUM + al((size_t)KVROWS * 8 * 4);
constexpr size_t WS_CDEC = WS_ST + al((size_t)NCHUNK * 131072 * 4);
constexpr size_t WS_PART = WS_CDEC + MiB;
constexpr size_t WS_XB = WS_PART + al((size_t)8 * MS * D * 4);
constexpr size_t WS_END = WS_XB + al((size_t)MP * D * 2);

constexpr int CW_TMO = 0, CW_BAR = 4096;
constexpr int CW_MGC = 12288;
constexpr int CW_QN2 = 8192, CW_KN2 = CW_QN2 + NL * 64 * 8;

constexpr int RING_BYTES = 131072, LDS_BYTES = 163840, LDSCTL_OFF = LDS_BYTES - 512, MISC_OFF = LDSCTL_OFF + 320;

struct Params {
    const float* in[N_IN];
    float* out;
    unsigned char* ws;
    int ph_lo, ph_hi;
};

typedef const __attribute__((address_space(4))) unsigned char* KA;
struct PV { KA k;
    __device__ __forceinline__ const float* in(int i) const { return *(const float* const __attribute__((address_space(4)))*)(k + 8 * i); }
    __device__ __forceinline__ float* out() const { return *(float* const __attribute__((address_space(4)))*)(k + 8 * N_IN); }
    __device__ __forceinline__ unsigned char* ws() const { return *(unsigned char* const __attribute__((address_space(4)))*)(k + 8 * N_IN + 8); }
    __device__ __forceinline__ int ph_lo() const { return *(const __attribute__((address_space(4))) int*)(k + 8 * N_IN + 16); }
    __device__ __forceinline__ int ph_hi() const { return *(const __attribute__((address_space(4))) int*)(k + 8 * N_IN + 20); }
};
__device__ __forceinline__ PV pv_get() { PV v; v.k = (KA)__builtin_amdgcn_kernarg_segment_ptr(); asm volatile("" : "+s"(v.k)); return v; }
static_assert(sizeof(Params) == 8 * N_IN + 24, "Params layout");

#define LDS_WAIT() asm volatile("s_waitcnt lgkmcnt(0)" ::: "memory")
#define VM_WAIT() asm volatile("s_waitcnt vmcnt(0)" ::: "memory")
__device__ __forceinline__ unsigned pk2(float lo, float hi) { bf2_t v = {(__bf16)lo, (__bf16)hi}; return __builtin_bit_cast(unsigned, v); }
__device__ __forceinline__ float bf_lo(unsigned w) { return __uint_as_float(w << 16); }
__device__ __forceinline__ float bf_hi(unsigned w) { return __uint_as_float(w & 0xffff0000u); }
__device__ __forceinline__ float bf2f(bf16_t b) { return __uint_as_float((unsigned)b << 16); }
__device__ __forceinline__ bf16_t f2bf(float f) { return (bf16_t)(pk2(f, 0.f) & 0xffffu); }
__device__ __forceinline__ float shx(float v, int o, int lane) { return __int_as_float(__builtin_amdgcn_ds_bpermute((lane ^ o) << 2, __float_as_int(v))); }
__device__ __forceinline__ float wave_sum(float v, int lane) {
#pragma unroll
    for (int o = 1; o < 64; o <<= 1) v += shx(v, o, lane);
    return v;
}
__device__ __forceinline__ float fast_exp2(float x) { return __builtin_amdgcn_exp2f(x); }
__device__ __forceinline__ float fast_exp(float x) { return __builtin_amdgcn_exp2f(x * LOG2E); }
__device__ __forceinline__ float fast_rsqrt(float x) { return __builtin_amdgcn_rsqf(x); }
__device__ __forceinline__ float fast_log(float x) { return __builtin_amdgcn_logf(x) * 0.6931471805599453f; }
__device__ __forceinline__ float sigmoidf_(float x) { return __builtin_amdgcn_rcpf(1.f + fast_exp2(-x * LOG2E)); }
__device__ __forceinline__ float siluf_(float x) { return x * sigmoidf_(x); }
__device__ __forceinline__ int kvrow_of(int m) { return m < MP ? m : MP + ((m - MP) >> 4) * KVS + PAST + ((m - MP) & 15); }
__device__ __forceinline__ int pos_of(int m) { return m < MP ? m : PAST + ((m - MP) & 15); }

#define XB_TMO      128
#define XB_XCNT(j)  (256  + 64 * (j))
#define XB_XSUB(j)  (1280 + 64 * (j))
#define XB_XGEN(j)  (2304 + 64 * (j))
#define XB_TOP      3328
#define XB_TOPGEN   3392
#define XCD_BAR_WORDS 3456
#define XB_SPIN_CAP (1u << 22)
__device__ __forceinline__ unsigned xb_ld(unsigned* p)              { return __hip_atomic_load(p, __ATOMIC_RELAXED, __HIP_MEMORY_SCOPE_AGENT); }
__device__ __forceinline__ unsigned xb_add(unsigned* p, unsigned v) { return __hip_atomic_fetch_add(p, v, __ATOMIC_RELAXED, __HIP_MEMORY_SCOPE_AGENT); }
__device__ __forceinline__ unsigned xb_xcc_id() { return (unsigned)__builtin_amdgcn_s_getreg((3 << 11) | 20) & 0xFu; }
#define XB_SPIN(cond, bar) do { unsigned _sp = 0; while (cond) { __builtin_amdgcn_s_sleep(1); \
    if ((++_sp & 255u) == 0u) { if (xb_ld(&(bar)[XB_TMO])) break; if (_sp > XB_SPIN_CAP) { atomicAdd(&(bar)[XB_TMO], 1u); break; } } } } while (0)
struct XcdBarrier { unsigned* bar; unsigned x; volatile LAS unsigned* st; };
__device__ __forceinline__ XcdBarrier xcd_barrier_post(unsigned* bar, volatile LAS unsigned* st, int tid) {
    XcdBarrier b; b.bar = bar; b.x = xb_xcc_id(); b.st = st;
    if (tid == 0) (void)xb_add(&bar[XB_XCNT(b.x)], 1u);
    return b;
}
__device__ __forceinline__ void xcd_barrier_complete(unsigned* bar, unsigned x, unsigned& nloc, unsigned& nx) {
    const unsigned G = gridDim.x * gridDim.y * gridDim.z;
    unsigned sum, cnt, mine, sp = 0u;
    for (;;) {
        sum = 0u; cnt = 0u; mine = 0u;
#pragma unroll
        for (unsigned j = 0; j < 16; ++j) { const unsigned c = xb_ld(&bar[XB_XCNT(j)]); sum += c; cnt += (c > 0u) ? 1u : 0u; mine = (j == x) ? c : mine; }
        if (sum == G) break;
        __builtin_amdgcn_s_sleep(1);
        if ((++sp & 255u) == 0u) { if (xb_ld(&bar[XB_TMO])) break; if (sp > XB_SPIN_CAP) { atomicAdd(&bar[XB_TMO], 1u); break; } }
    }
    nloc = mine > 0u ? mine : 1u; nx = cnt > 0u ? cnt : 1u;
}
__device__ __forceinline__ void xcd_barrier(const XcdBarrier& b, int wave_s) {
    asm volatile("s_waitcnt vmcnt(0)" ::: "memory");
    __syncthreads();
    int tid_b; { unsigned z_ = 0u; asm volatile("" : "+s"(z_)); tid_b = wave_s * 64 + (int)__builtin_amdgcn_mbcnt_hi(~0u, __builtin_amdgcn_mbcnt_lo(~0u, z_)); }
    if (tid_b == 0) {
        unsigned* bar = b.bar; asm volatile("" : "+s"(bar));
        __builtin_amdgcn_s_waitcnt(0);
        unsigned nloc = b.st[0], nx = b.st[1];
        if (nloc == 0u) { xcd_barrier_complete(bar, b.x, nloc, nx); b.st[0] = nloc; b.st[1] = nx; }
        const unsigned old = xb_add(&bar[XB_XSUB(b.x)], 1u);
        const unsigned gen = old / nloc;
        if (old + 1u == (gen + 1u) * nloc) {
            __builtin_amdgcn_fence(__ATOMIC_RELEASE, "agent");
            asm volatile("s_waitcnt vmcnt(0)" ::: "memory");
            const unsigned og = xb_add(&bar[XB_TOP], 1u);
            const unsigned tg = og / nx;
            if (og + 1u == (tg + 1u) * nx) xb_add(&bar[XB_TOPGEN], 1u);
            else XB_SPIN(xb_ld(&bar[XB_TOPGEN]) == tg, bar);
            __builtin_amdgcn_fence(__ATOMIC_ACQUIRE, "agent");
            xb_add(&bar[XB_XGEN(b.x)], 1u);
            asm volatile("s_waitcnt vmcnt(0)" ::: "memory");
        } else {
            XB_SPIN(xb_ld(&bar[XB_XGEN(b.x)]) == gen, bar);
            __builtin_amdgcn_fence(__ATOMIC_ACQUIRE, "agent");
            asm volatile("s_waitcnt vmcnt(0)" ::: "memory");
        }
    }
    __syncthreads();
}

namespace pg8 {
constexpr int BM = 256, BK = 64, HALF = 128, HTB = HALF * BK * 2, STAGE_BYTES = 8 * HTB, NXCD = 8, WGM = 8;
__host__ __device__ __forceinline__ int lds_byte(int r, int c) { const int st = (r >> 4) * 2 + (c >> 5), rr = r & 15, cc = c & 31, ob = rr * 64 + cc * 2; return st * 1024 + (ob ^ (((ob >> 9) & 1) << 5)); }
__host__ __device__ __forceinline__ void stage_rc(int b, int& R, int& C) { const int st = b / 1024, sb = b % 1024, swz = sb ^ (((sb >> 9) & 1) << 5); R = (st >> 1) * 16 + swz / 64; C = (st & 1) * 32 + (swz % 64) / 2; }
__host__ __device__ __forceinline__ int perm32(int rho) { const int n = rho >> 4, i = rho & 15; return 8 * (i >> 2) + 4 * n + (i & 3); }
struct Unit { int pm, pn, k0, nt, sp; };
struct Gemm { const bf16_t* A; const bf16_t* Bt; int lda, ldb, M, N, K; size_t ksA = 128, ksB = 128; };
struct StaticOrder {
    int nM, nN, nwg, G, c, ntK; bool nfast; bool nrev = false;
    __host__ __device__ __forceinline__ void init(int M, int N, int G_, int c_, int K_ = 0, bool nfast_ = false) { nM = M / BM; nN = N / BM; nwg = nM * nN; G = G_; c = c_; ntK = K_ / BK; nfast = nfast_; }
    __host__ __device__ __forceinline__ bool next(int i, Unit& u) const {
        const long L = (long)i * G + c; if (L >= nwg) return false;
        int wgid = (int)L; { const int q = nwg / NXCD, r = nwg % NXCD, xcd = wgid % NXCD, off = wgid / NXCD; wgid = (xcd < r ? xcd * (q + 1) : r * (q + 1) + (xcd - r) * q) + off; }
        const int nig = WGM * nN, gid = wgid / nig, fm = gid * WGM, gsz = (nM - fm) < WGM ? (nM - fm) : WGM;
        const int ig = wgid % nig;
        u.pm = nfast ? fm + ig / nN : fm + (ig % gsz); u.pn = nfast ? ig % nN : ig / gsz; if (nrev) u.pn = nN - 1 - u.pn; u.k0 = 0; u.nt = ntK; u.sp = 0; return true;
    }
    __device__ __forceinline__ void a_ready(const Unit&) const {}
    __device__ __forceinline__ void done(const Unit&) const {}
    __device__ __forceinline__ size_t a_extra(const Unit&) const { return 0; }
};
struct SplitOrder : StaticOrder {
    __host__ __device__ __forceinline__ void init(int M, int N, int G_, int c_, int K_) { StaticOrder::init(M - BM, N, G_, c_, K_, true); }
    __host__ __device__ __forceinline__ bool next(int i, Unit& u) const {
        const long L = (long)i * G + c;
        const bool reg = L < nwg; const int idx = (int)(L - nwg);
        const int ns = 8;
        if (!reg && idx >= nN * ns) return false;
        Unit a; a.pm = 0; a.pn = 0; a.k0 = 0; a.nt = ntK; a.sp = 0;
        if (reg) { Unit t; StaticOrder::next(i, t); a.pm = t.pm; a.pn = t.pn; }
        const int sp = idx / nN;
        const int base = (ntK / ns) & ~1, extra = (ntK - ns * base) / 2;
        const int s_nt = base + (sp < extra ? 2 : 0), s_k0 = base * sp + 2 * (sp < extra ? sp : extra);
        u.pm = reg ? a.pm : nM; u.pn = reg ? a.pn : idx % nN; u.k0 = reg ? 0 : s_k0; u.nt = reg ? ntK : s_nt; u.sp = reg ? 0 : sp;
        return true;
    }
};
struct SampleMergeOrder {
    int c;
    __host__ __device__ __forceinline__ bool next(int i, Unit& u) const {
        if (i != 0 || c >= 24) return false;
        u.pm = MP / BM; u.pn = c; u.k0 = 0; u.nt = 16; u.sp = 0; return true;
    }
    __device__ __forceinline__ void a_ready(const Unit&) const {}
    __device__ __forceinline__ void done(const Unit&) const {}
    __device__ __forceinline__ size_t a_extra(const Unit& u) const { const int br = u.pn >> 3; return (size_t)(br == 0 ? UC_OMLA : (br == 1 ? UC_OSSD : UC_OFOX)) * 2; }
};
template <class Epi, class Sched, bool ALIGN_EPI = false, bool SP2 = false>
__device__ __forceinline__ void gemm_phase(LAS unsigned char* lds, const Gemm g, const Sched& S, const Epi& E, int wave_s) {
    int tid_; { unsigned z_ = 0u; asm volatile("" : "+s"(z_)); tid_ = wave_s * 64 + (int)__builtin_amdgcn_mbcnt_hi(~0u, __builtin_amdgcn_mbcnt_lo(~0u, z_)); }
    const int tid = tid_, wid = __builtin_amdgcn_readfirstlane(tid >> 6), lane = tid & 63, wr = wid >> 2, wc = wid & 3, fr = lane & 15, fq = lane >> 4;
    unsigned voffA[2], voffB[2];
#pragma unroll
    for (int i = 0; i < 2; ++i) { int R, C; stage_rc(tid * 16 + i * 8192, R, C); const int Rb = Epi::PERM ? ((R & ~31) + perm32(R & 31)) : R;
        voffA[i] = (unsigned)(R * g.lda + C) * 2u; voffB[i] = (unsigned)(Rb * g.ldb + C) * 2u; }
    const size_t kstepA = g.ksA, kstepB = g.ksB;
    const size_t hstepA = (size_t)HALF * g.lda * 2, hstepB = (size_t)HALF * g.ldb * 2;
    const size_t tstepA = 2 * hstepA, tstepB = 2 * hstepB;
    const unsigned ldsw = (unsigned)wid * 1024u;
    const int aoff = lds_byte(wr * 64 + fr, fq * 8), boff = lds_byte(wc * 32 + fr, fq * 8);
#define PG8_SA(b, h) (((b) * 2 + (h)) * HTB)
#define PG8_SB(b, h) ((4 + (b) * 2 + (h)) * HTB)
#define PG8_STAGE(bufoff, gbase, voff) do { _Pragma("unroll") for (int _i = 0; _i < 2; ++_i) \
        __builtin_amdgcn_global_load_lds((const unsigned*)((const char*)(gbase) + (voff)[_i]), (LAS unsigned*)(lds + (bufoff) + ldsw + _i * 8192), 16, 0, 0); } while (0)
#define PG8_LDA(dst, b, h) do { _Pragma("unroll") for (int m = 0; m < 4; ++m) _Pragma("unroll") for (int k = 0; k < 2; ++k) dst[m][k] = *(const LAS bf16x8*)(lds + PG8_SA(b, h) + aoff + m * 2048 + k * 1024); } while (0)
#define PG8_LDB(dst, b, h) do { _Pragma("unroll") for (int n = 0; n < 2; ++n) _Pragma("unroll") for (int k = 0; k < 2; ++k) dst[n][k] = *(const LAS bf16x8*)(lds + PG8_SB(b, h) + boff + n * 2048 + k * 1024); } while (0)
#define PG8_MMA(ai, bj, At, Bt) do { __builtin_amdgcn_s_setprio(1); _Pragma("unroll") for (int m = 0; m < 4; ++m) _Pragma("unroll") for (int n = 0; n < 2; ++n) _Pragma("unroll") for (int k = 0; k < 2; ++k) \
        acc[ai][bj][m][n] = __builtin_amdgcn_mfma_f32_16x16x32_bf16(Bt[n][k], At[m][k], acc[ai][bj][m][n], 0, 0, 0); __builtin_amdgcn_s_setprio(0); } while (0)
#define PG8_WAIT_V(n) asm volatile("s_waitcnt vmcnt(" #n ")" ::: "memory")
#define PG8_WAIT_L(n) asm volatile("s_waitcnt lgkmcnt(" #n ")" ::: "memory")
#define PG8_BAR __builtin_amdgcn_s_barrier()
#define PG8_SCHED __builtin_amdgcn_sched_barrier(0)
    Unit cur, nxt; int ui = 0;
    if (!S.next(0, cur)) return;
    float zf_ = 0.f; asm volatile("" : "+v"(zf_));
    const f32x4 zero4 = {zf_, zf_, zf_, zf_};
    f32x4 acc[2][2][4][2];
#pragma unroll
    for (int a = 0; a < 2; ++a)
#pragma unroll
        for (int b = 0; b < 2; ++b)
#pragma unroll
            for (int m = 0; m < 4; ++m)
#pragma unroll
                for (int n = 0; n < 2; ++n) acc[a][b][m][n] = zero4;
    bf16x8 At[4][2], B0[2][2], B1[2][2];
    const char* cA = (const char*)g.A + (size_t)cur.pm * tstepA + (size_t)cur.k0 * kstepA + S.a_extra(cur); const char* cB = (const char*)g.Bt + (size_t)cur.pn * tstepB + (size_t)cur.k0 * kstepB;
    S.a_ready(cur);
    if constexpr (SP2) {
        PG8_STAGE(PG8_SB(0, 0), cB, voffB); PG8_STAGE(PG8_SB(0, 1), cB + hstepB, voffB); PG8_STAGE(PG8_SA(0, 0), cA, voffA); PG8_STAGE(PG8_SA(0, 1), cA + hstepA, voffA);
        if (wr == 1) PG8_BAR;
        PG8_WAIT_V(2); PG8_BAR;
        PG8_STAGE(PG8_SB(1, 0), cB + kstepB, voffB); PG8_STAGE(PG8_SA(1, 0), cA + kstepA, voffA); PG8_STAGE(PG8_SB(1, 1), cB + hstepB + kstepB, voffB);
        PG8_WAIT_V(6); PG8_BAR;
    } else {
        PG8_STAGE(PG8_SB(0, 0), cB, voffB); PG8_STAGE(PG8_SA(0, 0), cA, voffA); PG8_STAGE(PG8_SB(0, 1), cB + hstepB, voffB); PG8_STAGE(PG8_SA(0, 1), cA + hstepA, voffA);
        if (wr == 1) PG8_BAR;
        PG8_WAIT_V(4); PG8_BAR;
        PG8_STAGE(PG8_SB(1, 0), cB + kstepB, voffB); PG8_STAGE(PG8_SA(1, 0), cA + kstepA, voffA); PG8_STAGE(PG8_SB(1, 1), cB + hstepB + kstepB, voffB);
        PG8_WAIT_V(6); PG8_BAR;
    }
    for (;;) {
        const bool has_next = S.next(ui + 1, nxt);
        const char* nA = has_next ? (const char*)g.A + (size_t)nxt.pm * tstepA + (size_t)nxt.k0 * kstepA + S.a_extra(nxt) : cA; const char* nB = has_next ? (const char*)g.Bt + (size_t)nxt.pn * tstepB + (size_t)nxt.k0 * kstepB : cB;
        const int nt = cur.nt;
        for (int t = 0; t < nt; t += 2) {
            const bool last = (t == nt - 2);
            const char* a1 = cA + (size_t)(t + 1) * kstepA;
            const char* a2 = last ? nA : cA + (size_t)(t + 2) * kstepA; const char* b2 = last ? nB : cB + (size_t)(t + 2) * kstepB;
            const char* a3 = a2 + kstepA; const char* b3 = b2 + kstepB;
            if (last && has_next) S.a_ready(nxt);
            if constexpr (SP2) {
            PG8_LDB(B0, 0, 0); PG8_LDB(B1, 0, 1); PG8_SCHED; PG8_LDA(At, 0, 0); PG8_STAGE(PG8_SA(1, 1), a1 + hstepA, voffA);
            PG8_WAIT_V(8); PG8_WAIT_L(0); PG8_BAR; PG8_MMA(0, 0, At, B0); PG8_MMA(0, 1, At, B1); PG8_BAR; PG8_SCHED;
            PG8_LDA(At, 0, 1); PG8_STAGE(PG8_SB(0, 0), b2, voffB); PG8_STAGE(PG8_SB(0, 1), b2 + hstepB, voffB); PG8_STAGE(PG8_SA(0, 0), a2, voffA);
            PG8_WAIT_V(8); PG8_WAIT_L(0); PG8_BAR; PG8_MMA(1, 0, At, B0); PG8_MMA(1, 1, At, B1); PG8_BAR; PG8_SCHED;
            PG8_LDB(B0, 1, 0); PG8_LDB(B1, 1, 1); PG8_SCHED; PG8_LDA(At, 1, 0); PG8_STAGE(PG8_SA(0, 1), a2 + hstepA, voffA);
            PG8_WAIT_V(8); PG8_WAIT_L(0); PG8_BAR; PG8_MMA(0, 0, At, B0); PG8_MMA(0, 1, At, B1); PG8_BAR; PG8_SCHED;
            PG8_LDA(At, 1, 1); PG8_STAGE(PG8_SB(1, 0), b3, voffB); PG8_STAGE(PG8_SB(1, 1), b3 + hstepB, voffB); PG8_STAGE(PG8_SA(1, 0), a3, voffA);
            PG8_WAIT_V(8); PG8_WAIT_L(0); PG8_BAR; PG8_MMA(1, 0, At, B0); PG8_MMA(1, 1, At, B1); PG8_BAR; PG8_SCHED;
            } else {
            PG8_LDB(B0, 0, 0); PG8_SCHED; PG8_LDA(At, 0, 0); PG8_STAGE(PG8_SA(1, 1), a1 + hstepA, voffA);
            PG8_WAIT_L(8); PG8_BAR; PG8_WAIT_L(0); PG8_MMA(0, 0, At, B0); PG8_BAR; PG8_SCHED;
            PG8_LDB(B1, 0, 1); PG8_STAGE(PG8_SB(0, 0), b2, voffB);
            PG8_BAR; PG8_WAIT_L(0); PG8_MMA(0, 1, At, B1); PG8_BAR;
            PG8_LDA(At, 0, 1); PG8_STAGE(PG8_SA(0, 0), a2, voffA);
            PG8_BAR; PG8_WAIT_L(0); PG8_MMA(1, 0, At, B0); PG8_BAR; PG8_SCHED;
            PG8_STAGE(PG8_SB(0, 1), b2 + hstepB, voffB);
            PG8_WAIT_V(6); PG8_BAR; PG8_MMA(1, 1, At, B1); PG8_BAR;
            PG8_LDB(B0, 1, 0); PG8_SCHED; PG8_LDA(At, 1, 0); PG8_STAGE(PG8_SA(0, 1), a2 + hstepA, voffA);
            PG8_WAIT_L(8); PG8_BAR; PG8_WAIT_L(0); PG8_MMA(0, 0, At, B0); PG8_BAR; PG8_SCHED;
            PG8_LDB(B1, 1, 1); PG8_STAGE(PG8_SB(1, 0), b3, voffB);
            PG8_BAR; PG8_WAIT_L(0); PG8_MMA(0, 1, At, B1); PG8_BAR;
            PG8_LDA(At, 1, 1); PG8_STAGE(PG8_SA(1, 0), a3, voffA);
            PG8_BAR; PG8_WAIT_L(0); PG8_MMA(1, 0, At, B0); PG8_BAR; PG8_SCHED;
            PG8_STAGE(PG8_SB(1, 1), b3 + hstepB, voffB);
            PG8_WAIT_V(6); PG8_BAR; PG8_MMA(1, 1, At, B1); PG8_BAR;
            }
        }
        if constexpr (ALIGN_EPI) { if (wr == 0) PG8_BAR; }
        E(acc, cur, wr, wc, fr, fq); S.done(cur);
        if (!has_next) break;
#pragma unroll
        for (int a = 0; a < 2; ++a)
#pragma unroll
            for (int b = 0; b < 2; ++b)
#pragma unroll
                for (int m = 0; m < 4; ++m)
#pragma unroll
                    for (int n = 0; n < 2; ++n) acc[a][b][m][n] = zero4;
        cur = nxt; cA = nA; cB = nB; ++ui;
        if constexpr (ALIGN_EPI) { if (wr == 1) PG8_BAR; }
    }
    PG8_WAIT_V(0);
    if constexpr (!ALIGN_EPI) { if (wr == 0) PG8_BAR; }
    PG8_BAR;
#undef PG8_SA
#undef PG8_SB
#undef PG8_STAGE
#undef PG8_LDA
#undef PG8_LDB
#undef PG8_MMA
#undef PG8_WAIT_V
#undef PG8_WAIT_L
#undef PG8_BAR
#undef PG8_SCHED
}
}
using pg8::Unit;
typedef const f32x4 (&AccRef)[2][2][4][2];

struct EpiSwiGLU {
    static constexpr bool PERM = true;
    bf16_t* H;
    __device__ __forceinline__ void operator()(AccRef acc, const Unit& u, int wr, int wc, int fr, int fq) const {
        const int row0 = u.pm * 256 + wr * 64 + fr, col0 = u.pn * 128 + wc * 32 + 8 * fq;
#pragma unroll
        for (int ai = 0; ai < 2; ++ai)
#pragma unroll
            for (int m = 0; m < 4; ++m) {
                const f32x4 g0 = acc[ai][0][m][0], g1 = acc[ai][0][m][1], u0 = acc[ai][1][m][0], u1 = acc[ai][1][m][1];
                u32x4 w;
                w.x = pk2(siluf_(g0[0]) * u0[0], siluf_(g0[1]) * u0[1]); w.y = pk2(siluf_(g0[2]) * u0[2], siluf_(g0[3]) * u0[3]);
                w.z = pk2(siluf_(g1[0]) * u1[0], siluf_(g1[1]) * u1[1]); w.w = pk2(siluf_(g1[2]) * u1[2], siluf_(g1[3]) * u1[3]);
                *(u32x4*)(H + (size_t)(col0 >> 6) * ((size_t)MT * 64) + (size_t)(row0 + ai * 128 + m * 16) * 64 + (col0 & 63)) = w;
            }
    }
};
struct EpiResid {
    static constexpr bool PERM = true;
    const float* xin_f; bf16_t* xb; float alpha; float* part;
    __device__ __forceinline__ void operator()(AccRef acc, const Unit& u, int wr, int wc, int fr, int fq) const {
        const int row0 = u.pm * 256 + wr * 64 + fr, col0 = u.pn * 256 + wc * 32 + 8 * fq;
        if (u.pm * 256 >= MP) {
            float* pb_ = part + ((size_t)u.sp * MS - MP) * D;
#pragma unroll
            for (int ai = 0; ai < 2; ++ai)
#pragma unroll
                for (int m = 0; m < 4; ++m) { float* o = pb_ + (size_t)(row0 + ai * 128 + m * 16) * D + col0;
#pragma unroll
                    for (int bj = 0; bj < 2; ++bj)
#pragma unroll
                        for (int n = 0; n < 2; ++n) *(f32x4*)(o + bj * 128 + n * 4) = acc[ai][bj][m][n] * alpha; }
            return;
        }
        if (xin_f) {
#pragma unroll
            for (int ai = 0; ai < 2; ++ai) {
                f32x4 b[4][2][2];
#pragma unroll
                for (int m = 0; m < 4; ++m) { const size_t off = (size_t)(row0 + ai * 128 + m * 16) * D + col0;
#pragma unroll
                    for (int bj = 0; bj < 2; ++bj)
#pragma unroll
                        for (int n = 0; n < 2; ++n) b[m][bj][n] = *(const f32x4*)(xin_f + off + bj * 128 + n * 4); }
#pragma unroll
                for (int m = 0; m < 4; ++m) { const size_t off = (size_t)(row0 + ai * 128 + m * 16) * D + col0;
#pragma unroll
                    for (int bj = 0; bj < 2; ++bj) { const f32x4 a0 = b[m][bj][0] + acc[ai][bj][m][0] * alpha, a1 = b[m][bj][1] + acc[ai][bj][m][1] * alpha;
                        u32x4 w; w.x = pk2(a0[0], a0[1]); w.y = pk2(a0[2], a0[3]); w.z = pk2(a1[0], a1[1]); w.w = pk2(a1[2], a1[3]);
                        *(u32x4*)(xb + off + bj * 128) = w; } }
            }
        } else {
#pragma unroll
            for (int ai = 0; ai < 2; ++ai) {
                u32x4 b[4][2];
#pragma unroll
                for (int m = 0; m < 4; ++m) { const size_t off = (size_t)(row0 + ai * 128 + m * 16) * D + col0;
#pragma unroll
                    for (int bj = 0; bj < 2; ++bj) b[m][bj] = *(const u32x4*)(xb + off + bj * 128); }
#pragma unroll
                for (int m = 0; m < 4; ++m) { const size_t off = (size_t)(row0 + ai * 128 + m * 16) * D + col0;
#pragma unroll
                    for (int bj = 0; bj < 2; ++bj) { const u32x4 x = b[m][bj];
                        const f32x4 x0 = {bf_lo(x.x), bf_hi(x.x), bf_lo(x.y), bf_hi(x.y)}, x1 = {bf_lo(x.z), bf_hi(x.z), bf_lo(x.w), bf_hi(x.w)};
                        const f32x4 a0 = x0 + acc[ai][bj][m][0] * alpha, a1 = x1 + acc[ai][bj][m][1] * alpha;
                        u32x4 w; w.x = pk2(a0[0], a0[1]); w.y = pk2(a0[2], a0[3]); w.z = pk2(a1[0], a1[1]); w.w = pk2(a1[2], a1[3]);
                        *(u32x4*)(xb + off + bj * 128) = w; } }
            }
        }
    }
};
struct EpiWin {
    static constexpr bool PERM = true;
    bf16_t* U; float* US; float* fk_p; float* fk_s; float* fv_p; float* fv_s;
    __device__ __forceinline__ void operator()(AccRef acc, const Unit& u, int wr, int wc, int fr, int fq) const {
        const int row0 = u.pm * 256 + wr * 64 + fr, cw = wc * 32 + 8 * fq;
        const int pn = u.pn;
        if (pn < 26) {
            float* fo = nullptr;
            if (pn >= 18) { const bool isv = pn >= 22; const int hc = (pn - (isv ? 22 : 18)) * 256;
                fo = (u.pm * 256 < MP) ? (isv ? fv_p : fk_p) : (isv ? fv_s : fk_s) - (size_t)MP * 1024; fo += hc; }
#pragma unroll
            for (int ai = 0; ai < 2; ++ai)
#pragma unroll
                for (int m = 0; m < 4; ++m) { const int row = row0 + ai * 128 + m * 16;
#pragma unroll
                    for (int bj = 0; bj < 2; ++bj) { const f32x4 v0 = acc[ai][bj][m][0], v1 = acc[ai][bj][m][1];
                        u32x4 w; w.x = pk2(v0[0], v0[1]); w.y = pk2(v0[2], v0[3]); w.z = pk2(v1[0], v1[1]); w.w = pk2(v1[2], v1[3]);
                        *(u32x4*)(U + (size_t)row * LDU + pn * 256 + bj * 128 + cw) = w;
                        if (fo) { float* o = fo + (size_t)row * 1024 + bj * 128 + cw; *(f32x4*)o = v0; *(f32x4*)(o + 4) = v1; } } }
        } else if (pn < 50) {
#pragma unroll
            for (int ai = 0; ai < 2; ++ai)
#pragma unroll
                for (int m = 0; m < 4; ++m) { const int row = row0 + ai * 128 + m * 16;
#pragma unroll
                    for (int bj = 0; bj < 2; ++bj) { const f32x4 v0 = acc[ai][bj][m][0], v1 = acc[ai][bj][m][1];
                        u32x4 w; w.x = pk2(sigmoidf_(v0[0]), sigmoidf_(v0[1])); w.y = pk2(sigmoidf_(v0[2]), sigmoidf_(v0[3]));
                        w.z = pk2(sigmoidf_(v1[0]), sigmoidf_(v1[1])); w.w = pk2(sigmoidf_(v1[2]), sigmoidf_(v1[3]));
                        *(u32x4*)(U + (size_t)row * LDU + pn * 256 + bj * 128 + cw) = w; } }
        } else {
#pragma unroll
            for (int ai = 0; ai < 2; ++ai)
#pragma unroll
                for (int m = 0; m < 4; ++m) { const int row = row0 + ai * 128 + m * 16;
                    float* o = US + (size_t)row * LDUS + cw; *(f32x4*)o = acc[ai][0][m][0]; *(f32x4*)(o + 4) = acc[ai][0][m][1]; }
        }
    }
};
struct EpiUq {
    static constexpr bool PERM = true;
    bf16_t* Q; const f32x2* rope;
    __device__ __forceinline__ void operator()(AccRef acc, const Unit& u, int wr, int wc, int fr, int fq) const {
        const int row0 = u.pm * 256 + wr * 64 + fr;
#pragma unroll
        for (int bj = 0; bj < 2; ++bj) {
            const int c0 = u.pn * 256 + bj * 128 + wc * 32 + 8 * fq, r = c0 % 192;
            const bool isrope = r >= 128; const int j0 = (r - 128) >> 1;
#pragma unroll
            for (int ai = 0; ai < 2; ++ai)
#pragma unroll
                for (int m = 0; m < 4; ++m) { const int row = row0 + ai * 128 + m * 16;
                    f32x4 v0 = acc[ai][bj][m][0], v1 = acc[ai][bj][m][1];
                    if (isrope) { const f32x2* cs = rope + (size_t)pos_of(row) * 32 + j0;
                        const f32x2 a = cs[0], b = cs[1], c = cs[2], d = cs[3];
                        const f32x4 t0 = v0, t1 = v1;
                        v0[0] = t0[0] * a.x - t0[1] * a.y; v0[1] = t0[1] * a.x + t0[0] * a.y; v0[2] = t0[2] * b.x - t0[3] * b.y; v0[3] = t0[3] * b.x + t0[2] * b.y;
                        v1[0] = t1[0] * c.x - t1[1] * c.y; v1[1] = t1[1] * c.x + t1[0] * c.y; v1[2] = t1[2] * d.x - t1[3] * d.y; v1[3] = t1[3] * d.x + t1[2] * d.y; }
                    u32x4 w; w.x = pk2(v0[0], v0[1]); w.y = pk2(v0[2], v0[3]); w.z = pk2(v1[0], v1[1]); w.w = pk2(v1[2], v1[3]);
                    *(u32x4*)(Q + (size_t)row * 1536 + c0) = w; }
        }
    }
};
struct EpiUkv {
    static constexpr bool PERM = true;
    bf16_t* KM; bf16_t* VT;
    __device__ __forceinline__ void operator()(AccRef acc, const Unit& u, int wr, int wc, int fr, int fq) const {
        const int row0 = u.pm * 256 + wr * 64 + fr, h = u.pn, d0 = wc * 32 + 8 * fq;
#pragma unroll
        for (int ai = 0; ai < 2; ++ai)
#pragma unroll
            for (int m = 0; m < 4; ++m) { const int row = row0 + ai * 128 + m * 16;
                { const f32x4 v0 = acc[ai][0][m][0], v1 = acc[ai][0][m][1];
                  u32x4 w; w.x = pk2(v0[0], v0[1]); w.y = pk2(v0[2], v0[3]); w.z = pk2(v1[0], v1[1]); w.w = pk2(v1[2], v1[3]);
                  *(u32x4*)(KM + ((size_t)row * 8 + h) * 192 + d0) = w; }
                { const f32x4 v0 = acc[ai][1][m][0], v1 = acc[ai][1][m][1];
                  bf16_t* vt = VT + (size_t)(h * 128 + d0) * KVROWS + row;
#pragma unroll
                  for (int j = 0; j < 4; ++j) { vt[(size_t)j * KVROWS] = f2bf(v0[j]); vt[(size_t)(j + 4) * KVROWS] = f2bf(v1[j]); } } }
    }
};
template <int BR> struct EpiMerge {
    static constexpr bool PERM = true;
    const bf16_t* U; bf16_t* MG;
    __device__ __forceinline__ void operator()(AccRef acc, const Unit& u, int wr, int wc, int fr, int fq) const {
        const int row0 = u.pm * 256 + wr * 64 + fr, colb = u.pn * 256 + wc * 32 + 8 * fq;
#pragma unroll
        for (int ai = 0; ai < 2; ++ai) {
            u32x4 gt[4][2], od[4][2];
#pragma unroll
            for (int m = 0; m < 4; ++m) { const int row = row0 + ai * 128 + m * 16;
#pragma unroll
                for (int bj = 0; bj < 2; ++bj) { gt[m][bj] = *(const u32x4*)(U + (size_t)row * LDU + UC_GATE + BR * D + colb + bj * 128);
                    if (BR > 0) od[m][bj] = *(const u32x4*)(MG + (size_t)row * D + colb + bj * 128); } }
#pragma unroll
            for (int m = 0; m < 4; ++m) { const int row = row0 + ai * 128 + m * 16;
#pragma unroll
                for (int bj = 0; bj < 2; ++bj) { const u32x4 g = gt[m][bj];
                    f32x4 v0 = acc[ai][bj][m][0], v1 = acc[ai][bj][m][1];
                    v0[0] *= bf_lo(g.x); v0[1] *= bf_hi(g.x); v0[2] *= bf_lo(g.y); v0[3] *= bf_hi(g.y);
                    v1[0] *= bf_lo(g.z); v1[1] *= bf_hi(g.z); v1[2] *= bf_lo(g.w); v1[3] *= bf_hi(g.w);
                    if (BR > 0) { const u32x4 o = od[m][bj];
                        v0[0] += bf_lo(o.x); v0[1] += bf_hi(o.x); v0[2] += bf_lo(o.y); v0[3] += bf_hi(o.y);
                        v1[0] += bf_lo(o.z); v1[1] += bf_hi(o.z); v1[2] += bf_lo(o.w); v1[3] += bf_hi(o.w); }
                    u32x4 w; w.x = pk2(v0[0], v0[1]); w.y = pk2(v0[2], v0[3]); w.z = pk2(v1[0], v1[1]); w.w = pk2(v1[2], v1[3]);
                    *(u32x4*)(MG + (size_t)row * D + colb + bj * 128) = w; } }
        }
    }
};

struct EpiMergeSample {
    static constexpr bool PERM = true;
    const bf16_t* U; bf16_t* MG; float* part; unsigned* cnt; LAS unsigned* flag;
    __device__ __forceinline__ void operator()(AccRef acc, const Unit& u, int wr, int wc, int fr, int fq) const {
        const int br = u.pn >> 3, pn8 = u.pn & 7;
        const int row0 = wr * 64 + fr, colb = pn8 * 256 + wc * 32 + 8 * fq;
        float* pb = part + (size_t)br * MS * D;
#pragma unroll
        for (int ai = 0; ai < 2; ++ai)
#pragma unroll
            for (int m = 0; m < 4; ++m) { const int row = row0 + ai * 128 + m * 16;
#pragma unroll
                for (int bj = 0; bj < 2; ++bj) { const u32x4 g = *(const u32x4*)(U + (size_t)(MP + row) * LDU + UC_GATE + br * D + colb + bj * 128);
                    f32x4 v0 = acc[ai][bj][m][0], v1 = acc[ai][bj][m][1];
                    v0[0] *= bf_lo(g.x); v0[1] *= bf_hi(g.x); v0[2] *= bf_lo(g.y); v0[3] *= bf_hi(g.y);
                    v1[0] *= bf_lo(g.z); v1[1] *= bf_hi(g.z); v1[2] *= bf_lo(g.w); v1[3] *= bf_hi(g.w);
                    unsigned long long* o = (unsigned long long*)(pb + (size_t)row * D + colb + bj * 128);
                    __hip_atomic_store(o + 0, ((unsigned long long)__float_as_uint(v0[1]) << 32) | __float_as_uint(v0[0]), __ATOMIC_RELAXED, __HIP_MEMORY_SCOPE_AGENT);
                    __hip_atomic_store(o + 1, ((unsigned long long)__float_as_uint(v0[3]) << 32) | __float_as_uint(v0[2]), __ATOMIC_RELAXED, __HIP_MEMORY_SCOPE_AGENT);
                    __hip_atomic_store(o + 2, ((unsigned long long)__float_as_uint(v1[1]) << 32) | __float_as_uint(v1[0]), __ATOMIC_RELAXED, __HIP_MEMORY_SCOPE_AGENT);
                    __hip_atomic_store(o + 3, ((unsigned long long)__float_as_uint(v1[3]) << 32) | __float_as_uint(v1[2]), __ATOMIC_RELAXED, __HIP_MEMORY_SCOPE_AGENT); } }
        asm volatile("s_waitcnt vmcnt(0)" ::: "memory");
        __builtin_amdgcn_s_barrier();
        const int t = (wr * 4 + wc) * 64 + fq * 16 + fr;
        if (t == 0) { const unsigned old = __hip_atomic_fetch_add(cnt + 64 * pn8, 1u, __ATOMIC_RELAXED, __HIP_MEMORY_SCOPE_AGENT); *flag = (old == 2u) ? 1u : 0u; }
        asm volatile("s_waitcnt vmcnt(0) lgkmcnt(0)" ::: "memory");
        __builtin_amdgcn_s_barrier();
        asm volatile("" ::: "memory");
        if (*flag != 0u) {
            __builtin_amdgcn_fence(__ATOMIC_ACQUIRE, "agent");
            asm volatile("s_waitcnt vmcnt(0)" ::: "memory");
#pragma unroll 2
            for (int k = 0; k < 16; ++k) { const int e = (k * 512 + t) * 8, r = e >> 8, c = e & 255;
                const float* src = part + (size_t)r * D + pn8 * 256 + c;
                f32x4 a = *(const f32x4*)src, b = *(const f32x4*)(src + 4);
                a = a + *(const f32x4*)(src + (size_t)MS * D) + *(const f32x4*)(src + (size_t)2 * MS * D);
                b = b + *(const f32x4*)(src + (size_t)MS * D + 4) + *(const f32x4*)(src + (size_t)2 * MS * D + 4);
                u32x4 w; w.x = pk2(a[0], a[1]); w.y = pk2(a[2], a[3]); w.z = pk2(b[0], b[1]); w.w = pk2(b[2], b[3]);
                *(u32x4*)(MG + (size_t)(MP + r) * D + pn8 * 256 + c) = w; }
        }
    }
};

struct Frame {
    LAS unsigned char* lds;
    int tid, lane, wave, vcu, G, bx;
    int gw, NGW;
};
__device__ __forceinline__ int lane_now() { unsigned z = 0u; asm volatile("" : "+s"(z)); return (int)__builtin_amdgcn_mbcnt_hi(~0u, __builtin_amdgcn_mbcnt_lo(~0u, z)); }
__device__ __forceinline__ Frame mk_frame(int wave_s) {
    extern __shared__ __attribute__((aligned(16))) unsigned char lds_raw[];
    Frame F; F.lds = (LAS unsigned char*)lds_raw;
    asm volatile("" : "+s"(wave_s)); const int t = wave_s * 64 + lane_now();
    int bx = blockIdx.x, G = gridDim.x; asm volatile("" : "+s"(bx), "+s"(G));
    F.tid = t; F.lane = t & 63; F.wave = __builtin_amdgcn_readfirstlane(t >> 6);
    F.G = G; F.bx = bx; F.vcu = (G % 8 == 0) ? (bx % 8) * (G / 8) + bx / 8 : bx;
    F.gw = F.vcu * 8 + F.wave; F.NGW = G * 8;
    return F;
}

template <int KIND> __device__ __forceinline__ int map_row(int n, float& sc) {
    sc = 1.f;
    if (KIND == 0) return n;
    if (KIND == 1) return 256 * (n >> 7) + (n & 127);
    if (KIND == 2) return 256 * (n >> 7) + 128 + (n & 127);
    if (KIND == 3) {
        if (n < 1024) return n;
        if (n < 1088) return 12800 + (n - 1024);
        if (n < 2112) return UC_Z + (n - 1088);
        if (n < 3648) return UC_XBC + (n - 2112);
        if (n < 3664) return 12864 + (n - 3648);
        if (n < 4688) { sc = FOX_QSCALE; return UC_FQ + (n - 3664); }
        if (n < 5712) return UC_FK + (n - 4688);
        if (n < 6736) return UC_FV + (n - 5712);
        if (n < 6744) return 12880 + (n - 6736);
        return UC_GATE + (n - 6744);
    }
    if (KIND == 4) {
        sc = MLA_QSCALE; const int h = n / 192, r = n % 192;
        if (r < 128) return n;
        const int rr = r - 128; return h * 192 + 128 + 2 * (rr & 31) + (rr >> 5);
    }
    return n;
}
template <int KIND>
__device__ __forceinline__ void cvt_item(const float* W, int N, bf16_t* WT, size_t ldo, size_t coloff, LAS float* scr, int item, int lane, size_t kblk = 0) {
    const int nblk = (N + 31) / 32, kb = item / nblk, nb = item % nblk, k0 = 64 * kb, n0 = 32 * nb;
    const int nn = n0 + (lane & 31); const bool ok = nn < N;
#pragma unroll
    for (int i = 0; i < 32; ++i) { const int kk = 2 * i + (lane >> 5); scr[kk * 33 + (lane & 31)] = ok ? W[(size_t)(k0 + kk) * N + nn] : 0.f; }
    LDS_WAIT(); asm volatile("" ::: "memory");
    const int c = lane & 7;
#pragma unroll
    for (int j = 0; j < 4; ++j) { const int n = (lane >> 3) + 8 * j;
        if (n0 + n < N) { float sc; const int dr = map_row<KIND>(n0 + n, sc); const LAS float* s = scr + (8 * c) * 33 + n;
            u32x4 o; o.x = pk2(s[0 * 33] * sc, s[1 * 33] * sc); o.y = pk2(s[2 * 33] * sc, s[3 * 33] * sc); o.z = pk2(s[4 * 33] * sc, s[5 * 33] * sc); o.w = pk2(s[6 * 33] * sc, s[7 * 33] * sc);
            *(u32x4*)(kblk ? WT + (size_t)kb * kblk + (size_t)dr * 64 + 8 * c : WT + (size_t)dr * ldo + coloff + k0 + 8 * c) = o; } }
    LDS_WAIT(); asm volatile("" ::: "memory");
}

__device__ __forceinline__ void phase_convert(const Params&, const Frame& F0, int layer0) {
    const Frame F = mk_frame(F0.wave);
    const PV p = pv_get(); int layer = layer0; asm volatile("" : "+s"(layer));
    LAS float* scr = (LAS float*)(F.lds + F.wave * 16384);
    unsigned z0_ = 0u; asm volatile("" : "+v"(z0_)); const u32x4 Z4 = {z0_, z0_, z0_, z0_};
    bf16_t* W = (bf16_t*)(p.ws() + WS_W);
    const size_t lFF = (size_t)layer * D * FF;
    constexpr int IT_FF = (D / 64) * (FF / 32), IT_DN = (FF / 64) * (D / 32), IT_IN = (D / 64) * ((IN_COLS + 31) / 32), IT_UQ = 8 * 48, IT_UKV = 8 * 64, IT_BR = 16 * 64, IT_OUT = 32 * 64;
    constexpr int IT_FV = NB * 16 * 32;
    constexpr int NITEMS = 6 * IT_FF + IT_IN + IT_UQ + IT_UKV + 3 * IT_BR + IT_OUT + IT_FV;
    static_assert(IT_FF == IT_DN, "items");
    for (int it = F.gw; it < NITEMS; it += F.NGW) {
        int r = it;
        if (r < IT_FF) { cvt_item<1>(p.in(I_F1G) + lFF, FF, W + W_GU1, D, 0, scr, r, F.lane, (size_t)2 * FF * 64); continue; } r -= IT_FF;
        if (r < IT_FF) { cvt_item<2>(p.in(I_F1U) + lFF, FF, W + W_GU1, D, 0, scr, r, F.lane, (size_t)2 * FF * 64); continue; } r -= IT_FF;
        if (r < IT_DN) { cvt_item<0>(p.in(I_F1D) + lFF, D, W + W_D1, FF, 0, scr, r, F.lane, (size_t)D * 64); continue; } r -= IT_DN;
        if (r < IT_FF) { cvt_item<1>(p.in(I_F2G) + lFF, FF, W + W_GU2, D, 0, scr, r, F.lane, (size_t)2 * FF * 64); continue; } r -= IT_FF;
        if (r < IT_FF) { cvt_item<2>(p.in(I_F2U) + lFF, FF, W + W_GU2, D, 0, scr, r, F.lane, (size_t)2 * FF * 64); continue; } r -= IT_FF;
        if (r < IT_DN) { cvt_item<0>(p.in(I_F2D) + lFF, D, W + W_D2, FF, 0, scr, r, F.lane, (size_t)D * 64); continue; } r -= IT_DN;
        if (r < IT_IN) { cvt_item<3>(p.in(I_WIN) + (size_t)layer * D * IN_COLS, IN_COLS, W + W_IN, D, 0, scr, r, F.lane, (size_t)NWIN * 64); continue; } r -= IT_IN;
        if (r < IT_UQ) { cvt_item<4>(p.in(I_WUQ) + (size_t)layer * 512 * 1536, 1536, W + W_UQ, 512, 0, scr, r, F.lane); continue; } r -= IT_UQ;
        if (r < IT_UKV) { cvt_item<0>(p.in(I_WUKV) + (size_t)layer * 512 * 2048, 2048, W + W_UKV, 512, 0, scr, r, F.lane); continue; } r -= IT_UKV;
        if (r < IT_BR) { cvt_item<0>(p.in(I_BRM) + (size_t)layer * 1024 * D, D, W + W_BR, 1024, 0, scr, r, F.lane); continue; } r -= IT_BR;
        if (r < IT_BR) { cvt_item<0>(p.in(I_BRS) + (size_t)layer * 1024 * D, D, W + W_BR + (size_t)D * 1024, 1024, 0, scr, r, F.lane); continue; } r -= IT_BR;
        if (r < IT_BR) { cvt_item<0>(p.in(I_BRF) + (size_t)layer * 1024 * D, D, W + W_BR + (size_t)2 * D * 1024, 1024, 0, scr, r, F.lane); continue; } r -= IT_BR;
        if (r < IT_OUT) { cvt_item<0>(p.in(I_WOUT) + (size_t)layer * D * D, D, W + W_OUT, D, 0, scr, r, F.lane); continue; } r -= IT_OUT;
        { const int b = r / 512, ri = r % 512;
          cvt_item<0>(p.in(I_CFV) + ((size_t)layer * NB + b) * PAST * 1024, 1024, (bf16_t*)(p.ws() + WS_VTF), KVROWS, (size_t)MP + (size_t)b * KVS, scr, ri, F.lane); }
    }
    const size_t gt = (size_t)F.gw * 64 + F.lane, NT = (size_t)F.NGW * 64;
    {
        constexpr int PADE = (NWIN - IN_COLS) * 64 / 8;
        for (size_t i = gt; i < (size_t)PADE * (D / 64); i += NT) { const int kb = (int)(i / PADE), rem = (int)(i % PADE);
            *(u32x4*)(W + W_IN + (size_t)kb * ((size_t)NWIN * 64) + (size_t)IN_COLS * 64 + (size_t)rem * 8) = Z4; }
    }
    {
        const float* src = p.in(I_CCKV) + (size_t)layer * NB * PAST * 512; bf16_t* dst = (bf16_t*)(p.ws() + WS_CKV);
        for (size_t i = gt; i < (size_t)NB * PAST * 512 / 8; i += NT) { const size_t e = i * 8; const int b = (int)(e / (PAST * 512)), rem = (int)(e % (PAST * 512));
            const f32x4 a = *(const f32x4*)(src + e), c = *(const f32x4*)(src + e + 4);
            u32x4 w; w.x = pk2(a[0], a[1]); w.y = pk2(a[2], a[3]); w.z = pk2(c[0], c[1]); w.w = pk2(c[2], c[3]);
            *(u32x4*)(dst + ((size_t)MP + (size_t)b * KVS) * 512 + rem) = w; }
        for (size_t i = gt; i < (size_t)NB * (KVS - KVLEN_S) * 512 / 8; i += NT) { const size_t e = i * 8; const int b = (int)(e / ((KVS - KVLEN_S) * 512)), rem = (int)(e % ((KVS - KVLEN_S) * 512));
            *(u32x4*)(dst + ((size_t)MP + (size_t)b * KVS + KVLEN_S) * 512 + rem) = Z4; }
    }
    {
        const float* src = p.in(I_CFK) + (size_t)layer * NB * PAST * 1024; bf16_t* dst = (bf16_t*)(p.ws() + WS_KFS);
        for (size_t i = gt; i < (size_t)NB * PAST * 1024 / 8; i += NT) { const size_t e = i * 8; const int b = (int)(e / (PAST * 1024)), rem = (int)(e % (PAST * 1024));
            const f32x4 a = *(const f32x4*)(src + e), c = *(const f32x4*)(src + e + 4);
            u32x4 w; w.x = pk2(a[0], a[1]); w.y = pk2(a[2], a[3]); w.z = pk2(c[0], c[1]); w.w = pk2(c[2], c[3]);
            *(u32x4*)(dst + (size_t)b * KVS * 1024 + rem) = w; }
        for (size_t i = gt; i < (size_t)NB * (KVS - KVLEN_S) * 1024 / 8; i += NT) { const size_t e = i * 8; const int b = (int)(e / ((KVS - KVLEN_S) * 1024)), rem = (int)(e % ((KVS - KVLEN_S) * 1024));
            *(u32x4*)(dst + ((size_t)b * KVS + KVLEN_S) * 1024 + rem) = Z4; }
    }
    {
        const float* src = p.in(I_CKPE) + (size_t)layer * NB * PAST * 64; bf16_t* km = (bf16_t*)(p.ws() + WS_KM);
        for (size_t i = gt; i < (size_t)NB * KVS * 32; i += NT) { const int j = (int)(i & 31); const int pr = (int)(i >> 5) % KVS, b = (int)(i >> 5) / KVS;
            unsigned w = 0u;
            if (pr < PAST) { const float* s = src + ((size_t)b * PAST + pr) * 64; w = pk2(s[j], s[32 + j]); }
            if (pr < PAST || pr >= KVLEN_S) { const size_t kr = (size_t)MP + (size_t)b * KVS + pr;
#pragma unroll
                for (int h = 0; h < 8; ++h) *(unsigned*)(km + (kr * 8 + h) * 192 + 128 + 2 * j) = w; } }
        const float* ls = p.in(I_CLOGF) + (size_t)layer * NB * PAST * 8; float* ld = (float*)(p.ws() + WS_LOGF);
        for (size_t i = gt; i < (size_t)NB * KVS * 8; i += NT) { const int hh = (int)(i & 7); const int pr = (int)(i >> 3) % KVS, b = (int)(i >> 3) / KVS;
            if (pr < PAST) ld[((size_t)MP + (size_t)b * KVS + pr) * 8 + hh] = ls[((size_t)b * PAST + pr) * 8 + hh];
            else if (pr >= KVLEN_S) ld[((size_t)MP + (size_t)b * KVS + pr) * 8 + hh] = 0.f; }
        bf16_t* vtf = (bf16_t*)(p.ws() + WS_VTF);
        for (size_t i = gt; i < (size_t)1024 * NB * (KVS - KVLEN_S); i += NT) { const int pc = (int)(i % (KVS - KVLEN_S)); const int b = (int)(i / (KVS - KVLEN_S)) % NB, ch = (int)(i / (KVS - KVLEN_S)) / NB;
            vtf[(size_t)ch * KVROWS + MP + (size_t)b * KVS + KVLEN_S + pc] = 0; }
    }
}

__device__ __forceinline__ void phase_rope_table(const Frame& F0) {
    const Frame F = mk_frame(F0.wave);
    const PV p = pv_get();
    const size_t gt = (size_t)F.gw * 64 + F.lane, NT = (size_t)F.NGW * 64;
    f32x2* rt = (f32x2*)(p.ws() + WS_ROPE);
    for (size_t i = gt; i < (size_t)SEQ * 32; i += NT) { const int j = (int)(i & 31), ps = (int)(i >> 5);
        const float inv = powf(10000.0f, -(float)j / 32.0f); const float ang = (float)ps * inv;
        float sn, cs; sincosf(ang, &sn, &cs); rt[i] = (f32x2){cs, sn}; }
}
__device__ __forceinline__ void phase_norm(const Frame& F, const float* xp, const bf16_t* xb, const float* xs, const float* gain, bf16_t* XN, float* copy_s, const float* part) {
    f32x4 g[8];
#pragma unroll
    for (int j = 0; j < 8; ++j) g[j] = *(const f32x4*)(gain + 4 * F.lane + 256 * j);
    for (int m = F.gw; m < MT; m += F.NGW) {
        f32x4 v[8]; float s = 0.f;
        if (m < MP && !xp) { const bf16_t* xr = xb + (size_t)m * D + 4 * F.lane;
#pragma unroll
            for (int j = 0; j < 8; ++j) { const u32x2 w = *(const u32x2*)(xr + 256 * j); v[j] = (f32x4){bf_lo(w.x), bf_hi(w.x), bf_lo(w.y), bf_hi(w.y)}; }
        } else { const float* xr = (m < MP) ? xp + (size_t)m * D : xs + (size_t)(m - MP) * D;
#pragma unroll
            for (int j = 0; j < 8; ++j) v[j] = *(const f32x4*)(xr + 4 * F.lane + 256 * j); }
#pragma unroll
        for (int j = 0; j < 8; ++j) s += (v[j][0] * v[j][0] + v[j][1] * v[j][1]) + (v[j][2] * v[j][2] + v[j][3] * v[j][3]);
        if (m >= MP && (copy_s || part)) {
            if (part) { s = 0.f;
#pragma unroll
                for (int sp = 0; sp < 8; ++sp)
#pragma unroll
                    for (int j = 0; j < 8; ++j) v[j] += *(const f32x4*)(part + ((size_t)sp * MS + (m - MP)) * D + 4 * F.lane + 256 * j);
#pragma unroll
                for (int j = 0; j < 8; ++j) s += (v[j][0] * v[j][0] + v[j][1] * v[j][1]) + (v[j][2] * v[j][2] + v[j][3] * v[j][3]); }
            float* xo = (copy_s ? copy_s : const_cast<float*>(xs)) + (size_t)(m - MP) * D;
#pragma unroll
            for (int j = 0; j < 8; ++j) *(f32x4*)(xo + 4 * F.lane + 256 * j) = v[j]; }
        const float rs = fast_rsqrt(wave_sum(s, F.lane) * (1.0f / D) + EPS);
        bf16_t* o = XN + (size_t)(F.lane >> 4) * ((size_t)MT * 64) + (size_t)m * 64 + 4 * (F.lane & 15);
#pragma unroll
        for (int j = 0; j < 8; ++j) { u32x2 w; w.x = pk2(v[j][0] * rs * g[j][0], v[j][1] * rs * g[j][1]); w.y = pk2(v[j][2] * rs * g[j][2], v[j][3] * rs * g[j][3]); *(u32x2*)(o + (size_t)(4 * j) * ((size_t)MT * 64)) = w; }
    }
}
__device__ __forceinline__ void phase_final_norm(const Frame& F, float* x, const bf16_t* xb, const float* gain, const float* part) {
    f32x4 g[8];
#pragma unroll
    for (int j = 0; j < 8; ++j) g[j] = *(const f32x4*)(gain + 4 * F.lane + 256 * j);
    for (int m = F.gw; m < MT; m += F.NGW) {
        float* xr = x + (size_t)m * D;
        f32x4 v[8]; float s = 0.f;
        if (m < MP) { const bf16_t* xq = xb + (size_t)m * D + 4 * F.lane;
#pragma unroll
            for (int j = 0; j < 8; ++j) { const u32x2 w = *(const u32x2*)(xq + 256 * j); v[j] = (f32x4){bf_lo(w.x), bf_hi(w.x), bf_lo(w.y), bf_hi(w.y)}; }
        } else {
#pragma unroll
            for (int j = 0; j < 8; ++j) v[j] = *(const f32x4*)(xr + 4 * F.lane + 256 * j); }
        if (m >= MP) {
#pragma unroll
            for (int sp = 0; sp < 8; ++sp)
#pragma unroll
                for (int j = 0; j < 8; ++j) v[j] += *(const f32x4*)(part + ((size_t)sp * MS + (m - MP)) * D + 4 * F.lane + 256 * j); }
#pragma unroll
        for (int j = 0; j < 8; ++j) s += (v[j][0] * v[j][0] + v[j][1] * v[j][1]) + (v[j][2] * v[j][2] + v[j][3] * v[j][3]);
        const float rs = fast_rsqrt(wave_sum(s, F.lane) * (1.0f / D) + EPS);
#pragma unroll
        for (int j = 0; j < 8; ++j) *(f32x4*)(xr + 4 * F.lane + 256 * j) = v[j] * rs * g[j];
    }
}
__device__ __forceinline__ float softplusf_(float x) {
    if (x > 20.f) return x; const float y = fast_exp(x); return y < 0.03125f ? y * (1.0f + y * (-0.5f + y * (0.33333333f - 0.25f * y))) : fast_log(1.0f + y); }
__device__ __forceinline__ void unpack8(const u32x4 w, float (&v)[8]) {
    v[0] = bf_lo(w.x); v[1] = bf_hi(w.x); v[2] = bf_lo(w.y); v[3] = bf_hi(w.y); v[4] = bf_lo(w.z); v[5] = bf_hi(w.z); v[6] = bf_lo(w.w); v[7] = bf_hi(w.w);
}
__device__ __forceinline__ void phase_t1(const Params&, const Frame& F0, int layer0) {
    const Frame F = mk_frame(F0.wave);
    const PV p = pv_get(); int layer = layer0; asm volatile("" : "+s"(layer));
    bf16_t* U = (bf16_t*)(p.ws() + WS_U); const float* US = (const float*)(p.ws() + WS_US);
    bf16_t* CKV = (bf16_t*)(p.ws() + WS_CKV); bf16_t* KM = (bf16_t*)(p.ws() + WS_KM); bf16_t* KFS = (bf16_t*)(p.ws() + WS_KFS); bf16_t* VTF = (bf16_t*)(p.ws() + WS_VTF);
    float* LOGF = (float*)(p.ws() + WS_LOGF); float* DTB = (float*)(p.ws() + WS_DT); const f32x2* rope = (const f32x2*)(p.ws() + WS_ROPE);
    unsigned* ctl = (unsigned*)(p.ws() + WS_CTL);
    float* o_pckv = p.out() + O_PCKV + (size_t)layer * MP * 512; float* o_sckv = p.out() + O_SCKV + (size_t)layer * MS * 512;
    float* o_pkpe = p.out() + O_PKPE + (size_t)layer * MP * 64; float* o_skpe = p.out() + O_SKPE + (size_t)layer * MS * 64;
    float* o_plf = p.out() + O_PLOGF + (size_t)layer * MP * 8; float* o_slf = p.out() + O_SLOGF + (size_t)layer * MS * 8;
    float* o_pconv = p.out() + O_PCONV + (size_t)layer * 3 * 1536; float* o_sconv = p.out() + O_SCONV + (size_t)layer * NB * 3 * 1536;
    float qg[8], kg[8];
#pragma unroll
    for (int j = 0; j < 8; ++j) { qg[j] = p.in(I_QN)[layer * 512 + 8 * F.lane + j]; kg[j] = p.in(I_KVN)[layer * 512 + 8 * F.lane + j]; }
    const float fb = (F.lane < 8) ? p.in(I_FBF)[layer * 8 + F.lane] : 0.f;
    const float db = (F.lane < 16) ? p.in(I_DTB)[layer * 16 + F.lane] : 0.f;
    for (int m = F.gw; m < MT; m += F.NGW) {
        const int kr = kvrow_of(m), ps = pos_of(m); const bool smp = m >= MP; const int mi = m - MP;
        bf16_t* ur = U + (size_t)m * LDU;
        const float* us = US + (size_t)m * LDUS;
        const u32x4 wq = *(const u32x4*)(ur + UC_QLAT + 8 * F.lane), wc = *(const u32x4*)(ur + UC_CKV + 8 * F.lane);
        const u32x4 fq0 = *(const u32x4*)(ur + UC_FQ + 16 * F.lane), fq1 = *(const u32x4*)(ur + UC_FQ + 16 * F.lane + 8);
        const u32x4 fk0 = *(const u32x4*)(ur + UC_FK + 16 * F.lane), fk1 = *(const u32x4*)(ur + UC_FK + 16 * F.lane + 8);
        float x1 = 0.f, x2 = 0.f; f32x2 cs = {0.f, 0.f};
        if (F.lane < 32) { x1 = us[US_KPE + F.lane]; x2 = us[US_KPE + 32 + F.lane]; cs = rope[(size_t)ps * 32 + F.lane]; }
        const float uff = (F.lane < 8) ? us[US_FF + F.lane] : 0.f, udt = (F.lane < 16) ? us[US_DT + F.lane] : 0.f;
        float vq[8], vc[8]; unpack8(wq, vq); unpack8(wc, vc);
        float sq_ = 0.f, sc_ = 0.f;
#pragma unroll
        for (int j = 0; j < 8; ++j) { sq_ += vq[j] * vq[j]; sc_ += vc[j] * vc[j]; }
        float nq = 0.f, nk = 0.f;
        { float a8[8], b8[8]; unpack8(fq0, a8); unpack8(fq1, b8);
#pragma unroll
          for (int j = 0; j < 8; ++j) nq += a8[j] * a8[j] + b8[j] * b8[j];
          unpack8(fk0, a8); unpack8(fk1, b8);
#pragma unroll
          for (int j = 0; j < 8; ++j) nk += a8[j] * a8[j] + b8[j] * b8[j]; }
#pragma unroll
        for (int o = 1; o < 64; o <<= 1) { const float t0 = shx(sq_, o, F.lane), t1 = shx(sc_, o, F.lane); sq_ += t0; sc_ += t1;
            if (o < 8) { const float t2 = shx(nq, o, F.lane), t3 = shx(nk, o, F.lane); nq += t2; nk += t3; } }
        {
            const float rs = fast_rsqrt(sq_ * (1.0f / 512) + EPS);
            u32x4 w; w.x = pk2(vq[0] * rs * qg[0], vq[1] * rs * qg[1]); w.y = pk2(vq[2] * rs * qg[2], vq[3] * rs * qg[3]); w.z = pk2(vq[4] * rs * qg[4], vq[5] * rs * qg[5]); w.w = pk2(vq[6] * rs * qg[6], vq[7] * rs * qg[7]);
            *(u32x4*)(ur + UC_QLAT + 8 * F.lane) = w;
        }
        {
            const float rs = fast_rsqrt(sc_ * (1.0f / 512) + EPS);
#pragma unroll
            for (int j = 0; j < 8; ++j) vc[j] = vc[j] * rs * kg[j];
            float* o = (smp ? o_sckv + (size_t)mi * 512 : o_pckv + (size_t)m * 512) + 8 * F.lane;
            *(f32x4*)o = (f32x4){vc[0], vc[1], vc[2], vc[3]}; *(f32x4*)(o + 4) = (f32x4){vc[4], vc[5], vc[6], vc[7]};
            u32x4 w; w.x = pk2(vc[0], vc[1]); w.y = pk2(vc[2], vc[3]); w.z = pk2(vc[4], vc[5]); w.w = pk2(vc[6], vc[7]);
            *(u32x4*)(CKV + (size_t)kr * 512 + 8 * F.lane) = w;
        }
        if (F.lane < 32) {
            const float o1 = x1 * cs.x - x2 * cs.y, o2 = x2 * cs.x + x1 * cs.y;
            float* o = smp ? o_skpe + (size_t)mi * 64 : o_pkpe + (size_t)m * 64; o[F.lane] = o1; o[32 + F.lane] = o2;
            const unsigned w = pk2(o1, o2);
#pragma unroll
            for (int h = 0; h < 8; ++h) *(unsigned*)(KM + ((size_t)kr * 8 + h) * 192 + 128 + 2 * F.lane) = w;
        }
        if (F.lane < 8) {
            const float lf = -softplusf_(-(uff + fb));
            (smp ? o_slf + (size_t)mi * 8 : o_plf + (size_t)m * 8)[F.lane] = lf; LOGF[(size_t)kr * 8 + F.lane] = lf;
        }
        if (F.lane < 16) DTB[(size_t)m * 16 + F.lane] = softplusf_(udt + db);
        if (!smp) {
            if ((F.lane & 7) == 0) { const int hh = F.lane >> 3;
                atomicMax(ctl + CW_QN2 + (layer * 64 + (m >> 8)) * 8 + hh, __float_as_uint(nq));
                atomicMax(ctl + CW_KN2 + (layer * 64 + (m >> 8)) * 8 + hh, __float_as_uint(nk)); }
        } else {
            bf16_t* kd = KFS + (size_t)(kr - MP) * 1024 + 16 * F.lane; *(u32x4*)kd = fk0; *(u32x4*)(kd + 8) = fk1;
        }
        {
            int slot = -1; float* od = nullptr;
            if (!smp) { if (m >= MP - 3) { slot = m - (MP - 3); od = o_pconv; } }
            else { const int t = mi & 15; if (t >= 13) { slot = t - 13; od = o_sconv + (size_t)(mi >> 4) * 3 * 1536; } }
            if (slot >= 0) { for (int c = F.lane; c < 1536; c += 64) od[slot * 1536 + c] = bf2f(ur[UC_XBC + c]); }
        }
    }
    {
        bf16_t* XC = (bf16_t*)(p.ws() + WS_XN);
        const float* cw = p.in(I_CW) + (size_t)layer * 4 * 1536; const float* cb = p.in(I_CB) + (size_t)layer * 1536; const float* cst = p.in(I_CONV) + (size_t)layer * NB * 3 * 1536;
        const size_t gt = (size_t)F.gw * 64 + F.lane, NT = (size_t)F.NGW * 64;
        constexpr int STRIP = 25, NSTRIP = (MP + STRIP - 1) / STRIP;
        for (size_t it = gt; it < (size_t)NSTRIP * 192; it += NT) { const int strip = (int)(it / 192), ch0 = (int)(it % 192) * 8; const int r0 = strip * STRIP;
            float wt[4][8], bs[8];
            { const f32x4 b0 = *(const f32x4*)(cb + ch0), b1 = *(const f32x4*)(cb + ch0 + 4); bs[0] = b0[0]; bs[1] = b0[1]; bs[2] = b0[2]; bs[3] = b0[3]; bs[4] = b1[0]; bs[5] = b1[1]; bs[6] = b1[2]; bs[7] = b1[3]; }
#pragma unroll
            for (int k = 0; k < 4; ++k) { const f32x4 w0 = *(const f32x4*)(cw + k * 1536 + ch0), w1 = *(const f32x4*)(cw + k * 1536 + ch0 + 4);
                wt[k][0] = w0[0]; wt[k][1] = w0[1]; wt[k][2] = w0[2]; wt[k][3] = w0[3]; wt[k][4] = w1[0]; wt[k][5] = w1[1]; wt[k][6] = w1[2]; wt[k][7] = w1[3]; }
            const bf16_t* up = U + UC_XBC + ch0;
            u32x4 win[3];
#pragma unroll
            for (int k = 0; k < 3; ++k) { const int rr = r0 - 3 + k; u32x4 z = {0u, 0u, 0u, 0u}; if (rr >= 0) z = *(const u32x4*)(up + (size_t)rr * LDU); win[k] = z; }
#pragma unroll 1
            for (int rb = 0; rb < STRIP; rb += 5) {
                u32x4 nw[5];
#pragma unroll
                for (int e = 0; e < 5; ++e) { const int rr = r0 + rb + e; nw[e] = (rr < MP) ? *(const u32x4*)(up + (size_t)rr * LDU) : (u32x4){0u, 0u, 0u, 0u}; }
#pragma unroll
                for (int e = 0; e < 5; ++e) { const int rr = r0 + rb + e;
                    float x0[8], x1[8], x2[8], x3[8]; unpack8(win[0], x0); unpack8(win[1], x1); unpack8(win[2], x2); unpack8(nw[e], x3);
                    float acc[8];
#pragma unroll
                    for (int j = 0; j < 8; ++j) acc[j] = bs[j] + wt[0][j] * x0[j] + wt[1][j] * x1[j] + wt[2][j] * x2[j] + wt[3][j] * x3[j];
                    u32x4 o; o.x = pk2(siluf_(acc[0]), siluf_(acc[1])); o.y = pk2(siluf_(acc[2]), siluf_(acc[3])); o.z = pk2(siluf_(acc[4]), siluf_(acc[5])); o.w = pk2(siluf_(acc[6]), siluf_(acc[7]));
                    if (rr < MP) *(u32x4*)(XC + (size_t)rr * 1536 + ch0) = o;
                    win[0] = win[1]; win[1] = win[2]; win[2] = nw[e]; }
            }
        }
        for (size_t i = gt; i < (size_t)MS * 192; i += NT) { const int m = MP + (int)(i / 192), ch0 = (int)(i % 192) * 8;
            const int t = (m - MP) & 15;
            float acc[8];
            { const f32x4 b0 = *(const f32x4*)(cb + ch0), b1 = *(const f32x4*)(cb + ch0 + 4); acc[0] = b0[0]; acc[1] = b0[1]; acc[2] = b0[2]; acc[3] = b0[3]; acc[4] = b1[0]; acc[5] = b1[1]; acc[6] = b1[2]; acc[7] = b1[3]; }
#pragma unroll
            for (int k = 0; k < 4; ++k) { const int ii = t - 3 + k; float xv[8];
                if (ii >= 0) unpack8(*(const u32x4*)(U + (size_t)(m - 3 + k) * LDU + UC_XBC + ch0), xv);
                else { const float* sp = cst + ((size_t)((m - MP) >> 4) * 3 + (ii + 3)) * 1536 + ch0; const f32x4 s0 = *(const f32x4*)sp, s1 = *(const f32x4*)(sp + 4);
                    xv[0] = s0[0]; xv[1] = s0[1]; xv[2] = s0[2]; xv[3] = s0[3]; xv[4] = s1[0]; xv[5] = s1[1]; xv[6] = s1[2]; xv[7] = s1[3]; }
                const f32x4 w0 = *(const f32x4*)(cw + k * 1536 + ch0), w1 = *(const f32x4*)(cw + k * 1536 + ch0 + 4);
                acc[0] += w0[0] * xv[0]; acc[1] += w0[1] * xv[1]; acc[2] += w0[2] * xv[2]; acc[3] += w0[3] * xv[3];
                acc[4] += w1[0] * xv[4]; acc[5] += w1[1] * xv[5]; acc[6] += w1[2] * xv[6]; acc[7] += w1[3] * xv[7]; }
            u32x4 o; o.x = pk2(siluf_(acc[0]), siluf_(acc[1])); o.y = pk2(siluf_(acc[2]), siluf_(acc[3])); o.z = pk2(siluf_(acc[4]), siluf_(acc[5])); o.w = pk2(siluf_(acc[6]), siluf_(acc[7]));
            *(u32x4*)(XC + (size_t)m * 1536 + ch0) = o; }
    }
    {
        constexpr int PITCH = 72;
        LAS bf16_t* tile = (LAS bf16_t*)(F.lds + F.wave * (64 * PITCH * 2));
        for (int it = F.gw; it < (MP / 64) * 16; it += F.NGW) {
            const int rt = it >> 4, ct = it & 15, row0 = rt * 64, ch0 = ct * 64;
            u32x4 v[8];
#pragma unroll
            for (int k = 0; k < 8; ++k) { const int r = 8 * k + (F.lane >> 3), c8 = F.lane & 7; v[k] = *(const u32x4*)(U + (size_t)(row0 + r) * LDU + UC_FV + ch0 + 8 * c8); }
#pragma unroll
            for (int k = 0; k < 8; ++k) { const int r = 8 * k + (F.lane >> 3), c8 = F.lane & 7; bf16_t e8[8]; *(u32x4*)e8 = v[k];
#pragma unroll
                for (int e = 0; e < 8; ++e) tile[(8 * c8 + e) * PITCH + r] = e8[e]; }
            LDS_WAIT(); asm volatile("" ::: "memory");
#pragma unroll
            for (int k = 0; k < 8; ++k) { const int ch = 8 * k + (F.lane >> 3), r8 = F.lane & 7; const u32x4 w = *(const LAS u32x4*)(tile + ch * PITCH + 8 * r8);
                *(u32x4*)(VTF + (size_t)(ch0 + ch) * KVROWS + row0 + 8 * r8) = w; }
            LDS_WAIT(); asm volatile("" ::: "memory");
        }
        const size_t gt = (size_t)F.gw * 64 + F.lane, NT = (size_t)F.NGW * 64;
        for (size_t i = gt; i < (size_t)MS * 1024; i += NT) { const int mi = (int)(i >> 10), ch = (int)(i & 1023);
            VTF[(size_t)ch * KVROWS + kvrow_of(MP + mi)] = U[(size_t)(MP + mi) * LDU + UC_FV + ch]; }
    }
}

__device__ __forceinline__ void phase_t2(const Params&, const Frame& F0) {
    const Frame F = mk_frame(F0.wave);
    const PV p = pv_get();
    const float* LOGF = (const float*)(p.ws() + WS_LOGF); float* CUM = (float*)(p.ws() + WS_CUM);
    LAS double* wt = (LAS double*)F.lds;
    for (int job = (F.G == 256) ? (F.bx + 56) % 256 : F.bx; job < 1 + NB; job += F.G) {
        const int base = job == 0 ? 0 : MP + (job - 1) * KVS, n = job == 0 ? MP : KVS;
        const int per = (n + 511) / 512, i0 = F.tid * per, i1 = (i0 + per < n) ? i0 + per : n;
        double s[8];
#pragma unroll
        for (int h = 0; h < 8; ++h) s[h] = 0.0;
        for (int i = i0; i < i1; ++i) { const f32x4 a = *(const f32x4*)(LOGF + (size_t)(base + i) * 8), b = *(const f32x4*)(LOGF + (size_t)(base + i) * 8 + 4);
            s[0] += a[0]; s[1] += a[1]; s[2] += a[2]; s[3] += a[3]; s[4] += b[0]; s[5] += b[1]; s[6] += b[2]; s[7] += b[3]; }
        double pre[8];
#pragma unroll
        for (int h = 0; h < 8; ++h) { double v = s[h];
#pragma unroll
            for (int o = 1; o < 64; o <<= 1) { const long long vb = __builtin_bit_cast(long long, v); const int src = ((F.lane - o) & 63) << 2;
                const unsigned lo_ = (unsigned)__builtin_amdgcn_ds_bpermute(src, (int)(unsigned)vb), hi_ = (unsigned)__builtin_amdgcn_ds_bpermute(src, (int)(unsigned)(vb >> 32));
                const double t = __builtin_bit_cast(double, ((unsigned long long)hi_ << 32) | lo_); if (F.lane >= o) v += t; }
            pre[h] = v - s[h]; if (F.lane == 63) wt[F.wave * 8 + h] = v; }
        __syncthreads();
#pragma unroll
        for (int h = 0; h < 8; ++h) { double off = 0.0; for (int ww = 0; ww < F.wave; ++ww) off += wt[ww * 8 + h]; pre[h] += off; }
        for (int i = i0; i < i1; ++i) { const f32x4 a = *(const f32x4*)(LOGF + (size_t)(base + i) * 8), b = *(const f32x4*)(LOGF + (size_t)(base + i) * 8 + 4);
            pre[0] += a[0]; pre[1] += a[1]; pre[2] += a[2]; pre[3] += a[3]; pre[4] += b[0]; pre[5] += b[1]; pre[6] += b[2]; pre[7] += b[3];
            *(f32x4*)(CUM + (size_t)(base + i) * 8) = (f32x4){(float)pre[0] * LOG2E, (float)pre[1] * LOG2E, (float)pre[2] * LOG2E, (float)pre[3] * LOG2E};
            *(f32x4*)(CUM + (size_t)(base + i) * 8 + 4) = (f32x4){(float)pre[4] * LOG2E, (float)pre[5] * LOG2E, (float)pre[6] * LOG2E, (float)pre[7] * LOG2E}; }
        __syncthreads();
    }
}

#define MFMA32(a, b, c) __builtin_amdgcn_mfma_f32_32x32x16_bf16((a), (b), (c), 0, 0, 0)
__device__ __forceinline__ int crow(int r, int hi) { return (r & 3) + 8 * (r >> 2) + 4 * hi; }
struct AttnSeq {
    const bf16_t* Q; int qs;
    const bf16_t* K; int ks;
    const bf16_t* VT;
    bf16_t* O; int os;
    const float* cq; const float* ck;
};
__device__ __forceinline__ void softmax_tile(f32x16& s0, f32x16& s1, float& m, float& l, f32x16 (&o)[4], bf16x8 (&pa)[4]) {
    float pmax = s0[0];
#pragma unroll
    for (int r = 1; r < 16; ++r) pmax = fmaxf(pmax, s0[r]);
#pragma unroll
    for (int r = 0; r < 16; ++r) pmax = fmaxf(pmax, s1[r]);
    { auto rr = __builtin_amdgcn_permlane32_swap(__float_as_uint(pmax), __float_as_uint(pmax), false, false);
      pmax = fmaxf(__uint_as_float(rr[0]), __uint_as_float(rr[1])); }
    const bool resc = !__all(pmax - m <= 8.0f);
    const float mn = resc ? fmaxf(m, pmax) : m;
    const float alpha = resc ? fast_exp2(m - mn) : 1.0f; m = mn;
    float ps = 0.f;
#pragma unroll
    for (int r = 0; r < 16; ++r) { s0[r] = fast_exp2(s0[r] - mn); ps += s0[r]; }
#pragma unroll
    for (int r = 0; r < 16; ++r) { s1[r] = fast_exp2(s1[r] - mn); ps += s1[r]; }
    { auto rr = __builtin_amdgcn_permlane32_swap(__float_as_uint(ps), __float_as_uint(ps), false, false);
      ps = __uint_as_float(rr[0]) + __uint_as_float(rr[1]); }
    l = l * alpha + ps;
    if (resc) {
#pragma unroll
        for (int d = 0; d < 4; ++d)
#pragma unroll
            for (int r = 0; r < 16; ++r) o[d][r] *= alpha;
    }
#define PK4(P, B_, OUT) do { const unsigned a0 = pk2(P[B_ + 0], P[B_ + 1]), a1 = pk2(P[B_ + 2], P[B_ + 3]), b0 = pk2(P[B_ + 4], P[B_ + 5]), b1 = pk2(P[B_ + 6], P[B_ + 7]); \
        auto r0 = __builtin_amdgcn_permlane32_swap(a0, b0, false, false); auto r1 = __builtin_amdgcn_permlane32_swap(a1, b1, false, false); \
        u32x4 w_ = {r0[0], r1[0], r0[1], r1[1]}; OUT = __builtin_bit_cast(bf16x8, w_); } while (0)
    PK4(s0, 0, pa[0]); PK4(s0, 8, pa[1]); PK4(s1, 0, pa[2]); PK4(s1, 8, pa[3]);
#undef PK4
}
__device__ __forceinline__ void store_o(const f32x16 (&o)[4], float inv, bf16_t* orow, int hi) {
#pragma unroll
    for (int d = 0; d < 4; ++d)
#pragma unroll
        for (int rq = 0; rq < 4; ++rq) { u32x2 w; w.x = pk2(o[d][4 * rq] * inv, o[d][4 * rq + 1] * inv); w.y = pk2(o[d][4 * rq + 2] * inv, o[d][4 * rq + 3] * inv);
            *(u32x2*)(orow + 32 * d + 8 * rq + 4 * hi) = w; }
}

template <int DQK, bool FOX>
__device__ __forceinline__ void attn_prefill_unit(LAS unsigned char* lds, const AttnSeq& a, int qb, int tid0, float bound2 = 0.f) {
    int tid = tid0; asm volatile("" : "+v"(tid));
    constexpr int RB = DQK * 2, CPR = DQK / 8, KBUF = 64 * RB, NKI = DQK / 64, NKS = DQK / 16;
    constexpr int OFF_V = 2 * KBUF, OFF_CK = OFF_V + 2 * 16384, OFF_QR = OFF_CK + 1024;
    constexpr int NQR = NKS;
    static_assert(OFF_QR + 8 * 4096 <= LDSCTL_OFF, "attention LDS map");
    const int w = __builtin_amdgcn_readfirstlane(tid >> 6), lane = tid & 63, c = lane & 31, hi = lane >> 5;
    const int q0w = qb * 256 + 32 * w, qrow = q0w + c;
    const int last_tile = q0w >> 6, ntiles = 4 * qb + 4;
    int jmin = 0;
    if (FOX) {
        LAS int* jm = (LAS int*)(lds + 2 * KBUF + 2 * 16384 + 512);
        if (tid == 0) *jm = ntiles - 1;
        __syncthreads();
        if (tid < ntiles) { const float d = a.cq[(size_t)(qb * 256) * 8] - a.ck[(size_t)(tid * 64 + 63) * 8];
            if (!(d + bound2 < -40.f)) __hip_atomic_fetch_min(jm, tid, __ATOMIC_RELAXED, __HIP_MEMORY_SCOPE_WORKGROUP); }
        __syncthreads();
        jmin = __builtin_amdgcn_readfirstlane(*jm);
    }
    int koff[NKI], voff[2];
#pragma unroll
    for (int i = 0; i < NKI; ++i) { const int s = (i * 8 + w) * 64 + lane, row = s / CPR, cp = s % CPR;
        const int ch = (DQK == 128) ? (cp ^ (row & 15)) : ((cp & ~7) | ((cp & 7) ^ ((row >> 1) & 7)));
        koff[i] = row * a.ks + ch * 8; }
#pragma unroll
    for (int i = 0; i < 2; ++i) { const int s = (i * 8 + w) * 64 + lane, d = s >> 3, cp = s & 7; voff[i] = d * KVROWS + ((cp ^ ((d >> 1) & 7)) * 8); }
    const int krow_b = c * RB;
    const int vsw = (c >> 1) & 7;
    bf16x8 qf[NQR];
    { const bf16_t* qp = a.Q + (size_t)qrow * a.qs + 8 * hi;
#pragma unroll
      for (int ks = 0; ks < NQR; ++ks) qf[ks] = *(const bf16x8*)(qp + 16 * ks);
      if (DQK == 192) {
#pragma unroll
          for (int ks = 8; ks < NKS; ++ks) *(LAS bf16x8*)(lds + OFF_QR + w * 4096 + c * 128 + (((2 * (ks - 8) + hi) ^ vsw) * 16)) = *(const bf16x8*)(qp + 16 * ks); } }
    float cq = 0.f; if (FOX) cq = a.cq[(size_t)qrow * 8];
    f32x16 o[4];
#pragma unroll
    for (int d = 0; d < 4; ++d)
#pragma unroll
        for (int r = 0; r < 16; ++r) o[d][r] = 0.f;
    float m = -1e30f, l = 0.f;
#define ATT_ISSUE(j_, b_) do { const bf16_t* kb_ = a.K + (size_t)(j_) * 64 * a.ks; const bf16_t* vb_ = a.VT + (size_t)(j_) * 64; \
        _Pragma("unroll") for (int i_ = 0; i_ < NKI; ++i_) __builtin_amdgcn_global_load_lds((const unsigned*)(kb_ + koff[i_]), (LAS unsigned*)(lds + (b_) * KBUF + (i_ * 8 + w) * 1024), 16, 0, 0); \
        _Pragma("unroll") for (int i_ = 0; i_ < 2; ++i_) __builtin_amdgcn_global_load_lds((const unsigned*)(vb_ + voff[i_]), (LAS unsigned*)(lds + OFF_V + (b_) * 16384 + (i_ * 8 + w) * 1024), 16, 0, 0); } while (0)
    ATT_ISSUE(jmin, jmin & 1);
    float ckn = 0.f;
    if (FOX && w == 0) { ckn = a.ck[(size_t)(jmin * 64 + lane) * 8]; ((LAS float*)(lds + OFF_CK))[(jmin & 1) * 64 + lane] = ckn; }
    for (int j = jmin; j < ntiles; ++j) {
        const int b = j & 1;
        VM_WAIT();
        __syncthreads();
        if (j + 1 < ntiles) { ATT_ISSUE(j + 1, b ^ 1); if (FOX && w == 0) ckn = a.ck[(size_t)((j + 1) * 64 + lane) * 8]; }
        if (j <= last_tile) {
            const LAS unsigned char* kb = lds + b * KBUF; const LAS unsigned char* vb = lds + OFF_V + b * 16384;
            f32x16 s0, s1;
#pragma unroll
            for (int r = 0; r < 16; ++r) { s0[r] = 0.f; s1[r] = 0.f; }
            constexpr int NB4 = NKS / 4;
            bf16x8 kfa[2][4], kfb[2][4];
#define ATT_LDK(dst, b4) do { _Pragma("unroll") for (int e_ = 0; e_ < 4; ++e_) { const int ks_ = 4 * (b4) + e_, ch_ = 2 * ks_ + hi; \
                const int cp_ = (DQK == 128) ? (ch_ ^ (c & 15)) : ((ch_ & ~7) | ((ch_ & 7) ^ ((c >> 1) & 7))); \
                dst[0][e_] = *(const LAS bf16x8*)(kb + krow_b + cp_ * 16); dst[1][e_] = *(const LAS bf16x8*)(kb + 32 * RB + krow_b + cp_ * 16); } } while (0)
#define ATT_MMK(src, b4) do { _Pragma("unroll") for (int e_ = 0; e_ < 4; ++e_) { const int ks_ = 4 * (b4) + e_; \
                bf16x8 qv_; if (ks_ < NQR) qv_ = qf[ks_ < NQR ? ks_ : 0]; else qv_ = *(const LAS bf16x8*)(lds + OFF_QR + w * 4096 + c * 128 + (((2 * (ks_ - 8) + hi) ^ vsw) * 16)); \
                s0 = MFMA32(src[0][e_], qv_, s0); s1 = MFMA32(src[1][e_], qv_, s1); } } while (0)
            ATT_LDK(kfa, 0);
            __builtin_amdgcn_sched_barrier(0);
            ATT_LDK(kfb, 1);
            __builtin_amdgcn_sched_barrier(0);
            ATT_MMK(kfa, 0);
            __builtin_amdgcn_sched_barrier(0);
            if (NB4 > 2) { ATT_LDK(kfa, 2 < NB4 ? 2 : 0); }
            __builtin_amdgcn_sched_barrier(0);
            ATT_MMK(kfb, 1);
            __builtin_amdgcn_sched_barrier(0);
            if (NB4 > 2) { ATT_MMK(kfa, 2 < NB4 ? 2 : 0); }
            __builtin_amdgcn_sched_barrier(0);
#undef ATT_LDK
#undef ATT_MMK
            if (FOX) {
                const LAS float* ckb = (const LAS float*)(lds + OFF_CK) + b * 64;
#pragma unroll
                for (int r = 0; r < 16; ++r) { s0[r] += cq - ckb[crow(r, hi)]; s1[r] += cq - ckb[32 + crow(r, hi)]; }
                if (j == last_tile) { const int dq = qrow - j * 64;
#pragma unroll
                    for (int r = 0; r < 16; ++r) { if (crow(r, hi) > dq) s0[r] = -__builtin_inff(); if (32 + crow(r, hi) > dq) s1[r] = -__builtin_inff(); } }
            }
            bf16x8 pa[4];
            softmax_tile(s0, s1, m, l, o, pa);
            {
                bf16x8 va[2][4], vb2[2][4];
#define ATT_LDV(dst, k0_) do { _Pragma("unroll") for (int kk_ = 0; kk_ < 2; ++kk_) _Pragma("unroll") for (int d_ = 0; d_ < 4; ++d_) { const int cp_ = (2 * ((k0_) + kk_) + hi) ^ vsw; \
                    dst[kk_][d_] = *(const LAS bf16x8*)(vb + (32 * d_ + c) * 128 + cp_ * 16); } } while (0)
#define ATT_MMV(src, k0_) do { _Pragma("unroll") for (int kk_ = 0; kk_ < 2; ++kk_) _Pragma("unroll") for (int d_ = 0; d_ < 4; ++d_) o[d_] = MFMA32(src[kk_][d_], pa[(k0_) + kk_], o[d_]); } while (0)
                ATT_LDV(va, 0);
                __builtin_amdgcn_sched_barrier(0);
                ATT_LDV(vb2, 2);
                __builtin_amdgcn_sched_barrier(0);
                ATT_MMV(va, 0);
                __builtin_amdgcn_sched_barrier(0);
                ATT_MMV(vb2, 2);
#undef ATT_LDV
#undef ATT_MMV
            }
        }
        if (FOX && w == 0 && j + 1 < ntiles) ((LAS float*)(lds + OFF_CK))[(b ^ 1) * 64 + lane] = ckn;
    }
#undef ATT_ISSUE
    store_o(o, __builtin_amdgcn_rcpf(l), a.O + (size_t)qrow * a.os, hi);
    __syncthreads();
}

template <int DQK, bool FOX>
__device__ __forceinline__ void attn_decode_unit(LAS unsigned char* lds, const AttnSeq& a, int tid0) {
    int tid = tid0; asm volatile("" : "+v"(tid));
    constexpr int NKS = DQK / 16;
    const int w = __builtin_amdgcn_readfirstlane(tid >> 6), lane = tid & 63, c = lane & 31, hi = lane >> 5, t = c & 15;
    bf16x8 qf[NKS];
    { const bf16_t* qp = a.Q + (size_t)t * a.qs + 8 * hi;
#pragma unroll
      for (int ks = 0; ks < NKS; ++ks) qf[ks] = *(const bf16x8*)(qp + 16 * ks); }
    float cq = 0.f; if (FOX) cq = a.cq[(size_t)t * 8];
    f32x16 o[4];
#pragma unroll
    for (int d = 0; d < 4; ++d)
#pragma unroll
        for (int r = 0; r < 16; ++r) o[d][r] = 0.f;
    float m = -1e30f, l = 0.f;
    const int lim = FOX ? PAST + t : KVLEN_S - 1;
    for (int j = w; j < KVS / 64; j += 8) {
        f32x16 s0, s1;
#pragma unroll
        for (int r = 0; r < 16; ++r) { s0[r] = 0.f; s1[r] = 0.f; }
        const bf16_t* kp = a.K + (size_t)(j * 64 + c) * a.ks + 8 * hi;
#pragma unroll
        for (int ks = 0; ks < NKS; ++ks) {
            if ((ks & 3) == 0) __builtin_amdgcn_sched_barrier(0);
            const bf16x8 k0 = *(const bf16x8*)(kp + 16 * ks), k1 = *(const bf16x8*)(kp + (size_t)32 * a.ks + 16 * ks);
            s0 = MFMA32(k0, qf[ks], s0); s1 = MFMA32(k1, qf[ks], s1);
        }
#pragma unroll
        for (int r = 0; r < 16; ++r) { const int k0i = j * 64 + crow(r, hi), k1i = k0i + 32;
            if (FOX) { s0[r] += cq - a.ck[(size_t)k0i * 8]; s1[r] += cq - a.ck[(size_t)k1i * 8]; }
            if (k0i > lim) s0[r] = -__builtin_inff(); if (k1i > lim) s1[r] = -__builtin_inff(); }
        bf16x8 pa[4];
        softmax_tile(s0, s1, m, l, o, pa);
#pragma unroll
        for (int d = 0; d < 4; ++d) {
            __builtin_amdgcn_sched_barrier(0);
#pragma unroll
            for (int ks = 0; ks < 4; ++ks) { const bf16x8 vf = *(const bf16x8*)(a.VT + (size_t)(32 * d + c) * KVROWS + j * 64 + 16 * ks + 8 * hi);
                o[d] = MFMA32(vf, pa[ks], o[d]); } }
    }
    LAS float* Ot = (LAS float*)lds; LAS float* ML = (LAS float*)(lds + 8 * 128 * 16 * 4);
    if (c < 16) {
#pragma unroll
        for (int d = 0; d < 4; ++d)
#pragma unroll
            for (int r = 0; r < 16; ++r) Ot[(w * 128 + 32 * d + crow(r, hi)) * 16 + c] = o[d][r];
        if (hi == 0) { ML[(w * 16 + c) * 2] = m; ML[(w * 16 + c) * 2 + 1] = l; }
    }
    __syncthreads();
    { const int q = tid & 15, dg = tid >> 4;
      float M = -1e30f;
#pragma unroll
      for (int ww = 0; ww < 8; ++ww) M = fmaxf(M, ML[(ww * 16 + q) * 2]);
      float L = 0.f, acc[4] = {0.f, 0.f, 0.f, 0.f};
#pragma unroll
      for (int ww = 0; ww < 8; ++ww) { const float f = fast_exp2(ML[(ww * 16 + q) * 2] - M); L += ML[(ww * 16 + q) * 2 + 1] * f;
#pragma unroll
          for (int e = 0; e < 4; ++e) acc[e] += Ot[(ww * 128 + 4 * dg + e) * 16 + q] * f; }
      const float inv = __builtin_amdgcn_rcpf(L);
      u32x2 wv; wv.x = pk2(acc[0] * inv, acc[1] * inv); wv.y = pk2(acc[2] * inv, acc[3] * inv);
      *(u32x2*)(a.O + (size_t)q * a.os + 4 * dg) = wv; }
    __syncthreads();
}
#define MFMA16(a, b, c) __builtin_amdgcn_mfma_f32_16x16x32_bf16((a), (b), (c), 0, 0, 0)
constexpr int SSD_XP = 72;
constexpr int SSD_BP = 136;
__device__ __forceinline__ void ssd_dt_acs(const Frame& F, const float* DTB, int m0, int L, int g, float a_neg  , LAS float* Dt, LAS float* Ac) {
    { const int l = F.tid >> 3, h = F.tid & 7; Dt[F.tid] = (l < L) ? DTB[(size_t)(m0 + l) * 16 + 8 * g + h] : 0.f; }
    __syncthreads();
    if (F.tid < 8) { float acs = 0.f; for (int l = 0; l < 64; ++l) { acs += Dt[l * 8 + F.tid] * a_neg; Ac[l * 8 + F.tid] = acs; } }
    __syncthreads();
}
__device__ __forceinline__ void phase_s1(const Params&, const Frame& F0, int layer0) {
    const Frame F = mk_frame(F0.wave);
    const PV p = pv_get(); int layer = layer0; asm volatile("" : "+s"(layer));
    const bf16_t* XC = (const bf16_t*)(p.ws() + WS_XN);
    const float* DTB = (const float*)(p.ws() + WS_DT); float* ST = (float*)(p.ws() + WS_ST); float* CDEC = (float*)(p.ws() + WS_CDEC);
    LAS float* Dt = (LAS float*)F.lds; LAS float* Ac = (LAS float*)(F.lds + 2048);
    LAS bf16_t* BT = (LAS bf16_t*)(F.lds + 4096);
    LAS bf16_t* XT = (LAS bf16_t*)(F.lds + 4096 + 128 * SSD_XP * 2) + F.wave * 64 * SSD_XP;
    const int w = F.wave, lane = F.lane, fr = lane & 15, q = lane >> 4;
    for (int unit = (F.G == 256) ? (F.bx + 88) % 256 : F.bx; unit < NCHUNK * 2; unit += F.G) {
        const int ci = unit >> 1, g = unit & 1; const bool smp = ci >= 256; const int L = smp ? 16 : 64; const int m0 = smp ? MP + (ci - 256) * 16 : ci * 64;
        const int head = 8 * g + w;
        const float a_neg = (F.tid < 8) ? -fast_exp(p.in(I_ALOG)[layer * 16 + 8 * g + F.tid]) : 0.f;
        ssd_dt_acs(F, DTB, m0, L, g, a_neg, Dt, Ac);
        const float alast = Ac[63 * 8 + w];
        if (lane == 0) CDEC[ci * 16 + head] = fast_exp(alast);
        for (int idx = F.tid; idx < 64 * 16; idx += 512) { const int l = idx >> 4, n8 = idx & 15; bf16_t v[8];
            if (l < L) *(u32x4*)v = *(const u32x4*)(XC + (size_t)(m0 + l) * 1536 + 1024 + 128 * g + 8 * n8); else *(u32x4*)v = (u32x4){0u, 0u, 0u, 0u};
#pragma unroll
            for (int e = 0; e < 8; ++e) BT[(8 * n8 + e) * SSD_XP + l] = v[e]; }
#pragma unroll
        for (int it = 0; it < 8; ++it) { const int l = 8 * it + (lane >> 3), p8 = lane & 7; float xv[8];
            if (l < L) unpack8(*(const u32x4*)(XC + (size_t)(m0 + l) * 1536 + head * 64 + 8 * p8), xv); else { for (int e = 0; e < 8; ++e) xv[e] = 0.f; }
            const float wgt = fast_exp(alast - Ac[l * 8 + w]) * Dt[l * 8 + w];
#pragma unroll
            for (int e = 0; e < 8; ++e) XT[(8 * p8 + e) * SSD_XP + l] = f2bf(xv[e] * wgt); }
        __syncthreads();
#pragma unroll 1
        for (int nh = 0; nh < 2; ++nh) {
            f32x4 acc[4][4];
#pragma unroll
            for (int nb = 0; nb < 4; ++nb)
#pragma unroll
                for (int pb = 0; pb < 4; ++pb) acc[nb][pb] = (f32x4){0.f, 0.f, 0.f, 0.f};
#pragma unroll
            for (int ks = 0; ks < 2; ++ks) {
                bf16x8 xf[4];
#pragma unroll
                for (int pb = 0; pb < 4; ++pb) xf[pb] = *(const LAS bf16x8*)(XT + (16 * pb + fr) * SSD_XP + 32 * ks + 8 * q);
#pragma unroll
                for (int nb = 0; nb < 4; ++nb) { const bf16x8 bf = *(const LAS bf16x8*)(BT + (64 * nh + 16 * nb + fr) * SSD_XP + 32 * ks + 8 * q);
#pragma unroll
                    for (int pb = 0; pb < 4; ++pb) acc[nb][pb] = MFMA16(bf, xf[pb], acc[nb][pb]); }
            }
            float* so = ST + (size_t)(ci * 16 + head) * 8192;
#pragma unroll
            for (int nb = 0; nb < 4; ++nb)
#pragma unroll
                for (int pb = 0; pb < 4; ++pb) *(f32x4*)(so + (size_t)(16 * pb + fr) * 128 + 64 * nh + 16 * nb + 4 * q) = acc[nb][pb];
        }
        __syncthreads();
    }
}
__device__ __forceinline__ void phase_s2(const Params&, const Frame& F0, int layer0) {
    const Frame F = mk_frame(F0.wave);
    const PV p = pv_get(); int layer = layer0; asm volatile("" : "+s"(layer));
    const float* ST = (const float*)(p.ws() + WS_ST); const float* CDEC = (const float*)(p.ws() + WS_CDEC); bf16_t* HB = (bf16_t*)(p.ws() + WS_HB);
    float* o_p = p.out() + O_PSSM + (size_t)layer * 131072; float* o_s = p.out() + O_SSSM + (size_t)layer * NB * 131072;
    const float* h0s = p.in(I_SSM) + (size_t)layer * NB * 131072;
    const size_t gt = (size_t)F.bx * 512 + F.tid, NT = (size_t)F.G * 512;
    for (size_t e = gt; e < 131072; e += NT) { const int head = (int)(e >> 13);
        float h = 0.f;
        for (int c0 = 0; c0 < 256; c0 += 32) { float tv[32], dv[32];
#pragma unroll
            for (int i = 0; i < 32; ++i) { tv[i] = ST[(size_t)(c0 + i) * 131072 + e]; dv[i] = CDEC[(c0 + i) * 16 + head]; }
#pragma unroll
            for (int i = 0; i < 32; ++i) { HB[(size_t)(c0 + i) * 131072 + e] = f2bf(h); h = h * dv[i] + tv[i]; } }
        o_p[e] = h; }
    for (size_t i = gt; i < (size_t)NB * 131072; i += NT) { const int b = (int)(i >> 17); const size_t e = i & 131071; const int head = (int)(e >> 13), ci = 256 + b;
        const float h0 = h0s[i], tv = ST[(size_t)ci * 131072 + e];
        HB[(size_t)ci * 131072 + e] = f2bf(h0); o_s[i] = h0 * CDEC[ci * 16 + head] + tv; }
}
__device__ __forceinline__ void phase_s3(const Params&, const Frame& F0, int layer0) {
    const Frame F = mk_frame(F0.wave);
    const PV p = pv_get(); int layer = layer0; asm volatile("" : "+s"(layer));
    const bf16_t* XC = (const bf16_t*)(p.ws() + WS_XN); bf16_t* U = (bf16_t*)(p.ws() + WS_U);
    const float* DTB = (const float*)(p.ws() + WS_DT);
    LAS float* Dt = (LAS float*)F.lds; LAS float* Ac = (LAS float*)(F.lds + 2048); LAS float* Rs = (LAS float*)(F.lds + 4096);
    LAS bf16_t* Bs = (LAS bf16_t*)(F.lds + 4608);
    LAS bf16_t* Cs = (LAS bf16_t*)(F.lds + 4608 + 64 * SSD_BP * 2);
    LAS bf16_t* XT = (LAS bf16_t*)(F.lds + 4608 + 2 * 64 * SSD_BP * 2) + F.wave * 64 * SSD_XP;
    const int w = F.wave, lane = F.lane, fr = lane & 15, q = lane >> 4;
    for (int unit = F.bx; unit < NCHUNK * 2; unit += F.G) {
        const int ci = unit >> 1, g = unit & 1; const bool smp = ci >= 256; const int L = smp ? 16 : 64; const int m0 = smp ? MP + (ci - 256) * 16 : ci * 64;
        const int head = 8 * g + w;
        const float a_neg = (F.tid < 8) ? -fast_exp(p.in(I_ALOG)[layer * 16 + 8 * g + F.tid]) : 0.f;
        bf16x8 hfr[4][4];
        { const bf16_t* hb = (const bf16_t*)(p.ws() + WS_HB) + (size_t)(ci * 16 + head) * 8192 + (size_t)fr * 128 + 8 * q;
#pragma unroll
          for (int ks = 0; ks < 4; ++ks)
#pragma unroll
              for (int pb = 0; pb < 4; ++pb) hfr[ks][pb] = *(const bf16x8*)(hb + (size_t)(16 * pb) * 128 + 32 * ks); }
        __builtin_amdgcn_sched_barrier(0);
        if (F.tid < 64) Rs[F.tid] = 0.f;
        ssd_dt_acs(F, DTB, m0, L, g, a_neg, Dt, Ac);
        for (int idx = F.tid; idx < 64 * 16; idx += 512) { const int l = idx >> 4, n8 = idx & 15; u32x4 vb = {0u, 0u, 0u, 0u}, vc = {0u, 0u, 0u, 0u};
            if (l < L) { const bf16_t* src = XC + (size_t)(m0 + l) * 1536 + 1024 + 128 * g + 8 * n8; vb = *(const u32x4*)src; vc = *(const u32x4*)(src + 256); }
            *(LAS u32x4*)(Bs + l * SSD_BP + 8 * n8) = vb; *(LAS u32x4*)(Cs + l * SSD_BP + 8 * n8) = vc; }
#pragma unroll
        for (int it = 0; it < 8; ++it) { const int l = 8 * it + (lane >> 3), p8 = lane & 7; bf16_t v[8];
            if (l < L) *(u32x4*)v = *(const u32x4*)(XC + (size_t)(m0 + l) * 1536 + head * 64 + 8 * p8); else *(u32x4*)v = (u32x4){0u, 0u, 0u, 0u};
#pragma unroll
            for (int e = 0; e < 8; ++e) XT[(8 * p8 + e) * SSD_XP + l] = v[e]; }
        __syncthreads();
        f32x4 acc[4][4];
#pragma unroll
        for (int pb = 0; pb < 4; ++pb)
#pragma unroll
            for (int lb = 0; lb < 4; ++lb) acc[pb][lb] = (f32x4){0.f, 0.f, 0.f, 0.f};
#pragma unroll
        for (int ks = 0; ks < 4; ++ks) { bf16x8 cf[4];
#pragma unroll
            for (int lb = 0; lb < 4; ++lb) cf[lb] = *(const LAS bf16x8*)(Cs + (16 * lb + fr) * SSD_BP + 32 * ks + 8 * q);
#pragma unroll
            for (int pb = 0; pb < 4; ++pb) {
#pragma unroll
                for (int lb = 0; lb < 4; ++lb) acc[pb][lb] = MFMA16(hfr[ks][pb], cf[lb], acc[pb][lb]); } }
        f32x4 gt[4][4];
#pragma unroll
        for (int sb = 0; sb < 4; ++sb)
#pragma unroll
            for (int lb = 0; lb < 4; ++lb) gt[sb][lb] = (f32x4){0.f, 0.f, 0.f, 0.f};
#pragma unroll
        for (int ks = 0; ks < 4; ++ks) { bf16x8 cf[4];
#pragma unroll
            for (int lb = 0; lb < 4; ++lb) cf[lb] = *(const LAS bf16x8*)(Cs + (16 * lb + fr) * SSD_BP + 32 * ks + 8 * q);
#pragma unroll
            for (int sb = 0; sb < 4; ++sb) { const bf16x8 bf = *(const LAS bf16x8*)(Bs + (16 * sb + fr) * SSD_BP + 32 * ks + 8 * q);
#pragma unroll
                for (int lb = 0; lb < 4; ++lb) gt[sb][lb] = MFMA16(bf, cf[lb], gt[sb][lb]); } }
        float al[4];
#pragma unroll
        for (int lb = 0; lb < 4; ++lb) { al[lb] = Ac[(16 * lb + fr) * 8 + w]; const float el = fast_exp(al[lb]);
#pragma unroll
            for (int pb = 0; pb < 4; ++pb) acc[pb][lb] = acc[pb][lb] * el; }
#pragma unroll
        for (int ks2 = 0; ks2 < 2; ++ks2) {
            float as_[2][4], ds_[2][4];
#pragma unroll
            for (int jh = 0; jh < 2; ++jh)
#pragma unroll
                for (int r = 0; r < 4; ++r) { const int s = 32 * ks2 + 16 * jh + 4 * q + r; as_[jh][r] = Ac[s * 8 + w]; ds_[jh][r] = Dt[s * 8 + w]; }
            bf16x8 mf[4];
#pragma unroll
            for (int lb = 0; lb < 4; ++lb) { const int l = 16 * lb + fr; float mv[8];
#pragma unroll
                for (int jh = 0; jh < 2; ++jh)
#pragma unroll
                    for (int r = 0; r < 4; ++r) { const int s = 32 * ks2 + 16 * jh + 4 * q + r;
                        mv[4 * jh + r] = (s <= l) ? gt[2 * ks2 + jh][lb][r] * fast_exp(al[lb] - as_[jh][r]) * ds_[jh][r] : 0.f; }
                u32x4 mw; mw.x = pk2(mv[0], mv[1]); mw.y = pk2(mv[2], mv[3]); mw.z = pk2(mv[4], mv[5]); mw.w = pk2(mv[6], mv[7]);
                mf[lb] = __builtin_bit_cast(bf16x8, mw); }
#pragma unroll
            for (int pb = 0; pb < 4; ++pb) { const LAS bf16_t* xp = XT + (16 * pb + fr) * SSD_XP + 32 * ks2 + 4 * q;
                const u32x2 x0 = *(const LAS u32x2*)xp, x1 = *(const LAS u32x2*)(xp + 16);
                const u32x4 xw = {x0.x, x0.y, x1.x, x1.y}; const bf16x8 xf = __builtin_bit_cast(bf16x8, xw);
#pragma unroll
                for (int lb = 0; lb < 4; ++lb) acc[pb][lb] = MFMA16(xf, mf[lb], acc[pb][lb]); }
        }
        const float dsk = p.in(I_SD)[layer * 16 + head];
        float sq[4] = {0.f, 0.f, 0.f, 0.f};
#pragma unroll
        for (int lb = 0; lb < 4; ++lb) { const int l = 16 * lb + fr; const bool ok = l < L;
#pragma unroll
            for (int pb = 0; pb < 4; ++pb) { const int pc = 16 * pb + 4 * q;
                u32x2 xw = {0u, 0u}, zw = {0u, 0u};
                if (ok) { xw = *(const u32x2*)(XC + (size_t)(m0 + l) * 1536 + head * 64 + pc); zw = *(const u32x2*)(U + (size_t)(m0 + l) * LDU + UC_Z + head * 64 + pc); }
                f32x4 y = acc[pb][lb];
                y[0] = (y[0] + dsk * bf_lo(xw.x)) * siluf_(bf_lo(zw.x)); y[1] = (y[1] + dsk * bf_hi(xw.x)) * siluf_(bf_hi(zw.x));
                y[2] = (y[2] + dsk * bf_lo(xw.y)) * siluf_(bf_lo(zw.y)); y[3] = (y[3] + dsk * bf_hi(xw.y)) * siluf_(bf_hi(zw.y));
                acc[pb][lb] = y; sq[lb] += (y[0] * y[0] + y[1] * y[1]) + (y[2] * y[2] + y[3] * y[3]); } }
#pragma unroll
        for (int lb = 0; lb < 4; ++lb) { float s = sq[lb]; s += shx(s, 16, F.lane); s += shx(s, 32, F.lane);
            if (q == 0) __hip_atomic_fetch_add(Rs + 16 * lb + fr, s, __ATOMIC_RELAXED, __HIP_MEMORY_SCOPE_WORKGROUP); }
        __syncthreads();
#pragma unroll
        for (int lb = 0; lb < 4; ++lb) { const int l = 16 * lb + fr;
            if (l < L) { const float rs = fast_rsqrt(Rs[l] * (1.0f / 512) + EPS);
#pragma unroll
                for (int pb = 0; pb < 4; ++pb) { const int pc = 16 * pb + 4 * q; const f32x4 gn = *(const f32x4*)(p.in(I_SN) + layer * 1024 + head * 64 + pc); const f32x4 y = acc[pb][lb];
                    u32x2 ow; ow.x = pk2(y[0] * rs * gn[0], y[1] * rs * gn[1]); ow.y = pk2(y[2] * rs * gn[2], y[3] * rs * gn[3]);
                    *(u32x2*)(U + (size_t)(m0 + l) * LDU + UC_OSSD + head * 64 + pc) = ow; } } }
        __syncthreads();
    }
}
#ifndef DUPMASK
#define DUPMASK 0
#endif
__device__ __forceinline__ void phase_attn(const Params&, const Frame& F0, int layer0) {
    const Frame F = mk_frame(F0.wave);
    const PV p = pv_get(); int layer = layer0; asm volatile("" : "+s"(layer));
    bf16_t* U = (bf16_t*)(p.ws() + WS_U); const bf16_t* QM = (const bf16_t*)(p.ws() + WS_QM); const bf16_t* KM = (const bf16_t*)(p.ws() + WS_KM);
    const bf16_t* VTM = (const bf16_t*)(p.ws() + WS_VTM); const bf16_t* KFS = (const bf16_t*)(p.ws() + WS_KFS); const bf16_t* VTF = (const bf16_t*)(p.ws() + WS_VTF);
    const float* CUM = (const float*)(p.ws() + WS_CUM);
    for (int it = F.vcu; it < 256; it += F.G) {
        const int h = it >> 5, pr = it & 31;
        AttnSeq a; a.Q = QM + h * 192; a.qs = 1536; a.K = KM + h * 192; a.ks = 1536; a.VT = VTM + (size_t)h * 128 * KVROWS; a.O = U + UC_OMLA + h * 128; a.os = LDU; a.cq = nullptr; a.ck = nullptr;
#pragma unroll 1
        for (int half = 0; half < 2; ++half) attn_prefill_unit<192, false>(F.lds, a, half ? pr : 63 - pr, F.tid);
    }
#if defined(DUPMASK)
    if ((DUPMASK >> 8) & 1) for (int it = F.vcu; it < 256; it += F.G) {
        const int h = it >> 5, pr = it & 31;
        AttnSeq a; a.Q = QM + h * 192; a.qs = 1536; a.K = KM + h * 192; a.ks = 1536; a.VT = VTM + (size_t)h * 128 * KVROWS; a.O = U + UC_OMLA + h * 128; a.os = LDU; a.cq = nullptr; a.ck = nullptr;
#pragma unroll 1
        for (int half = 0; half < 2; ++half) attn_prefill_unit<192, false>(F.lds, a, half ? pr : 63 - pr, F.tid);
    }
#endif
    for (int it = F.vcu; it < 256; it += F.G) {
        const int h = it >> 5, pr = it & 31;
        AttnSeq a; a.Q = U + UC_FQ + h * 128; a.qs = LDU; a.K = U + UC_FK + h * 128; a.ks = LDU; a.VT = VTF + (size_t)h * 128 * KVROWS; a.O = U + UC_OFOX + h * 128; a.os = LDU; a.cq = CUM + h; a.ck = CUM + h;
        const unsigned* ctl = (const unsigned*)(p.ws() + WS_CTL);
        float kn2; { float v = __uint_as_float(ctl[CW_KN2 + (layer * 64 + F.lane) * 8 + h]);
#pragma unroll
            for (int o = 1; o < 64; o <<= 1) v = fmaxf(v, shx(v, o, F.lane)); kn2 = v; }
#pragma unroll 1
        for (int half = 0; half < 2; ++half) { const int qb = half ? pr : 63 - pr;
            attn_prefill_unit<128, true>(F.lds, a, qb, F.tid, 2.02f * __builtin_amdgcn_sqrtf(__uint_as_float(ctl[CW_QN2 + (layer * 64 + qb) * 8 + h]) * kn2)); }
    }
#if defined(DUPMASK)
    if ((DUPMASK >> 9) & 1) for (int it = F.vcu; it < 256; it += F.G) {
        const int h = it >> 5, pr = it & 31;
        AttnSeq a; a.Q = U + UC_FQ + h * 128; a.qs = LDU; a.K = U + UC_FK + h * 128; a.ks = LDU; a.VT = VTF + (size_t)h * 128 * KVROWS; a.O = (bf16_t*)(p.ws() + WS_ST) + h * 128; a.os = 1024; a.cq = CUM + h; a.ck = CUM + h;
        const unsigned* ctl = (const unsigned*)(p.ws() + WS_CTL);
        float kn2; { float v = __uint_as_float(ctl[CW_KN2 + (layer * 64 + F.lane) * 8 + h]);
#pragma unroll
            for (int o = 1; o < 64; o <<= 1) v = fmaxf(v, shx(v, o, F.lane)); kn2 = v; }
#pragma unroll 1
        for (int half = 0; half < 2; ++half) { const int qb = half ? pr : 63 - pr;
            attn_prefill_unit<128, true>(F.lds, a, qb, F.tid, 2.02f * __builtin_amdgcn_sqrtf(__uint_as_float(ctl[CW_QN2 + (layer * 64 + qb) * 8 + h]) * kn2)); }
    }
#endif
    for (int it = F.vcu; it < 2 * NB * 8; it += F.G) {
        const int kind = it >> 7, s = (it & 127) >> 3, h = it & 7; const size_t q0 = (size_t)MP + 16 * s, k0 = (size_t)MP + (size_t)s * KVS;
        if (kind == 0) { AttnSeq a; a.Q = QM + q0 * 1536 + h * 192; a.qs = 1536; a.K = KM + k0 * 1536 + h * 192; a.ks = 1536; a.VT = VTM + (size_t)h * 128 * KVROWS + k0; a.O = U + q0 * LDU + UC_OMLA + h * 128; a.os = LDU; a.cq = nullptr; a.ck = nullptr;
          attn_decode_unit<192, false>(F.lds, a, F.tid); }
        else { AttnSeq a; a.Q = U + q0 * LDU + UC_FQ + h * 128; a.qs = LDU; a.K = KFS + (size_t)s * KVS * 1024 + h * 128; a.ks = 1024; a.VT = VTF + (size_t)h * 128 * KVROWS + k0; a.O = U + q0 * LDU + UC_OFOX + h * 128; a.os = LDU;
          a.cq = CUM + (k0 + PAST) * 8 + h; a.ck = CUM + k0 * 8 + h;
          attn_decode_unit<128, true>(F.lds, a, F.tid); }
    }
}

#define LAUNDER_P const PV p = pv_get()
#define LAUNDER_PL const PV p = pv_get(); int layer = layer0; asm volatile("" : "+s"(layer))
__device__ __forceinline__ void ph_gateup(const Params&, const Frame& F0, size_t woff) {
    const Frame F = mk_frame(F0.wave);
    LAUNDER_P; bf16_t* W = (bf16_t*)(p.ws() + WS_W); bf16_t* XN = (bf16_t*)(p.ws() + WS_XN); bf16_t* H = (bf16_t*)(p.ws() + WS_U);
    pg8::Gemm g{XN, W + woff, 64, 64, MT, 2 * FF, D, (size_t)MT * 128, (size_t)2 * FF * 128}; pg8::StaticOrder S; S.init(MT, 2 * FF, F.G, F.bx, D); S.nrev = true;
    EpiSwiGLU E{H}; pg8::gemm_phase<EpiSwiGLU, pg8::StaticOrder, true, true>(F.lds, g, S, E, F.wave);
}
__device__ __forceinline__ void ph_down(const Params&, const Frame& F0, size_t woff, bool from_input, bool dummy = false) {
    const Frame F = mk_frame(F0.wave);
    LAUNDER_P; bf16_t* W = (bf16_t*)(p.ws() + WS_W); bf16_t* H = (bf16_t*)(p.ws() + WS_U);
    pg8::Gemm g{H, W + woff, 64, 64, MT, D, FF, (size_t)MT * 128, (size_t)D * 128}; pg8::SplitOrder S;
    S.init(MT, D, F.G, F.bx, FF);
    EpiResid E{from_input ? p.in(I_XP) : nullptr, (bf16_t*)(p.ws() + (dummy ? WS_ST : WS_XB)), 0.5f, (float*)(p.ws() + WS_PART)}; pg8::gemm_phase<EpiResid, pg8::SplitOrder, true, true>(F.lds, g, S, E, F.wave);
}
__device__ __forceinline__ void ph_win(const Params&, const Frame& F0, int layer0) {
    const Frame F = mk_frame(F0.wave);
    LAUNDER_PL; bf16_t* W = (bf16_t*)(p.ws() + WS_W); bf16_t* XN = (bf16_t*)(p.ws() + WS_XN); bf16_t* U = (bf16_t*)(p.ws() + WS_U);
    pg8::Gemm g{XN, W + W_IN, 64, 64, MT, NWIN, D, (size_t)MT * 128, (size_t)NWIN * 128}; pg8::StaticOrder S; S.init(MT, NWIN, F.G, F.bx, D);
    EpiWin E{U, (float*)(p.ws() + WS_US), p.out() + O_PFK + (size_t)layer * MP * 1024, p.out() + O_SFK + (size_t)layer * MS * 1024,
             p.out() + O_PFV + (size_t)layer * MP * 1024, p.out() + O_SFV + (size_t)layer * MS * 1024};
    pg8::gemm_phase<EpiWin, pg8::StaticOrder, true, true>(F.lds, g, S, E, F.wave);
}
__device__ __forceinline__ void ph_uq(const Params&, const Frame& F0) {
    const Frame F = mk_frame(F0.wave);
    LAUNDER_P; bf16_t* W = (bf16_t*)(p.ws() + WS_W); bf16_t* U = (bf16_t*)(p.ws() + WS_U);
    pg8::Gemm g{U + UC_QLAT, W + W_UQ, LDU, 512, MT, 1536, 512}; pg8::StaticOrder S; S.init(MT, 1536, F.G, F.bx, 512);
    EpiUq E{(bf16_t*)(p.ws() + WS_QM), (const f32x2*)(p.ws() + WS_ROPE)}; pg8::gemm_phase<EpiUq, pg8::StaticOrder, true, true>(F.lds, g, S, E, F.wave);
}
__device__ __forceinline__ void ph_ukv(const Params&, const Frame& F0) {
    const Frame F = mk_frame(F0.wave);
    LAUNDER_P; bf16_t* W = (bf16_t*)(p.ws() + WS_W);
    pg8::Gemm g{(const bf16_t*)(p.ws() + WS_CKV), W + W_UKV, 512, 512, KVROWS, 2048, 512}; pg8::StaticOrder S; S.init(KVROWS, 2048, F.G, (F.G == 256) ? (F.bx + 120) % 256 : F.bx, 512);
    EpiUkv E{(bf16_t*)(p.ws() + WS_KM), (bf16_t*)(p.ws() + WS_VTM)}; pg8::gemm_phase<EpiUkv, pg8::StaticOrder, true, true>(F.lds, g, S, E, F.wave);
}
template <int BR> __device__ __forceinline__ void ph_merge(const Params&, const Frame& F0) {
    const Frame F = mk_frame(F0.wave);
    LAUNDER_P; bf16_t* W = (bf16_t*)(p.ws() + WS_W); bf16_t* U = (bf16_t*)(p.ws() + WS_U); bf16_t* XN = (bf16_t*)(p.ws() + WS_XN);
    constexpr int acol = BR == 0 ? UC_OMLA : (BR == 1 ? UC_OSSD : UC_OFOX);
    pg8::StaticOrder S; S.init(MP, D, F.G, F.bx, 1024, true);
    pg8::Gemm g{U + acol, W + W_BR + (size_t)BR * D * 1024, LDU, 1024, MP, D, 1024}; EpiMerge<BR> E{U, XN}; pg8::gemm_phase<EpiMerge<BR>, pg8::StaticOrder, true, true>(F.lds, g, S, E, F.wave);
}
__device__ __forceinline__ void ph_merge_sample(const Params&, const Frame& F0, int layer0) {
    const Frame F = mk_frame(F0.wave);
    LAUNDER_PL; bf16_t* W = (bf16_t*)(p.ws() + WS_W); bf16_t* U = (bf16_t*)(p.ws() + WS_U); bf16_t* XN = (bf16_t*)(p.ws() + WS_XN);
    pg8::SampleMergeOrder S; S.c = F.bx;
    pg8::Gemm g{U, W + W_BR, LDU, 1024, MT, 3 * D, 1024};
    EpiMergeSample E{U, XN, (float*)(p.ws() + WS_PART), (unsigned*)(p.ws() + WS_CTL) + CW_MGC + layer * 8 * 64, (LAS unsigned*)(F.lds + RING_BYTES)};
    pg8::gemm_phase<EpiMergeSample, pg8::SampleMergeOrder, true, true>(F.lds, g, S, E, F.wave);
}
__device__ __forceinline__ void ph_wout(const Params&, const Frame& F0, bool dummy = false) {
    const Frame F = mk_frame(F0.wave);
    LAUNDER_P; bf16_t* W = (bf16_t*)(p.ws() + WS_W); bf16_t* XN = (bf16_t*)(p.ws() + WS_XN);
    pg8::Gemm g{XN, W + W_OUT, D, D, MT, D, D}; pg8::SplitOrder S; S.init(MT, D, F.G, F.bx, D);
    EpiResid E{nullptr, (bf16_t*)(p.ws() + (dummy ? WS_ST : WS_XB)), 1.0f, (float*)(p.ws() + WS_PART)}; pg8::gemm_phase<EpiResid, pg8::SplitOrder, true, true>(F.lds, g, S, E, F.wave);
}
__device__ __forceinline__ void ph_norm(const Params&, const Frame& F0, int layer0, int which, bool from_input) {
    const Frame F = mk_frame(F0.wave);
    LAUNDER_PL; float* ys = p.out() + O_YS;
    phase_norm(F, from_input ? p.in(I_XP) : nullptr, (const bf16_t*)(p.ws() + WS_XB), from_input ? p.in(I_XS) : ys, p.in(which) + layer * D, (bf16_t*)(p.ws() + WS_XN), from_input ? ys : nullptr, from_input ? nullptr : (const float*)(p.ws() + WS_PART));
}

constexpr int PH_PER_LAYER = 15, N_PHASES = NL * PH_PER_LAYER + 1;
#ifndef N_LAUNCHES
#define N_LAUNCHES 1
#endif
#ifndef PHMASK
#define PHMASK 0xffff
#endif
#ifndef DUPMASK
#define DUPMASK 0
#endif
#define DUP(k) (((DUPMASK) >> (k)) & 1)

__global__ void __launch_bounds__(512, 2) hybrid_fwd(Params p) {
    extern __shared__ __attribute__((aligned(16))) unsigned char lds_raw[];
    const int wave_k = __builtin_amdgcn_readfirstlane((int)threadIdx.x >> 6);
    const Frame F = mk_frame(wave_k);
    volatile LAS unsigned* MISC = (volatile LAS unsigned*)(F.lds + MISC_OFF);
    for (int u = F.tid; u < (LDS_BYTES - LDSCTL_OFF) / 4; u += 512) ((LAS unsigned*)(F.lds + LDSCTL_OFF))[u] = 0u;
    __syncthreads();
    const PV pk = pv_get();
    unsigned* ctl = (unsigned*)(pk.ws() + WS_CTL);
    const int lo = pk.ph_lo(), hi = pk.ph_hi();
    XcdBarrier bar; bar.bar = ctl + CW_BAR; bar.x = 0; bar.st = nullptr;
    if (hi - lo > 1) bar = xcd_barrier_post(ctl + CW_BAR, MISC + 8, F.tid);
#define IN(k) ((((PHMASK) >> (((k) == NL * PH_PER_LAYER) ? 15 : ((k) % PH_PER_LAYER))) & 1) && lo <= (k) && (k) < hi)
#define SEAM(k) do { if (IN(k) && IN((k) + 1)) xcd_barrier(bar, wave_k); } while (0)
    if (IN(0)) phase_rope_table(F);
#pragma unroll 1
    for (int layer = 0; layer < NL; ++layer) {
        const int pb = layer * PH_PER_LAYER;
        if (IN(pb + 0)) { phase_convert(p, F, layer); if (DUP(0)) phase_convert(p, F, layer); }
        if (IN(pb + 1)) { ph_norm(p, F, layer, I_F1N, layer == 0); if (DUP(1)) ph_norm(p, F, layer, I_F1N, layer == 0); }
        SEAM(pb + 1);
        if (IN(pb + 2)) { ph_gateup(p, F, W_GU1); if (DUP(2)) ph_gateup(p, F, W_GU1); }
        SEAM(pb + 2);
        if (IN(pb + 3)) { if (DUP(3)) ph_down(p, F, W_D1, layer == 0, true); ph_down(p, F, W_D1, layer == 0); }
        SEAM(pb + 3);
        if (IN(pb + 4)) ph_norm(p, F, layer, I_MIXN, false);
        SEAM(pb + 4);
        if (IN(pb + 5)) { ph_win(p, F, layer); if (DUP(5)) ph_win(p, F, layer); }
        SEAM(pb + 5);
        if (IN(pb + 6)) phase_t1(p, F, layer);
        SEAM(pb + 6);
        if (IN(pb + 7)) { phase_t2(p, F); ph_uq(p, F); ph_ukv(p, F); phase_s1(p, F, layer); if (DUP(7)) { ph_uq(p, F); ph_ukv(p, F); } if (DUP(6)) phase_s1(p, F, layer); }
        SEAM(pb + 7);
        if (IN(pb + 8)) { phase_attn(p, F, layer); phase_s2(p, F, layer); }
        SEAM(pb + 8);
        if (IN(pb + 9)) phase_s3(p, F, layer);
        SEAM(pb + 9);
        if (IN(pb + 10)) { ph_merge_sample(p, F, layer); ph_merge<0>(p, F); ph_merge<1>(p, F); ph_merge<2>(p, F); }
        SEAM(pb + 10);
        if (IN(pb + 11)) { if (DUP(11)) ph_wout(p, F, true); ph_wout(p, F); }
        SEAM(pb + 11);
        if (IN(pb + 12)) ph_norm(p, F, layer, I_F2N, false);
        SEAM(pb + 12);
        if (IN(pb + 13)) ph_gateup(p, F, W_GU2);
        SEAM(pb + 13);
        if (IN(pb + 14)) ph_down(p, F, W_D2, false);
        SEAM(pb + 14);
    }
    if (IN(NL * PH_PER_LAYER)) { const PV q = pv_get(); const Frame F2 = mk_frame(wave_k); phase_final_norm(F2, q.out() + O_YP, (const bf16_t*)(q.ws() + WS_XB), q.in(I_FN), (const float*)(q.ws() + WS_PART)); }
#undef IN
#undef SEAM
}

extern "C" void kernel_launch(void* const* d_in, const int* in_sizes, int n_in, void* d_out, int out_size, void* d_ws, size_t ws_size, hipStream_t stream) {
    static int grid = 0;
    if (grid == 0) {
        if (n_in != N_IN || (size_t)out_size != O_TOTAL || ws_size < WS_END) { fprintf(stderr, "kernel_launch: unexpected shapes: n_in %d out %d ws %zu (need %zu)\n", n_in, out_size, ws_size, (size_t)WS_END); grid = -1; return; }
        int dev = 0, cus = 0, per_cu = 0;
        if (hipGetDevice(&dev) != hipSuccess || hipDeviceGetAttribute(&cus, hipDeviceAttributeMultiprocessorCount, dev) != hipSuccess) { grid = -1; return; }
        if (hipFuncSetAttribute((const void*)hybrid_fwd, hipFuncAttributeMaxDynamicSharedMemorySize, LDS_BYTES) != hipSuccess) { fprintf(stderr, "kernel_launch: hipFuncSetAttribute failed\n"); grid = -1; return; }
        if (hipOccupancyMaxActiveBlocksPerMultiprocessor(&per_cu, (const void*)hybrid_fwd, 512, LDS_BYTES) != hipSuccess || per_cu < 1) { fprintf(stderr, "kernel_launch: occupancy query says %d\n", per_cu); }
        (void)hipGetLastError();
        grid = cus;
    }
    if (grid < 0) return;
    (void)hipMemsetAsync((char*)d_ws + WS_CTL, 0, CTL_BYTES, stream);
    Params p{};
    for (int i = 0; i < N_IN; ++i) p.in[i] = (const float*)d_in[i];
    p.out = (float*)d_out; p.ws = (unsigned char*)d_ws;
#if defined(PROBE_K)
    p.ph_lo = 0; p.ph_hi = PROBE_K;
    hipLaunchKernelGGL(hybrid_fwd, dim3(grid), dim3(512), LDS_BYTES, stream, p);
    (void)hipMemsetAsync((char*)d_ws + WS_CTL, 0, CTL_BYTES, stream);
    p.ph_lo = 0; p.ph_hi = N_PHASES;
    hipLaunchKernelGGL(hybrid_fwd, dim3(grid), dim3(512), LDS_BYTES, stream, p);
#elif N_LAUNCHES == 1
    p.ph_lo = 0; p.ph_hi = N_PHASES;
    hipLaunchKernelGGL(hybrid_fwd, dim3(grid), dim3(512), LDS_BYTES, stream, p);
#else
    for (int k = 0; k < N_PHASES; ++k) { p.ph_lo = k; p.ph_hi = k + 1; hipLaunchKernelGGL(hybrid_fwd, dim3(grid), dim3(512), LDS_BYTES, stream, p); }
#endif
}
```

```cpp
#include <hip/hip_runtime.h>
#include <cstdio>
#include <cstdint>

#define LAS __attribute__((address_space(3)))
typedef unsigned short bf16_t;
typedef short bf16x8 __attribute__((ext_vector_type(8)));
typedef float f32x4 __attribute__((ext_vector_type(4)));
typedef float f32x2 __attribute__((ext_vector_type(2)));
typedef float f32x16 __attribute__((ext_vector_type(16)));
typedef unsigned u32x4 __attribute__((ext_vector_type(4)));
typedef unsigned u32x2 __attribute__((ext_vector_type(2)));
typedef __bf16 bf2_t __attribute__((ext_vector_type(2)));

constexpr int D = 2048, SEQ = 16384, NB = 16, NS = 16, PAST = 1024, FF = 5504, NL = 2;
constexpr int MP = SEQ, MS = NB * NS, MT = MP + MS;
constexpr int KVS = 1088, KVLEN_S = PAST + NS;
constexpr int KVROWS = MP + NB * KVS;
constexpr int LDU = 12800;
constexpr int IN_COLS = 12888, NWIN = 13056;
constexpr float LOG2E = 1.4426950408889634f;
constexpr float MLA_QSCALE = 0.07216878364870322f * LOG2E;
constexpr float FOX_QSCALE = 0.08838834764831845f * LOG2E;
constexpr float EPS = 1e-6f;
constexpr int UC_QLAT = 0, UC_CKV = 512, UC_Z = 1024, UC_XBC = 2048, UC_FQ = 3584, UC_FK = 4608, UC_FV = 5632, UC_GATE = 6656;
constexpr int UC_OMLA = 0, UC_OSSD = UC_Z, UC_OFOX = UC_FQ;
constexpr int US_KPE = 0, US_DT = 64, US_FF = 80, LDUS = 128;

enum { I_XP = 0, I_XS, I_CCKV, I_CKPE, I_CFK, I_CFV, I_CLOGF, I_SSM, I_CONV, I_F1N, I_F1G, I_F1U, I_F1D, I_MIXN, I_WIN, I_QN, I_WUQ, I_KVN, I_WUKV,
       I_CW, I_CB, I_DTB, I_ALOG, I_SD, I_SN, I_FBF, I_BRM, I_BRS, I_BRF, I_WOUT, I_F2N, I_F2G, I_F2U, I_F2D, I_FN, N_IN };
constexpr size_t O_YP = 0, O_YS = 33554432, O_PCKV = 34078720, O_PKPE = 50855936, O_PFK = 52953088, O_PFV = 86507520, O_PLOGF = 120061952,
                 O_PSSM = 120324096, O_PCONV = 120586240, O_SCKV = 120595456, O_SKPE = 120857600, O_SFK = 120890368, O_SFV = 121414656,
                 O_SLOGF = 121938944, O_SSSM = 121943040, O_SCONV = 126137344, O_TOTAL = 126284800;

constexpr size_t W_GU1 = 0, W_D1 = W_GU1 + (size_t)2 * FF * D, W_IN = W_D1 + (size_t)D * FF, W_UQ = W_IN + (size_t)NWIN * D, W_UKV = W_UQ + (size_t)1536 * 512,
                 W_BR = W_UKV + (size_t)2048 * 512, W_OUT = W_BR + (size_t)3 * 2048 * 1024, W_GU2 = W_OUT + (size_t)D * D, W_D2 = W_GU2 + (size_t)2 * FF * D,
                 W_TOTAL = W_D2 + (size_t)D * FF;

constexpr size_t MiB = 1u << 20;
constexpr size_t al(size_t x) { return (x + MiB - 1) / MiB * MiB; }
constexpr size_t WS_CTL = 0, CTL_BYTES = 1 * MiB;
constexpr size_t WS_ROPE = WS_CTL + CTL_BYTES;
constexpr size_t WS_W = WS_ROPE + al((size_t)SEQ * 32 * 8);
constexpr size_t WS_HB = WS_W;
constexpr size_t WS_XN = WS_W + al(W_TOTAL * 2);
constexpr size_t WS_U = WS_XN + al((size_t)MT * D * 2);
constexpr size_t WS_US = WS_U + al((size_t)MT * LDU * 2);
constexpr size_t WS_DT = WS_US + al((size_t)MT * LDUS * 4);
constexpr size_t WS_QM = WS_DT + al((size_t)MT * 16 * 4);
constexpr size_t WS_CKV = WS_QM + al((size_t)MT * 1536 * 2);
constexpr size_t WS_KM = WS_CKV + al((size_t)KVROWS * 512 * 2);
constexpr size_t WS_VTM = WS_KM + al((size_t)KVROWS * 1536 * 2);
constexpr size_t WS_KFS = WS_VTM + al((size_t)1024 * KVROWS * 2);
constexpr size_t WS_VTF = WS_KFS + al((size_t)NB * KVS * 1024 * 2);
constexpr size_t WS_LOGF = WS_VTF + al((size_t)1024 * KVROWS * 2);
constexpr size_t WS_CUM = WS_LOGF + al((size_t)KVROWS * 8 * 4);
constexpr int NCHUNK = 256 + NB;
constexpr size_t WS_ST = WS_CUM + al((size_t)KVROWS * 8 * 4);
constexpr size_t WS_CDEC = WS_ST + al((size_t)NCHUNK * 131072 * 4);
constexpr size_t WS_PART = WS_CDEC + MiB;
constexpr size_t WS_XB = WS_PART + al((size_t)8 * MS * D * 4);
constexpr size_t WS_SS = WS_XB + al((size_t)MT * D * 2);
constexpr size_t RS_OFF = 196608;
constexpr size_t WS_END = WS_SS + al((size_t)MT * 8 * 4);
static_assert((size_t)MT * 8 <= RS_OFF && (RS_OFF + MT) * 4 <= MiB, "ss / rs");

constexpr int CW_TMO = 0, CW_BAR = 4096;
constexpr int CW_MGC = 12288;
constexpr int CW_QN2 = 8192, CW_KN2 = CW_QN2 + NL * 64 * 8;

constexpr int RING_BYTES = 131072, LDS_BYTES = 163840, LDSCTL_OFF = LDS_BYTES - 512, MISC_OFF = LDSCTL_OFF + 320;

struct Params {
    const float* in[N_IN];
    float* out;
    unsigned char* ws;
    int ph_lo, ph_hi;
};

typedef const __attribute__((address_space(4))) unsigned char* KA;
struct PV { KA k;
    __device__ __forceinline__ const float* in(int i) const { return *(const float* const __attribute__((address_space(4)))*)(k + 8 * i); }
    __device__ __forceinline__ float* out() const { return *(float* const __attribute__((address_space(4)))*)(k + 8 * N_IN); }
    __device__ __forceinline__ unsigned char* ws() const { return *(unsigned char* const __attribute__((address_space(4)))*)(k + 8 * N_IN + 8); }
    __device__ __forceinline__ int ph_lo() const { return *(const __attribute__((address_space(4))) int*)(k + 8 * N_IN + 16); }
    __device__ __forceinline__ int ph_hi() const { return *(const __attribute__((address_space(4))) int*)(k + 8 * N_IN + 20); }
};
__device__ __forceinline__ PV pv_get() { PV v; v.k = (KA)__builtin_amdgcn_kernarg_segment_ptr(); asm volatile("" : "+s"(v.k)); return v; }
static_assert(sizeof(Params) == 8 * N_IN + 24, "Params layout");

#define LDS_WAIT() asm volatile("s_waitcnt lgkmcnt(0)" ::: "memory")
#define VM_WAIT() asm volatile("s_waitcnt vmcnt(0)" ::: "memory")
__device__ __forceinline__ unsigned pk2(float lo, float hi) { bf2_t v = {(__bf16)lo, (__bf16)hi}; return __builtin_bit_cast(unsigned, v); }
__device__ __forceinline__ float bf_lo(unsigned w) { return __uint_as_float(w << 16); }
__device__ __forceinline__ float bf_hi(unsigned w) { return __uint_as_float(w & 0xffff0000u); }
__device__ __forceinline__ float bf2f(bf16_t b) { return __uint_as_float((unsigned)b << 16); }
__device__ __forceinline__ bf16_t f2bf(float f) { return (bf16_t)(pk2(f, 0.f) & 0xffffu); }
__device__ __forceinline__ float shx(float v, int o, int lane) { return __int_as_float(__builtin_amdgcn_ds_bpermute((lane ^ o) << 2, __float_as_int(v))); }
__device__ __forceinline__ float wave_sum(float v, int lane) {
#pragma unroll
    for (int o = 1; o < 64; o <<= 1) v += shx(v, o, lane);
    return v;
}
__device__ __forceinline__ float fast_exp2(float x) { return __builtin_amdgcn_exp2f(x); }
__device__ __forceinline__ float fast_exp(float x) { return __builtin_amdgcn_exp2f(x * LOG2E); }
__device__ __forceinline__ float fast_rsqrt(float x) { return __builtin_amdgcn_rsqf(x); }
__device__ __forceinline__ float fast_log(float x) { return __builtin_amdgcn_logf(x) * 0.6931471805599453f; }
__device__ __forceinline__ float sigmoidf_(float x) { return __builtin_amdgcn_rcpf(1.f + fast_exp2(-x * LOG2E)); }
__device__ __forceinline__ float siluf_(float x) { return x * sigmoidf_(x); }
__device__ __forceinline__ int kvrow_of(int m) { return m < MP ? m : MP + ((m - MP) >> 4) * KVS + PAST + ((m - MP) & 15); }
__device__ __forceinline__ int pos_of(int m) { return m < MP ? m : PAST + ((m - MP) & 15); }

#define XB_TMO      128
#define XB_XCNT(j)  (256  + 64 * (j))
#define XB_XSUB(j)  (1280 + 64 * (j))
#define XB_XGEN(j)  (2304 + 64 * (j))
#define XB_TOP      3328
#define XB_TOPGEN   3392
#define XCD_BAR_WORDS 3456
#define XB_SPIN_CAP (1u << 22)
__device__ __forceinline__ unsigned xb_ld(unsigned* p)              { return __hip_atomic_load(p, __ATOMIC_RELAXED, __HIP_MEMORY_SCOPE_AGENT); }
__device__ __forceinline__ unsigned xb_add(unsigned* p, unsigned v) { return __hip_atomic_fetch_add(p, v, __ATOMIC_RELAXED, __HIP_MEMORY_SCOPE_AGENT); }
__device__ __forceinline__ unsigned xb_xcc_id() { return (unsigned)__builtin_amdgcn_s_getreg((3 << 11) | 20) & 0xFu; }
#define XB_SPIN(cond, bar) do { unsigned _sp = 0; while (cond) { __builtin_amdgcn_s_sleep(1); \
    if ((++_sp & 255u) == 0u) { if (xb_ld(&(bar)[XB_TMO])) break; if (_sp > XB_SPIN_CAP) { atomicAdd(&(bar)[XB_TMO], 1u); break; } } } } while (0)
struct XcdBarrier { unsigned* bar; unsigned x; volatile LAS unsigned* st; };
__device__ __forceinline__ XcdBarrier xcd_barrier_post(unsigned* bar, volatile LAS unsigned* st, int tid) {
    XcdBarrier b; b.bar = bar; b.x = xb_xcc_id(); b.st = st;
    if (tid == 0) (void)xb_add(&bar[XB_XCNT(b.x)], 1u);
    return b;
}
__device__ __forceinline__ void xcd_barrier_complete(unsigned* bar, unsigned x, unsigned& nloc, unsigned& nx) {
    const unsigned G = gridDim.x * gridDim.y * gridDim.z;
    unsigned sum, cnt, mine, sp = 0u;
    for (;;) {
        sum = 0u; cnt = 0u; mine = 0u;
#pragma unroll
        for (unsigned j = 0; j < 16; ++j) { const unsigned c = xb_ld(&bar[XB_XCNT(j)]); sum += c; cnt += (c > 0u) ? 1u : 0u; mine = (j == x) ? c : mine; }
        if (sum == G) break;
        __builtin_amdgcn_s_sleep(1);
        if ((++sp & 255u) == 0u) { if (xb_ld(&bar[XB_TMO])) break; if (sp > XB_SPIN_CAP) { atomicAdd(&bar[XB_TMO], 1u); break; } }
    }
    nloc = mine > 0u ? mine : 1u; nx = cnt > 0u ? cnt : 1u;
}
__device__ __forceinline__ void xcd_barrier(const XcdBarrier& b, int wave_s) {
    asm volatile("s_waitcnt vmcnt(0)" ::: "memory");
    __syncthreads();
    int tid_b; { unsigned z_ = 0u; asm volatile("" : "+s"(z_)); tid_b = wave_s * 64 + (int)__builtin_amdgcn_mbcnt_hi(~0u, __builtin_amdgcn_mbcnt_lo(~0u, z_)); }
    if (tid_b == 0) {
        unsigned* bar = b.bar; asm volatile("" : "+s"(bar));
        __builtin_amdgcn_s_waitcnt(0);
        unsigned nloc = b.st[0], nx = b.st[1];
        if (nloc == 0u) { xcd_barrier_complete(bar, b.x, nloc, nx); b.st[0] = nloc; b.st[1] = nx; }
        const unsigned old = xb_add(&bar[XB_XSUB(b.x)], 1u);
        const unsigned gen = old / nloc;
        if (old + 1u == (gen + 1u) * nloc) {
            __builtin_amdgcn_fence(__ATOMIC_RELEASE, "agent");
            asm volatile("s_waitcnt vmcnt(0)" ::: "memory");
            const unsigned og = xb_add(&bar[XB_TOP], 1u);
            const unsigned tg = og / nx;
            if (og + 1u == (tg + 1u) * nx) xb_add(&bar[XB_TOPGEN], 1u);
            else XB_SPIN(xb_ld(&bar[XB_TOPGEN]) == tg, bar);
            __builtin_amdgcn_fence(__ATOMIC_ACQUIRE, "agent");
            xb_add(&bar[XB_XGEN(b.x)], 1u);
            asm volatile("s_waitcnt vmcnt(0)" ::: "memory");
        } else {
            XB_SPIN(xb_ld(&bar[XB_XGEN(b.x)]) == gen, bar);
            __builtin_amdgcn_fence(__ATOMIC_ACQUIRE, "agent");
            asm volatile("s_waitcnt vmcnt(0)" ::: "memory");
        }
    }
    __syncthreads();
}

namespace pg8 {
constexpr int BM = 256, BK = 64, HALF = 128, HTB = HALF * BK * 2, STAGE_BYTES = 8 * HTB, NXCD = 8, WGM = 8;
__host__ __device__ __forceinline__ int lds_byte(int r, int c) { const int st = (r >> 4) * 2 + (c >> 5), rr = r & 15, cc = c & 31, ob = rr * 64 + cc * 2; return st * 1024 + (ob ^ (((ob >> 9) & 1) << 5)); }
__host__ __device__ __forceinline__ void stage_rc(int b, int& R, int& C) { const int st = b / 1024, sb = b % 1024, swz = sb ^ (((sb >> 9) & 1) << 5); R = (st >> 1) * 16 + swz / 64; C = (st & 1) * 32 + (swz % 64) / 2; }
__host__ __device__ __forceinline__ int perm32(int rho) { const int n = rho >> 4, i = rho & 15; return 8 * (i >> 2) + 4 * n + (i & 3); }
struct Unit { int pm, pn, k0, nt, sp; };
struct Gemm { const bf16_t* A; const bf16_t* Bt; int lda, ldb, M, N, K; size_t ksA = 128, ksB = 128; };
struct StaticOrder {
    int nM, nN, nwg, G, c, ntK; bool nfast; bool nrev = false;
    __host__ __device__ __forceinline__ void init(int M, int N, int G_, int c_, int K_ = 0, bool nfast_ = false) { nM = M / BM; nN = N / BM; nwg = nM * nN; G = G_; c = c_; ntK = K_ / BK; nfast = nfast_; }
    __host__ __device__ __forceinline__ bool next(int i, Unit& u) const {
        const long L = (long)i * G + c; if (L >= nwg) return false;
        int wgid = (int)L; { const int q = nwg / NXCD, r = nwg % NXCD, xcd = wgid % NXCD, off = wgid / NXCD; wgid = (xcd < r ? xcd * (q + 1) : r * (q + 1) + (xcd - r) * q) + off; }
        const int nig = WGM * nN, gid = wgid / nig, fm = gid * WGM, gsz = (nM - fm) < WGM ? (nM - fm) : WGM;
        const int ig = wgid % nig;
        u.pm = nfast ? fm + ig / nN : fm + (ig % gsz); u.pn = nfast ? ig % nN : ig / gsz; if (nrev) u.pn = nN - 1 - u.pn; u.k0 = 0; u.nt = ntK; u.sp = 0; return true;
    }
    __device__ __forceinline__ void a_ready(const Unit&) const {}
    __device__ __forceinline__ void done(const Unit&) const {}
    __device__ __forceinline__ size_t a_extra(const Unit&) const { return 0; }
};
struct SplitOrder : StaticOrder {
    __host__ __device__ __forceinline__ void init(int M, int N, int G_, int c_, int K_) { StaticOrder::init(M - BM, N, G_, c_, K_, true); }
    __host__ __device__ __forceinline__ bool next(int i, Unit& u) const {
        const long L = (long)i * G + c;
        const bool reg = L < nwg; const int idx = (int)(L - nwg);
        const int ns = 8;
        if (!reg && idx >= nN * ns) return false;
        Unit a; a.pm = 0; a.pn = 0; a.k0 = 0; a.nt = ntK; a.sp = 0;
        if (reg) { Unit t; StaticOrder::next(i, t); a.pm = t.pm; a.pn = t.pn; }
        const int sp = idx / nN;
        const int base = (ntK / ns) & ~1, extra = (ntK - ns * base) / 2;
        const int s_nt = base + (sp < extra ? 2 : 0), s_k0 = base * sp + 2 * (sp < extra ? sp : extra);
        u.pm = reg ? a.pm : nM; u.pn = reg ? a.pn : idx % nN; u.k0 = reg ? 0 : s_k0; u.nt = reg ? ntK : s_nt; u.sp = reg ? 0 : sp;
        return true;
    }
};
struct SampleMergeOrder {
    int c;
    __host__ __device__ __forceinline__ bool next(int i, Unit& u) const {
        if (i != 0 || c >= 24) return false;
        u.pm = MP / BM; u.pn = c; u.k0 = 0; u.nt = 16; u.sp = 0; return true;
    }
    __device__ __forceinline__ void a_ready(const Unit&) const {}
    __device__ __forceinline__ void done(const Unit&) const {}
    __device__ __forceinline__ size_t a_extra(const Unit& u) const { const int br = u.pn >> 3; return (size_t)(br == 0 ? UC_OMLA : (br == 1 ? UC_OSSD : UC_OFOX)) * 2; }
};
template <class Epi, class Sched, bool ALIGN_EPI = false, bool SP2 = false>
__device__ __forceinline__ void gemm_phase(LAS unsigned char* lds, const Gemm g, const Sched& S, const Epi& E, int wave_s) {
    int tid_; { unsigned z_ = 0u; asm volatile("" : "+s"(z_)); tid_ = wave_s * 64 + (int)__builtin_amdgcn_mbcnt_hi(~0u, __builtin_amdgcn_mbcnt_lo(~0u, z_)); }
    const int tid = tid_, wid = __builtin_amdgcn_readfirstlane(tid >> 6), lane = tid & 63, wr = wid >> 2, wc = wid & 3, fr = lane & 15, fq = lane >> 4;
    unsigned voffA[2], voffB[2];
#pragma unroll
    for (int i = 0; i < 2; ++i) { int R, C; stage_rc(tid * 16 + i * 8192, R, C); const int Rb = Epi::PERM ? ((R & ~31) + perm32(R & 31)) : R;
        voffA[i] = (unsigned)(R * g.lda + C) * 2u; voffB[i] = (unsigned)(Rb * g.ldb + C) * 2u; }
    const size_t kstepA = g.ksA, kstepB = g.ksB;
    const size_t hstepA = (size_t)HALF * g.lda * 2, hstepB = (size_t)HALF * g.ldb * 2;
    const size_t tstepA = 2 * hstepA, tstepB = 2 * hstepB;
    const unsigned ldsw = (unsigned)wid * 1024u;
    const int aoff = lds_byte(wr * 64 + fr, fq * 8), boff = lds_byte(wc * 32 + fr, fq * 8);
#define PG8_SA(b, h) (((b) * 2 + (h)) * HTB)
#define PG8_SB(b, h) ((4 + (b) * 2 + (h)) * HTB)
#define PG8_STAGE(bufoff, gbase, voff) do { _Pragma("unroll") for (int _i = 0; _i < 2; ++_i) \
        __builtin_amdgcn_global_load_lds((const unsigned*)((const char*)(gbase) + (voff)[_i]), (LAS unsigned*)(lds + (bufoff) + ldsw + _i * 8192), 16, 0, 0); } while (0)
#define PG8_LDA(dst, b, h) do { _Pragma("unroll") for (int m = 0; m < 4; ++m) _Pragma("unroll") for (int k = 0; k < 2; ++k) dst[m][k] = *(const LAS bf16x8*)(lds + PG8_SA(b, h) + aoff + m * 2048 + k * 1024); } while (0)
#define PG8_LDB(dst, b, h) do { _Pragma("unroll") for (int n = 0; n < 2; ++n) _Pragma("unroll") for (int k = 0; k < 2; ++k) dst[n][k] = *(const LAS bf16x8*)(lds + PG8_SB(b, h) + boff + n * 2048 + k * 1024); } while (0)
#define PG8_MMA(ai, bj, At, Bt) do { __builtin_amdgcn_s_setprio(1); _Pragma("unroll") for (int m = 0; m < 4; ++m) _Pragma("unroll") for (int n = 0; n < 2; ++n) _Pragma("unroll") for (int k = 0; k < 2; ++k) \
        acc[ai][bj][m][n] = __builtin_amdgcn_mfma_f32_16x16x32_bf16(Bt[n][k], At[m][k], acc[ai][bj][m][n], 0, 0, 0); __builtin_amdgcn_s_setprio(0); } while (0)
#define PG8_WAIT_V(n) asm volatile("s_waitcnt vmcnt(" #n ")" ::: "memory")
#define PG8_WAIT_L(n) asm volatile("s_waitcnt lgkmcnt(" #n ")" ::: "memory")
#define PG8_BAR __builtin_amdgcn_s_barrier()
#define PG8_SCHED __builtin_amdgcn_sched_barrier(0)
    Unit cur, nxt; int ui = 0;
    if (!S.next(0, cur)) return;
    float zf_ = 0.f; asm volatile("" : "+v"(zf_));
    const f32x4 zero4 = {zf_, zf_, zf_, zf_};
    f32x4 acc[2][2][4][2];
#pragma unroll
    for (int a = 0; a < 2; ++a)
#pragma unroll
        for (int b = 0; b < 2; ++b)
#pragma unroll
            for (int m = 0; m < 4; ++m)
#pragma unroll
                for (int n = 0; n < 2; ++n) acc[a][b][m][n] = zero4;
    bf16x8 At[4][2], B0[2][2], B1[2][2];
    const char* cA = (const char*)g.A + (size_t)cur.pm * tstepA + (size_t)cur.k0 * kstepA + S.a_extra(cur); const char* cB = (const char*)g.Bt + (size_t)cur.pn * tstepB + (size_t)cur.k0 * kstepB;
    S.a_ready(cur);
    if constexpr (SP2) {
        PG8_STAGE(PG8_SB(0, 0), cB, voffB); PG8_STAGE(PG8_SB(0, 1), cB + hstepB, voffB); PG8_STAGE(PG8_SA(0, 0), cA, voffA); PG8_STAGE(PG8_SA(0, 1), cA + hstepA, voffA);
        if (wr == 1) PG8_BAR;
        PG8_WAIT_V(2); PG8_BAR;
        PG8_STAGE(PG8_SB(1, 0), cB + kstepB, voffB); PG8_STAGE(PG8_SA(1, 0), cA + kstepA, voffA); PG8_STAGE(PG8_SB(1, 1), cB + hstepB + kstepB, voffB);
        PG8_WAIT_V(6); PG8_BAR;
    } else {
        PG8_STAGE(PG8_SB(0, 0), cB, voffB); PG8_STAGE(PG8_SA(0, 0), cA, voffA); PG8_STAGE(PG8_SB(0, 1), cB + hstepB, voffB); PG8_STAGE(PG8_SA(0, 1), cA + hstepA, voffA);
        if (wr == 1) PG8_BAR;
        PG8_WAIT_V(4); PG8_BAR;
        PG8_STAGE(PG8_SB(1, 0), cB + kstepB, voffB); PG8_STAGE(PG8_SA(1, 0), cA + kstepA, voffA); PG8_STAGE(PG8_SB(1, 1), cB + hstepB + kstepB, voffB);
        PG8_WAIT_V(6); PG8_BAR;
    }
    for (;;) {
        float st0 = 0.f, st1 = 0.f;
        if constexpr (Epi::PRE) E.pre(cur, wr, lane, st0, st1);
        const bool has_next = S.next(ui + 1, nxt);
        const char* nA = has_next ? (const char*)g.A + (size_t)nxt.pm * tstepA + (size_t)nxt.k0 * kstepA + S.a_extra(nxt) : cA; const char* nB = has_next ? (const char*)g.Bt + (size_t)nxt.pn * tstepB + (size_t)nxt.k0 * kstepB : cB;
        const int nt = cur.nt;
        for (int t = 0; t < nt; t += 2) {
            const bool last = (t == nt - 2);
            const char* a1 = cA + (size_t)(t + 1) * kstepA;
            const char* a2 = last ? nA : cA + (size_t)(t + 2) * kstepA; const char* b2 = last ? nB : cB + (size_t)(t + 2) * kstepB;
            const char* a3 = a2 + kstepA; const char* b3 = b2 + kstepB;
            if (last && has_next) S.a_ready(nxt);
            if constexpr (SP2) {
            PG8_LDB(B0, 0, 0); PG8_LDB(B1, 0, 1); PG8_SCHED; PG8_LDA(At, 0, 0); PG8_STAGE(PG8_SA(1, 1), a1 + hstepA, voffA);
            PG8_WAIT_V(8); PG8_WAIT_L(0); PG8_BAR; PG8_MMA(0, 0, At, B0); PG8_MMA(0, 1, At, B1); PG8_BAR; PG8_SCHED;
            PG8_LDA(At, 0, 1); PG8_STAGE(PG8_SB(0, 0), b2, voffB); PG8_STAGE(PG8_SB(0, 1), b2 + hstepB, voffB); PG8_STAGE(PG8_SA(0, 0), a2, voffA);
            PG8_WAIT_V(8); PG8_WAIT_L(0); PG8_BAR; PG8_MMA(1, 0, At, B0); PG8_MMA(1, 1, At, B1); PG8_BAR; PG8_SCHED;
            PG8_LDB(B0, 1, 0); PG8_LDB(B1, 1, 1); PG8_SCHED; PG8_LDA(At, 1, 0); PG8_STAGE(PG8_SA(0, 1), a2 + hstepA, voffA);
            PG8_WAIT_V(8); PG8_WAIT_L(0); PG8_BAR; PG8_MMA(0, 0, At, B0); PG8_MMA(0, 1, At, B1); PG8_BAR; PG8_SCHED;
            PG8_LDA(At, 1, 1); PG8_STAGE(PG8_SB(1, 0), b3, voffB); PG8_STAGE(PG8_SB(1, 1), b3 + hstepB, voffB); PG8_STAGE(PG8_SA(1, 0), a3, voffA);
            PG8_WAIT_V(8); PG8_WAIT_L(0); PG8_BAR; PG8_MMA(1, 0, At, B0); PG8_MMA(1, 1, At, B1); PG8_BAR; PG8_SCHED;
            } else {
            PG8_LDB(B0, 0, 0); PG8_SCHED; PG8_LDA(At, 0, 0); PG8_STAGE(PG8_SA(1, 1), a1 + hstepA, voffA);
            PG8_WAIT_L(8); PG8_BAR; PG8_WAIT_L(0); PG8_MMA(0, 0, At, B0); PG8_BAR; PG8_SCHED;
            PG8_LDB(B1, 0, 1); PG8_STAGE(PG8_SB(0, 0), b2, voffB);
            PG8_BAR; PG8_WAIT_L(0); PG8_MMA(0, 1, At, B1); PG8_BAR;
            PG8_LDA(At, 0, 1); PG8_STAGE(PG8_SA(0, 0), a2, voffA);
            PG8_BAR; PG8_WAIT_L(0); PG8_MMA(1, 0, At, B0); PG8_BAR; PG8_SCHED;
            PG8_STAGE(PG8_SB(0, 1), b2 + hstepB, voffB);
            PG8_WAIT_V(6); PG8_BAR; PG8_MMA(1, 1, At, B1); PG8_BAR;
            PG8_LDB(B0, 1, 0); PG8_SCHED; PG8_LDA(At, 1, 0); PG8_STAGE(PG8_SA(0, 1), a2 + hstepA, voffA);
            PG8_WAIT_L(8); PG8_BAR; PG8_WAIT_L(0); PG8_MMA(0, 0, At, B0); PG8_BAR; PG8_SCHED;
            PG8_LDB(B1, 1, 1); PG8_STAGE(PG8_SB(1, 0), b3, voffB);
            PG8_BAR; PG8_WAIT_L(0); PG8_MMA(0, 1, At, B1); PG8_BAR;
            PG8_LDA(At, 1, 1); PG8_STAGE(PG8_SA(1, 0), a3, voffA);
            PG8_BAR; PG8_WAIT_L(0); PG8_MMA(1, 0, At, B0); PG8_BAR; PG8_SCHED;
            PG8_STAGE(PG8_SB(1, 1), b3 + hstepB, voffB);
            PG8_WAIT_V(6); PG8_BAR; PG8_MMA(1, 1, At, B1); PG8_BAR;
            }
        }
        if constexpr (ALIGN_EPI) { if (wr == 0) PG8_BAR; }
        if constexpr (Epi::PRE) E(acc, cur, wr, wc, fr, fq, st0, st1); else E(acc, cur, wr, wc, fr, fq);
        S.done(cur);
        if (!has_next) break;
#pragma unroll
        for (int a = 0; a < 2; ++a)
#pragma unroll
            for (int b = 0; b < 2; ++b)
#pragma unroll
                for (int m = 0; m < 4; ++m)
#pragma unroll
                    for (int n = 0; n < 2; ++n) acc[a][b][m][n] = zero4;
        cur = nxt; cA = nA; cB = nB; ++ui;
        if constexpr (ALIGN_EPI) { if (wr == 1) PG8_BAR; }
    }
    PG8_WAIT_V(0);
    if constexpr (!ALIGN_EPI) { if (wr == 0) PG8_BAR; }
    PG8_BAR;
#undef PG8_SA
#undef PG8_SB
#undef PG8_STAGE
#undef PG8_LDA
#undef PG8_LDB
#undef PG8_MMA
#undef PG8_WAIT_V
#undef PG8_WAIT_L
#undef PG8_BAR
#undef PG8_SCHED
}
}
using pg8::Unit;
typedef const f32x4 (&AccRef)[2][2][4][2];

__device__ __forceinline__ void rs_pre(const float* RS, int pm, int wr, int lane, float& a, float& b) { const float* q = RS + pm * 256 + wr * 64 + lane; a = q[0]; b = q[128]; }
__device__ __forceinline__ void row_rs(float st0, float st1, int fr, float (&rs)[2][4]) {
#pragma unroll
    for (int ai = 0; ai < 2; ++ai)
#pragma unroll
        for (int m = 0; m < 4; ++m) rs[ai][m] = __int_as_float(__builtin_amdgcn_ds_bpermute((m * 16 + fr) << 2, __float_as_int(ai ? st1 : st0)));
}
struct EpiSwiGLU {
    static constexpr bool PERM = true; static constexpr bool PRE = true;
    bf16_t* H; const float* SS;
    __device__ __forceinline__ void pre(const Unit& u, int wr, int lane, float& a, float& b) const { rs_pre(SS, u.pm, wr, lane, a, b); }
    __device__ __forceinline__ void operator()(AccRef acc, const Unit& u, int wr, int wc, int fr, int fq, float st0, float st1) const {
        const int row0 = u.pm * 256 + wr * 64 + fr, col0 = u.pn * 128 + wc * 32 + 8 * fq;
        float rs[2][4]; row_rs(st0, st1, fr, rs);
#pragma unroll
        for (int ai = 0; ai < 2; ++ai)
#pragma unroll
            for (int m = 0; m < 4; ++m) {
                const float r_ = rs[ai][m]; const f32x4 g0 = acc[ai][0][m][0] * r_, g1 = acc[ai][0][m][1] * r_, u0 = acc[ai][1][m][0] * r_, u1 = acc[ai][1][m][1] * r_;
                u32x4 w;
                w.x = pk2(siluf_(g0[0]) * u0[0], siluf_(g0[1]) * u0[1]); w.y = pk2(siluf_(g0[2]) * u0[2], siluf_(g0[3]) * u0[3]);
                w.z = pk2(siluf_(g1[0]) * u1[0], siluf_(g1[1]) * u1[1]); w.w = pk2(siluf_(g1[2]) * u1[2], siluf_(g1[3]) * u1[3]);
                *(u32x4*)(H + (size_t)(col0 >> 6) * ((size_t)MT * 64) + (size_t)(row0 + ai * 128 + m * 16) * 64 + (col0 & 63)) = w;
            }
    }
};
struct EpiResid {
    static constexpr bool PERM = true; static constexpr bool PRE = false;
    bf16_t* xb; float* ss; float alpha; float* part; LAS float* red;
    __device__ __forceinline__ void operator()(AccRef acc, const Unit& u, int wr, int wc, int fr, int fq) const {
        const int row0 = u.pm * 256 + wr * 64 + fr, col0 = u.pn * 256 + wc * 32 + 8 * fq;
        if (u.pm * 256 >= MP) {
            float* pb_ = part + ((size_t)u.sp * MS - MP) * D;
#pragma unroll
            for (int ai = 0; ai < 2; ++ai)
#pragma unroll
                for (int m = 0; m < 4; ++m) { float* o = pb_ + (size_t)(row0 + ai * 128 + m * 16) * D + col0;
#pragma unroll
                    for (int bj = 0; bj < 2; ++bj)
#pragma unroll
                        for (int n = 0; n < 2; ++n) *(f32x4*)(o + bj * 128 + n * 4) = acc[ai][bj][m][n] * alpha; }
            return;
        }
        bf16_t* xq = xb + (size_t)(col0 >> 6) * ((size_t)MT * 64) + (size_t)row0 * 64 + (col0 & 63);
        const int lane = fq * 16 + fr;
#pragma unroll
        for (int ai = 0; ai < 2; ++ai) {
            u32x4 b[4][2];
#pragma unroll
            for (int m = 0; m < 4; ++m)
#pragma unroll
                for (int bj = 0; bj < 2; ++bj) b[m][bj] = *(const u32x4*)(xq + (size_t)(2 * bj) * ((size_t)MT * 64) + (size_t)(ai * 128 + m * 16) * 64);
#pragma unroll
            for (int m = 0; m < 4; ++m) { float sq = 0.f;
#pragma unroll
                for (int bj = 0; bj < 2; ++bj) { const u32x4 x = b[m][bj];
                    const f32x4 x0 = {bf_lo(x.x), bf_hi(x.x), bf_lo(x.y), bf_hi(x.y)}, x1 = {bf_lo(x.z), bf_hi(x.z), bf_lo(x.w), bf_hi(x.w)};
                    const f32x4 a0 = x0 + acc[ai][bj][m][0] * alpha, a1 = x1 + acc[ai][bj][m][1] * alpha;
                    sq += ((a0[0] * a0[0] + a0[1] * a0[1]) + (a0[2] * a0[2] + a0[3] * a0[3])) + ((a1[0] * a1[0] + a1[1] * a1[1]) + (a1[2] * a1[2] + a1[3] * a1[3]));
                    u32x4 w; w.x = pk2(a0[0], a0[1]); w.y = pk2(a0[2], a0[3]); w.z = pk2(a1[0], a1[1]); w.w = pk2(a1[2], a1[3]);
                    *(u32x4*)(xq + (size_t)(2 * bj) * ((size_t)MT * 64) + (size_t)(ai * 128 + m * 16) * 64) = w; }
                sq += shx(sq, 16, lane); sq += shx(sq, 32, lane);
                if (fq == 0) red[wc * 256 + ai * 128 + wr * 64 + m * 16 + fr] = sq; }
        }
        asm volatile("s_waitcnt lgkmcnt(0)" ::: "memory");
        __builtin_amdgcn_s_barrier();
        asm volatile("" ::: "memory");
        const int t = (wr * 4 + wc) * 64 + lane;
        if (t < 256) ss[(size_t)(u.pm * 256 + t) * 8 + u.pn] = (red[t] + red[256 + t]) + (red[512 + t] + red[768 + t]);
    }
};
struct EpiWin {
    static constexpr bool PERM = true; static constexpr bool PRE = true;
    bf16_t* U; float* US; float* fk_p; float* fk_s; float* fv_p; float* fv_s;
    const float* SS;
    __device__ __forceinline__ void pre(const Unit& u, int wr, int lane, float& a, float& b) const { rs_pre(SS, u.pm, wr, lane, a, b); }
    __device__ __forceinline__ void operator()(AccRef acc, const Unit& u, int wr, int wc, int fr, int fq, float st0, float st1) const {
        const int row0 = u.pm * 256 + wr * 64 + fr, cw = wc * 32 + 8 * fq;
        const int pn = u.pn;
        float rs[2][4]; row_rs(st0, st1, fr, rs);
        if (pn < 26) {
            float* fo = nullptr;
            if (pn >= 18) { const bool isv = pn >= 22; const int hc = (pn - (isv ? 22 : 18)) * 256;
                fo = (u.pm * 256 < MP) ? (isv ? fv_p : fk_p) : (isv ? fv_s : fk_s) - (size_t)MP * 1024; fo += hc; }
#pragma unroll
            for (int ai = 0; ai < 2; ++ai)
#pragma unroll
                for (int m = 0; m < 4; ++m) { const int row = row0 + ai * 128 + m * 16;
#pragma unroll
                    for (int bj = 0; bj < 2; ++bj) { const f32x4 v0 = acc[ai][bj][m][0] * rs[ai][m], v1 = acc[ai][bj][m][1] * rs[ai][m];
                        u32x4 w; w.x = pk2(v0[0], v0[1]); w.y = pk2(v0[2], v0[3]); w.z = pk2(v1[0], v1[1]); w.w = pk2(v1[2], v1[3]);
                        *(u32x4*)(U + (size_t)row * LDU + pn * 256 + bj * 128 + cw) = w;
                        if (fo) { float* o = fo + (size_t)row * 1024 + bj * 128 + cw; *(f32x4*)o = v0; *(f32x4*)(o + 4) = v1; } } }
        } else if (pn < 50) {
#pragma unroll
            for (int ai = 0; ai < 2; ++ai)
#pragma unroll
                for (int m = 0; m < 4; ++m) { const int row = row0 + ai * 128 + m * 16;
#pragma unroll
                    for (int bj = 0; bj < 2; ++bj) { const f32x4 v0 = acc[ai][bj][m][0] * rs[ai][m], v1 = acc[ai][bj][m][1] * rs[ai][m];
                        u32x4 w; w.x = pk2(sigmoidf_(v0[0]), sigmoidf_(v0[1])); w.y = pk2(sigmoidf_(v0[2]), sigmoidf_(v0[3]));
                        w.z = pk2(sigmoidf_(v1[0]), sigmoidf_(v1[1])); w.w = pk2(sigmoidf_(v1[2]), sigmoidf_(v1[3]));
                        *(u32x4*)(U + (size_t)row * LDU + pn * 256 + bj * 128 + cw) = w; } }
        } else {
#pragma unroll
            for (int ai = 0; ai < 2; ++ai)
#pragma unroll
                for (int m = 0; m < 4; ++m) { const int row = row0 + ai * 128 + m * 16;
                    float* o = US + (size_t)row * LDUS + cw; *(f32x4*)o = acc[ai][0][m][0] * rs[ai][m]; *(f32x4*)(o + 4) = acc[ai][0][m][1] * rs[ai][m]; }
        }
    }
};
struct EpiUq {
    static constexpr bool PERM = true; static constexpr bool PRE = false;
    bf16_t* Q; const f32x2* rope;
    __device__ __forceinline__ void operator()(AccRef acc, const Unit& u, int wr, int wc, int fr, int fq) const {
        const int row0 = u.pm * 256 + wr * 64 + fr;
#pragma unroll
        for (int bj = 0; bj < 2; ++bj) {
            const int c0 = u.pn * 256 + bj * 128 + wc * 32 + 8 * fq, r = c0 % 192;
            const bool isrope = r >= 128; const int j0 = (r - 128) >> 1;
#pragma unroll
            for (int ai = 0; ai < 2; ++ai)
#pragma unroll
                for (int m = 0; m < 4; ++m) { const int row = row0 + ai * 128 + m * 16;
                    f32x4 v0 = acc[ai][bj][m][0], v1 = acc[ai][bj][m][1];
                    if (isrope) { const f32x2* cs = rope + (size_t)pos_of(row) * 32 + j0;
                        const f32x2 a = cs[0], b = cs[1], c = cs[2], d = cs[3];
                        const f32x4 t0 = v0, t1 = v1;
                        v0[0] = t0[0] * a.x - t0[1] * a.y; v0[1] = t0[1] * a.x + t0[0] * a.y; v0[2] = t0[2] * b.x - t0[3] * b.y; v0[3] = t0[3] * b.x + t0[2] * b.y;
                        v1[0] = t1[0] * c.x - t1[1] * c.y; v1[1] = t1[1] * c.x + t1[0] * c.y; v1[2] = t1[2] * d.x - t1[3] * d.y; v1[3] = t1[3] * d.x + t1[2] * d.y; }
                    u32x4 w; w.x = pk2(v0[0], v0[1]); w.y = pk2(v0[2], v0[3]); w.z = pk2(v1[0], v1[1]); w.w = pk2(v1[2], v1[3]);
                    *(u32x4*)(Q + (size_t)row * 1536 + c0) = w; }
        }
    }
};
struct EpiUkv {
    static constexpr bool PERM = true; static constexpr bool PRE = false;
    bf16_t* KM; bf16_t* VT;
    __device__ __forceinline__ void operator()(AccRef acc, const Unit& u, int wr, int wc, int fr, int fq) const {
        const int row0 = u.pm * 256 + wr * 64 + fr, h = u.pn, d0 = wc * 32 + 8 * fq;
#pragma unroll
        for (int ai = 0; ai < 2; ++ai)
#pragma unroll
            for (int m = 0; m < 4; ++m) { const int row = row0 + ai * 128 + m * 16;
                { const f32x4 v0 = acc[ai][0][m][0], v1 = acc[ai][0][m][1];
                  u32x4 w; w.x = pk2(v0[0], v0[1]); w.y = pk2(v0[2], v0[3]); w.z = pk2(v1[0], v1[1]); w.w = pk2(v1[2], v1[3]);
                  *(u32x4*)(KM + ((size_t)row * 8 + h) * 192 + d0) = w; }
                { const f32x4 v0 = acc[ai][1][m][0], v1 = acc[ai][1][m][1];
                  bf16_t* vt = VT + (size_t)(h * 128 + d0) * KVROWS + row;
#pragma unroll
                  for (int j = 0; j < 4; ++j) { vt[(size_t)j * KVROWS] = f2bf(v0[j]); vt[(size_t)(j + 4) * KVROWS] = f2bf(v1[j]); } } }
    }
};
template <int BR> struct EpiMerge {
    static constexpr bool PERM = true; static constexpr bool PRE = false;
    const bf16_t* U; bf16_t* MG;
    __device__ __forceinline__ void operator()(AccRef acc, const Unit& u, int wr, int wc, int fr, int fq) const {
        const int row0 = u.pm * 256 + wr * 64 + fr, colb = u.pn * 256 + wc * 32 + 8 * fq;
#pragma unroll
        for (int ai = 0; ai < 2; ++ai) {
            u32x4 gt[4][2], od[4][2];
#pragma unroll
            for (int m = 0; m < 4; ++m) { const int row = row0 + ai * 128 + m * 16;
#pragma unroll
                for (int bj = 0; bj < 2; ++bj) { gt[m][bj] = *(const u32x4*)(U + (size_t)row * LDU + UC_GATE + BR * D + colb + bj * 128);
                    if (BR > 0) od[m][bj] = *(const u32x4*)(MG + (size_t)row * D + colb + bj * 128); } }
#pragma unroll
            for (int m = 0; m < 4; ++m) { const int row = row0 + ai * 128 + m * 16;
#pragma unroll
                for (int bj = 0; bj < 2; ++bj) { const u32x4 g = gt[m][bj];
                    f32x4 v0 = acc[ai][bj][m][0], v1 = acc[ai][bj][m][1];
                    v0[0] *= bf_lo(g.x); v0[1] *= bf_hi(g.x); v0[2] *= bf_lo(g.y); v0[3] *= bf_hi(g.y);
                    v1[0] *= bf_lo(g.z); v1[1] *= bf_hi(g.z); v1[2] *= bf_lo(g.w); v1[3] *= bf_hi(g.w);
                    if (BR > 0) { const u32x4 o = od[m][bj];
                        v0[0] += bf_lo(o.x); v0[1] += bf_hi(o.x); v0[2] += bf_lo(o.y); v0[3] += bf_hi(o.y);
                        v1[0] += bf_lo(o.z); v1[1] += bf_hi(o.z); v1[2] += bf_lo(o.w); v1[3] += bf_hi(o.w); }
                    u32x4 w; w.x = pk2(v0[0], v0[1]); w.y = pk2(v0[2], v0[3]); w.z = pk2(v1[0], v1[1]); w.w = pk2(v1[2], v1[3]);
                    *(u32x4*)(MG + (size_t)row * D + colb + bj * 128) = w; } }
        }
    }
};

struct EpiMergeSample {
    static constexpr bool PERM = true; static constexpr bool PRE = false;
    const bf16_t* U; bf16_t* MG; float* part; unsigned* cnt; LAS unsigned* flag;
    __device__ __forceinline__ void operator()(AccRef acc, const Unit& u, int wr, int wc, int fr, int fq) const {
        const int br = u.pn >> 3, pn8 = u.pn & 7;
        const int row0 = wr * 64 + fr, colb = pn8 * 256 + wc * 32 + 8 * fq;
        float* pb = part + (size_t)br * MS * D;
#pragma unroll
        for (int ai = 0; ai < 2; ++ai)
#pragma unroll
            for (int m = 0; m < 4; ++m) { const int row = row0 + ai * 128 + m * 16;
#pragma unroll
                for (int bj = 0; bj < 2; ++bj) { const u32x4 g = *(const u32x4*)(U + (size_t)(MP + row) * LDU + UC_GATE + br * D + colb + bj * 128);
                    f32x4 v0 = acc[ai][bj][m][0], v1 = acc[ai][bj][m][1];
                    v0[0] *= bf_lo(g.x); v0[1] *= bf_hi(g.x); v0[2] *= bf_lo(g.y); v0[3] *= bf_hi(g.y);
                    v1[0] *= bf_lo(g.z); v1[1] *= bf_hi(g.z); v1[2] *= bf_lo(g.w); v1[3] *= bf_hi(g.w);
                    unsigned long long* o = (unsigned long long*)(pb + (size_t)row * D + colb + bj * 128);
                    __hip_atomic_store(o + 0, ((unsigned long long)__float_as_uint(v0[1]) << 32) | __float_as_uint(v0[0]), __ATOMIC_RELAXED, __HIP_MEMORY_SCOPE_AGENT);
                    __hip_atomic_store(o + 1, ((unsigned long long)__float_as_uint(v0[3]) << 32) | __float_as_uint(v0[2]), __ATOMIC_RELAXED, __HIP_MEMORY_SCOPE_AGENT);
                    __hip_atomic_store(o + 2, ((unsigned long long)__float_as_uint(v1[1]) << 32) | __float_as_uint(v1[0]), __ATOMIC_RELAXED, __HIP_MEMORY_SCOPE_AGENT);
                    __hip_atomic_store(o + 3, ((unsigned long long)__float_as_uint(v1[3]) << 32) | __float_as_uint(v1[2]), __ATOMIC_RELAXED, __HIP_MEMORY_SCOPE_AGENT); } }
        asm volatile("s_waitcnt vmcnt(0)" ::: "memory");
        __builtin_amdgcn_s_barrier();
        const int t = (wr * 4 + wc) * 64 + fq * 16 + fr;
        if (t == 0) { const unsigned old = __hip_atomic_fetch_add(cnt + 64 * pn8, 1u, __ATOMIC_RELAXED, __HIP_MEMORY_SCOPE_AGENT); *flag = (old == 2u) ? 1u : 0u; }
        asm volatile("s_waitcnt vmcnt(0) lgkmcnt(0)" ::: "memory");
        __builtin_amdgcn_s_barrier();
        asm volatile("" ::: "memory");
        if (*flag != 0u) {
            __builtin_amdgcn_fence(__ATOMIC_ACQUIRE, "agent");
            asm volatile("s_waitcnt vmcnt(0)" ::: "memory");
#pragma unroll 2
            for (int k = 0; k < 16; ++k) { const int e = (k * 512 + t) * 8, r = e >> 8, c = e & 255;
                const float* src = part + (size_t)r * D + pn8 * 256 + c;
                f32x4 a = *(const f32x4*)src, b = *(const f32x4*)(src + 4);
                a = a + *(const f32x4*)(src + (size_t)MS * D) + *(const f32x4*)(src + (size_t)2 * MS * D);
                b = b + *(const f32x4*)(src + (size_t)MS * D + 4) + *(const f32x4*)(src + (size_t)2 * MS * D + 4);
                u32x4 w; w.x = pk2(a[0], a[1]); w.y = pk2(a[2], a[3]); w.z = pk2(b[0], b[1]); w.w = pk2(b[2], b[3]);
                *(u32x4*)(MG + (size_t)(MP + r) * D + pn8 * 256 + c) = w; }
        }
    }
};

struct Frame {
    LAS unsigned char* lds;
    int tid, lane, wave, vcu, G, bx;
    int gw, NGW;
};
__device__ __forceinline__ int lane_now() { unsigned z = 0u; asm volatile("" : "+s"(z)); return (int)__builtin_amdgcn_mbcnt_hi(~0u, __builtin_amdgcn_mbcnt_lo(~0u, z)); }
__device__ __forceinline__ Frame mk_frame(int wave_s) {
    extern __shared__ __attribute__((aligned(16))) unsigned char lds_raw[];
    Frame F; F.lds = (LAS unsigned char*)lds_raw;
    asm volatile("" : "+s"(wave_s)); const int t = wave_s * 64 + lane_now();
    int bx = blockIdx.x, G = gridDim.x; asm volatile("" : "+s"(bx), "+s"(G));
    F.tid = t; F.lane = t & 63; F.wave = __builtin_amdgcn_readfirstlane(t >> 6);
    F.G = G; F.bx = bx; F.vcu = (G % 8 == 0) ? (bx % 8) * (G / 8) + bx / 8 : bx;
    F.gw = F.vcu * 8 + F.wave; F.NGW = G * 8;
    return F;
}

template <int KIND> __device__ __forceinline__ int map_row(int n, float& sc) {
    sc = 1.f;
    if (KIND == 0) return n;
    if (KIND == 1) return 256 * (n >> 7) + (n & 127);
    if (KIND == 2) return 256 * (n >> 7) + 128 + (n & 127);
    if (KIND == 3) {
        if (n < 1024) return n;
        if (n < 1088) return 12800 + (n - 1024);
        if (n < 2112) return UC_Z + (n - 1088);
        if (n < 3648) return UC_XBC + (n - 2112);
        if (n < 3664) return 12864 + (n - 3648);
        if (n < 4688) { sc = FOX_QSCALE; return UC_FQ + (n - 3664); }
        if (n < 5712) return UC_FK + (n - 4688);
        if (n < 6736) return UC_FV + (n - 5712);
        if (n < 6744) return 12880 + (n - 6736);
        return UC_GATE + (n - 6744);
    }
    if (KIND == 4) {
        sc = MLA_QSCALE; const int h = n / 192, r = n % 192;
        if (r < 128) return n;
        const int rr = r - 128; return h * 192 + 128 + 2 * (rr & 31) + (rr >> 5);
    }
    return n;
}
template <int KIND>
__device__ __forceinline__ void cvt_item(const float* W, int N, bf16_t* WT, size_t ldo, size_t coloff, LAS float* scr, int item, int lane, size_t kblk = 0, const float* kg = nullptr) {
    const int nblk = (N + 31) / 32, kb = item / nblk, nb = item % nblk, k0 = 64 * kb, n0 = 32 * nb;
    const int nn = n0 + (lane & 31); const bool ok = nn < N;
    f32x4 kg0 = {1.f, 1.f, 1.f, 1.f}, kg1 = kg0;
    if (kg) { kg0 = *(const f32x4*)(kg + k0 + 8 * (lane & 7)); kg1 = *(const f32x4*)(kg + k0 + 8 * (lane & 7) + 4); }
#pragma unroll
    for (int i = 0; i < 32; ++i) { const int kk = 2 * i + (lane >> 5); scr[kk * 33 + (lane & 31)] = ok ? W[(size_t)(k0 + kk) * N + nn] : 0.f; }
    LDS_WAIT(); asm volatile("" ::: "memory");
    const int c = lane & 7;
#pragma unroll
    for (int j = 0; j < 4; ++j) { const int n = (lane >> 3) + 8 * j;
        if (n0 + n < N) { float sc; const int dr = map_row<KIND>(n0 + n, sc); const LAS float* s = scr + (8 * c) * 33 + n;
            u32x4 o; o.x = pk2(s[0 * 33] * (sc * kg0[0]), s[1 * 33] * (sc * kg0[1])); o.y = pk2(s[2 * 33] * (sc * kg0[2]), s[3 * 33] * (sc * kg0[3])); o.z = pk2(s[4 * 33] * (sc * kg1[0]), s[5 * 33] * (sc * kg1[1])); o.w = pk2(s[6 * 33] * (sc * kg1[2]), s[7 * 33] * (sc * kg1[3]));
            *(u32x4*)(kblk ? WT + (size_t)kb * kblk + (size_t)dr * 64 + 8 * c : WT + (size_t)dr * ldo + coloff + k0 + 8 * c) = o; } }
    LDS_WAIT(); asm volatile("" ::: "memory");
}

__device__ __forceinline__ void phase_convert(const Params&, const Frame& F0, int layer0) {
    const Frame F = mk_frame(F0.wave);
    const PV p = pv_get(); int layer = layer0; asm volatile("" : "+s"(layer));
    LAS float* scr = (LAS float*)(F.lds + F.wave * 16384);
    unsigned z0_ = 0u; asm volatile("" : "+v"(z0_)); const u32x4 Z4 = {z0_, z0_, z0_, z0_};
    bf16_t* W = (bf16_t*)(p.ws() + WS_W);
    const size_t lFF = (size_t)layer * D * FF;
    constexpr int IT_FF = (D / 64) * (FF / 32), IT_DN = (FF / 64) * (D / 32), IT_IN = (D / 64) * ((IN_COLS + 31) / 32), IT_UQ = 8 * 48, IT_UKV = 8 * 64, IT_BR = 16 * 64, IT_OUT = 32 * 64;
    constexpr int IT_FV = NB * 16 * 32;
    constexpr int NITEMS = 6 * IT_FF + IT_IN + IT_UQ + IT_UKV + 3 * IT_BR + IT_OUT + IT_FV;
    static_assert(IT_FF == IT_DN, "items");
    for (int it = F.gw; it < NITEMS; it += F.NGW) {
        int r = it;
        if (r < IT_FF) { cvt_item<1>(p.in(I_F1G) + lFF, FF, W + W_GU1, D, 0, scr, r, F.lane, (size_t)2 * FF * 64, p.in(I_F1N) + layer * D); continue; } r -= IT_FF;
        if (r < IT_FF) { cvt_item<2>(p.in(I_F1U) + lFF, FF, W + W_GU1, D, 0, scr, r, F.lane, (size_t)2 * FF * 64, p.in(I_F1N) + layer * D); continue; } r -= IT_FF;
        if (r < IT_DN) { cvt_item<0>(p.in(I_F1D) + lFF, D, W + W_D1, FF, 0, scr, r, F.lane, (size_t)D * 64); continue; } r -= IT_DN;
        if (r < IT_FF) { cvt_item<1>(p.in(I_F2G) + lFF, FF, W + W_GU2, D, 0, scr, r, F.lane, (size_t)2 * FF * 64, p.in(I_F2N) + layer * D); continue; } r -= IT_FF;
        if (r < IT_FF) { cvt_item<2>(p.in(I_F2U) + lFF, FF, W + W_GU2, D, 0, scr, r, F.lane, (size_t)2 * FF * 64, p.in(I_F2N) + layer * D); continue; } r -= IT_FF;
        if (r < IT_DN) { cvt_item<0>(p.in(I_F2D) + lFF, D, W + W_D2, FF, 0, scr, r, F.lane, (size_t)D * 64); continue; } r -= IT_DN;
        if (r < IT_IN) { cvt_item<3>(p.in(I_WIN) + (size_t)layer * D * IN_COLS, IN_COLS, W + W_IN, D, 0, scr, r, F.lane, (size_t)NWIN * 64, p.in(I_MIXN) + layer * D); continue; } r -= IT_IN;
        if (r < IT_UQ) { cvt_item<4>(p.in(I_WUQ) + (size_t)layer * 512 * 1536, 1536, W + W_UQ, 512, 0, scr, r, F.lane); continue; } r -= IT_UQ;
        if (r < IT_UKV) { cvt_item<0>(p.in(I_WUKV) + (size_t)layer * 512 * 2048, 2048, W + W_UKV, 512, 0, scr, r, F.lane); continue; } r -= IT_UKV;
        if (r < IT_BR) { cvt_item<0>(p.in(I_BRM) + (size_t)layer * 1024 * D, D, W + W_BR, 1024, 0, scr, r, F.lane); continue; } r -= IT_BR;
        if (r < IT_BR) { cvt_item<0>(p.in(I_BRS) + (size_t)layer * 1024 * D, D, W + W_BR + (size_t)D * 1024, 1024, 0, scr, r, F.lane); continue; } r -= IT_BR;
        if (r < IT_BR) { cvt_item<0>(p.in(I_BRF) + (size_t)layer * 1024 * D, D, W + W_BR + (size_t)2 * D * 1024, 1024, 0, scr, r, F.lane); continue; } r -= IT_BR;
        if (r < IT_OUT) { cvt_item<0>(p.in(I_WOUT) + (size_t)layer * D * D, D, W + W_OUT, D, 0, scr, r, F.lane); continue; } r -= IT_OUT;
        { const int b = r / 512, ri = r % 512;
          cvt_item<0>(p.in(I_CFV) + ((size_t)layer * NB + b) * PAST * 1024, 1024, (bf16_t*)(p.ws() + WS_VTF), KVROWS, (size_t)MP + (size_t)b * KVS, scr, ri, F.lane); }
    }
    const size_t gt = (size_t)F.gw * 64 + F.lane, NT = (size_t)F.NGW * 64;
    {
        constexpr int PADE = (NWIN - IN_COLS) * 64 / 8;
        for (size_t i = gt; i < (size_t)PADE * (D / 64); i += NT) { const int kb = (int)(i / PADE), rem = (int)(i % PADE);
            *(u32x4*)(W + W_IN + (size_t)kb * ((size_t)NWIN * 64) + (size_t)IN_COLS * 64 + (size_t)rem * 8) = Z4; }
    }
    {
        const float* src = p.in(I_CCKV) + (size_t)layer * NB * PAST * 512; bf16_t* dst = (bf16_t*)(p.ws() + WS_CKV);
        for (size_t i = gt; i < (size_t)NB * PAST * 512 / 8; i += NT) { const size_t e = i * 8; const int b = (int)(e / (PAST * 512)), rem = (int)(e % (PAST * 512));
            const f32x4 a = *(const f32x4*)(src + e), c = *(const f32x4*)(src + e + 4);
            u32x4 w; w.x = pk2(a[0], a[1]); w.y = pk2(a[2], a[3]); w.z = pk2(c[0], c[1]); w.w = pk2(c[2], c[3]);
            *(u32x4*)(dst + ((size_t)MP + (size_t)b * KVS) * 512 + rem) = w; }
        for (size_t i = gt; i < (size_t)NB * (KVS - KVLEN_S) * 512 / 8; i += NT) { const size_t e = i * 8; const int b = (int)(e / ((KVS - KVLEN_S) * 512)), rem = (int)(e % ((KVS - KVLEN_S) * 512));
            *(u32x4*)(dst + ((size_t)MP + (size_t)b * KVS + KVLEN_S) * 512 + rem) = Z4; }
    }
    {
        const float* src = p.in(I_CFK) + (size_t)layer * NB * PAST * 1024; bf16_t* dst = (bf16_t*)(p.ws() + WS_KFS);
        for (size_t i = gt; i < (size_t)NB * PAST * 1024 / 8; i += NT) { const size_t e = i * 8; const int b = (int)(e / (PAST * 1024)), rem = (int)(e % (PAST * 1024));
            const f32x4 a = *(const f32x4*)(src + e), c = *(const f32x4*)(src + e + 4);
            u32x4 w; w.x = pk2(a[0], a[1]); w.y = pk2(a[2], a[3]); w.z = pk2(c[0], c[1]); w.w = pk2(c[2], c[3]);
            *(u32x4*)(dst + (size_t)b * KVS * 1024 + rem) = w; }
        for (size_t i = gt; i < (size_t)NB * (KVS - KVLEN_S) * 1024 / 8; i += NT) { const size_t e = i * 8; const int b = (int)(e / ((KVS - KVLEN_S) * 1024)), rem = (int)(e % ((KVS - KVLEN_S) * 1024));
            *(u32x4*)(dst + ((size_t)b * KVS + KVLEN_S) * 1024 + rem) = Z4; }
    }
    {
        const float* src = p.in(I_CKPE) + (size_t)layer * NB * PAST * 64; bf16_t* km = (bf16_t*)(p.ws() + WS_KM);
        for (size_t i = gt; i < (size_t)NB * KVS * 32; i += NT) { const int j = (int)(i & 31); const int pr = (int)(i >> 5) % KVS, b = (int)(i >> 5) / KVS;
            unsigned w = 0u;
            if (pr < PAST) { const float* s = src + ((size_t)b * PAST + pr) * 64; w = pk2(s[j], s[32 + j]); }
            if (pr < PAST || pr >= KVLEN_S) { const size_t kr = (size_t)MP + (size_t)b * KVS + pr;
#pragma unroll
                for (int h = 0; h < 8; ++h) *(unsigned*)(km + (kr * 8 + h) * 192 + 128 + 2 * j) = w; } }
        const float* ls = p.in(I_CLOGF) + (size_t)layer * NB * PAST * 8; float* ld = (float*)(p.ws() + WS_LOGF);
        for (size_t i = gt; i < (size_t)NB * KVS * 8; i += NT) { const int hh = (int)(i & 7); const int pr = (int)(i >> 3) % KVS, b = (int)(i >> 3) / KVS;
            if (pr < PAST) ld[((size_t)MP + (size_t)b * KVS + pr) * 8 + hh] = ls[((size_t)b * PAST + pr) * 8 + hh];
            else if (pr >= KVLEN_S) ld[((size_t)MP + (size_t)b * KVS + pr) * 8 + hh] = 0.f; }
        bf16_t* vtf = (bf16_t*)(p.ws() + WS_VTF);
        for (size_t i = gt; i < (size_t)1024 * NB * (KVS - KVLEN_S); i += NT) { const int pc = (int)(i % (KVS - KVLEN_S)); const int b = (int)(i / (KVS - KVLEN_S)) % NB, ch = (int)(i / (KVS - KVLEN_S)) / NB;
            vtf[(size_t)ch * KVROWS + MP + (size_t)b * KVS + KVLEN_S + pc] = 0; }
    }
}

__device__ __forceinline__ void phase_rope_table(const Frame& F0) {
    const Frame F = mk_frame(F0.wave);
    const PV p = pv_get();
    const size_t gt = (size_t)F.gw * 64 + F.lane, NT = (size_t)F.NGW * 64;
    f32x2* rt = (f32x2*)(p.ws() + WS_ROPE);
    for (size_t i = gt; i < (size_t)SEQ * 32; i += NT) { const int j = (int)(i & 31), ps = (int)(i >> 5);
        const float inv = powf(10000.0f, -(float)j / 32.0f); const float ang = (float)ps * inv;
        float sn, cs; sincosf(ang, &sn, &cs); rt[i] = (f32x2){cs, sn}; }
}
__device__ __forceinline__ void phase_prep(const Frame& F, const float* xp, const float* xs, bf16_t* XB, float* SS, float* copy_s, const float* part) {
    const int nrows = xp ? MT : MS;
    for (int i = F.wave * F.G + F.vcu; i < nrows; i += F.NGW) {
        const int m = xp ? i : MP + i;
        const float* xr = (m < MP) ? xp + (size_t)m * D : xs + (size_t)(m - MP) * D;
        f32x4 v[8]; float s = 0.f;
#pragma unroll
        for (int j = 0; j < 8; ++j) v[j] = *(const f32x4*)(xr + 4 * F.lane + 256 * j);
        if (m >= MP) {
            if (part) {
#pragma unroll
                for (int sp = 0; sp < 8; ++sp)
#pragma unroll
                    for (int j = 0; j < 8; ++j) v[j] += *(const f32x4*)(part + ((size_t)sp * MS + (m - MP)) * D + 4 * F.lane + 256 * j); }
            float* xo = (copy_s ? copy_s : const_cast<float*>(xs)) + (size_t)(m - MP) * D;
#pragma unroll
            for (int j = 0; j < 8; ++j) *(f32x4*)(xo + 4 * F.lane + 256 * j) = v[j]; }
#pragma unroll
        for (int j = 0; j < 8; ++j) s += (v[j][0] * v[j][0] + v[j][1] * v[j][1]) + (v[j][2] * v[j][2] + v[j][3] * v[j][3]);
        s = wave_sum(s, F.lane);
        bf16_t* o = XB + (size_t)(F.lane >> 4) * ((size_t)MT * 64) + (size_t)m * 64 + 4 * (F.lane & 15);
#pragma unroll
        for (int j = 0; j < 8; ++j) { u32x2 w; w.x = pk2(v[j][0], v[j][1]); w.y = pk2(v[j][2], v[j][3]); *(u32x2*)(o + (size_t)(4 * j) * ((size_t)MT * 64)) = w; }
        if (F.lane == 0) SS[RS_OFF + m] = fast_rsqrt(s * (1.0f / D) + EPS);
    }
    if (!xp) {
        for (int r = F.gw * 64 + F.lane; r < MP; r += F.NGW * 64) { const f32x4 a = *(const f32x4*)(SS + (size_t)r * 8), b = *(const f32x4*)(SS + (size_t)r * 8 + 4);
            SS[RS_OFF + r] = fast_rsqrt((((a[0] + a[1]) + (a[2] + a[3])) + ((b[0] + b[1]) + (b[2] + b[3]))) * (1.0f / D) + EPS); }
    }
}
__device__ __forceinline__ void phase_final_norm(const Frame& F, float* x, const bf16_t* xb, const float* gain, const float* part) {
    f32x4 g[8];
#pragma unroll
    for (int j = 0; j < 8; ++j) g[j] = *(const f32x4*)(gain + 4 * F.lane + 256 * j);
    for (int m = F.gw; m < MT; m += F.NGW) {
        float* xr = x + (size_t)m * D;
        f32x4 v[8]; float s = 0.f;
        if (m < MP) { const bf16_t* xq = xb + (size_t)(F.lane >> 4) * ((size_t)MT * 64) + (size_t)m * 64 + 4 * (F.lane & 15);
#pragma unroll
            for (int j = 0; j < 8; ++j) { const u32x2 w = *(const u32x2*)(xq + (size_t)(4 * j) * ((size_t)MT * 64)); v[j] = (f32x4){bf_lo(w.x), bf_hi(w.x), bf_lo(w.y), bf_hi(w.y)}; }
        } else {
#pragma unroll
            for (int j = 0; j < 8; ++j) v[j] = *(const f32x4*)(xr + 4 * F.lane + 256 * j); }
        if (m >= MP) {
#pragma unroll
            for (int sp = 0; sp < 8; ++sp)
#pragma unroll
                for (int j = 0; j < 8; ++j) v[j] += *(const f32x4*)(part + ((size_t)sp * MS + (m - MP)) * D + 4 * F.lane + 256 * j); }
#pragma unroll
        for (int j = 0; j < 8; ++j) s += (v[j][0] * v[j][0] + v[j][1] * v[j][1]) + (v[j][2] * v[j][2] + v[j][3] * v[j][3]);
        const float rs = fast_rsqrt(wave_sum(s, F.lane) * (1.0f / D) + EPS);
#pragma unroll
        for (int j = 0; j < 8; ++j) *(f32x4*)(xr + 4 * F.lane + 256 * j) = v[j] * rs * g[j];
    }
}
__device__ __forceinline__ float softplusf_(float x) {
    if (x > 20.f) return x; const float y = fast_exp(x); return y < 0.03125f ? y * (1.0f + y * (-0.5f + y * (0.33333333f - 0.25f * y))) : fast_log(1.0f + y); }
__device__ __forceinline__ void unpack8(const u32x4 w, float (&v)[8]) {
    v[0] = bf_lo(w.x); v[1] = bf_hi(w.x); v[2] = bf_lo(w.y); v[3] = bf_hi(w.y); v[4] = bf_lo(w.z); v[5] = bf_hi(w.z); v[6] = bf_lo(w.w); v[7] = bf_hi(w.w);
}
__device__ __forceinline__ void phase_t1(const Params&, const Frame& F0, int layer0) {
    const Frame F = mk_frame(F0.wave);
    const PV p = pv_get(); int layer = layer0; asm volatile("" : "+s"(layer));
    bf16_t* U = (bf16_t*)(p.ws() + WS_U); const float* US = (const float*)(p.ws() + WS_US);
    bf16_t* CKV = (bf16_t*)(p.ws() + WS_CKV); bf16_t* KM = (bf16_t*)(p.ws() + WS_KM); bf16_t* KFS = (bf16_t*)(p.ws() + WS_KFS); bf16_t* VTF = (bf16_t*)(p.ws() + WS_VTF);
    float* LOGF = (float*)(p.ws() + WS_LOGF); float* DTB = (float*)(p.ws() + WS_DT); const f32x2* rope = (const f32x2*)(p.ws() + WS_ROPE);
    unsigned* ctl = (unsigned*)(p.ws() + WS_CTL);
    float* o_pckv = p.out() + O_PCKV + (size_t)layer * MP * 512; float* o_sckv = p.out() + O_SCKV + (size_t)layer * MS * 512;
    float* o_pkpe = p.out() + O_PKPE + (size_t)layer * MP * 64; float* o_skpe = p.out() + O_SKPE + (size_t)layer * MS * 64;
    float* o_plf = p.out() + O_PLOGF + (size_t)layer * MP * 8; float* o_slf = p.out() + O_SLOGF + (size_t)layer * MS * 8;
    float* o_pconv = p.out() + O_PCONV + (size_t)layer * 3 * 1536; float* o_sconv = p.out() + O_SCONV + (size_t)layer * NB * 3 * 1536;
    float qg[8], kg[8];
#pragma unroll
    for (int j = 0; j < 8; ++j) { qg[j] = p.in(I_QN)[layer * 512 + 8 * F.lane + j]; kg[j] = p.in(I_KVN)[layer * 512 + 8 * F.lane + j]; }
    const float fb = (F.lane < 8) ? p.in(I_FBF)[layer * 8 + F.lane] : 0.f;
    const float db = (F.lane < 16) ? p.in(I_DTB)[layer * 16 + F.lane] : 0.f;
    for (int m = F.gw; m < MT; m += F.NGW) {
        const int kr = kvrow_of(m), ps = pos_of(m); const bool smp = m >= MP; const int mi = m - MP;
        bf16_t* ur = U + (size_t)m * LDU;
        const float* us = US + (size_t)m * LDUS;
        const u32x4 wq = *(const u32x4*)(ur + UC_QLAT + 8 * F.lane), wc = *(const u32x4*)(ur + UC_CKV + 8 * F.lane);
        const u32x4 fq0 = *(const u32x4*)(ur + UC_FQ + 16 * F.lane), fq1 = *(const u32x4*)(ur + UC_FQ + 16 * F.lane + 8);
        const u32x4 fk0 = *(const u32x4*)(ur + UC_FK + 16 * F.lane), fk1 = *(const u32x4*)(ur + UC_FK + 16 * F.lane + 8);
        float x1 = 0.f, x2 = 0.f; f32x2 cs = {0.f, 0.f};
        if (F.lane < 32) { x1 = us[US_KPE + F.lane]; x2 = us[US_KPE + 32 + F.lane]; cs = rope[(size_t)ps * 32 + F.lane]; }
        const float uff = (F.lane < 8) ? us[US_FF + F.lane] : 0.f, udt = (F.lane < 16) ? us[US_DT + F.lane] : 0.f;
        float vq[8], vc[8]; unpack8(wq, vq); unpack8(wc, vc);
        float sq_ = 0.f, sc_ = 0.f;
#pragma unroll
        for (int j = 0; j < 8; ++j) { sq_ += vq[j] * vq[j]; sc_ += vc[j] * vc[j]; }
        float nq = 0.f, nk = 0.f;
        { float a8[8], b8[8]; unpack8(fq0, a8); unpack8(fq1, b8);
#pragma unroll
          for (int j = 0; j < 8; ++j) nq += a8[j] * a8[j] + b8[j] * b8[j];
          unpack8(fk0, a8); unpack8(fk1, b8);
#pragma unroll
          for (int j = 0; j < 8; ++j) nk += a8[j] * a8[j] + b8[j] * b8[j]; }
#pragma unroll
        for (int o = 1; o < 64; o <<= 1) { const float t0 = shx(sq_, o, F.lane), t1 = shx(sc_, o, F.lane); sq_ += t0; sc_ += t1;
            if (o < 8) { const float t2 = shx(nq, o, F.lane), t3 = shx(nk, o, F.lane); nq += t2; nk += t3; } }
        {
            const float rs = fast_rsqrt(sq_ * (1.0f / 512) + EPS);
            u32x4 w; w.x = pk2(vq[0] * rs * qg[0], vq[1] * rs * qg[1]); w.y = pk2(vq[2] * rs * qg[2], vq[3] * rs * qg[3]); w.z = pk2(vq[4] * rs * qg[4], vq[5] * rs * qg[5]); w.w = pk2(vq[6] * rs * qg[6], vq[7] * rs * qg[7]);
            *(u32x4*)(ur + UC_QLAT + 8 * F.lane) = w;
        }
        {
            const float rs = fast_rsqrt(sc_ * (1.0f / 512) + EPS);
#pragma unroll
            for (int j = 0; j < 8; ++j) vc[j] = vc[j] * rs * kg[j];
            float* o = (smp ? o_sckv + (size_t)mi * 512 : o_pckv + (size_t)m * 512) + 8 * F.lane;
            *(f32x4*)o = (f32x4){vc[0], vc[1], vc[2], vc[3]}; *(f32x4*)(o + 4) = (f32x4){vc[4], vc[5], vc[6], vc[7]};
            u32x4 w; w.x = pk2(vc[0], vc[1]); w.y = pk2(vc[2], vc[3]); w.z = pk2(vc[4], vc[5]); w.w = pk2(vc[6], vc[7]);
            *(u32x4*)(CKV + (size_t)kr * 512 + 8 * F.lane) = w;
        }
        if (F.lane < 32) {
            const float o1 = x1 * cs.x - x2 * cs.y, o2 = x2 * cs.x + x1 * cs.y;
            float* o = smp ? o_skpe + (size_t)mi * 64 : o_pkpe + (size_t)m * 64; o[F.lane] = o1; o[32 + F.lane] = o2;
            const unsigned w = pk2(o1, o2);
#pragma unroll
            for (int h = 0; h < 8; ++h) *(unsigned*)(KM + ((size_t)kr * 8 + h) * 192 + 128 + 2 * F.lane) = w;
        }
        if (F.lane < 8) {
            const float lf = -softplusf_(-(uff + fb));
            (smp ? o_slf + (size_t)mi * 8 : o_plf + (size_t)m * 8)[F.lane] = lf; LOGF[(size_t)kr * 8 + F.lane] = lf;
        }
        if (F.lane < 16) DTB[(size_t)m * 16 + F.lane] = softplusf_(udt + db);
        if (!smp) {
            if ((F.lane & 7) == 0) { const int hh = F.lane >> 3;
                atomicMax(ctl + CW_QN2 + (layer * 64 + (m >> 8)) * 8 + hh, __float_as_uint(nq));
                atomicMax(ctl + CW_KN2 + (layer * 64 + (m >> 8)) * 8 + hh, __float_as_uint(nk)); }
        } else {
            bf16_t* kd = KFS + (size_t)(kr - MP) * 1024 + 16 * F.lane; *(u32x4*)kd = fk0; *(u32x4*)(kd + 8) = fk1;
        }
        {
            int slot = -1; float* od = nullptr;
            if (!smp) { if (m >= MP - 3) { slot = m - (MP - 3); od = o_pconv; } }
            else { const int t = mi & 15; if (t >= 13) { slot = t - 13; od = o_sconv + (size_t)(mi >> 4) * 3 * 1536; } }
            if (slot >= 0) { for (int c = F.lane; c < 1536; c += 64) od[slot * 1536 + c] = bf2f(ur[UC_XBC + c]); }
        }
    }
    {
        bf16_t* XC = (bf16_t*)(p.ws() + WS_XN);
        const float* cw = p.in(I_CW) + (size_t)layer * 4 * 1536; const float* cb = p.in(I_CB) + (size_t)layer * 1536; const float* cst = p.in(I_CONV) + (size_t)layer * NB * 3 * 1536;
        const size_t gt = (size_t)F.gw * 64 + F.lane, NT = (size_t)F.NGW * 64;
        constexpr int STRIP = 25, NSTRIP = (MP + STRIP - 1) / STRIP;
        for (size_t it = gt; it < (size_t)NSTRIP * 192; it += NT) { const int strip = (int)(it / 192), ch0 = (int)(it % 192) * 8; const int r0 = strip * STRIP;
            float wt[4][8], bs[8];
            { const f32x4 b0 = *(const f32x4*)(cb + ch0), b1 = *(const f32x4*)(cb + ch0 + 4); bs[0] = b0[0]; bs[1] = b0[1]; bs[2] = b0[2]; bs[3] = b0[3]; bs[4] = b1[0]; bs[5] = b1[1]; bs[6] = b1[2]; bs[7] = b1[3]; }
#pragma unroll
            for (int k = 0; k < 4; ++k) { const f32x4 w0 = *(const f32x4*)(cw + k * 1536 + ch0), w1 = *(const f32x4*)(cw + k * 1536 + ch0 + 4);
                wt[k][0] = w0[0]; wt[k][1] = w0[1]; wt[k][2] = w0[2]; wt[k][3] = w0[3]; wt[k][4] = w1[0]; wt[k][5] = w1[1]; wt[k][6] = w1[2]; wt[k][7] = w1[3]; }
            const bf16_t* up = U + UC_XBC + ch0;
            u32x4 win[3];
#pragma unroll
            for (int k = 0; k < 3; ++k) { const int rr = r0 - 3 + k; u32x4 z = {0u, 0u, 0u, 0u}; if (rr >= 0) z = *(const u32x4*)(up + (size_t)rr * LDU); win[k] = z; }
#pragma unroll 1
            for (int rb = 0; rb < STRIP; rb += 5) {
                u32x4 nw[5];
#pragma unroll
                for (int e = 0; e < 5; ++e) { const int rr = r0 + rb + e; nw[e] = (rr < MP) ? *(const u32x4*)(up + (size_t)rr * LDU) : (u32x4){0u, 0u, 0u, 0u}; }
#pragma unroll
                for (int e = 0; e < 5; ++e) { const int rr = r0 + rb + e;
                    float x0[8], x1[8], x2[8], x3[8]; unpack8(win[0], x0); unpack8(win[1], x1); unpack8(win[2], x2); unpack8(nw[e], x3);
                    float acc[8];
#pragma unroll
                    for (int j = 0; j < 8; ++j) acc[j] = bs[j] + wt[0][j] * x0[j] + wt[1][j] * x1[j] + wt[2][j] * x2[j] + wt[3][j] * x3[j];
                    u32x4 o; o.x = pk2(siluf_(acc[0]), siluf_(acc[1])); o.y = pk2(siluf_(acc[2]), siluf_(acc[3])); o.z = pk2(siluf_(acc[4]), siluf_(acc[5])); o.w = pk2(siluf_(acc[6]), siluf_(acc[7]));
                    if (rr < MP) *(u32x4*)(XC + (size_t)rr * 1536 + ch0) = o;
                    win[0] = win[1]; win[1] = win[2]; win[2] = nw[e]; }
            }
        }
        for (size_t i = gt; i < (size_t)MS * 192; i += NT) { const int m = MP + (int)(i / 192), ch0 = (int)(i % 192) * 8;
            const int t = (m - MP) & 15;
            float acc[8];
            { const f32x4 b0 = *(const f32x4*)(cb + ch0), b1 = *(const f32x4*)(cb + ch0 + 4); acc[0] = b0[0]; acc[1] = b0[1]; acc[2] = b0[2]; acc[3] = b0[3]; acc[4] = b1[0]; acc[5] = b1[1]; acc[6] = b1[2]; acc[7] = b1[3]; }
#pragma unroll
            for (int k = 0; k < 4; ++k) { const int ii = t - 3 + k; float xv[8];
                if (ii >= 0) unpack8(*(const u32x4*)(U + (size_t)(m - 3 + k) * LDU + UC_XBC + ch0), xv);
                else { const float* sp = cst + ((size_t)((m - MP) >> 4) * 3 + (ii + 3)) * 1536 + ch0; const f32x4 s0 = *(const f32x4*)sp, s1 = *(const f32x4*)(sp + 4);
                    xv[0] = s0[0]; xv[1] = s0[1]; xv[2] = s0[2]; xv[3] = s0[3]; xv[4] = s1[0]; xv[5] = s1[1]; xv[6] = s1[2]; xv[7] = s1[3]; }
                const f32x4 w0 = *(const f32x4*)(cw + k * 1536 + ch0), w1 = *(const f32x4*)(cw + k * 1536 + ch0 + 4);
                acc[0] += w0[0] * xv[0]; acc[1] += w0[1] * xv[1]; acc[2] += w0[2] * xv[2]; acc[3] += w0[3] * xv[3];
                acc[4] += w1[0] * xv[4]; acc[5] += w1[1] * xv[5]; acc[6] += w1[2] * xv[6]; acc[7] += w1[3] * xv[7]; }
            u32x4 o; o.x = pk2(siluf_(acc[0]), siluf_(acc[1])); o.y = pk2(siluf_(acc[2]), siluf_(acc[3])); o.z = pk2(siluf_(acc[4]), siluf_(acc[5])); o.w = pk2(siluf_(acc[6]), siluf_(acc[7]));
            *(u32x4*)(XC + (size_t)m * 1536 + ch0) = o; }
    }
    {
        constexpr int PITCH = 72;
        LAS bf16_t* tile = (LAS bf16_t*)(F.lds + F.wave * (64 * PITCH * 2));
        for (int it = F.gw; it < (MP / 64) * 16; it += F.NGW) {
            const int rt = it >> 4, ct = it & 15, row0 = rt * 64, ch0 = ct * 64;
            u32x4 v[8];
#pragma unroll
            for (int k = 0; k < 8; ++k) { const int r = 8 * k + (F.lane >> 3), c8 = F.lane & 7; v[k] = *(const u32x4*)(U + (size_t)(row0 + r) * LDU + UC_FV + ch0 + 8 * c8); }
#pragma unroll
            for (int k = 0; k < 8; ++k) { const int r = 8 * k + (F.lane >> 3), c8 = F.lane & 7; bf16_t e8[8]; *(u32x4*)e8 = v[k];
#pragma unroll
                for (int e = 0; e < 8; ++e) tile[(8 * c8 + e) * PITCH + r] = e8[e]; }
            LDS_WAIT(); asm volatile("" ::: "memory");
#pragma unroll
            for (int k = 0; k < 8; ++k) { const int ch = 8 * k + (F.lane >> 3), r8 = F.lane & 7; const u32x4 w = *(const LAS u32x4*)(tile + ch * PITCH + 8 * r8);
                *(u32x4*)(VTF + (size_t)(ch0 + ch) * KVROWS + row0 + 8 * r8) = w; }
            LDS_WAIT(); asm volatile("" ::: "memory");
        }
        const size_t gt = (size_t)F.gw * 64 + F.lane, NT = (size_t)F.NGW * 64;
        for (size_t i = gt; i < (size_t)MS * 1024; i += NT) { const int mi = (int)(i >> 10), ch = (int)(i & 1023);
            VTF[(size_t)ch * KVROWS + kvrow_of(MP + mi)] = U[(size_t)(MP + mi) * LDU + UC_FV + ch]; }
    }
}

__device__ __forceinline__ void phase_t2(const Params&, const Frame& F0) {
    const Frame F = mk_frame(F0.wave);
    const PV p = pv_get();
    const float* LOGF = (const float*)(p.ws() + WS_LOGF); float* CUM = (float*)(p.ws() + WS_CUM);
    LAS double* wt = (LAS double*)F.lds;
    for (int job = (F.G == 256) ? (F.bx + 56) % 256 : F.bx; job < 1 + NB; job += F.G) {
        const int base = job == 0 ? 0 : MP + (job - 1) * KVS, n = job == 0 ? MP : KVS;
        const int per = (n + 511) / 512, i0 = F.tid * per, i1 = (i0 + per < n) ? i0 + per : n;
        double s[8];
#pragma unroll
        for (int h = 0; h < 8; ++h) s[h] = 0.0;
        for (int i = i0; i < i1; ++i) { const f32x4 a = *(const f32x4*)(LOGF + (size_t)(base + i) * 8), b = *(const f32x4*)(LOGF + (size_t)(base + i) * 8 + 4);
            s[0] += a[0]; s[1] += a[1]; s[2] += a[2]; s[3] += a[3]; s[4] += b[0]; s[5] += b[1]; s[6] += b[2]; s[7] += b[3]; }
        double pre[8];
#pragma unroll
        for (int h = 0; h < 8; ++h) { double v = s[h];
#pragma unroll
            for (int o = 1; o < 64; o <<= 1) { const long long vb = __builtin_bit_cast(long long, v); const int src = ((F.lane - o) & 63) << 2;
                const unsigned lo_ = (unsigned)__builtin_amdgcn_ds_bpermute(src, (int)(unsigned)vb), hi_ = (unsigned)__builtin_amdgcn_ds_bpermute(src, (int)(unsigned)(vb >> 32));
                const double t = __builtin_bit_cast(double, ((unsigned long long)hi_ << 32) | lo_); if (F.lane >= o) v += t; }
            pre[h] = v - s[h]; if (F.lane == 63) wt[F.wave * 8 + h] = v; }
        __syncthreads();
#pragma unroll
        for (int h = 0; h < 8; ++h) { double off = 0.0; for (int ww = 0; ww < F.wave; ++ww) off += wt[ww * 8 + h]; pre[h] += off; }
        for (int i = i0; i < i1; ++i) { const f32x4 a = *(const f32x4*)(LOGF + (size_t)(base + i) * 8), b = *(const f32x4*)(LOGF + (size_t)(base + i) * 8 + 4);
            pre[0] += a[0]; pre[1] += a[1]; pre[2] += a[2]; pre[3] += a[3]; pre[4] += b[0]; pre[5] += b[1]; pre[6] += b[2]; pre[7] += b[3];
            *(f32x4*)(CUM + (size_t)(base + i) * 8) = (f32x4){(float)pre[0] * LOG2E, (float)pre[1] * LOG2E, (float)pre[2] * LOG2E, (float)pre[3] * LOG2E};
            *(f32x4*)(CUM + (size_t)(base + i) * 8 + 4) = (f32x4){(float)pre[4] * LOG2E, (float)pre[5] * LOG2E, (float)pre[6] * LOG2E, (float)pre[7] * LOG2E}; }
        __syncthreads();
    }
}

#define MFMA32(a, b, c) __builtin_amdgcn_mfma_f32_32x32x16_bf16((a), (b), (c), 0, 0, 0)
__device__ __forceinline__ int crow(int r, int hi) { return (r & 3) + 8 * (r >> 2) + 4 * hi; }
struct AttnSeq {
    const bf16_t* Q; int qs;
    const bf16_t* K; int ks;
    const bf16_t* VT;
    bf16_t* O; int os;
    const float* cq; const float* ck;
};
__device__ __forceinline__ void softmax_tile(f32x16& s0, f32x16& s1, float& m, float& l, f32x16 (&o)[4], bf16x8 (&pa)[4]) {
    float pmax = s0[0];
#pragma unroll
    for (int r = 1; r < 16; ++r) pmax = fmaxf(pmax, s0[r]);
#pragma unroll
    for (int r = 0; r < 16; ++r) pmax = fmaxf(pmax, s1[r]);
    { auto rr = __builtin_amdgcn_permlane32_swap(__float_as_uint(pmax), __float_as_uint(pmax), false, false);
      pmax = fmaxf(__uint_as_float(rr[0]), __uint_as_float(rr[1])); }
    const bool resc = !__all(pmax - m <= 8.0f);
    const float mn = resc ? fmaxf(m, pmax) : m;
    const float alpha = resc ? fast_exp2(m - mn) : 1.0f; m = mn;
    float ps = 0.f;
#pragma unroll
    for (int r = 0; r < 16; ++r) { s0[r] = fast_exp2(s0[r] - mn); ps += s0[r]; }
#pragma unroll
    for (int r = 0; r < 16; ++r) { s1[r] = fast_exp2(s1[r] - mn); ps += s1[r]; }
    { auto rr = __builtin_amdgcn_permlane32_swap(__float_as_uint(ps), __float_as_uint(ps), false, false);
      ps = __uint_as_float(rr[0]) + __uint_as_float(rr[1]); }
    l = l * alpha + ps;
    if (resc) {
#pragma unroll
        for (int d = 0; d < 4; ++d)
#pragma unroll
            for (int r = 0; r < 16; ++r) o[d][r] *= alpha;
    }
#define PK4(P, B_, OUT) do { const unsigned a0 = pk2(P[B_ + 0], P[B_ + 1]), a1 = pk2(P[B_ + 2], P[B_ + 3]), b0 = pk2(P[B_ + 4], P[B_ + 5]), b1 = pk2(P[B_ + 6], P[B_ + 7]); \
        auto r0 = __builtin_amdgcn_permlane32_swap(a0, b0, false, false); auto r1 = __builtin_amdgcn_permlane32_swap(a1, b1, false, false); \
        u32x4 w_ = {r0[0], r1[0], r0[1], r1[1]}; OUT = __builtin_bit_cast(bf16x8, w_); } while (0)
    PK4(s0, 0, pa[0]); PK4(s0, 8, pa[1]); PK4(s1, 0, pa[2]); PK4(s1, 8, pa[3]);
#undef PK4
}
__device__ __forceinline__ void store_o(const f32x16 (&o)[4], float inv, bf16_t* orow, int hi) {
#pragma unroll
    for (int d = 0; d < 4; ++d)
#pragma unroll
        for (int rq = 0; rq < 4; ++rq) { u32x2 w; w.x = pk2(o[d][4 * rq] * inv, o[d][4 * rq + 1] * inv); w.y = pk2(o[d][4 * rq + 2] * inv, o[d][4 * rq + 3] * inv);
            *(u32x2*)(orow + 32 * d + 8 * rq + 4 * hi) = w; }
}

template <int DQK, bool FOX>
__device__ __forceinline__ void attn_prefill_unit(LAS unsigned char* lds, const AttnSeq& a, int qb, int tid0, float bound2 = 0.f) {
    int tid = tid0; asm volatile("" : "+v"(tid));
    constexpr int RB = DQK * 2, CPR = DQK / 8, KBUF = 64 * RB, NKI = DQK / 64, NKS = DQK / 16;
    constexpr int OFF_V = 2 * KBUF, OFF_CK = OFF_V + 2 * 16384, OFF_QR = OFF_CK + 1024;
    constexpr int NQR = NKS;
    static_assert(OFF_QR + 8 * 4096 <= LDSCTL_OFF, "attention LDS map");
    const int w = __builtin_amdgcn_readfirstlane(tid >> 6), lane = tid & 63, c = lane & 31, hi = lane >> 5;
    const int q0w = qb * 256 + 32 * w, qrow = q0w + c;
    const int last_tile = q0w >> 6, ntiles = 4 * qb + 4;
    int jmin = 0;
    if (FOX) {
        LAS int* jm = (LAS int*)(lds + 2 * KBUF + 2 * 16384 + 512);
        if (tid == 0) *jm = ntiles - 1;
        __syncthreads();
        if (tid < ntiles) { const float d = a.cq[(size_t)(qb * 256) * 8] - a.ck[(size_t)(tid * 64 + 63) * 8];
            if (!(d + bound2 < -40.f)) __hip_atomic_fetch_min(jm, tid, __ATOMIC_RELAXED, __HIP_MEMORY_SCOPE_WORKGROUP); }
        __syncthreads();
        jmin = __builtin_amdgcn_readfirstlane(*jm);
    }
    int koff[NKI], voff[2];
#pragma unroll
    for (int i = 0; i < NKI; ++i) { const int s = (i * 8 + w) * 64 + lane, row = s / CPR, cp = s % CPR;
        const int ch = (DQK == 128) ? (cp ^ (row & 15)) : ((cp & ~7) | ((cp & 7) ^ ((row >> 1) & 7)));
        koff[i] = row * a.ks + ch * 8; }
#pragma unroll
    for (int i = 0; i < 2; ++i) { const int s = (i * 8 + w) * 64 + lane, d = s >> 3, cp = s & 7; voff[i] = d * KVROWS + ((cp ^ ((d >> 1) & 7)) * 8); }
    const int krow_b = c * RB;
    const int vsw = (c >> 1) & 7;
    bf16x8 qf[NQR];
    { const bf16_t* qp = a.Q + (size_t)qrow * a.qs + 8 * hi;
#pragma unroll
      for (int ks = 0; ks < NQR; ++ks) qf[ks] = *(const bf16x8*)(qp + 16 * ks);
      if (DQK == 192) {
#pragma unroll
          for (int ks = 8; ks < NKS; ++ks) *(LAS bf16x8*)(lds + OFF_QR + w * 4096 + c * 128 + (((2 * (ks - 8) + hi) ^ vsw) * 16)) = *(const bf16x8*)(qp + 16 * ks); } }
    float cq = 0.f; if (FOX) cq = a.cq[(size_t)qrow * 8];
    f32x16 o[4];
#pragma unroll
    for (int d = 0; d < 4; ++d)
#pragma unroll
        for (int r = 0; r < 16; ++r) o[d][r] = 0.f;
    float m = -1e30f, l = 0.f;
#define ATT_ISSUE(j_, b_) do { const bf16_t* kb_ = a.K + (size_t)(j_) * 64 * a.ks; const bf16_t* vb_ = a.VT + (size_t)(j_) * 64; \
        _Pragma("unroll") for (int i_ = 0; i_ < NKI; ++i_) __builtin_amdgcn_global_load_lds((const unsigned*)(kb_ + koff[i_]), (LAS unsigned*)(lds + (b_) * KBUF + (i_ * 8 + w) * 1024), 16, 0, 0); \
        _Pragma("unroll") for (int i_ = 0; i_ < 2; ++i_) __builtin_amdgcn_global_load_lds((const unsigned*)(vb_ + voff[i_]), (LAS unsigned*)(lds + OFF_V + (b_) * 16384 + (i_ * 8 + w) * 1024), 16, 0, 0); } while (0)
    ATT_ISSUE(jmin, jmin & 1);
    float ckn = 0.f;
    if (FOX && w == 0) { ckn = a.ck[(size_t)(jmin * 64 + lane) * 8]; ((LAS float*)(lds + OFF_CK))[(jmin & 1) * 64 + lane] = ckn; }
    for (int j = jmin; j < ntiles; ++j) {
        const int b = j & 1;
        VM_WAIT();
        __syncthreads();
        if (j + 1 < ntiles) { ATT_ISSUE(j + 1, b ^ 1); if (FOX && w == 0) ckn = a.ck[(size_t)((j + 1) * 64 + lane) * 8]; }
        if (j <= last_tile) {
            const LAS unsigned char* kb = lds + b * KBUF; const LAS unsigned char* vb = lds + OFF_V + b * 16384;
            f32x16 s0, s1;
#pragma unroll
            for (int r = 0; r < 16; ++r) { s0[r] = 0.f; s1[r] = 0.f; }
            constexpr int NB4 = NKS / 4;
            bf16x8 kfa[2][4], kfb[2][4];
#define ATT_LDK(dst, b4) do { _Pragma("unroll") for (int e_ = 0; e_ < 4; ++e_) { const int ks_ = 4 * (b4) + e_, ch_ = 2 * ks_ + hi; \
                const int cp_ = (DQK == 128) ? (ch_ ^ (c & 15)) : ((ch_ & ~7) | ((ch_ & 7) ^ ((c >> 1) & 7))); \
                dst[0][e_] = *(const LAS bf16x8*)(kb + krow_b + cp_ * 16); dst[1][e_] = *(const LAS bf16x8*)(kb + 32 * RB + krow_b + cp_ * 16); } } while (0)
#define ATT_MMK(src, b4) do { _Pragma("unroll") for (int e_ = 0; e_ < 4; ++e_) { const int ks_ = 4 * (b4) + e_; \
                bf16x8 qv_; if (ks_ < NQR) qv_ = qf[ks_ < NQR ? ks_ : 0]; else qv_ = *(const LAS bf16x8*)(lds + OFF_QR + w * 4096 + c * 128 + (((2 * (ks_ - 8) + hi) ^ vsw) * 16)); \
                s0 = MFMA32(src[0][e_], qv_, s0); s1 = MFMA32(src[1][e_], qv_, s1); } } while (0)
            ATT_LDK(kfa, 0);
            __builtin_amdgcn_sched_barrier(0);
            ATT_LDK(kfb, 1);
            __builtin_amdgcn_sched_barrier(0);
            ATT_MMK(kfa, 0);
            __builtin_amdgcn_sched_barrier(0);
            if (NB4 > 2) { ATT_LDK(kfa, 2 < NB4 ? 2 : 0); }
            __builtin_amdgcn_sched_barrier(0);
            ATT_MMK(kfb, 1);
            __builtin_amdgcn_sched_barrier(0);
            if (NB4 > 2) { ATT_MMK(kfa, 2 < NB4 ? 2 : 0); }
            __builtin_amdgcn_sched_barrier(0);
#undef ATT_LDK
#undef ATT_MMK
            if (FOX) {
                const LAS float* ckb = (const LAS float*)(lds + OFF_CK) + b * 64;
#pragma unroll
                for (int r = 0; r < 16; ++r) { s0[r] += cq - ckb[crow(r, hi)]; s1[r] += cq - ckb[32 + crow(r, hi)]; }
                if (j == last_tile) { const int dq = qrow - j * 64;
#pragma unroll
                    for (int r = 0; r < 16; ++r) { if (crow(r, hi) > dq) s0[r] = -__builtin_inff(); if (32 + crow(r, hi) > dq) s1[r] = -__builtin_inff(); } }
            }
            bf16x8 pa[4];
            softmax_tile(s0, s1, m, l, o, pa);
            {
                bf16x8 va[2][4], vb2[2][4];
#define ATT_LDV(dst, k0_) do { _Pragma("unroll") for (int kk_ = 0; kk_ < 2; ++kk_) _Pragma("unroll") for (int d_ = 0; d_ < 4; ++d_) { const int cp_ = (2 * ((k0_) + kk_) + hi) ^ vsw; \
                    dst[kk_][d_] = *(const LAS bf16x8*)(vb + (32 * d_ + c) * 128 + cp_ * 16); } } while (0)
#define ATT_MMV(src, k0_) do { _Pragma("unroll") for (int kk_ = 0; kk_ < 2; ++kk_) _Pragma("unroll") for (int d_ = 0; d_ < 4; ++d_) o[d_] = MFMA32(src[kk_][d_], pa[(k0_) + kk_], o[d_]); } while (0)
                ATT_LDV(va, 0);
                __builtin_amdgcn_sched_barrier(0);
                ATT_LDV(vb2, 2);
                __builtin_amdgcn_sched_barrier(0);
                ATT_MMV(va, 0);
                __builtin_amdgcn_sched_barrier(0);
                ATT_MMV(vb2, 2);
#undef ATT_LDV
#undef ATT_MMV
            }
        }
        if (FOX && w == 0 && j + 1 < ntiles) ((LAS float*)(lds + OFF_CK))[(b ^ 1) * 64 + lane] = ckn;
    }
#undef ATT_ISSUE
    store_o(o, __builtin_amdgcn_rcpf(l), a.O + (size_t)qrow * a.os, hi);
    __syncthreads();
}

template <int DQK, bool FOX>
__device__ __forceinline__ void attn_decode_unit(LAS unsigned char* lds, const AttnSeq& a, int tid0) {
    int tid = tid0; asm volatile("" : "+v"(tid));
    constexpr int NKS = DQK / 16;
    const int w = __builtin_amdgcn_readfirstlane(tid >> 6), lane = tid & 63, c = lane & 31, hi = lane >> 5, t = c & 15;
    bf16x8 qf[NKS];
    { const bf16_t* qp = a.Q + (size_t)t * a.qs + 8 * hi;
#pragma unroll
      for (int ks = 0; ks < NKS; ++ks) qf[ks] = *(const bf16x8*)(qp + 16 * ks); }
    float cq = 0.f; if (FOX) cq = a.cq[(size_t)t * 8];
    f32x16 o[4];
#pragma unroll
    for (int d = 0; d < 4; ++d)
#pragma unroll
        for (int r = 0; r < 16; ++r) o[d][r] = 0.f;
    float m = -1e30f, l = 0.f;
    const int lim = FOX ? PAST + t : KVLEN_S - 1;
    for (int j = w; j < KVS / 64; j += 8) {
        f32x16 s0, s1;
#pragma unroll
        for (int r = 0; r < 16; ++r) { s0[r] = 0.f; s1[r] = 0.f; }
        const bf16_t* kp = a.K + (size_t)(j * 64 + c) * a.ks + 8 * hi;
#pragma unroll
        for (int ks = 0; ks < NKS; ++ks) {
            if ((ks & 3) == 0) __builtin_amdgcn_sched_barrier(0);
            const bf16x8 k0 = *(const bf16x8*)(kp + 16 * ks), k1 = *(const bf16x8*)(kp + (size_t)32 * a.ks + 16 * ks);
            s0 = MFMA32(k0, qf[ks], s0); s1 = MFMA32(k1, qf[ks], s1);
        }
#pragma unroll
        for (int r = 0; r < 16; ++r) { const int k0i = j * 64 + crow(r, hi), k1i = k0i + 32;
            if (FOX) { s0[r] += cq - a.ck[(size_t)k0i * 8]; s1[r] += cq - a.ck[(size_t)k1i * 8]; }
            if (k0i > lim) s0[r] = -__builtin_inff(); if (k1i > lim) s1[r] = -__builtin_inff(); }
        bf16x8 pa[4];
        softmax_tile(s0, s1, m, l, o, pa);
#pragma unroll
        for (int d = 0; d < 4; ++d) {
            __builtin_amdgcn_sched_barrier(0);
#pragma unroll
            for (int ks = 0; ks < 4; ++ks) { const bf16x8 vf = *(const bf16x8*)(a.VT + (size_t)(32 * d + c) * KVROWS + j * 64 + 16 * ks + 8 * hi);
                o[d] = MFMA32(vf, pa[ks], o[d]); } }
    }
    LAS float* Ot = (LAS float*)lds; LAS float* ML = (LAS float*)(lds + 8 * 128 * 16 * 4);
    if (c < 16) {
#pragma unroll
        for (int d = 0; d < 4; ++d)
#pragma unroll
            for (int r = 0; r < 16; ++r) Ot[(w * 128 + 32 * d + crow(r, hi)) * 16 + c] = o[d][r];
        if (hi == 0) { ML[(w * 16 + c) * 2] = m; ML[(w * 16 + c) * 2 + 1] = l; }
    }
    __syncthreads();
    { const int q = tid & 15, dg = tid >> 4;
      float M = -1e30f;
#pragma unroll
      for (int ww = 0; ww < 8; ++ww) M = fmaxf(M, ML[(ww * 16 + q) * 2]);
      float L = 0.f, acc[4] = {0.f, 0.f, 0.f, 0.f};
#pragma unroll
      for (int ww = 0; ww < 8; ++ww) { const float f = fast_exp2(ML[(ww * 16 + q) * 2] - M); L += ML[(ww * 16 + q) * 2 + 1] * f;
#pragma unroll
          for (int e = 0; e < 4; ++e) acc[e] += Ot[(ww * 128 + 4 * dg + e) * 16 + q] * f; }
      const float inv = __builtin_amdgcn_rcpf(L);
      u32x2 wv; wv.x = pk2(acc[0] * inv, acc[1] * inv); wv.y = pk2(acc[2] * inv, acc[3] * inv);
      *(u32x2*)(a.O + (size_t)q * a.os + 4 * dg) = wv; }
    __syncthreads();
}
#define MFMA16(a, b, c) __builtin_amdgcn_mfma_f32_16x16x32_bf16((a), (b), (c), 0, 0, 0)
constexpr int SSD_XP = 72;
constexpr int SSD_BP = 136;
__device__ __forceinline__ void ssd_dt_acs(const Frame& F, const float* DTB, int m0, int L, int g, float a_neg  , LAS float* Dt, LAS float* Ac) {
    { const int l = F.tid >> 3, h = F.tid & 7; Dt[F.tid] = (l < L) ? DTB[(size_t)(m0 + l) * 16 + 8 * g + h] : 0.f; }
    __syncthreads();
    if (F.tid < 8) { float acs = 0.f; for (int l = 0; l < 64; ++l) { acs += Dt[l * 8 + F.tid] * a_neg; Ac[l * 8 + F.tid] = acs; } }
    __syncthreads();
}
__device__ __forceinline__ void phase_s1(const Params&, const Frame& F0, int layer0) {
    const Frame F = mk_frame(F0.wave);
    const PV p = pv_get(); int layer = layer0; asm volatile("" : "+s"(layer));
    const bf16_t* XC = (const bf16_t*)(p.ws() + WS_XN);
    const float* DTB = (const float*)(p.ws() + WS_DT); float* ST = (float*)(p.ws() + WS_ST); float* CDEC = (float*)(p.ws() + WS_CDEC);
    LAS float* Dt = (LAS float*)F.lds; LAS float* Ac = (LAS float*)(F.lds + 2048);
    LAS bf16_t* BT = (LAS bf16_t*)(F.lds + 4096);
    LAS bf16_t* XT = (LAS bf16_t*)(F.lds + 4096 + 128 * SSD_XP * 2) + F.wave * 64 * SSD_XP;
    const int w = F.wave, lane = F.lane, fr = lane & 15, q = lane >> 4;
    for (int unit = (F.G == 256) ? (F.bx + 88) % 256 : F.bx; unit < NCHUNK * 2; unit += F.G) {
        const int ci = unit >> 1, g = unit & 1; const bool smp = ci >= 256; const int L = smp ? 16 : 64; const int m0 = smp ? MP + (ci - 256) * 16 : ci * 64;
        const int head = 8 * g + w;
        const float a_neg = (F.tid < 8) ? -fast_exp(p.in(I_ALOG)[layer * 16 + 8 * g + F.tid]) : 0.f;
        ssd_dt_acs(F, DTB, m0, L, g, a_neg, Dt, Ac);
        const float alast = Ac[63 * 8 + w];
        if (lane == 0) CDEC[ci * 16 + head] = fast_exp(alast);
        for (int idx = F.tid; idx < 64 * 16; idx += 512) { const int l = idx >> 4, n8 = idx & 15; bf16_t v[8];
            if (l < L) *(u32x4*)v = *(const u32x4*)(XC + (size_t)(m0 + l) * 1536 + 1024 + 128 * g + 8 * n8); else *(u32x4*)v = (u32x4){0u, 0u, 0u, 0u};
#pragma unroll
            for (int e = 0; e < 8; ++e) BT[(8 * n8 + e) * SSD_XP + l] = v[e]; }
#pragma unroll
        for (int it = 0; it < 8; ++it) { const int l = 8 * it + (lane >> 3), p8 = lane & 7; float xv[8];
            if (l < L) unpack8(*(const u32x4*)(XC + (size_t)(m0 + l) * 1536 + head * 64 + 8 * p8), xv); else { for (int e = 0; e < 8; ++e) xv[e] = 0.f; }
            const float wgt = fast_exp(alast - Ac[l * 8 + w]) * Dt[l * 8 + w];
#pragma unroll
            for (int e = 0; e < 8; ++e) XT[(8 * p8 + e) * SSD_XP + l] = f2bf(xv[e] * wgt); }
        __syncthreads();
#pragma unroll 1
        for (int nh = 0; nh < 2; ++nh) {
            f32x4 acc[4][4];
#pragma unroll
            for (int nb = 0; nb < 4; ++nb)
#pragma unroll
                for (int pb = 0; pb < 4; ++pb) acc[nb][pb] = (f32x4){0.f, 0.f, 0.f, 0.f};
#pragma unroll
            for (int ks = 0; ks < 2; ++ks) {
                bf16x8 xf[4];
#pragma unroll
                for (int pb = 0; pb < 4; ++pb) xf[pb] = *(const LAS bf16x8*)(XT + (16 * pb + fr) * SSD_XP + 32 * ks + 8 * q);
#pragma unroll
                for (int nb = 0; nb < 4; ++nb) { const bf16x8 bf = *(const LAS bf16x8*)(BT + (64 * nh + 16 * nb + fr) * SSD_XP + 32 * ks + 8 * q);
#pragma unroll
                    for (int pb = 0; pb < 4; ++pb) acc[nb][pb] = MFMA16(bf, xf[pb], acc[nb][pb]); }
            }
            float* so = ST + (size_t)(ci * 16 + head) * 8192;
#pragma unroll
            for (int nb = 0; nb < 4; ++nb)
#pragma unroll
                for (int pb = 0; pb < 4; ++pb) *(f32x4*)(so + (size_t)(16 * pb + fr) * 128 + 64 * nh + 16 * nb + 4 * q) = acc[nb][pb];
        }
        __syncthreads();
    }
}
__device__ __forceinline__ void phase_s2(const Params&, const Frame& F0, int layer0) {
    const Frame F = mk_frame(F0.wave);
    const PV p = pv_get(); int layer = layer0; asm volatile("" : "+s"(layer));
    const float* ST = (const float*)(p.ws() + WS_ST); const float* CDEC = (const float*)(p.ws() + WS_CDEC); bf16_t* HB = (bf16_t*)(p.ws() + WS_HB);
    float* o_p = p.out() + O_PSSM + (size_t)layer * 131072; float* o_s = p.out() + O_SSSM + (size_t)layer * NB * 131072;
    const float* h0s = p.in(I_SSM) + (size_t)layer * NB * 131072;
    const size_t gt = (size_t)F.bx * 512 + F.tid, NT = (size_t)F.G * 512;
    for (size_t e = gt; e < 131072; e += NT) { const int head = (int)(e >> 13);
        float h = 0.f;
        for (int c0 = 0; c0 < 256; c0 += 32) { float tv[32], dv[32];
#pragma unroll
            for (int i = 0; i < 32; ++i) { tv[i] = ST[(size_t)(c0 + i) * 131072 + e]; dv[i] = CDEC[(c0 + i) * 16 + head]; }
#pragma unroll
            for (int i = 0; i < 32; ++i) { HB[(size_t)(c0 + i) * 131072 + e] = f2bf(h); h = h * dv[i] + tv[i]; } }
        o_p[e] = h; }
    for (size_t i = gt; i < (size_t)NB * 131072; i += NT) { const int b = (int)(i >> 17); const size_t e = i & 131071; const int head = (int)(e >> 13), ci = 256 + b;
        const float h0 = h0s[i], tv = ST[(size_t)ci * 131072 + e];
        HB[(size_t)ci * 131072 + e] = f2bf(h0); o_s[i] = h0 * CDEC[ci * 16 + head] + tv; }
}
__device__ __forceinline__ void phase_s3(const Params&, const Frame& F0, int layer0) {
    const Frame F = mk_frame(F0.wave);
    const PV p = pv_get(); int layer = layer0; asm volatile("" : "+s"(layer));
    const bf16_t* XC = (const bf16_t*)(p.ws() + WS_XN); bf16_t* U = (bf16_t*)(p.ws() + WS_U);
    const float* DTB = (const float*)(p.ws() + WS_DT);
    LAS float* Dt = (LAS float*)F.lds; LAS float* Ac = (LAS float*)(F.lds + 2048); LAS float* Rs = (LAS float*)(F.lds + 4096);
    LAS bf16_t* Bs = (LAS bf16_t*)(F.lds + 4608);
    LAS bf16_t* Cs = (LAS bf16_t*)(F.lds + 4608 + 64 * SSD_BP * 2);
    LAS bf16_t* XT = (LAS bf16_t*)(F.lds + 4608 + 2 * 64 * SSD_BP * 2) + F.wave * 64 * SSD_XP;
    const int w = F.wave, lane = F.lane, fr = lane & 15, q = lane >> 4;
    for (int unit = F.bx; unit < NCHUNK * 2; unit += F.G) {
        const int ci = unit >> 1, g = unit & 1; const bool smp = ci >= 256; const int L = smp ? 16 : 64; const int m0 = smp ? MP + (ci - 256) * 16 : ci * 64;
        const int head = 8 * g + w;
        const float a_neg = (F.tid < 8) ? -fast_exp(p.in(I_ALOG)[layer * 16 + 8 * g + F.tid]) : 0.f;
        bf16x8 hfr[4][4];
        { const bf16_t* hb = (const bf16_t*)(p.ws() + WS_HB) + (size_t)(ci * 16 + head) * 8192 + (size_t)fr * 128 + 8 * q;
#pragma unroll
          for (int ks = 0; ks < 4; ++ks)
#pragma unroll
              for (int pb = 0; pb < 4; ++pb) hfr[ks][pb] = *(const bf16x8*)(hb + (size_t)(16 * pb) * 128 + 32 * ks); }
        __builtin_amdgcn_sched_barrier(0);
        if (F.tid < 64) Rs[F.tid] = 0.f;
        ssd_dt_acs(F, DTB, m0, L, g, a_neg, Dt, Ac);
        for (int idx = F.tid; idx < 64 * 16; idx += 512) { const int l = idx >> 4, n8 = idx & 15; u32x4 vb = {0u, 0u, 0u, 0u}, vc = {0u, 0u, 0u, 0u};
            if (l < L) { const bf16_t* src = XC + (size_t)(m0 + l) * 1536 + 1024 + 128 * g + 8 * n8; vb = *(const u32x4*)src; vc = *(const u32x4*)(src + 256); }
            *(LAS u32x4*)(Bs + l * SSD_BP + 8 * n8) = vb; *(LAS u32x4*)(Cs + l * SSD_BP + 8 * n8) = vc; }
#pragma unroll
        for (int it = 0; it < 8; ++it) { const int l = 8 * it + (lane >> 3), p8 = lane & 7; bf16_t v[8];
            if (l < L) *(u32x4*)v = *(const u32x4*)(XC + (size_t)(m0 + l) * 1536 + head * 64 + 8 * p8); else *(u32x4*)v = (u32x4){0u, 0u, 0u, 0u};
#pragma unroll
            for (int e = 0; e < 8; ++e) XT[(8 * p8 + e) * SSD_XP + l] = v[e]; }
        __syncthreads();
        f32x4 acc[4][4];
#pragma unroll
        for (int pb = 0; pb < 4; ++pb)
#pragma unroll
            for (int lb = 0; lb < 4; ++lb) acc[pb][lb] = (f32x4){0.f, 0.f, 0.f, 0.f};
#pragma unroll
        for (int ks = 0; ks < 4; ++ks) { bf16x8 cf[4];
#pragma unroll
            for (int lb = 0; lb < 4; ++lb) cf[lb] = *(const LAS bf16x8*)(Cs + (16 * lb + fr) * SSD_BP + 32 * ks + 8 * q);
#pragma unroll
            for (int pb = 0; pb < 4; ++pb) {
#pragma unroll
                for (int lb = 0; lb < 4; ++lb) acc[pb][lb] = MFMA16(hfr[ks][pb], cf[lb], acc[pb][lb]); } }
        f32x4 gt[4][4];
#pragma unroll
        for (int sb = 0; sb < 4; ++sb)
#pragma unroll
            for (int lb = 0; lb < 4; ++lb) gt[sb][lb] = (f32x4){0.f, 0.f, 0.f, 0.f};
#pragma unroll
        for (int ks = 0; ks < 4; ++ks) { bf16x8 cf[4];
#pragma unroll
            for (int lb = 0; lb < 4; ++lb) cf[lb] = *(const LAS bf16x8*)(Cs + (16 * lb + fr) * SSD_BP + 32 * ks + 8 * q);
#pragma unroll
            for (int sb = 0; sb < 4; ++sb) { const bf16x8 bf = *(const LAS bf16x8*)(Bs + (16 * sb + fr) * SSD_BP + 32 * ks + 8 * q);
#pragma unroll
                for (int lb = 0; lb < 4; ++lb) gt[sb][lb] = MFMA16(bf, cf[lb], gt[sb][lb]); } }
        float al[4];
#pragma unroll
        for (int lb = 0; lb < 4; ++lb) { al[lb] = Ac[(16 * lb + fr) * 8 + w]; const float el = fast_exp(al[lb]);
#pragma unroll
            for (int pb = 0; pb < 4; ++pb) acc[pb][lb] = acc[pb][lb] * el; }
#pragma unroll
        for (int ks2 = 0; ks2 < 2; ++ks2) {
            float as_[2][4], ds_[2][4];
#pragma unroll
            for (int jh = 0; jh < 2; ++jh)
#pragma unroll
                for (int r = 0; r < 4; ++r) { const int s = 32 * ks2 + 16 * jh + 4 * q + r; as_[jh][r] = Ac[s * 8 + w]; ds_[jh][r] = Dt[s * 8 + w]; }
            bf16x8 mf[4];
#pragma unroll
            for (int lb = 0; lb < 4; ++lb) { const int l = 16 * lb + fr; float mv[8];
#pragma unroll
                for (int jh = 0; jh < 2; ++jh)
#pragma unroll
                    for (int r = 0; r < 4; ++r) { const int s = 32 * ks2 + 16 * jh + 4 * q + r;
                        mv[4 * jh + r] = (s <= l) ? gt[2 * ks2 + jh][lb][r] * fast_exp(al[lb] - as_[jh][r]) * ds_[jh][r] : 0.f; }
                u32x4 mw; mw.x = pk2(mv[0], mv[1]); mw.y = pk2(mv[2], mv[3]); mw.z = pk2(mv[4], mv[5]); mw.w = pk2(mv[6], mv[7]);
                mf[lb] = __builtin_bit_cast(bf16x8, mw); }
#pragma unroll
            for (int pb = 0; pb < 4; ++pb) { const LAS bf16_t* xp = XT + (16 * pb + fr) * SSD_XP + 32 * ks2 + 4 * q;
                const u32x2 x0 = *(const LAS u32x2*)xp, x1 = *(const LAS u32x2*)(xp + 16);
                const u32x4 xw = {x0.x, x0.y, x1.x, x1.y}; const bf16x8 xf = __builtin_bit_cast(bf16x8, xw);
#pragma unroll
                for (int lb = 0; lb < 4; ++lb) acc[pb][lb] = MFMA16(xf, mf[lb], acc[pb][lb]); }
        }
        const float dsk = p.in(I_SD)[layer * 16 + head];
        float sq[4] = {0.f, 0.f, 0.f, 0.f};
#pragma unroll
        for (int lb = 0; lb < 4; ++lb) { const int l = 16 * lb + fr; const bool ok = l < L;
#pragma unroll
            for (int pb = 0; pb < 4; ++pb) { const int pc = 16 * pb + 4 * q;
                u32x2 xw = {0u, 0u}, zw = {0u, 0u};
                if (ok) { xw = *(const u32x2*)(XC + (size_t)(m0 + l) * 1536 + head * 64 + pc); zw = *(const u32x2*)(U + (size_t)(m0 + l) * LDU + UC_Z + head * 64 + pc); }
                f32x4 y = acc[pb][lb];
                y[0] = (y[0] + dsk * bf_lo(xw.x)) * siluf_(bf_lo(zw.x)); y[1] = (y[1] + dsk * bf_hi(xw.x)) * siluf_(bf_hi(zw.x));
                y[2] = (y[2] + dsk * bf_lo(xw.y)) * siluf_(bf_lo(zw.y)); y[3] = (y[3] + dsk * bf_hi(xw.y)) * siluf_(bf_hi(zw.y));
                acc[pb][lb] = y; sq[lb] += (y[0] * y[0] + y[1] * y[1]) + (y[2] * y[2] + y[3] * y[3]); } }
#pragma unroll
        for (int lb = 0; lb < 4; ++lb) { float s = sq[lb]; s += shx(s, 16, F.lane); s += shx(s, 32, F.lane);
            if (q == 0) __hip_atomic_fetch_add(Rs + 16 * lb + fr, s, __ATOMIC_RELAXED, __HIP_MEMORY_SCOPE_WORKGROUP); }
        __syncthreads();
#pragma unroll
        for (int lb = 0; lb < 4; ++lb) { const int l = 16 * lb + fr;
            if (l < L) { const float rs = fast_rsqrt(Rs[l] * (1.0f / 512) + EPS);
#pragma unroll
                for (int pb = 0; pb < 4; ++pb) { const int pc = 16 * pb + 4 * q; const f32x4 gn = *(const f32x4*)(p.in(I_SN) + layer * 1024 + head * 64 + pc); const f32x4 y = acc[pb][lb];
                    u32x2 ow; ow.x = pk2(y[0] * rs * gn[0], y[1] * rs * gn[1]); ow.y = pk2(y[2] * rs * gn[2], y[3] * rs * gn[3]);
                    *(u32x2*)(U + (size_t)(m0 + l) * LDU + UC_OSSD + head * 64 + pc) = ow; } } }
        __syncthreads();
    }
}
#ifndef DUPMASK
#define DUPMASK 0
#endif
__device__ __forceinline__ void phase_attn(const Params&, const Frame& F0, int layer0) {
    const Frame F = mk_frame(F0.wave);
    const PV p = pv_get(); int layer = layer0; asm volatile("" : "+s"(layer));
    bf16_t* U = (bf16_t*)(p.ws() + WS_U); const bf16_t* QM = (const bf16_t*)(p.ws() + WS_QM); const bf16_t* KM = (const bf16_t*)(p.ws() + WS_KM);
    const bf16_t* VTM = (const bf16_t*)(p.ws() + WS_VTM); const bf16_t* KFS = (const bf16_t*)(p.ws() + WS_KFS); const bf16_t* VTF = (const bf16_t*)(p.ws() + WS_VTF);
    const float* CUM = (const float*)(p.ws() + WS_CUM);
    for (int it = F.vcu; it < 256; it += F.G) {
        const int h = it >> 5, pr = it & 31;
        AttnSeq a; a.Q = QM + h * 192; a.qs = 1536; a.K = KM + h * 192; a.ks = 1536; a.VT = VTM + (size_t)h * 128 * KVROWS; a.O = U + UC_OMLA + h * 128; a.os = LDU; a.cq = nullptr; a.ck = nullptr;
#pragma unroll 1
        for (int half = 0; half < 2; ++half) attn_prefill_unit<192, false>(F.lds, a, half ? pr : 63 - pr, F.tid);
    }
#if defined(DUPMASK)
    if ((DUPMASK >> 8) & 1) for (int it = F.vcu; it < 256; it += F.G) {
        const int h = it >> 5, pr = it & 31;
        AttnSeq a; a.Q = QM + h * 192; a.qs = 1536; a.K = KM + h * 192; a.ks = 1536; a.VT = VTM + (size_t)h * 128 * KVROWS; a.O = U + UC_OMLA + h * 128; a.os = LDU; a.cq = nullptr; a.ck = nullptr;
#pragma unroll 1
        for (int half = 0; half < 2; ++half) attn_prefill_unit<192, false>(F.lds, a, half ? pr : 63 - pr, F.tid);
    }
#endif
    for (int it = F.vcu; it < 256; it += F.G) {
        const int h = it >> 5, pr = it & 31;
        AttnSeq a; a.Q = U + UC_FQ + h * 128; a.qs = LDU; a.K = U + UC_FK + h * 128; a.ks = LDU; a.VT = VTF + (size_t)h * 128 * KVROWS; a.O = U + UC_OFOX + h * 128; a.os = LDU; a.cq = CUM + h; a.ck = CUM + h;
        const unsigned* ctl = (const unsigned*)(p.ws() + WS_CTL);
        float kn2; { float v = __uint_as_float(ctl[CW_KN2 + (layer * 64 + F.lane) * 8 + h]);
#pragma unroll
            for (int o = 1; o < 64; o <<= 1) v = fmaxf(v, shx(v, o, F.lane)); kn2 = v; }
#pragma unroll 1
        for (int half = 0; half < 2; ++half) { const int qb = half ? pr : 63 - pr;
            attn_prefill_unit<128, true>(F.lds, a, qb, F.tid, 2.02f * __builtin_amdgcn_sqrtf(__uint_as_float(ctl[CW_QN2 + (layer * 64 + qb) * 8 + h]) * kn2)); }
    }
#if defined(DUPMASK)
    if ((DUPMASK >> 9) & 1) for (int it = F.vcu; it < 256; it += F.G) {
        const int h = it >> 5, pr = it & 31;
        AttnSeq a; a.Q = U + UC_FQ + h * 128; a.qs = LDU; a.K = U + UC_FK + h * 128; a.ks = LDU; a.VT = VTF + (size_t)h * 128 * KVROWS; a.O = (bf16_t*)(p.ws() + WS_ST) + h * 128; a.os = 1024; a.cq = CUM + h; a.ck = CUM + h;
        const unsigned* ctl = (const unsigned*)(p.ws() + WS_CTL);
        float kn2; { float v = __uint_as_float(ctl[CW_KN2 + (layer * 64 + F.lane) * 8 + h]);
#pragma unroll
            for (int o = 1; o < 64; o <<= 1) v = fmaxf(v, shx(v, o, F.lane)); kn2 = v; }
#pragma unroll 1
        for (int half = 0; half < 2; ++half) { const int qb = half ? pr : 63 - pr;
            attn_prefill_unit<128, true>(F.lds, a, qb, F.tid, 2.02f * __builtin_amdgcn_sqrtf(__uint_as_float(ctl[CW_QN2 + (layer * 64 + qb) * 8 + h]) * kn2)); }
    }
#endif
    for (int it = F.vcu; it < 2 * NB * 8; it += F.G) {
        const int kind = it >> 7, s = (it & 127) >> 3, h = it & 7; const size_t q0 = (size_t)MP + 16 * s, k0 = (size_t)MP + (size_t)s * KVS;
        if (kind == 0) { AttnSeq a; a.Q = QM + q0 * 1536 + h * 192; a.qs = 1536; a.K = KM + k0 * 1536 + h * 192; a.ks = 1536; a.VT = VTM + (size_t)h * 128 * KVROWS + k0; a.O = U + q0 * LDU + UC_OMLA + h * 128; a.os = LDU; a.cq = nullptr; a.ck = nullptr;
          attn_decode_unit<192, false>(F.lds, a, F.tid); }
        else { AttnSeq a; a.Q = U + q0 * LDU + UC_FQ + h * 128; a.qs = LDU; a.K = KFS + (size_t)s * KVS * 1024 + h * 128; a.ks = 1024; a.VT = VTF + (size_t)h * 128 * KVROWS + k0; a.O = U + q0 * LDU + UC_OFOX + h * 128; a.os = LDU;
          a.cq = CUM + (k0 + PAST) * 8 + h; a.ck = CUM + k0 * 8 + h;
          attn_decode_unit<128, true>(F.lds, a, F.tid); }
    }
}

#define LAUNDER_P const PV p = pv_get()
#define LAUNDER_PL const PV p = pv_get(); int layer = layer0; asm volatile("" : "+s"(layer))
__device__ __forceinline__ void ph_gateup(const Params&, const Frame& F0, size_t woff) {
    const Frame F = mk_frame(F0.wave);
    LAUNDER_P; bf16_t* W = (bf16_t*)(p.ws() + WS_W); bf16_t* XN = (bf16_t*)(p.ws() + WS_XB); bf16_t* H = (bf16_t*)(p.ws() + WS_U);
    pg8::Gemm g{XN, W + woff, 64, 64, MT, 2 * FF, D, (size_t)MT * 128, (size_t)2 * FF * 128}; pg8::StaticOrder S; S.init(MT, 2 * FF, F.G, F.bx, D); S.nrev = true;
    EpiSwiGLU E{H, (const float*)(p.ws() + WS_SS) + RS_OFF}; pg8::gemm_phase<EpiSwiGLU, pg8::StaticOrder, true, true>(F.lds, g, S, E, F.wave);
}
__device__ __forceinline__ void ph_down(const Params&, const Frame& F0, size_t woff, bool from_input, bool dummy = false) {
    const Frame F = mk_frame(F0.wave);
    LAUNDER_P; bf16_t* W = (bf16_t*)(p.ws() + WS_W); bf16_t* H = (bf16_t*)(p.ws() + WS_U);
    pg8::Gemm g{H, W + woff, 64, 64, MT, D, FF, (size_t)MT * 128, (size_t)D * 128}; pg8::SplitOrder S;
    S.init(MT, D, F.G, F.bx, FF);
    EpiResid E{(bf16_t*)(p.ws() + (dummy ? WS_ST : WS_XB)), (float*)(p.ws() + WS_SS), 0.5f, (float*)(p.ws() + WS_PART), (LAS float*)(F.lds + RING_BYTES + 1024)}; pg8::gemm_phase<EpiResid, pg8::SplitOrder, true, true>(F.lds, g, S, E, F.wave);
}
__device__ __forceinline__ void ph_win(const Params&, const Frame& F0, int layer0) {
    const Frame F = mk_frame(F0.wave);
    LAUNDER_PL; bf16_t* W = (bf16_t*)(p.ws() + WS_W); bf16_t* XN = (bf16_t*)(p.ws() + WS_XB); bf16_t* U = (bf16_t*)(p.ws() + WS_U);
    pg8::Gemm g{XN, W + W_IN, 64, 64, MT, NWIN, D, (size_t)MT * 128, (size_t)NWIN * 128}; pg8::StaticOrder S; S.init(MT, NWIN, F.G, F.bx, D);
    EpiWin E{U, (float*)(p.ws() + WS_US), p.out() + O_PFK + (size_t)layer * MP * 1024, p.out() + O_SFK + (size_t)layer * MS * 1024,
             p.out() + O_PFV + (size_t)layer * MP * 1024, p.out() + O_SFV + (size_t)layer * MS * 1024, (const float*)(p.ws() + WS_SS) + RS_OFF};
    pg8::gemm_phase<EpiWin, pg8::StaticOrder, true, true>(F.lds, g, S, E, F.wave);
}
__device__ __forceinline__ void ph_uq(const Params&, const Frame& F0) {
    const Frame F = mk_frame(F0.wave);
    LAUNDER_P; bf16_t* W = (bf16_t*)(p.ws() + WS_W); bf16_t* U = (bf16_t*)(p.ws() + WS_U);
    pg8::Gemm g{U + UC_QLAT, W + W_UQ, LDU, 512, MT, 1536, 512}; pg8::StaticOrder S; S.init(MT, 1536, F.G, F.bx, 512);
    EpiUq E{(bf16_t*)(p.ws() + WS_QM), (const f32x2*)(p.ws() + WS_ROPE)}; pg8::gemm_phase<EpiUq, pg8::StaticOrder, true, true>(F.lds, g, S, E, F.wave);
}
__device__ __forceinline__ void ph_ukv(const Params&, const Frame& F0) {
    const Frame F = mk_frame(F0.wave);
    LAUNDER_P; bf16_t* W = (bf16_t*)(p.ws() + WS_W);
    pg8::Gemm g{(const bf16_t*)(p.ws() + WS_CKV), W + W_UKV, 512, 512, KVROWS, 2048, 512}; pg8::StaticOrder S; S.init(KVROWS, 2048, F.G, (F.G == 256) ? (F.bx + 120) % 256 : F.bx, 512);
    EpiUkv E{(bf16_t*)(p.ws() + WS_KM), (bf16_t*)(p.ws() + WS_VTM)}; pg8::gemm_phase<EpiUkv, pg8::StaticOrder, true, true>(F.lds, g, S, E, F.wave);
}
template <int BR> __device__ __forceinline__ void ph_merge(const Params&, const Frame& F0) {
    const Frame F = mk_frame(F0.wave);
    LAUNDER_P; bf16_t* W = (bf16_t*)(p.ws() + WS_W); bf16_t* U = (bf16_t*)(p.ws() + WS_U); bf16_t* XN = (bf16_t*)(p.ws() + WS_XN);
    constexpr int acol = BR == 0 ? UC_OMLA : (BR == 1 ? UC_OSSD : UC_OFOX);
    pg8::StaticOrder S; S.init(MP, D, F.G, F.bx, 1024, true);
    pg8::Gemm g{U + acol, W + W_BR + (size_t)BR * D * 1024, LDU, 1024, MP, D, 1024}; EpiMerge<BR> E{U, XN}; pg8::gemm_phase<EpiMerge<BR>, pg8::StaticOrder, true, true>(F.lds, g, S, E, F.wave);
}
__device__ __forceinline__ void ph_merge_sample(const Params&, const Frame& F0, int layer0) {
    const Frame F = mk_frame(F0.wave);
    LAUNDER_PL; bf16_t* W = (bf16_t*)(p.ws() + WS_W); bf16_t* U = (bf16_t*)(p.ws() + WS_U); bf16_t* XN = (bf16_t*)(p.ws() + WS_XN);
    pg8::SampleMergeOrder S; S.c = F.bx;
    pg8::Gemm g{U, W + W_BR, LDU, 1024, MT, 3 * D, 1024};
    EpiMergeSample E{U, XN, (float*)(p.ws() + WS_PART), (unsigned*)(p.ws() + WS_CTL) + CW_MGC + layer * 8 * 64, (LAS unsigned*)(F.lds + RING_BYTES)};
    pg8::gemm_phase<EpiMergeSample, pg8::SampleMergeOrder, true, true>(F.lds, g, S, E, F.wave);
}
__device__ __forceinline__ void ph_wout(const Params&, const Frame& F0, bool dummy = false) {
    const Frame F = mk_frame(F0.wave);
    LAUNDER_P; bf16_t* W = (bf16_t*)(p.ws() + WS_W); bf16_t* XN = (bf16_t*)(p.ws() + WS_XN);
    pg8::Gemm g{XN, W + W_OUT, D, D, MT, D, D}; pg8::SplitOrder S; S.init(MT, D, F.G, F.bx, D);
    EpiResid E{(bf16_t*)(p.ws() + (dummy ? WS_ST : WS_XB)), (float*)(p.ws() + WS_SS), 1.0f, (float*)(p.ws() + WS_PART), (LAS float*)(F.lds + RING_BYTES + 1024)}; pg8::gemm_phase<EpiResid, pg8::SplitOrder, true, true>(F.lds, g, S, E, F.wave);
}
__device__ __forceinline__ void ph_norm(const Params&, const Frame& F0, int layer0, int which, bool from_input) {
    const Frame F = mk_frame(F0.wave);
    LAUNDER_PL; float* ys = p.out() + O_YS;
    (void)which; (void)layer;
    phase_prep(F, from_input ? p.in(I_XP) : nullptr, from_input ? p.in(I_XS) : ys, (bf16_t*)(p.ws() + WS_XB), (float*)(p.ws() + WS_SS), from_input ? ys : nullptr, from_input ? nullptr : (const float*)(p.ws() + WS_PART));
}

constexpr int PH_PER_LAYER = 15, N_PHASES = NL * PH_PER_LAYER + 1;
#ifndef N_LAUNCHES
#define N_LAUNCHES 1
#endif
#ifndef PHMASK
#define PHMASK 0xffff
#endif
#ifndef DUPMASK
#define DUPMASK 0
#endif
#define DUP(k) (((DUPMASK) >> (k)) & 1)

__global__ void __launch_bounds__(512, 2) hybrid_fwd(Params p) {
    extern __shared__ __attribute__((aligned(16))) unsigned char lds_raw[];
    const int wave_k = __builtin_amdgcn_readfirstlane((int)threadIdx.x >> 6);
    const Frame F = mk_frame(wave_k);
    volatile LAS unsigned* MISC = (volatile LAS unsigned*)(F.lds + MISC_OFF);
    for (int u = F.tid; u < (LDS_BYTES - LDSCTL_OFF) / 4; u += 512) ((LAS unsigned*)(F.lds + LDSCTL_OFF))[u] = 0u;
    __syncthreads();
    const PV pk = pv_get();
    unsigned* ctl = (unsigned*)(pk.ws() + WS_CTL);
    const int lo = pk.ph_lo(), hi = pk.ph_hi();
    XcdBarrier bar; bar.bar = ctl + CW_BAR; bar.x = 0; bar.st = nullptr;
    if (hi - lo > 1) bar = xcd_barrier_post(ctl + CW_BAR, MISC + 8, F.tid);
#define IN(k) ((((PHMASK) >> (((k) == NL * PH_PER_LAYER) ? 15 : ((k) % PH_PER_LAYER))) & 1) && lo <= (k) && (k) < hi)
#define SEAM(k) do { if (IN(k) && IN((k) + 1)) xcd_barrier(bar, wave_k); } while (0)
    if (IN(0)) phase_rope_table(F);
#pragma unroll 1
    for (int layer = 0; layer < NL; ++layer) {
        const int pb = layer * PH_PER_LAYER;
        if (IN(pb + 0)) { phase_convert(p, F, layer); if (DUP(0)) phase_convert(p, F, layer); }
        if (IN(pb + 1)) { ph_norm(p, F, layer, I_F1N, layer == 0); if (DUP(1)) ph_norm(p, F, layer, I_F1N, layer == 0); }
        SEAM(pb + 1);
        if (IN(pb + 2)) { ph_gateup(p, F, W_GU1); if (DUP(2)) ph_gateup(p, F, W_GU1); }
        SEAM(pb + 2);
        if (IN(pb + 3)) { if (DUP(3)) ph_down(p, F, W_D1, layer == 0, true); ph_down(p, F, W_D1, layer == 0); }
        SEAM(pb + 3);
        if (IN(pb + 4)) ph_norm(p, F, layer, I_MIXN, false);
        SEAM(pb + 4);
        if (IN(pb + 5)) { ph_win(p, F, layer); if (DUP(5)) ph_win(p, F, layer); }
        SEAM(pb + 5);
        if (IN(pb + 6)) phase_t1(p, F, layer);
        SEAM(pb + 6);
        if (IN(pb + 7)) { phase_t2(p, F); ph_uq(p, F); ph_ukv(p, F); phase_s1(p, F, layer); if (DUP(7)) { ph_uq(p, F); ph_ukv(p, F); } if (DUP(6)) phase_s1(p, F, layer); }
        SEAM(pb + 7);
        if (IN(pb + 8)) { phase_attn(p, F, layer); phase_s2(p, F, layer); }
        SEAM(pb + 8);
        if (IN(pb + 9)) phase_s3(p, F, layer);
        SEAM(pb + 9);
        if (IN(pb + 10)) { ph_merge_sample(p, F, layer); ph_merge<0>(p, F); ph_merge<1>(p, F); ph_merge<2>(p, F); }
        SEAM(pb + 10);
        if (IN(pb + 11)) { if (DUP(11)) ph_wout(p, F, true); ph_wout(p, F); }
        SEAM(pb + 11);
        if (IN(pb + 12)) ph_norm(p, F, layer, I_F2N, false);
        SEAM(pb + 12);
        if (IN(pb + 13)) ph_gateup(p, F, W_GU2);
        SEAM(pb + 13);
        if (IN(pb + 14)) ph_down(p, F, W_D2, false);
        SEAM(pb + 14);
    }
    if (IN(NL * PH_PER_LAYER)) { const PV q = pv_get(); const Frame F2 = mk_frame(wave_k); phase_final_norm(F2, q.out() + O_YP, (const bf16_t*)(q.ws() + WS_XB), q.in(I_FN), (const float*)(q.ws() + WS_PART)); }
#undef IN
#undef SEAM
}

extern "C" void kernel_launch(void* const* d_in, const int* in_sizes, int n_in, void* d_out, int out_size, void* d_ws, size_t ws_size, hipStream_t stream) {
    static int grid = 0;
    if (grid == 0) {
        if (n_in != N_IN || (size_t)out_size != O_TOTAL || ws_size < WS_END) { fprintf(stderr, "kernel_launch: unexpected shapes: n_in %d out %d ws %zu (need %zu)\n", n_in, out_size, ws_size, (size_t)WS_END); grid = -1; return; }
        int dev = 0, cus = 0, per_cu = 0;
        if (hipGetDevice(&dev) != hipSuccess || hipDeviceGetAttribute(&cus, hipDeviceAttributeMultiprocessorCount, dev) != hipSuccess) { grid = -1; return; }
        if (hipFuncSetAttribute((const void*)hybrid_fwd, hipFuncAttributeMaxDynamicSharedMemorySize, LDS_BYTES) != hipSuccess) { fprintf(stderr, "kernel_launch: hipFuncSetAttribute failed\n"); grid = -1; return; }
        if (hipOccupancyMaxActiveBlocksPerMultiprocessor(&per_cu, (const void*)hybrid_fwd, 512, LDS_BYTES) != hipSuccess || per_cu < 1) { fprintf(stderr, "kernel_launch: occupancy query says %d\n", per_cu); }
        (void)hipGetLastError();
        grid = cus;
    }
    if (grid < 0) return;
    (void)hipMemsetAsync((char*)d_ws + WS_CTL, 0, CTL_BYTES, stream);
    Params p{};
    for (int i = 0; i < N_IN; ++i) p.in[i] = (const float*)d_in[i];
    p.out = (float*)d_out; p.ws = (unsigned char*)d_ws;
#if defined(PROBE_K)
    p.ph_lo = 0; p.ph_hi = PROBE_K;
    hipLaunchKernelGGL(hybrid_fwd, dim3(grid), dim3(512), LDS_BYTES, stream, p);
    (void)hipMemsetAsync((char*)d_ws + WS_CTL, 0, CTL_BYTES, stream);
    p.ph_lo = 0; p.ph_hi = N_PHASES;
    hipLaunchKernelGGL(hybrid_fwd, dim3(grid), dim3(512), LDS_BYTES, stream, p);
#elif N_LAUNCHES == 1
    p.ph_lo = 0; p.ph_hi = N_PHASES;
    hipLaunchKernelGGL(hybrid_fwd, dim3(grid), dim3(512), LDS_BYTES, stream, p);
#else
    for (int k = 0; k < N_PHASES; ++k) { p.ph_lo = k; p.ph_hi = k + 1; hipLaunchKernelGGL(hybrid_fwd, dim3(grid), dim3(512), LDS_BYTES, stream, p); }
#endif
}
```

```cpp
#include <hip/hip_runtime.h>
#include <cstdio>
#include <cstdint>

#define LAS __attribute__((address_space(3)))
typedef unsigned short bf16_t;
typedef short bf16x8 __attribute__((ext_vector_type(8)));
typedef float f32x4 __attribute__((ext_vector_type(4)));
typedef float f32x2 __attribute__((ext_vector_type(2)));
typedef float f32x16 __attribute__((ext_vector_type(16)));
typedef unsigned u32x4 __attribute__((ext_vector_type(4)));
typedef unsigned u32x2 __attribute__((ext_vector_type(2)));
typedef __bf16 bf2_t __attribute__((ext_vector_type(2)));

constexpr int D = 2048, SEQ = 16384, NB = 16, NS = 16, PAST = 1024, FF = 5504, NL = 2;
constexpr int MP = SEQ, MS = NB * NS, MT = MP + MS;
constexpr int KVS = 1088, KVLEN_S = PAST + NS;
constexpr int KVROWS = MP + NB * KVS;
constexpr int LDU = 12800;
constexpr int IN_COLS = 12888, NWIN = 13056;
constexpr float LOG2E = 1.4426950408889634f;
constexpr float MLA_QSCALE = 0.07216878364870322f * LOG2E;
constexpr float FOX_QSCALE = 0.08838834764831845f * LOG2E;
constexpr float EPS = 1e-6f;
constexpr int UC_QLAT = 0, UC_CKV = 512, UC_Z = 1024, UC_XBC = 2048, UC_FQ = 3584, UC_FK = 4608, UC_FV = 5632, UC_GATE = 6656;
constexpr int UC_OMLA = 0, UC_OSSD = UC_Z, UC_OFOX = UC_FQ;
constexpr int US_KPE = 0, US_DT = 64, US_FF = 80, LDUS = 128;

enum { I_XP = 0, I_XS, I_CCKV, I_CKPE, I_CFK, I_CFV, I_CLOGF, I_SSM, I_CONV, I_F1N, I_F1G, I_F1U, I_F1D, I_MIXN, I_WIN, I_QN, I_WUQ, I_KVN, I_WUKV,
       I_CW, I_CB, I_DTB, I_ALOG, I_SD, I_SN, I_FBF, I_BRM, I_BRS, I_BRF, I_WOUT, I_F2N, I_F2G, I_F2U, I_F2D, I_FN, N_IN };
constexpr size_t O_YP = 0, O_YS = 33554432, O_PCKV = 34078720, O_PKPE = 50855936, O_PFK = 52953088, O_PFV = 86507520, O_PLOGF = 120061952,
                 O_PSSM = 120324096, O_PCONV = 120586240, O_SCKV = 120595456, O_SKPE = 120857600, O_SFK = 120890368, O_SFV = 121414656,
                 O_SLOGF = 121938944, O_SSSM = 121943040, O_SCONV = 126137344, O_TOTAL = 126284800;

constexpr size_t W_GU1 = 0, W_D1 = W_GU1 + (size_t)2 * FF * D, W_IN = W_D1 + (size_t)D * FF, W_UQ = W_IN + (size_t)NWIN * D, W_UKV = W_UQ + (size_t)1536 * 512,
                 W_BR = W_UKV + (size_t)2048 * 512, W_OUT = W_BR + (size_t)3 * 2048 * 1024, W_GU2 = W_OUT + (size_t)D * D, W_D2 = W_GU2 + (size_t)2 * FF * D,
                 W_TOTAL = W_D2 + (size_t)D * FF;

constexpr size_t MiB = 1u << 20;
constexpr size_t al(size_t x) { return (x + MiB - 1) / MiB * MiB; }
constexpr size_t WS_CTL = 0, CTL_BYTES = 1 * MiB;
constexpr size_t WS_ROPE = WS_CTL + CTL_BYTES;
constexpr size_t WS_W = WS_ROPE + al((size_t)SEQ * 32 * 8);
constexpr size_t WS_HB = WS_W;
constexpr size_t WS_XN = WS_W + al(W_TOTAL * 2);
constexpr size_t WS_U = WS_XN + al((size_t)MT * D * 2);
constexpr size_t WS_US = WS_U + al((size_t)MT * LDU * 2);
constexpr size_t WS_DT = WS_US + al((size_t)MT * LDUS * 4);
constexpr size_t WS_QM = WS_DT + al((size_t)MT * 16 * 4);
constexpr size_t WS_CKV = WS_QM + al((size_t)MT * 1536 * 2);
constexpr size_t WS_KM = WS_CKV + al((size_t)KVROWS * 512 * 2);
constexpr size_t WS_VTM = WS_KM + al((size_t)KVROWS * 1536 * 2);
constexpr size_t WS_KFS = WS_VTM + al((size_t)1024 * KVROWS * 2);
constexpr size_t WS_VTF = WS_KFS + al((size_t)NB * KVS * 1024 * 2);
constexpr size_t WS_LOGF = WS_VTF + al((size_t)1024 * KVROWS * 2);
constexpr size_t WS_CUM = WS_LOGF + al((size_t)KVROWS * 8 * 4);
constexpr int NCHUNK = 256 + NB;
constexpr size_t WS_ST = WS_CUM + al((size_t)KVROWS * 8 * 4);
constexpr size_t WS_CDEC = WS_ST + al((size_t)NCHUNK * 131072 * 4);
constexpr size_t WS_PART = WS_CDEC + MiB;
constexpr size_t WS_XB = WS_PART + al((size_t)8 * MS * D * 4);
constexpr size_t WS_SS = WS_XB + al((size_t)MT * D * 2);
constexpr size_t RS_OFF = 196608;
constexpr size_t WS_END = WS_SS + al((size_t)MT * 8 * 4);
static_assert((size_t)MT * 8 <= RS_OFF && (RS_OFF + MT) * 4 <= MiB, "ss / rs");

constexpr int CW_TMO = 0, CW_BAR = 4096;
constexpr int CW_MGC = 12288;
constexpr int CW_QN2 = 8192, CW_KN2 = CW_QN2 + NL * 64 * 8;

constexpr int RING_BYTES = 131072, LDS_BYTES = 163840, LDSCTL_OFF = LDS_BYTES - 512, MISC_OFF = LDSCTL_OFF + 320;

struct Params {
    const float* in[N_IN];
    float* out;
    unsigned char* ws;
    int ph_lo, ph_hi;
};

typedef const __attribute__((address_space(4))) unsigned char* KA;
struct PV { KA k;
    __device__ __forceinline__ const float* in(int i) const { return *(const float* const __attribute__((address_space(4)))*)(k + 8 * i); }
    __device__ __forceinline__ float* out() const { return *(float* const __attribute__((address_space(4)))*)(k + 8 * N_IN); }
    __device__ __forceinline__ unsigned char* ws() const { return *(unsigned char* const __attribute__((address_space(4)))*)(k + 8 * N_IN + 8); }
    __device__ __forceinline__ int ph_lo() const { return *(const __attribute__((address_space(4))) int*)(k + 8 * N_IN + 16); }
    __device__ __forceinline__ int ph_hi() const { return *(const __attribute__((address_space(4))) int*)(k + 8 * N_IN + 20); }
};
__device__ __forceinline__ PV pv_get() { PV v; v.k = (KA)__builtin_amdgcn_kernarg_segment_ptr(); asm volatile("" : "+s"(v.k)); return v; }
static_assert(sizeof(Params) == 8 * N_IN + 24, "Params layout");

#define LDS_WAIT() asm volatile("s_waitcnt lgkmcnt(0)" ::: "memory")
#define VM_WAIT() asm volatile("s_waitcnt vmcnt(0)" ::: "memory")
__device__ __forceinline__ unsigned pk2(float lo, float hi) { bf2_t v = {(__bf16)lo, (__bf16)hi}; return __builtin_bit_cast(unsigned, v); }
__device__ __forceinline__ float bf_lo(unsigned w) { return __uint_as_float(w << 16); }
__device__ __forceinline__ float bf_hi(unsigned w) { return __uint_as_float(w & 0xffff0000u); }
__device__ __forceinline__ float bf2f(bf16_t b) { return __uint_as_float((unsigned)b << 16); }
__device__ __forceinline__ bf16_t f2bf(float f) { return (bf16_t)(pk2(f, 0.f) & 0xffffu); }
__device__ __forceinline__ float shx(float v, int o, int lane) { return __int_as_float(__builtin_amdgcn_ds_bpermute((lane ^ o) << 2, __float_as_int(v))); }
__device__ __forceinline__ float wave_sum(float v, int lane) {
#pragma unroll
    for (int o = 1; o < 64; o <<= 1) v += shx(v, o, lane);
    return v;
}
__device__ __forceinline__ float fast_exp2(float x) { return __builtin_amdgcn_exp2f(x); }
__device__ __forceinline__ float fast_exp(float x) { return __builtin_amdgcn_exp2f(x * LOG2E); }
__device__ __forceinline__ float fast_rsqrt(float x) { return __builtin_amdgcn_rsqf(x); }
__device__ __forceinline__ float fast_log(float x) { return __builtin_amdgcn_logf(x) * 0.6931471805599453f; }
__device__ __forceinline__ float sigmoidf_(float x) { return __builtin_amdgcn_rcpf(1.f + fast_exp2(-x * LOG2E)); }
__device__ __forceinline__ float siluf_(float x) { return x * sigmoidf_(x); }
__device__ __forceinline__ int kvrow_of(int m) { return m < MP ? m : MP + ((m - MP) >> 4) * KVS + PAST + ((m - MP) & 15); }
__device__ __forceinline__ int pos_of(int m) { return m < MP ? m : PAST + ((m - MP) & 15); }

#define XB_TMO      128
#define XB_XCNT(j)  (256  + 64 * (j))
#define XB_XSUB(j)  (1280 + 64 * (j))
#define XB_XGEN(j)  (2304 + 64 * (j))
#define XB_TOP      3328
#define XB_TOPGEN   3392
#define XCD_BAR_WORDS 3456
#define XB_SPIN_CAP (1u << 22)
__device__ __forceinline__ unsigned xb_ld(unsigned* p)              { return __hip_atomic_load(p, __ATOMIC_RELAXED, __HIP_MEMORY_SCOPE_AGENT); }
__device__ __forceinline__ unsigned xb_add(unsigned* p, unsigned v) { return __hip_atomic_fetch_add(p, v, __ATOMIC_RELAXED, __HIP_MEMORY_SCOPE_AGENT); }
__device__ __forceinline__ unsigned xb_xcc_id() { return (unsigned)__builtin_amdgcn_s_getreg((3 << 11) | 20) & 0xFu; }
#define XB_SPIN(cond, bar) do { unsigned _sp = 0; while (cond) { __builtin_amdgcn_s_sleep(1); \
    if ((++_sp & 255u) == 0u) { if (xb_ld(&(bar)[XB_TMO])) break; if (_sp > XB_SPIN_CAP) { atomicAdd(&(bar)[XB_TMO], 1u); break; } } } } while (0)
struct XcdBarrier { unsigned* bar; unsigned x; volatile LAS unsigned* st; };
__device__ __forceinline__ XcdBarrier xcd_barrier_post(unsigned* bar, volatile LAS unsigned* st, int tid) {
    XcdBarrier b; b.bar = bar; b.x = xb_xcc_id(); b.st = st;
    if (tid == 0) (void)xb_add(&bar[XB_XCNT(b.x)], 1u);
    return b;
}
__device__ __forceinline__ void xcd_barrier_complete(unsigned* bar, unsigned x, unsigned& nloc, unsigned& nx) {
    const unsigned G = gridDim.x * gridDim.y * gridDim.z;
    unsigned sum, cnt, mine, sp = 0u;
    for (;;) {
        sum = 0u; cnt = 0u; mine = 0u;
#pragma unroll
        for (unsigned j = 0; j < 16; ++j) { const unsigned c = xb_ld(&bar[XB_XCNT(j)]); sum += c; cnt += (c > 0u) ? 1u : 0u; mine = (j == x) ? c : mine; }
        if (sum == G) break;
        __builtin_amdgcn_s_sleep(1);
        if ((++sp & 255u) == 0u) { if (xb_ld(&bar[XB_TMO])) break; if (sp > XB_SPIN_CAP) { atomicAdd(&bar[XB_TMO], 1u); break; } }
    }
    nloc = mine > 0u ? mine : 1u; nx = cnt > 0u ? cnt : 1u;
}
__device__ __forceinline__ void xcd_barrier(const XcdBarrier& b, int wave_s) {
    asm volatile("s_waitcnt vmcnt(0)" ::: "memory");
    __syncthreads();
    int tid_b; { unsigned z_ = 0u; asm volatile("" : "+s"(z_)); tid_b = wave_s * 64 + (int)__builtin_amdgcn_mbcnt_hi(~0u, __builtin_amdgcn_mbcnt_lo(~0u, z_)); }
    if (tid_b == 0) {
        unsigned* bar = b.bar; asm volatile("" : "+s"(bar));
        __builtin_amdgcn_s_waitcnt(0);
        unsigned nloc = b.st[0], nx = b.st[1];
        if (nloc == 0u) { xcd_barrier_complete(bar, b.x, nloc, nx); b.st[0] = nloc; b.st[1] = nx; }
        const unsigned old = xb_add(&bar[XB_XSUB(b.x)], 1u);
        const unsigned gen = old / nloc;
        if (old + 1u == (gen + 1u) * nloc) {
            __builtin_amdgcn_fence(__ATOMIC_RELEASE, "agent");
            asm volatile("s_waitcnt vmcnt(0)" ::: "memory");
            const unsigned og = xb_add(&bar[XB_TOP], 1u);
            const unsigned tg = og / nx;
            if (og + 1u == (tg + 1u) * nx) xb_add(&bar[XB_TOPGEN], 1u);
            else XB_SPIN(xb_ld(&bar[XB_TOPGEN]) == tg, bar);
            __builtin_amdgcn_fence(__ATOMIC_ACQUIRE, "agent");
            xb_add(&bar[XB_XGEN(b.x)], 1u);
            asm volatile("s_waitcnt vmcnt(0)" ::: "memory");
        } else {
            XB_SPIN(xb_ld(&bar[XB_XGEN(b.x)]) == gen, bar);
            __builtin_amdgcn_fence(__ATOMIC_ACQUIRE, "agent");
            asm volatile("s_waitcnt vmcnt(0)" ::: "memory");
        }
    }
    __syncthreads();
}

namespace pg8 {
constexpr int BM = 256, BK = 64, HALF = 128, HTB = HALF * BK * 2, STAGE_BYTES = 8 * HTB, NXCD = 8, WGM = 8;
__host__ __device__ __forceinline__ int lds_byte(int r, int c) { const int st = (r >> 4) * 2 + (c >> 5), rr = r & 15, cc = c & 31, ob = rr * 64 + cc * 2; return st * 1024 + (ob ^ (((ob >> 9) & 1) << 5)); }
__host__ __device__ __forceinline__ void stage_rc(int b, int& R, int& C) { const int st = b / 1024, sb = b % 1024, swz = sb ^ (((sb >> 9) & 1) << 5); R = (st >> 1) * 16 + swz / 64; C = (st & 1) * 32 + (swz % 64) / 2; }
__host__ __device__ __forceinline__ int perm32(int rho) { const int n = rho >> 4, i = rho & 15; return 8 * (i >> 2) + 4 * n + (i & 3); }
struct Unit { int pm, pn, k0, nt, sp; };
struct Gemm { const bf16_t* A; const bf16_t* Bt; int lda, ldb, M, N, K; size_t ksA = 128, ksB = 128; };
struct StaticOrder {
    int nM, nN, nwg, G, c, ntK; bool nfast; bool nrev = false;
    __host__ __device__ __forceinline__ void init(int M, int N, int G_, int c_, int K_ = 0, bool nfast_ = false) { nM = M / BM; nN = N / BM; nwg = nM * nN; G = G_; c = c_; ntK = K_ / BK; nfast = nfast_; }
    __host__ __device__ __forceinline__ bool next(int i, Unit& u) const {
        const long L = (long)i * G + c; if (L >= nwg) return false;
        int wgid = (int)L; { const int q = nwg / NXCD, r = nwg % NXCD, xcd = wgid % NXCD, off = wgid / NXCD; wgid = (xcd < r ? xcd * (q + 1) : r * (q + 1) + (xcd - r) * q) + off; }
        const int nig = WGM * nN, gid = wgid / nig, fm = gid * WGM, gsz = (nM - fm) < WGM ? (nM - fm) : WGM;
        const int ig = wgid % nig;
        u.pm = nfast ? fm + ig / nN : fm + (ig % gsz); u.pn = nfast ? ig % nN : ig / gsz; if (nrev) u.pn = nN - 1 - u.pn; u.k0 = 0; u.nt = ntK; u.sp = 0; return true;
    }
    __device__ __forceinline__ void a_ready(const Unit&) const {}
    __device__ __forceinline__ void done(const Unit&) const {}
    __device__ __forceinline__ size_t a_extra(const Unit&) const { return 0; }
};
struct SplitOrder : StaticOrder {
    __host__ __device__ __forceinline__ void init(int M, int N, int G_, int c_, int K_) { StaticOrder::init(M - BM, N, G_, c_, K_, true); }
    __host__ __device__ __forceinline__ bool next(int i, Unit& u) const {
        const long L = (long)i * G + c;
        const bool reg = L < nwg; const int idx = (int)(L - nwg);
        const int ns = 8;
        if (!reg && idx >= nN * ns) return false;
        Unit a; a.pm = 0; a.pn = 0; a.k0 = 0; a.nt = ntK; a.sp = 0;
        if (reg) { Unit t; StaticOrder::next(i, t); a.pm = t.pm; a.pn = t.pn; }
        const int sp = idx / nN;
        const int base = (ntK / ns) & ~1, extra = (ntK - ns * base) / 2;
        const int s_nt = base + (sp < extra ? 2 : 0), s_k0 = base * sp + 2 * (sp < extra ? sp : extra);
        u.pm = reg ? a.pm : nM; u.pn = reg ? a.pn : idx % nN; u.k0 = reg ? 0 : s_k0; u.nt = reg ? ntK : s_nt; u.sp = reg ? 0 : sp;
        return true;
    }
};
struct SampleMergeOrder {
    int c;
    __host__ __device__ __forceinline__ bool next(int i, Unit& u) const {
        if (i != 0 || c >= 24) return false;
        u.pm = MP / BM; u.pn = c; u.k0 = 0; u.nt = 16; u.sp = 0; return true;
    }
    __device__ __forceinline__ void a_ready(const Unit&) const {}
    __device__ __forceinline__ void done(const Unit&) const {}
    __device__ __forceinline__ size_t a_extra(const Unit& u) const { const int br = u.pn >> 3; return (size_t)(br == 0 ? UC_OMLA : (br == 1 ? UC_OSSD : UC_OFOX)) * 2; }
};
template <class Epi, class Sched, bool ALIGN_EPI = false, bool SP2 = false>
__device__ __forceinline__ void gemm_phase(LAS unsigned char* lds, const Gemm g, const Sched& S, const Epi& E, int wave_s) {
    int tid_; { unsigned z_ = 0u; asm volatile("" : "+s"(z_)); tid_ = wave_s * 64 + (int)__builtin_amdgcn_mbcnt_hi(~0u, __builtin_amdgcn_mbcnt_lo(~0u, z_)); }
    const int tid = tid_, wid = __builtin_amdgcn_readfirstlane(tid >> 6), lane = tid & 63, wr = wid >> 2, wc = wid & 3, fr = lane & 15, fq = lane >> 4;
    unsigned voffA[2], voffB[2];
#pragma unroll
    for (int i = 0; i < 2; ++i) { int R, C; stage_rc(tid * 16 + i * 8192, R, C); const int Rb = Epi::PERM ? ((R & ~31) + perm32(R & 31)) : R;
        voffA[i] = (unsigned)(R * g.lda + C) * 2u; voffB[i] = (unsigned)(Rb * g.ldb + C) * 2u; }
    const size_t kstepA = g.ksA, kstepB = g.ksB;
    const size_t hstepA = (size_t)HALF * g.lda * 2, hstepB = (size_t)HALF * g.ldb * 2;
    const size_t tstepA = 2 * hstepA, tstepB = 2 * hstepB;
    const unsigned ldsw = (unsigned)wid * 1024u;
    const int aoff = lds_byte(wr * 64 + fr, fq * 8), boff = lds_byte(wc * 32 + fr, fq * 8);
#define PG8_SA(b, h) (((b) * 2 + (h)) * HTB)
#define PG8_SB(b, h) ((4 + (b) * 2 + (h)) * HTB)
#define PG8_STAGE(bufoff, gbase, voff) do { _Pragma("unroll") for (int _i = 0; _i < 2; ++_i) \
        __builtin_amdgcn_global_load_lds((const unsigned*)((const char*)(gbase) + (voff)[_i]), (LAS unsigned*)(lds + (bufoff) + ldsw + _i * 8192), 16, 0, 0); } while (0)
#define PG8_LDA(dst, b, h) do { _Pragma("unroll") for (int m = 0; m < 4; ++m) _Pragma("unroll") for (int k = 0; k < 2; ++k) dst[m][k] = *(const LAS bf16x8*)(lds + PG8_SA(b, h) + aoff + m * 2048 + k * 1024); } while (0)
#define PG8_LDB(dst, b, h) do { _Pragma("unroll") for (int n = 0; n < 2; ++n) _Pragma("unroll") for (int k = 0; k < 2; ++k) dst[n][k] = *(const LAS bf16x8*)(lds + PG8_SB(b, h) + boff + n * 2048 + k * 1024); } while (0)
#define PG8_MMA(ai, bj, At, Bt) do { __builtin_amdgcn_s_setprio(1); _Pragma("unroll") for (int m = 0; m < 4; ++m) _Pragma("unroll") for (int n = 0; n < 2; ++n) _Pragma("unroll") for (int k = 0; k < 2; ++k) \
        acc[ai][bj][m][n] = __builtin_amdgcn_mfma_f32_16x16x32_bf16(Bt[n][k], At[m][k], acc[ai][bj][m][n], 0, 0, 0); __builtin_amdgcn_s_setprio(0); } while (0)
#define PG8_WAIT_V(n) asm volatile("s_waitcnt vmcnt(" #n ")" ::: "memory")
#define PG8_WAIT_L(n) asm volatile("s_waitcnt lgkmcnt(" #n ")" ::: "memory")
#define PG8_BAR __builtin_amdgcn_s_barrier()
#define PG8_SCHED __builtin_amdgcn_sched_barrier(0)
    Unit cur, nxt; int ui = 0;
    if (!S.next(0, cur)) return;
    float zf_ = 0.f; asm volatile("" : "+v"(zf_));
    const f32x4 zero4 = {zf_, zf_, zf_, zf_};
    f32x4 acc[2][2][4][2];
#pragma unroll
    for (int a = 0; a < 2; ++a)
#pragma unroll
        for (int b = 0; b < 2; ++b)
#pragma unroll
            for (int m = 0; m < 4; ++m)
#pragma unroll
                for (int n = 0; n < 2; ++n) acc[a][b][m][n] = zero4;
    bf16x8 At[4][2], B0[2][2], B1[2][2];
    const char* cA = (const char*)g.A + (size_t)cur.pm * tstepA + (size_t)cur.k0 * kstepA + S.a_extra(cur); const char* cB = (const char*)g.Bt + (size_t)cur.pn * tstepB + (size_t)cur.k0 * kstepB;
    S.a_ready(cur);
    if constexpr (SP2) {
        PG8_STAGE(PG8_SB(0, 0), cB, voffB); PG8_STAGE(PG8_SB(0, 1), cB + hstepB, voffB); PG8_STAGE(PG8_SA(0, 0), cA, voffA); PG8_STAGE(PG8_SA(0, 1), cA + hstepA, voffA);
        if (wr == 1) PG8_BAR;
        PG8_WAIT_V(2); PG8_BAR;
        PG8_STAGE(PG8_SB(1, 0), cB + kstepB, voffB); PG8_STAGE(PG8_SA(1, 0), cA + kstepA, voffA); PG8_STAGE(PG8_SB(1, 1), cB + hstepB + kstepB, voffB);
        PG8_WAIT_V(6); PG8_BAR;
    } else {
        PG8_STAGE(PG8_SB(0, 0), cB, voffB); PG8_STAGE(PG8_SA(0, 0), cA, voffA); PG8_STAGE(PG8_SB(0, 1), cB + hstepB, voffB); PG8_STAGE(PG8_SA(0, 1), cA + hstepA, voffA);
        if (wr == 1) PG8_BAR;
        PG8_WAIT_V(4); PG8_BAR;
        PG8_STAGE(PG8_SB(1, 0), cB + kstepB, voffB); PG8_STAGE(PG8_SA(1, 0), cA + kstepA, voffA); PG8_STAGE(PG8_SB(1, 1), cB + hstepB + kstepB, voffB);
        PG8_WAIT_V(6); PG8_BAR;
    }
    for (;;) {
        float st0 = 0.f, st1 = 0.f;
        if constexpr (Epi::PRE) E.pre(cur, wr, lane, st0, st1);
        const bool has_next = S.next(ui + 1, nxt);
        const char* nA = has_next ? (const char*)g.A + (size_t)nxt.pm * tstepA + (size_t)nxt.k0 * kstepA + S.a_extra(nxt) : cA; const char* nB = has_next ? (const char*)g.Bt + (size_t)nxt.pn * tstepB + (size_t)nxt.k0 * kstepB : cB;
        const int nt = cur.nt;
        for (int t = 0; t < nt; t += 2) {
            const bool last = (t == nt - 2);
            const char* a1 = cA + (size_t)(t + 1) * kstepA;
            const char* a2 = last ? nA : cA + (size_t)(t + 2) * kstepA; const char* b2 = last ? nB : cB + (size_t)(t + 2) * kstepB;
            const char* a3 = a2 + kstepA; const char* b3 = b2 + kstepB;
            if (last && has_next) S.a_ready(nxt);
            if constexpr (SP2) {
            PG8_LDB(B0, 0, 0); PG8_LDB(B1, 0, 1); PG8_SCHED; PG8_LDA(At, 0, 0); PG8_STAGE(PG8_SA(1, 1), a1 + hstepA, voffA);
            PG8_WAIT_V(8); PG8_WAIT_L(0); PG8_BAR; PG8_MMA(0, 0, At, B0); PG8_MMA(0, 1, At, B1); PG8_BAR; PG8_SCHED;
            PG8_LDA(At, 0, 1); PG8_STAGE(PG8_SB(0, 0), b2, voffB); PG8_STAGE(PG8_SB(0, 1), b2 + hstepB, voffB); PG8_STAGE(PG8_SA(0, 0), a2, voffA);
            PG8_WAIT_V(8); PG8_WAIT_L(0); PG8_BAR; PG8_MMA(1, 0, At, B0); PG8_MMA(1, 1, At, B1); PG8_BAR; PG8_SCHED;
            PG8_LDB(B0, 1, 0); PG8_LDB(B1, 1, 1); PG8_SCHED; PG8_LDA(At, 1, 0); PG8_STAGE(PG8_SA(0, 1), a2 + hstepA, voffA);
            PG8_WAIT_V(8); PG8_WAIT_L(0); PG8_BAR; PG8_MMA(0, 0, At, B0); PG8_MMA(0, 1, At, B1); PG8_BAR; PG8_SCHED;
            PG8_LDA(At, 1, 1); PG8_STAGE(PG8_SB(1, 0), b3, voffB); PG8_STAGE(PG8_SB(1, 1), b3 + hstepB, voffB); PG8_STAGE(PG8_SA(1, 0), a3, voffA);
            PG8_WAIT_V(8); PG8_WAIT_L(0); PG8_BAR; PG8_MMA(1, 0, At, B0); PG8_MMA(1, 1, At, B1); PG8_BAR; PG8_SCHED;
            } else {
            PG8_LDB(B0, 0, 0); PG8_SCHED; PG8_LDA(At, 0, 0); PG8_STAGE(PG8_SA(1, 1), a1 + hstepA, voffA);
            PG8_WAIT_L(8); PG8_BAR; PG8_WAIT_L(0); PG8_MMA(0, 0, At, B0); PG8_BAR; PG8_SCHED;
            PG8_LDB(B1, 0, 1); PG8_STAGE(PG8_SB(0, 0), b2, voffB);
            PG8_BAR; PG8_WAIT_L(0); PG8_MMA(0, 1, At, B1); PG8_BAR;
            PG8_LDA(At, 0, 1); PG8_STAGE(PG8_SA(0, 0), a2, voffA);
            PG8_BAR; PG8_WAIT_L(0); PG8_MMA(1, 0, At, B0); PG8_BAR; PG8_SCHED;
            PG8_STAGE(PG8_SB(0, 1), b2 + hstepB, voffB);
            PG8_WAIT_V(6); PG8_BAR; PG8_MMA(1, 1, At, B1); PG8_BAR;
            PG8_LDB(B0, 1, 0); PG8_SCHED; PG8_LDA(At, 1, 0); PG8_STAGE(PG8_SA(0, 1), a2 + hstepA, voffA);
            PG8_WAIT_L(8); PG8_BAR; PG8_WAIT_L(0); PG8_MMA(0, 0, At, B0); PG8_BAR; PG8_SCHED;
            PG8_LDB(B1, 1, 1); PG8_STAGE(PG8_SB(1, 0), b3, voffB);
            PG8_BAR; PG8_WAIT_L(0); PG8_MMA(0, 1, At, B1); PG8_BAR;
            PG8_LDA(At, 1, 1); PG8_STAGE(PG8_SA(1, 0), a3, voffA);
            PG8_BAR; PG8_WAIT_L(0); PG8_MMA(1, 0, At, B0); PG8_BAR; PG8_SCHED;
            PG8_STAGE(PG8_SB(1, 1), b3 + hstepB, voffB);
            PG8_WAIT_V(6); PG8_BAR; PG8_MMA(1, 1, At, B1); PG8_BAR;
            }
        }
        if constexpr (ALIGN_EPI) { if (wr == 0) PG8_BAR; }
        if constexpr (Epi::PRE) E(acc, cur, wr, wc, fr, fq, st0, st1); else E(acc, cur, wr, wc, fr, fq);
        S.done(cur);
        if (!has_next) break;
#pragma unroll
        for (int a = 0; a < 2; ++a)
#pragma unroll
            for (int b = 0; b < 2; ++b)
#pragma unroll
                for (int m = 0; m < 4; ++m)
#pragma unroll
                    for (int n = 0; n < 2; ++n) acc[a][b][m][n] = zero4;
        cur = nxt; cA = nA; cB = nB; ++ui;
        if constexpr (ALIGN_EPI) { if (wr == 1) PG8_BAR; }
    }
    PG8_WAIT_V(0);
    if constexpr (!ALIGN_EPI) { if (wr == 0) PG8_BAR; }
    PG8_BAR;
#undef PG8_SA
#undef PG8_SB
#undef PG8_STAGE
#undef PG8_LDA
#undef PG8_LDB
#undef PG8_MMA
#undef PG8_WAIT_V
#undef PG8_WAIT_L
#undef PG8_BAR
#undef PG8_SCHED
}
}
using pg8::Unit;
typedef const f32x4 (&AccRef)[2][2][4][2];

__device__ __forceinline__ void rs_pre(const float* RS, int pm, int wr, int lane, float& a, float& b) { const float* q = RS + pm * 256 + wr * 64 + lane; a = q[0]; b = q[128]; }
__device__ __forceinline__ void row_rs(float st0, float st1, int fr, float (&rs)[2][4]) {
#pragma unroll
    for (int ai = 0; ai < 2; ++ai)
#pragma unroll
        for (int m = 0; m < 4; ++m) rs[ai][m] = __int_as_float(__builtin_amdgcn_ds_bpermute((m * 16 + fr) << 2, __float_as_int(ai ? st1 : st0)));
}
struct EpiSwiGLU {
    static constexpr bool PERM = true; static constexpr bool PRE = true;
    bf16_t* H; const float* SS;
    __device__ __forceinline__ void pre(const Unit& u, int wr, int lane, float& a, float& b) const { rs_pre(SS, u.pm, wr, lane, a, b); }
    __device__ __forceinline__ void operator()(AccRef acc, const Unit& u, int wr, int wc, int fr, int fq, float st0, float st1) const {
        const int row0 = u.pm * 256 + wr * 64 + fr, col0 = u.pn * 128 + wc * 32 + 8 * fq;
        float rs[2][4]; row_rs(st0, st1, fr, rs);
#pragma unroll
        for (int ai = 0; ai < 2; ++ai)
#pragma unroll
            for (int m = 0; m < 4; ++m) {
                const float r_ = rs[ai][m]; const f32x4 g0 = acc[ai][0][m][0] * r_, g1 = acc[ai][0][m][1] * r_, u0 = acc[ai][1][m][0] * r_, u1 = acc[ai][1][m][1] * r_;
                u32x4 w;
                w.x = pk2(siluf_(g0[0]) * u0[0], siluf_(g0[1]) * u0[1]); w.y = pk2(siluf_(g0[2]) * u0[2], siluf_(g0[3]) * u0[3]);
                w.z = pk2(siluf_(g1[0]) * u1[0], siluf_(g1[1]) * u1[1]); w.w = pk2(siluf_(g1[2]) * u1[2], siluf_(g1[3]) * u1[3]);
                *(u32x4*)(H + (size_t)(col0 >> 6) * ((size_t)MT * 64) + (size_t)(row0 + ai * 128 + m * 16) * 64 + (col0 & 63)) = w;
            }
    }
};
struct EpiResid {
    static constexpr bool PERM = true; static constexpr bool PRE = false;
    bf16_t* xb; float* ss; float alpha; float* part; LAS float* red;
    __device__ __forceinline__ void operator()(AccRef acc, const Unit& u, int wr, int wc, int fr, int fq) const {
        const int row0 = u.pm * 256 + wr * 64 + fr, col0 = u.pn * 256 + wc * 32 + 8 * fq;
        if (u.pm * 256 >= MP) {
            float* pb_ = part + ((size_t)u.sp * MS - MP) * D;
#pragma unroll
            for (int ai = 0; ai < 2; ++ai)
#pragma unroll
                for (int m = 0; m < 4; ++m) { float* o = pb_ + (size_t)(row0 + ai * 128 + m * 16) * D + col0;
#pragma unroll
                    for (int bj = 0; bj < 2; ++bj)
#pragma unroll
                        for (int n = 0; n < 2; ++n) *(f32x4*)(o + bj * 128 + n * 4) = acc[ai][bj][m][n] * alpha; }
            return;
        }
        bf16_t* xq = xb + (size_t)(col0 >> 6) * ((size_t)MT * 64) + (size_t)row0 * 64 + (col0 & 63);
        const int lane = fq * 16 + fr;
#pragma unroll
        for (int ai = 0; ai < 2; ++ai) {
            u32x4 b[4][2];
#pragma unroll
            for (int m = 0; m < 4; ++m)
#pragma unroll
                for (int bj = 0; bj < 2; ++bj) b[m][bj] = *(const u32x4*)(xq + (size_t)(2 * bj) * ((size_t)MT * 64) + (size_t)(ai * 128 + m * 16) * 64);
#pragma unroll
            for (int m = 0; m < 4; ++m) { float sq = 0.f;
#pragma unroll
                for (int bj = 0; bj < 2; ++bj) { const u32x4 x = b[m][bj];
                    const f32x4 x0 = {bf_lo(x.x), bf_hi(x.x), bf_lo(x.y), bf_hi(x.y)}, x1 = {bf_lo(x.z), bf_hi(x.z), bf_lo(x.w), bf_hi(x.w)};
                    const f32x4 a0 = x0 + acc[ai][bj][m][0] * alpha, a1 = x1 + acc[ai][bj][m][1] * alpha;
                    sq += ((a0[0] * a0[0] + a0[1] * a0[1]) + (a0[2] * a0[2] + a0[3] * a0[3])) + ((a1[0] * a1[0] + a1[1] * a1[1]) + (a1[2] * a1[2] + a1[3] * a1[3]));
                    u32x4 w; w.x = pk2(a0[0], a0[1]); w.y = pk2(a0[2], a0[3]); w.z = pk2(a1[0], a1[1]); w.w = pk2(a1[2], a1[3]);
                    *(u32x4*)(xq + (size_t)(2 * bj) * ((size_t)MT * 64) + (size_t)(ai * 128 + m * 16) * 64) = w; }
                sq += shx(sq, 16, lane); sq += shx(sq, 32, lane);
                if (fq == 0) red[wc * 256 + ai * 128 + wr * 64 + m * 16 + fr] = sq; }
        }
        asm volatile("s_waitcnt lgkmcnt(0)" ::: "memory");
        __builtin_amdgcn_s_barrier();
        asm volatile("" ::: "memory");
        const int t = (wr * 4 + wc) * 64 + lane;
        if (t < 256) ss[(size_t)(u.pm * 256 + t) * 8 + u.pn] = (red[t] + red[256 + t]) + (red[512 + t] + red[768 + t]);
    }
};
struct EpiWin {
    static constexpr bool PERM = true; static constexpr bool PRE = true;
    bf16_t* U; float* US; float* fk_p; float* fk_s; float* fv_p; float* fv_s;
    const float* SS;
    __device__ __forceinline__ void pre(const Unit& u, int wr, int lane, float& a, float& b) const { rs_pre(SS, u.pm, wr, lane, a, b); }
    __device__ __forceinline__ void operator()(AccRef acc, const Unit& u, int wr, int wc, int fr, int fq, float st0, float st1) const {
        const int row0 = u.pm * 256 + wr * 64 + fr, cw = wc * 32 + 8 * fq;
        const int pn = u.pn;
        float rs[2][4]; row_rs(st0, st1, fr, rs);
        if (pn < 26) {
            float* fo = nullptr;
            if (pn >= 18) { const bool isv = pn >= 22; const int hc = (pn - (isv ? 22 : 18)) * 256;
                fo = (u.pm * 256 < MP) ? (isv ? fv_p : fk_p) : (isv ? fv_s : fk_s) - (size_t)MP * 1024; fo += hc; }
#pragma unroll
            for (int ai = 0; ai < 2; ++ai)
#pragma unroll
                for (int m = 0; m < 4; ++m) { const int row = row0 + ai * 128 + m * 16;
#pragma unroll
                    for (int bj = 0; bj < 2; ++bj) { const f32x4 v0 = acc[ai][bj][m][0] * rs[ai][m], v1 = acc[ai][bj][m][1] * rs[ai][m];
                        u32x4 w; w.x = pk2(v0[0], v0[1]); w.y = pk2(v0[2], v0[3]); w.z = pk2(v1[0], v1[1]); w.w = pk2(v1[2], v1[3]);
                        *(u32x4*)(U + (size_t)row * LDU + pn * 256 + bj * 128 + cw) = w;
                        if (fo) { float* o = fo + (size_t)row * 1024 + bj * 128 + cw; *(f32x4*)o = v0; *(f32x4*)(o + 4) = v1; } } }
        } else if (pn < 50) {
#pragma unroll
            for (int ai = 0; ai < 2; ++ai)
#pragma unroll
                for (int m = 0; m < 4; ++m) { const int row = row0 + ai * 128 + m * 16;
#pragma unroll
                    for (int bj = 0; bj < 2; ++bj) { const f32x4 v0 = acc[ai][bj][m][0] * rs[ai][m], v1 = acc[ai][bj][m][1] * rs[ai][m];
                        u32x4 w; w.x = pk2(sigmoidf_(v0[0]), sigmoidf_(v0[1])); w.y = pk2(sigmoidf_(v0[2]), sigmoidf_(v0[3]));
                        w.z = pk2(sigmoidf_(v1[0]), sigmoidf_(v1[1])); w.w = pk2(sigmoidf_(v1[2]), sigmoidf_(v1[3]));
                        *(u32x4*)(U + (size_t)row * LDU + pn * 256 + bj * 128 + cw) = w; } }
        } else {
#pragma unroll
            for (int ai = 0; ai < 2; ++ai)
#pragma unroll
                for (int m = 0; m < 4; ++m) { const int row = row0 + ai * 128 + m * 16;
                    float* o = US + (size_t)row * LDUS + cw; *(f32x4*)o = acc[ai][0][m][0] * rs[ai][m]; *(f32x4*)(o + 4) = acc[ai][0][m][1] * rs[ai][m]; }
        }
    }
};
struct EpiUq {
    static constexpr bool PERM = true; static constexpr bool PRE = false;
    bf16_t* Q; const f32x2* rope;
    __device__ __forceinline__ void operator()(AccRef acc, const Unit& u, int wr, int wc, int fr, int fq) const {
        const int row0 = u.pm * 256 + wr * 64 + fr;
#pragma unroll
        for (int bj = 0; bj < 2; ++bj) {
            const int c0 = u.pn * 256 + bj * 128 + wc * 32 + 8 * fq, r = c0 % 192;
            const bool isrope = r >= 128; const int j0 = (r - 128) >> 1;
#pragma unroll
            for (int ai = 0; ai < 2; ++ai)
#pragma unroll
                for (int m = 0; m < 4; ++m) { const int row = row0 + ai * 128 + m * 16;
                    f32x4 v0 = acc[ai][bj][m][0], v1 = acc[ai][bj][m][1];
                    if (isrope) { const f32x2* cs = rope + (size_t)pos_of(row) * 32 + j0;
                        const f32x2 a = cs[0], b = cs[1], c = cs[2], d = cs[3];
                        const f32x4 t0 = v0, t1 = v1;
                        v0[0] = t0[0] * a.x - t0[1] * a.y; v0[1] = t0[1] * a.x + t0[0] * a.y; v0[2] = t0[2] * b.x - t0[3] * b.y; v0[3] = t0[3] * b.x + t0[2] * b.y;
                        v1[0] = t1[0] * c.x - t1[1] * c.y; v1[1] = t1[1] * c.x + t1[0] * c.y; v1[2] = t1[2] * d.x - t1[3] * d.y; v1[3] = t1[3] * d.x + t1[2] * d.y; }
                    u32x4 w; w.x = pk2(v0[0], v0[1]); w.y = pk2(v0[2], v0[3]); w.z = pk2(v1[0], v1[1]); w.w = pk2(v1[2], v1[3]);
                    *(u32x4*)(Q + (size_t)row * 1536 + c0) = w; }
        }
    }
};
struct EpiUkv {
    static constexpr bool PERM = true; static constexpr bool PRE = false;
    bf16_t* KM; bf16_t* VT;
    __device__ __forceinline__ void operator()(AccRef acc, const Unit& u, int wr, int wc, int fr, int fq) const {
        const int row0 = u.pm * 256 + wr * 64 + fr, h = u.pn, d0 = wc * 32 + 8 * fq;
#pragma unroll
        for (int ai = 0; ai < 2; ++ai)
#pragma unroll
            for (int m = 0; m < 4; ++m) { const int row = row0 + ai * 128 + m * 16;
                { const f32x4 v0 = acc[ai][0][m][0], v1 = acc[ai][0][m][1];
                  u32x4 w; w.x = pk2(v0[0], v0[1]); w.y = pk2(v0[2], v0[3]); w.z = pk2(v1[0], v1[1]); w.w = pk2(v1[2], v1[3]);
                  *(u32x4*)(KM + ((size_t)row * 8 + h) * 192 + d0) = w; }
                { const f32x4 v0 = acc[ai][1][m][0], v1 = acc[ai][1][m][1];
                  bf16_t* vt = VT + (size_t)(h * 128 + d0) * KVROWS + row;
#pragma unroll
                  for (int j = 0; j < 4; ++j) { vt[(size_t)j * KVROWS] = f2bf(v0[j]); vt[(size_t)(j + 4) * KVROWS] = f2bf(v1[j]); } } }
    }
};
template <int BR> struct EpiMerge {
    static constexpr bool PERM = true; static constexpr bool PRE = false;
    const bf16_t* U; bf16_t* MG;
    __device__ __forceinline__ void operator()(AccRef acc, const Unit& u, int wr, int wc, int fr, int fq) const {
        const int row0 = u.pm * 256 + wr * 64 + fr, colb = u.pn * 256 + wc * 32 + 8 * fq;
#pragma unroll
        for (int ai = 0; ai < 2; ++ai) {
            u32x4 gt[4][2], od[4][2];
#pragma unroll
            for (int m = 0; m < 4; ++m) { const int row = row0 + ai * 128 + m * 16;
#pragma unroll
                for (int bj = 0; bj < 2; ++bj) { gt[m][bj] = *(const u32x4*)(U + (size_t)row * LDU + UC_GATE + BR * D + colb + bj * 128);
                    if (BR > 0) od[m][bj] = *(const u32x4*)(MG + (size_t)row * D + colb + bj * 128); } }
#pragma unroll
            for (int m = 0; m < 4; ++m) { const int row = row0 + ai * 128 + m * 16;
#pragma unroll
                for (int bj = 0; bj < 2; ++bj) { const u32x4 g = gt[m][bj];
                    f32x4 v0 = acc[ai][bj][m][0], v1 = acc[ai][bj][m][1];
                    v0[0] *= bf_lo(g.x); v0[1] *= bf_hi(g.x); v0[2] *= bf_lo(g.y); v0[3] *= bf_hi(g.y);
                    v1[0] *= bf_lo(g.z); v1[1] *= bf_hi(g.z); v1[2] *= bf_lo(g.w); v1[3] *= bf_hi(g.w);
                    if (BR > 0) { const u32x4 o = od[m][bj];
                        v0[0] += bf_lo(o.x); v0[1] += bf_hi(o.x); v0[2] += bf_lo(o.y); v0[3] += bf_hi(o.y);
                        v1[0] += bf_lo(o.z); v1[1] += bf_hi(o.z); v1[2] += bf_lo(o.w); v1[3] += bf_hi(o.w); }
                    u32x4 w; w.x = pk2(v0[0], v0[1]); w.y = pk2(v0[2], v0[3]); w.z = pk2(v1[0], v1[1]); w.w = pk2(v1[2], v1[3]);
                    *(u32x4*)(MG + (size_t)row * D + colb + bj * 128) = w; } }
        }
    }
};

struct EpiMergeSample {
    static constexpr bool PERM = true; static constexpr bool PRE = false;
    const bf16_t* U; bf16_t* MG; float* part; unsigned* cnt; LAS unsigned* flag;
    __device__ __forceinline__ void operator()(AccRef acc, const Unit& u, int wr, int wc, int fr, int fq) const {
        const int br = u.pn >> 3, pn8 = u.pn & 7;
        const int row0 = wr * 64 + fr, colb = pn8 * 256 + wc * 32 + 8 * fq;
        float* pb = part + (size_t)br * MS * D;
#pragma unroll
        for (int ai = 0; ai < 2; ++ai)
#pragma unroll
            for (int m = 0; m < 4; ++m) { const int row = row0 + ai * 128 + m * 16;
#pragma unroll
                for (int bj = 0; bj < 2; ++bj) { const u32x4 g = *(const u32x4*)(U + (size_t)(MP + row) * LDU + UC_GATE + br * D + colb + bj * 128);
                    f32x4 v0 = acc[ai][bj][m][0], v1 = acc[ai][bj][m][1];
                    v0[0] *= bf_lo(g.x); v0[1] *= bf_hi(g.x); v0[2] *= bf_lo(g.y); v0[3] *= bf_hi(g.y);
                    v1[0] *= bf_lo(g.z); v1[1] *= bf_hi(g.z); v1[2] *= bf_lo(g.w); v1[3] *= bf_hi(g.w);
                    unsigned long long* o = (unsigned long long*)(pb + (size_t)row * D + colb + bj * 128);
                    __hip_atomic_store(o + 0, ((unsigned long long)__float_as_uint(v0[1]) << 32) | __float_as_uint(v0[0]), __ATOMIC_RELAXED, __HIP_MEMORY_SCOPE_AGENT);
                    __hip_atomic_store(o + 1, ((unsigned long long)__float_as_uint(v0[3]) << 32) | __float_as_uint(v0[2]), __ATOMIC_RELAXED, __HIP_MEMORY_SCOPE_AGENT);
                    __hip_atomic_store(o + 2, ((unsigned long long)__float_as_uint(v1[1]) << 32) | __float_as_uint(v1[0]), __ATOMIC_RELAXED, __HIP_MEMORY_SCOPE_AGENT);
                    __hip_atomic_store(o + 3, ((unsigned long long)__float_as_uint(v1[3]) << 32) | __float_as_uint(v1[2]), __ATOMIC_RELAXED, __HIP_MEMORY_SCOPE_AGENT); } }
        asm volatile("s_waitcnt vmcnt(0)" ::: "memory");
        __builtin_amdgcn_s_barrier();
        const int t = (wr * 4 + wc) * 64 + fq * 16 + fr;
        if (t == 0) { const unsigned old = __hip_atomic_fetch_add(cnt + 64 * pn8, 1u, __ATOMIC_RELAXED, __HIP_MEMORY_SCOPE_AGENT); *flag = (old == 2u) ? 1u : 0u; }
        asm volatile("s_waitcnt vmcnt(0) lgkmcnt(0)" ::: "memory");
        __builtin_amdgcn_s_barrier();
        asm volatile("" ::: "memory");
        if (*flag != 0u) {
            __builtin_amdgcn_fence(__ATOMIC_ACQUIRE, "agent");
            asm volatile("s_waitcnt vmcnt(0)" ::: "memory");
#pragma unroll 2
            for (int k = 0; k < 16; ++k) { const int e = (k * 512 + t) * 8, r = e >> 8, c = e & 255;
                const float* src = part + (size_t)r * D + pn8 * 256 + c;
                f32x4 a = *(const f32x4*)src, b = *(const f32x4*)(src + 4);
                a = a + *(const f32x4*)(src + (size_t)MS * D) + *(const f32x4*)(src + (size_t)2 * MS * D);
                b = b + *(const f32x4*)(src + (size_t)MS * D + 4) + *(const f32x4*)(src + (size_t)2 * MS * D + 4);
                u32x4 w; w.x = pk2(a[0], a[1]); w.y = pk2(a[2], a[3]); w.z = pk2(b[0], b[1]); w.w = pk2(b[2], b[3]);
                *(u32x4*)(MG + (size_t)(MP + r) * D + pn8 * 256 + c) = w; }
        }
    }
};

struct Frame {
    LAS unsigned char* lds;
    int tid, lane, wave, vcu, G, bx;
    int gw, NGW;
};
__device__ __forceinline__ int lane_now() { unsigned z = 0u; asm volatile("" : "+s"(z)); return (int)__builtin_amdgcn_mbcnt_hi(~0u, __builtin_amdgcn_mbcnt_lo(~0u, z)); }
__device__ __forceinline__ Frame mk_frame(int wave_s) {
    extern __shared__ __attribute__((aligned(16))) unsigned char lds_raw[];
    Frame F; F.lds = (LAS unsigned char*)lds_raw;
    asm volatile("" : "+s"(wave_s)); const int t = wave_s * 64 + lane_now();
    int bx = blockIdx.x, G = gridDim.x; asm volatile("" : "+s"(bx), "+s"(G));
    F.tid = t; F.lane = t & 63; F.wave = __builtin_amdgcn_readfirstlane(t >> 6);
    F.G = G; F.bx = bx; F.vcu = (G % 8 == 0) ? (bx % 8) * (G / 8) + bx / 8 : bx;
    F.gw = F.vcu * 8 + F.wave; F.NGW = G * 8;
    return F;
}

template <int KIND> __device__ __forceinline__ int map_row(int n, float& sc) {
    sc = 1.f;
    if (KIND == 0) return n;
    if (KIND == 1) return 256 * (n >> 7) + (n & 127);
    if (KIND == 2) return 256 * (n >> 7) + 128 + (n & 127);
    if (KIND == 3) {
        if (n < 1024) return n;
        if (n < 1088) return 12800 + (n - 1024);
        if (n < 2112) return UC_Z + (n - 1088);
        if (n < 3648) return UC_XBC + (n - 2112);
        if (n < 3664) return 12864 + (n - 3648);
        if (n < 4688) { sc = FOX_QSCALE; return UC_FQ + (n - 3664); }
        if (n < 5712) return UC_FK + (n - 4688);
        if (n < 6736) return UC_FV + (n - 5712);
        if (n < 6744) return 12880 + (n - 6736);
        return UC_GATE + (n - 6744);
    }
    if (KIND == 4) {
        sc = MLA_QSCALE; const int h = n / 192, r = n % 192;
        if (r < 128) return n;
        const int rr = r - 128; return h * 192 + 128 + 2 * (rr & 31) + (rr >> 5);
    }
    return n;
}
template <int KIND>
__device__ __forceinline__ void cvt_item(const float* W, int N, bf16_t* WT, size_t ldo, size_t coloff, LAS float* scr, int item, int lane, size_t kblk = 0, const float* kg = nullptr) {
    const int nblk = (N + 31) / 32, kb = item / nblk, nb = item % nblk, k0 = 64 * kb, n0 = 32 * nb;
    const int nn = n0 + (lane & 31); const bool ok = nn < N;
    f32x4 kg0 = {1.f, 1.f, 1.f, 1.f}, kg1 = kg0;
    if (kg) { kg0 = *(const f32x4*)(kg + k0 + 8 * (lane & 7)); kg1 = *(const f32x4*)(kg + k0 + 8 * (lane & 7) + 4); }
#pragma unroll
    for (int i = 0; i < 32; ++i) { const int kk = 2 * i + (lane >> 5); scr[kk * 33 + (lane & 31)] = ok ? W[(size_t)(k0 + kk) * N + nn] : 0.f; }
    LDS_WAIT(); asm volatile("" ::: "memory");
    const int c = lane & 7;
#pragma unroll
    for (int j = 0; j < 4; ++j) { const int n = (lane >> 3) + 8 * j;
        if (n0 + n < N) { float sc; const int dr = map_row<KIND>(n0 + n, sc); const LAS float* s = scr + (8 * c) * 33 + n;
            u32x4 o; o.x = pk2(s[0 * 33] * (sc * kg0[0]), s[1 * 33] * (sc * kg0[1])); o.y = pk2(s[2 * 33] * (sc * kg0[2]), s[3 * 33] * (sc * kg0[3])); o.z = pk2(s[4 * 33] * (sc * kg1[0]), s[5 * 33] * (sc * kg1[1])); o.w = pk2(s[6 * 33] * (sc * kg1[2]), s[7 * 33] * (sc * kg1[3]));
            *(u32x4*)(kblk ? WT + (size_t)kb * kblk + (size_t)dr * 64 + 8 * c : WT + (size_t)dr * ldo + coloff + k0 + 8 * c) = o; } }
    LDS_WAIT(); asm volatile("" ::: "memory");
}

__device__ __forceinline__ void phase_convert(const Params&, const Frame& F0, int layer0) {
    const Frame F = mk_frame(F0.wave);
    const PV p = pv_get(); int layer = layer0; asm volatile("" : "+s"(layer));
    LAS float* scr = (LAS float*)(F.lds + F.wave * 16384);
    unsigned z0_ = 0u; asm volatile("" : "+v"(z0_)); const u32x4 Z4 = {z0_, z0_, z0_, z0_};
    bf16_t* W = (bf16_t*)(p.ws() + WS_W);
    const size_t lFF = (size_t)layer * D * FF;
    constexpr int IT_FF = (D / 64) * (FF / 32), IT_DN = (FF / 64) * (D / 32), IT_IN = (D / 64) * ((IN_COLS + 31) / 32), IT_UQ = 8 * 48, IT_UKV = 8 * 64, IT_BR = 16 * 64, IT_OUT = 32 * 64;
    constexpr int IT_FV = NB * 16 * 32;
    constexpr int NITEMS = 6 * IT_FF + IT_IN + IT_UQ + IT_UKV + 3 * IT_BR + IT_OUT + IT_FV;
    static_assert(IT_FF == IT_DN, "items");
    for (int it = F.gw; it < NITEMS; it += F.NGW) {
        int r = it;
        if (r < IT_FF) { cvt_item<1>(p.in(I_F1G) + lFF, FF, W + W_GU1, D, 0, scr, r, F.lane, (size_t)2 * FF * 64, p.in(I_F1N) + layer * D); continue; } r -= IT_FF;
        if (r < IT_FF) { cvt_item<2>(p.in(I_F1U) + lFF, FF, W + W_GU1, D, 0, scr, r, F.lane, (size_t)2 * FF * 64, p.in(I_F1N) + layer * D); continue; } r -= IT_FF;
        if (r < IT_DN) { cvt_item<0>(p.in(I_F1D) + lFF, D, W + W_D1, FF, 0, scr, r, F.lane, (size_t)D * 64); continue; } r -= IT_DN;
        if (r < IT_FF) { cvt_item<1>(p.in(I_F2G) + lFF, FF, W + W_GU2, D, 0, scr, r, F.lane, (size_t)2 * FF * 64, p.in(I_F2N) + layer * D); continue; } r -= IT_FF;
        if (r < IT_FF) { cvt_item<2>(p.in(I_F2U) + lFF, FF, W + W_GU2, D, 0, scr, r, F.lane, (size_t)2 * FF * 64, p.in(I_F2N) + layer * D); continue; } r -= IT_FF;
        if (r < IT_DN) { cvt_item<0>(p.in(I_F2D) + lFF, D, W + W_D2, FF, 0, scr, r, F.lane, (size_t)D * 64); continue; } r -= IT_DN;
        if (r < IT_IN) { cvt_item<3>(p.in(I_WIN) + (size_t)layer * D * IN_COLS, IN_COLS, W + W_IN, D, 0, scr, r, F.lane, (size_t)NWIN * 64, p.in(I_MIXN) + layer * D); continue; } r -= IT_IN;
        if (r < IT_UQ) { cvt_item<4>(p.in(I_WUQ) + (size_t)layer * 512 * 1536, 1536, W + W_UQ, 512, 0, scr, r, F.lane); continue; } r -= IT_UQ;
        if (r < IT_UKV) { cvt_item<0>(p.in(I_WUKV) + (size_t)layer * 512 * 2048, 2048, W + W_UKV, 512, 0, scr, r, F.lane); continue; } r -= IT_UKV;
        if (r < IT_BR) { cvt_item<0>(p.in(I_BRM) + (size_t)layer * 1024 * D, D, W + W_BR, 1024, 0, scr, r, F.lane); continue; } r -= IT_BR;
        if (r < IT_BR) { cvt_item<0>(p.in(I_BRS) + (size_t)layer * 1024 * D, D, W + W_BR + (size_t)D * 1024, 1024, 0, scr, r, F.lane); continue; } r -= IT_BR;
        if (r < IT_BR) { cvt_item<0>(p.in(I_BRF) + (size_t)layer * 1024 * D, D, W + W_BR + (size_t)2 * D * 1024, 1024, 0, scr, r, F.lane); continue; } r -= IT_BR;
        if (r < IT_OUT) { cvt_item<0>(p.in(I_WOUT) + (size_t)layer * D * D, D, W + W_OUT, D, 0, scr, r, F.lane); continue; } r -= IT_OUT;
        { const int b = r / 512, ri = r % 512;
          cvt_item<0>(p.in(I_CFV) + ((size_t)layer * NB + b) * PAST * 1024, 1024, (bf16_t*)(p.ws() + WS_VTF), KVROWS, (size_t)MP + (size_t)b * KVS, scr, ri, F.lane); }
    }
    const size_t gt = (size_t)F.gw * 64 + F.lane, NT = (size_t)F.NGW * 64;
    {
        constexpr int PADE = (NWIN - IN_COLS) * 64 / 8;
        for (size_t i = gt; i < (size_t)PADE * (D / 64); i += NT) { const int kb = (int)(i / PADE), rem = (int)(i % PADE);
            *(u32x4*)(W + W_IN + (size_t)kb * ((size_t)NWIN * 64) + (size_t)IN_COLS * 64 + (size_t)rem * 8) = Z4; }
    }
    {
        const float* src = p.in(I_CCKV) + (size_t)layer * NB * PAST * 512; bf16_t* dst = (bf16_t*)(p.ws() + WS_CKV);
        for (size_t i = gt; i < (size_t)NB * PAST * 512 / 8; i += NT) { const size_t e = i * 8; const int b = (int)(e / (PAST * 512)), rem = (int)(e % (PAST * 512));
            const f32x4 a = *(const f32x4*)(src + e), c = *(const f32x4*)(src + e + 4);
            u32x4 w; w.x = pk2(a[0], a[1]); w.y = pk2(a[2], a[3]); w.z = pk2(c[0], c[1]); w.w = pk2(c[2], c[3]);
            *(u32x4*)(dst + ((size_t)MP + (size_t)b * KVS) * 512 + rem) = w; }
        for (size_t i = gt; i < (size_t)NB * (KVS - KVLEN_S) * 512 / 8; i += NT) { const size_t e = i * 8; const int b = (int)(e / ((KVS - KVLEN_S) * 512)), rem = (int)(e % ((KVS - KVLEN_S) * 512));
            *(u32x4*)(dst + ((size_t)MP + (size_t)b * KVS + KVLEN_S) * 512 + rem) = Z4; }
    }
    {
        const float* src = p.in(I_CFK) + (size_t)layer * NB * PAST * 1024; bf16_t* dst = (bf16_t*)(p.ws() + WS_KFS);
        for (size_t i = gt; i < (size_t)NB * PAST * 1024 / 8; i += NT) { const size_t e = i * 8; const int b = (int)(e / (PAST * 1024)), rem = (int)(e % (PAST * 1024));
            const f32x4 a = *(const f32x4*)(src + e), c = *(const f32x4*)(src + e + 4);
            u32x4 w; w.x = pk2(a[0], a[1]); w.y = pk2(a[2], a[3]); w.z = pk2(c[0], c[1]); w.w = pk2(c[2], c[3]);
            *(u32x4*)(dst + (size_t)b * KVS * 1024 + rem) = w; }
        for (size_t i = gt; i < (size_t)NB * (KVS - KVLEN_S) * 1024 / 8; i += NT) { const size_t e = i * 8; const int b = (int)(e / ((KVS - KVLEN_S) * 1024)), rem = (int)(e % ((KVS - KVLEN_S) * 1024));
            *(u32x4*)(dst + ((size_t)b * KVS + KVLEN_S) * 1024 + rem) = Z4; }
    }
    {
        const float* src = p.in(I_CKPE) + (size_t)layer * NB * PAST * 64; bf16_t* km = (bf16_t*)(p.ws() + WS_KM);
        for (size_t i = gt; i < (size_t)NB * KVS * 32; i += NT) { const int j = (int)(i & 31); const int pr = (int)(i >> 5) % KVS, b = (int)(i >> 5) / KVS;
            unsigned w = 0u;
            if (pr < PAST) { const float* s = src + ((size_t)b * PAST + pr) * 64; w = pk2(s[j], s[32 + j]); }
            if (pr < PAST || pr >= KVLEN_S) { const size_t kr = (size_t)MP + (size_t)b * KVS + pr;
#pragma unroll
                for (int h = 0; h < 8; ++h) *(unsigned*)(km + (kr * 8 + h) * 192 + 128 + 2 * j) = w; } }
        const float* ls = p.in(I_CLOGF) + (size_t)layer * NB * PAST * 8; float* ld = (float*)(p.ws() + WS_LOGF);
        for (size_t i = gt; i < (size_t)NB * KVS * 8; i += NT) { const int hh = (int)(i & 7); const int pr = (int)(i >> 3) % KVS, b = (int)(i >> 3) / KVS;
            if (pr < PAST) ld[((size_t)MP + (size_t)b * KVS + pr) * 8 + hh] = ls[((size_t)b * PAST + pr) * 8 + hh];
            else if (pr >= KVLEN_S) ld[((size_t)MP + (size_t)b * KVS + pr) * 8 + hh] = 0.f; }
        bf16_t* vtf = (bf16_t*)(p.ws() + WS_VTF);
        for (size_t i = gt; i < (size_t)1024 * NB * (KVS - KVLEN_S); i += NT) { const int pc = (int)(i % (KVS - KVLEN_S)); const int b = (int)(i / (KVS - KVLEN_S)) % NB, ch = (int)(i / (KVS - KVLEN_S)) / NB;
            vtf[(size_t)ch * KVROWS + MP + (size_t)b * KVS + KVLEN_S + pc] = 0; }
    }
}

__device__ __forceinline__ void phase_rope_table(const Frame& F0) {
    const Frame F = mk_frame(F0.wave);
    const PV p = pv_get();
    const size_t gt = (size_t)F.gw * 64 + F.lane, NT = (size_t)F.NGW * 64;
    f32x2* rt = (f32x2*)(p.ws() + WS_ROPE);
    for (size_t i = gt; i < (size_t)SEQ * 32; i += NT) { const int j = (int)(i & 31), ps = (int)(i >> 5);
        const float inv = powf(10000.0f, -(float)j / 32.0f); const float ang = (float)ps * inv;
        float sn, cs; sincosf(ang, &sn, &cs); rt[i] = (f32x2){cs, sn}; }
}
__device__ __forceinline__ void phase_prep(const Frame& F, const float* xp, const float* xs, bf16_t* XB, float* SS, float* copy_s, const float* part) {
    const int nrows = xp ? MT : MS;
    for (int i = F.wave * F.G + F.vcu; i < nrows; i += F.NGW) {
        const int m = xp ? i : MP + i;
        const float* xr = (m < MP) ? xp + (size_t)m * D : xs + (size_t)(m - MP) * D;
        f32x4 v[8]; float s = 0.f;
#pragma unroll
        for (int j = 0; j < 8; ++j) v[j] = *(const f32x4*)(xr + 4 * F.lane + 256 * j);
        if (m >= MP) {
            if (part) {
#pragma unroll
                for (int sp = 0; sp < 8; ++sp)
#pragma unroll
                    for (int j = 0; j < 8; ++j) v[j] += *(const f32x4*)(part + ((size_t)sp * MS + (m - MP)) * D + 4 * F.lane + 256 * j); }
            float* xo = (copy_s ? copy_s : const_cast<float*>(xs)) + (size_t)(m - MP) * D;
#pragma unroll
            for (int j = 0; j < 8; ++j) *(f32x4*)(xo + 4 * F.lane + 256 * j) = v[j]; }
#pragma unroll
        for (int j = 0; j < 8; ++j) s += (v[j][0] * v[j][0] + v[j][1] * v[j][1]) + (v[j][2] * v[j][2] + v[j][3] * v[j][3]);
        s = wave_sum(s, F.lane);
        bf16_t* o = XB + (size_t)(F.lane >> 4) * ((size_t)MT * 64) + (size_t)m * 64 + 4 * (F.lane & 15);
#pragma unroll
        for (int j = 0; j < 8; ++j) { u32x2 w; w.x = pk2(v[j][0], v[j][1]); w.y = pk2(v[j][2], v[j][3]); *(u32x2*)(o + (size_t)(4 * j) * ((size_t)MT * 64)) = w; }
        if (F.lane == 0) SS[RS_OFF + m] = fast_rsqrt(s * (1.0f / D) + EPS);
    }
    if (!xp) {
        for (int r = F.gw * 64 + F.lane; r < MP; r += F.NGW * 64) { const f32x4 a = *(const f32x4*)(SS + (size_t)r * 8), b = *(const f32x4*)(SS + (size_t)r * 8 + 4);
            SS[RS_OFF + r] = fast_rsqrt((((a[0] + a[1]) + (a[2] + a[3])) + ((b[0] + b[1]) + (b[2] + b[3]))) * (1.0f / D) + EPS); }
    }
}
__device__ __forceinline__ void phase_final_norm(const Frame& F, float* x, const bf16_t* xb, const float* gain, const float* part) {
    f32x4 g[8];
#pragma unroll
    for (int j = 0; j < 8; ++j) g[j] = *(const f32x4*)(gain + 4 * F.lane + 256 * j);
    for (int m = F.gw; m < MT; m += F.NGW) {
        float* xr = x + (size_t)m * D;
        f32x4 v[8]; float s = 0.f;
        if (m < MP) { const bf16_t* xq = xb + (size_t)(F.lane >> 4) * ((size_t)MT * 64) + (size_t)m * 64 + 4 * (F.lane & 15);
#pragma unroll
            for (int j = 0; j < 8; ++j) { const u32x2 w = *(const u32x2*)(xq + (size_t)(4 * j) * ((size_t)MT * 64)); v[j] = (f32x4){bf_lo(w.x), bf_hi(w.x), bf_lo(w.y), bf_hi(w.y)}; }
        } else {
#pragma unroll
            for (int j = 0; j < 8; ++j) v[j] = *(const f32x4*)(xr + 4 * F.lane + 256 * j); }
        if (m >= MP) {
#pragma unroll
            for (int sp = 0; sp < 8; ++sp)
#pragma unroll
                for (int j = 0; j < 8; ++j) v[j] += *(const f32x4*)(part + ((size_t)sp * MS + (m - MP)) * D + 4 * F.lane + 256 * j); }
#pragma unroll
        for (int j = 0; j < 8; ++j) s += (v[j][0] * v[j][0] + v[j][1] * v[j][1]) + (v[j][2] * v[j][2] + v[j][3] * v[j][3]);
        const float rs = fast_rsqrt(wave_sum(s, F.lane) * (1.0f / D) + EPS);
#pragma unroll
        for (int j = 0; j < 8; ++j) *(f32x4*)(xr + 4 * F.lane + 256 * j) = v[j] * rs * g[j];
    }
}
__device__ __forceinline__ float softplusf_(float x) {
    if (x > 20.f) return x; const float y = fast_exp(x); return y < 0.03125f ? y * (1.0f + y * (-0.5f + y * (0.33333333f - 0.25f * y))) : fast_log(1.0f + y); }
__device__ __forceinline__ void unpack8(const u32x4 w, float (&v)[8]) {
    v[0] = bf_lo(w.x); v[1] = bf_hi(w.x); v[2] = bf_lo(w.y); v[3] = bf_hi(w.y); v[4] = bf_lo(w.z); v[5] = bf_hi(w.z); v[6] = bf_lo(w.w); v[7] = bf_hi(w.w);
}
__device__ __forceinline__ void phase_t1(const Params&, const Frame& F0, int layer0) {
    const Frame F = mk_frame(F0.wave);
    const PV p = pv_get(); int layer = layer0; asm volatile("" : "+s"(layer));
    bf16_t* U = (bf16_t*)(p.ws() + WS_U); const float* US = (const float*)(p.ws() + WS_US);
    bf16_t* CKV = (bf16_t*)(p.ws() + WS_CKV); bf16_t* KM = (bf16_t*)(p.ws() + WS_KM); bf16_t* KFS = (bf16_t*)(p.ws() + WS_KFS); bf16_t* VTF = (bf16_t*)(p.ws() + WS_VTF);
    float* LOGF = (float*)(p.ws() + WS_LOGF); float* DTB = (float*)(p.ws() + WS_DT); const f32x2* rope = (const f32x2*)(p.ws() + WS_ROPE);
    unsigned* ctl = (unsigned*)(p.ws() + WS_CTL);
    float* o_pckv = p.out() + O_PCKV + (size_t)layer * MP * 512; float* o_sckv = p.out() + O_SCKV + (size_t)layer * MS * 512;
    float* o_pkpe = p.out() + O_PKPE + (size_t)layer * MP * 64; float* o_skpe = p.out() + O_SKPE + (size_t)layer * MS * 64;
    float* o_plf = p.out() + O_PLOGF + (size_t)layer * MP * 8; float* o_slf = p.out() + O_SLOGF + (size_t)layer * MS * 8;
    float* o_pconv = p.out() + O_PCONV + (size_t)layer * 3 * 1536; float* o_sconv = p.out() + O_SCONV + (size_t)layer * NB * 3 * 1536;
    float qg[8], kg[8];
#pragma unroll
    for (int j = 0; j < 8; ++j) { qg[j] = p.in(I_QN)[layer * 512 + 8 * F.lane + j]; kg[j] = p.in(I_KVN)[layer * 512 + 8 * F.lane + j]; }
    const float fb = (F.lane < 8) ? p.in(I_FBF)[layer * 8 + F.lane] : 0.f;
    const float db = (F.lane < 16) ? p.in(I_DTB)[layer * 16 + F.lane] : 0.f;
    for (int m = F.gw; m < MT; m += F.NGW) {
        const int kr = kvrow_of(m), ps = pos_of(m); const bool smp = m >= MP; const int mi = m - MP;
        bf16_t* ur = U + (size_t)m * LDU;
        const float* us = US + (size_t)m * LDUS;
        const u32x4 wq = *(const u32x4*)(ur + UC_QLAT + 8 * F.lane), wc = *(const u32x4*)(ur + UC_CKV + 8 * F.lane);
        const u32x4 fq0 = *(const u32x4*)(ur + UC_FQ + 16 * F.lane), fq1 = *(const u32x4*)(ur + UC_FQ + 16 * F.lane + 8);
        const u32x4 fk0 = *(const u32x4*)(ur + UC_FK + 16 * F.lane), fk1 = *(const u32x4*)(ur + UC_FK + 16 * F.lane + 8);
        float x1 = 0.f, x2 = 0.f; f32x2 cs = {0.f, 0.f};
        if (F.lane < 32) { x1 = us[US_KPE + F.lane]; x2 = us[US_KPE + 32 + F.lane]; cs = rope[(size_t)ps * 32 + F.lane]; }
        const float uff = (F.lane < 8) ? us[US_FF + F.lane] : 0.f, udt = (F.lane < 16) ? us[US_DT + F.lane] : 0.f;
        float vq[8], vc[8]; unpack8(wq, vq); unpack8(wc, vc);
        float sq_ = 0.f, sc_ = 0.f;
#pragma unroll
        for (int j = 0; j < 8; ++j) { sq_ += vq[j] * vq[j]; sc_ += vc[j] * vc[j]; }
        float nq = 0.f, nk = 0.f;
        { float a8[8], b8[8]; unpack8(fq0, a8); unpack8(fq1, b8);
#pragma unroll
          for (int j = 0; j < 8; ++j) nq += a8[j] * a8[j] + b8[j] * b8[j];
          unpack8(fk0, a8); unpack8(fk1, b8);
#pragma unroll
          for (int j = 0; j < 8; ++j) nk += a8[j] * a8[j] + b8[j] * b8[j]; }
#pragma unroll
        for (int o = 1; o < 64; o <<= 1) { const float t0 = shx(sq_, o, F.lane), t1 = shx(sc_, o, F.lane); sq_ += t0; sc_ += t1;
            if (o < 8) { const float t2 = shx(nq, o, F.lane), t3 = shx(nk, o, F.lane); nq += t2; nk += t3; } }
        {
            const float rs = fast_rsqrt(sq_ * (1.0f / 512) + EPS);
            u32x4 w; w.x = pk2(vq[0] * rs * qg[0], vq[1] * rs * qg[1]); w.y = pk2(vq[2] * rs * qg[2], vq[3] * rs * qg[3]); w.z = pk2(vq[4] * rs * qg[4], vq[5] * rs * qg[5]); w.w = pk2(vq[6] * rs * qg[6], vq[7] * rs * qg[7]);
            *(u32x4*)(ur + UC_QLAT + 8 * F.lane) = w;
        }
        {
            const float rs = fast_rsqrt(sc_ * (1.0f / 512) + EPS);
#pragma unroll
            for (int j = 0; j < 8; ++j) vc[j] = vc[j] * rs * kg[j];
            float* o = (smp ? o_sckv + (size_t)mi * 512 : o_pckv + (size_t)m * 512) + 8 * F.lane;
            *(f32x4*)o = (f32x4){vc[0], vc[1], vc[2], vc[3]}; *(f32x4*)(o + 4) = (f32x4){vc[4], vc[5], vc[6], vc[7]};
            u32x4 w; w.x = pk2(vc[0], vc[1]); w.y = pk2(vc[2], vc[3]); w.z = pk2(vc[4], vc[5]); w.w = pk2(vc[6], vc[7]);
            *(u32x4*)(CKV + (size_t)kr * 512 + 8 * F.lane) = w;
        }
        if (F.lane < 32) {
            const float o1 = x1 * cs.x - x2 * cs.y, o2 = x2 * cs.x + x1 * cs.y;
            float* o = smp ? o_skpe + (size_t)mi * 64 : o_pkpe + (size_t)m * 64; o[F.lane] = o1; o[32 + F.lane] = o2;
            const unsigned w = pk2(o1, o2);
#pragma unroll
            for (int h = 0; h < 8; ++h) *(unsigned*)(KM + ((size_t)kr * 8 + h) * 192 + 128 + 2 * F.lane) = w;
        }
        if (F.lane < 8) {
            const float lf = -softplusf_(-(uff + fb));
            (smp ? o_slf + (size_t)mi * 8 : o_plf + (size_t)m * 8)[F.lane] = lf; LOGF[(size_t)kr * 8 + F.lane] = lf;
        }
        if (F.lane < 16) DTB[(size_t)m * 16 + F.lane] = softplusf_(udt + db);
        if (!smp) {
            if ((F.lane & 7) == 0) { const int hh = F.lane >> 3;
                atomicMax(ctl + CW_QN2 + (layer * 64 + (m >> 8)) * 8 + hh, __float_as_uint(nq));
                atomicMax(ctl + CW_KN2 + (layer * 64 + (m >> 8)) * 8 + hh, __float_as_uint(nk)); }
        } else {
            bf16_t* kd = KFS + (size_t)(kr - MP) * 1024 + 16 * F.lane; *(u32x4*)kd = fk0; *(u32x4*)(kd + 8) = fk1;
        }
        {
            int slot = -1; float* od = nullptr;
            if (!smp) { if (m >= MP - 3) { slot = m - (MP - 3); od = o_pconv; } }
            else { const int t = mi & 15; if (t >= 13) { slot = t - 13; od = o_sconv + (size_t)(mi >> 4) * 3 * 1536; } }
            if (slot >= 0) { for (int c = F.lane; c < 1536; c += 64) od[slot * 1536 + c] = bf2f(ur[UC_XBC + c]); }
        }
    }
    {
        bf16_t* XC = (bf16_t*)(p.ws() + WS_XN);
        const float* cw = p.in(I_CW) + (size_t)layer * 4 * 1536; const float* cb = p.in(I_CB) + (size_t)layer * 1536; const float* cst = p.in(I_CONV) + (size_t)layer * NB * 3 * 1536;
        const size_t gt = (size_t)F.gw * 64 + F.lane, NT = (size_t)F.NGW * 64;
        constexpr int STRIP = 25, NSTRIP = (MP + STRIP - 1) / STRIP;
        for (size_t it = gt; it < (size_t)NSTRIP * 192; it += NT) { const int strip = (int)(it / 192), ch0 = (int)(it % 192) * 8; const int r0 = strip * STRIP;
            float wt[4][8], bs[8];
            { const f32x4 b0 = *(const f32x4*)(cb + ch0), b1 = *(const f32x4*)(cb + ch0 + 4); bs[0] = b0[0]; bs[1] = b0[1]; bs[2] = b0[2]; bs[3] = b0[3]; bs[4] = b1[0]; bs[5] = b1[1]; bs[6] = b1[2]; bs[7] = b1[3]; }
#pragma unroll
            for (int k = 0; k < 4; ++k) { const f32x4 w0 = *(const f32x4*)(cw + k * 1536 + ch0), w1 = *(const f32x4*)(cw + k * 1536 + ch0 + 4);
                wt[k][0] = w0[0]; wt[k][1] = w0[1]; wt[k][2] = w0[2]; wt[k][3] = w0[3]; wt[k][4] = w1[0]; wt[k][5] = w1[1]; wt[k][6] = w1[2]; wt[k][7] = w1[3]; }
            const bf16_t* up = U + UC_XBC + ch0;
            u32x4 win[3];
#pragma unroll
            for (int k = 0; k < 3; ++k) { const int rr = r0 - 3 + k; u32x4 z = {0u, 0u, 0u, 0u}; if (rr >= 0) z = *(const u32x4*)(up + (size_t)rr * LDU); win[k] = z; }
#pragma unroll 1
            for (int rb = 0; rb < STRIP; rb += 5) {
                u32x4 nw[5];
#pragma unroll
                for (int e = 0; e < 5; ++e) { const int rr = r0 + rb + e; nw[e] = (rr < MP) ? *(const u32x4*)(up + (size_t)rr * LDU) : (u32x4){0u, 0u, 0u, 0u}; }
#pragma unroll
                for (int e = 0; e < 5; ++e) { const int rr = r0 + rb + e;
                    float x0[8], x1[8], x2[8], x3[8]; unpack8(win[0], x0); unpack8(win[1], x1); unpack8(win[2], x2); unpack8(nw[e], x3);
                    float acc[8];
#pragma unroll
                    for (int j = 0; j < 8; ++j) acc[j] = bs[j] + wt[0][j] * x0[j] + wt[1][j] * x1[j] + wt[2][j] * x2[j] + wt[3][j] * x3[j];
                    u32x4 o; o.x = pk2(siluf_(acc[0]), siluf_(acc[1])); o.y = pk2(siluf_(acc[2]), siluf_(acc[3])); o.z = pk2(siluf_(acc[4]), siluf_(acc[5])); o.w = pk2(siluf_(acc[6]), siluf_(acc[7]));
                    if (rr < MP) *(u32x4*)(XC + (size_t)rr * 1536 + ch0) = o;
                    win[0] = win[1]; win[1] = win[2]; win[2] = nw[e]; }
            }
        }
        for (size_t i = gt; i < (size_t)MS * 192; i += NT) { const int m = MP + (int)(i / 192), ch0 = (int)(i % 192) * 8;
            const int t = (m - MP) & 15;
            float acc[8];
            { const f32x4 b0 = *(const f32x4*)(cb + ch0), b1 = *(const f32x4*)(cb + ch0 + 4); acc[0] = b0[0]; acc[1] = b0[1]; acc[2] = b0[2]; acc[3] = b0[3]; acc[4] = b1[0]; acc[5] = b1[1]; acc[6] = b1[2]; acc[7] = b1[3]; }
#pragma unroll
            for (int k = 0; k < 4; ++k) { const int ii = t - 3 + k; float xv[8];
                if (ii >= 0) unpack8(*(const u32x4*)(U + (size_t)(m - 3 + k) * LDU + UC_XBC + ch0), xv);
                else { const float* sp = cst + ((size_t)((m - MP) >> 4) * 3 + (ii + 3)) * 1536 + ch0; const f32x4 s0 = *(const f32x4*)sp, s1 = *(const f32x4*)(sp + 4);
                    xv[0] = s0[0]; xv[1] = s0[1]; xv[2] = s0[2]; xv[3] = s0[3]; xv[4] = s1[0]; xv[5] = s1[1]; xv[6] = s1[2]; xv[7] = s1[3]; }
                const f32x4 w0 = *(const f32x4*)(cw + k * 1536 + ch0), w1 = *(const f32x4*)(cw + k * 1536 + ch0 + 4);
                acc[0] += w0[0] * xv[0]; acc[1] += w0[1] * xv[1]; acc[2] += w0[2] * xv[2]; acc[3] += w0[3] * xv[3];
                acc[4] += w1[0] * xv[4]; acc[5] += w1[1] * xv[5]; acc[6] += w1[2] * xv[6]; acc[7] += w1[3] * xv[7]; }
            u32x4 o; o.x = pk2(siluf_(acc[0]), siluf_(acc[1])); o.y = pk2(siluf_(acc[2]), siluf_(acc[3])); o.z = pk2(siluf_(acc[4]), siluf_(acc[5])); o.w = pk2(siluf_(acc[6]), siluf_(acc[7]));
            *(u32x4*)(XC + (size_t)m * 1536 + ch0) = o; }
    }
    {
        constexpr int PITCH = 72;
        LAS bf16_t* tile = (LAS bf16_t*)(F.lds + F.wave * (64 * PITCH * 2));
        for (int it = F.gw; it < (MP / 64) * 16; it += F.NGW) {
            const int rt = it >> 4, ct = it & 15, row0 = rt * 64, ch0 = ct * 64;
            u32x4 v[8];
#pragma unroll
            for (int k = 0; k < 8; ++k) { const int r = 8 * k + (F.lane >> 3), c8 = F.lane & 7; v[k] = *(const u32x4*)(U + (size_t)(row0 + r) * LDU + UC_FV + ch0 + 8 * c8); }
#pragma unroll
            for (int k = 0; k < 8; ++k) { const int r = 8 * k + (F.lane >> 3), c8 = F.lane & 7; bf16_t e8[8]; *(u32x4*)e8 = v[k];
#pragma unroll
                for (int e = 0; e < 8; ++e) tile[(8 * c8 + e) * PITCH + r] = e8[e]; }
            LDS_WAIT(); asm volatile("" ::: "memory");
#pragma unroll
            for (int k = 0; k < 8; ++k) { const int ch = 8 * k + (F.lane >> 3), r8 = F.lane & 7; const u32x4 w = *(const LAS u32x4*)(tile + ch * PITCH + 8 * r8);
                *(u32x4*)(VTF + (size_t)(ch0 + ch) * KVROWS + row0 + 8 * r8) = w; }
            LDS_WAIT(); asm volatile("" ::: "memory");
        }
        const size_t gt = (size_t)F.gw * 64 + F.lane, NT = (size_t)F.NGW * 64;
        for (size_t i = gt; i < (size_t)MS * 1024; i += NT) { const int mi = (int)(i >> 10), ch = (int)(i & 1023);
            VTF[(size_t)ch * KVROWS + kvrow_of(MP + mi)] = U[(size_t)(MP + mi) * LDU + UC_FV + ch]; }
    }
}

__device__ __forceinline__ void phase_t2(const Params&, const Frame& F0) {
    const Frame F = mk_frame(F0.wave);
    const PV p = pv_get();
    const float* LOGF = (const float*)(p.ws() + WS_LOGF); float* CUM = (float*)(p.ws() + WS_CUM);
    LAS double* wt = (LAS double*)F.lds;
    for (int job = (F.G == 256) ? (F.bx + 56) % 256 : F.bx; job < 1 + NB; job += F.G) {
        const int base = job == 0 ? 0 : MP + (job - 1) * KVS, n = job == 0 ? MP : KVS;
        const int per = (n + 511) / 512, i0 = F.tid * per, i1 = (i0 + per < n) ? i0 + per : n;
        double s[8];
#pragma unroll
        for (int h = 0; h < 8; ++h) s[h] = 0.0;
        for (int i = i0; i < i1; ++i) { const f32x4 a = *(const f32x4*)(LOGF + (size_t)(base + i) * 8), b = *(const f32x4*)(LOGF + (size_t)(base + i) * 8 + 4);
            s[0] += a[0]; s[1] += a[1]; s[2] += a[2]; s[3] += a[3]; s[4] += b[0]; s[5] += b[1]; s[6] += b[2]; s[7] += b[3]; }
        double pre[8];
#pragma unroll
        for (int h = 0; h < 8; ++h) { double v = s[h];
#pragma unroll
            for (int o = 1; o < 64; o <<= 1) { const long long vb = __builtin_bit_cast(long long, v); const int src = ((F.lane - o) & 63) << 2;
                const unsigned lo_ = (unsigned)__builtin_amdgcn_ds_bpermute(src, (int)(unsigned)vb), hi_ = (unsigned)__builtin_amdgcn_ds_bpermute(src, (int)(unsigned)(vb >> 32));
                const double t = __builtin_bit_cast(double, ((unsigned long long)hi_ << 32) | lo_); if (F.lane >= o) v += t; }
            pre[h] = v - s[h]; if (F.lane == 63) wt[F.wave * 8 + h] = v; }
        __syncthreads();
#pragma unroll
        for (int h = 0; h < 8; ++h) { double off = 0.0; for (int ww = 0; ww < F.wave; ++ww) off += wt[ww * 8 + h]; pre[h] += off; }
        for (int i = i0; i < i1; ++i) { const f32x4 a = *(const f32x4*)(LOGF + (size_t)(base + i) * 8), b = *(const f32x4*)(LOGF + (size_t)(base + i) * 8 + 4);
            pre[0] += a[0]; pre[1] += a[1]; pre[2] += a[2]; pre[3] += a[3]; pre[4] += b[0]; pre[5] += b[1]; pre[6] += b[2]; pre[7] += b[3];
            *(f32x4*)(CUM + (size_t)(base + i) * 8) = (f32x4){(float)pre[0] * LOG2E, (float)pre[1] * LOG2E, (float)pre[2] * LOG2E, (float)pre[3] * LOG2E};
            *(f32x4*)(CUM + (size_t)(base + i) * 8 + 4) = (f32x4){(float)pre[4] * LOG2E, (float)pre[5] * LOG2E, (float)pre[6] * LOG2E, (float)pre[7] * LOG2E}; }
        __syncthreads();
    }
}

#define MFMA32(a, b, c) __builtin_amdgcn_mfma_f32_32x32x16_bf16((a), (b), (c), 0, 0, 0)
__device__ __forceinline__ int crow(int r, int hi) { return (r & 3) + 8 * (r >> 2) + 4 * hi; }
struct AttnSeq {
    const bf16_t* Q; int qs;
    const bf16_t* K; int ks;
    const bf16_t* VT;
    bf16_t* O; int os;
    const float* cq; const float* ck;
};
__device__ __forceinline__ void softmax_tile(f32x16& s0, f32x16& s1, float& m, float& l, f32x16 (&o)[4], bf16x8 (&pa)[4]) {
    float pmax = s0[0];
#pragma unroll
    for (int r = 1; r < 16; ++r) pmax = fmaxf(pmax, s0[r]);
#pragma unroll
    for (int r = 0; r < 16; ++r) pmax = fmaxf(pmax, s1[r]);
    { auto rr = __builtin_amdgcn_permlane32_swap(__float_as_uint(pmax), __float_as_uint(pmax), false, false);
      pmax = fmaxf(__uint_as_float(rr[0]), __uint_as_float(rr[1])); }
    const bool resc = !__all(pmax - m <= 8.0f);
    const float mn = resc ? fmaxf(m, pmax) : m;
    const float alpha = resc ? fast_exp2(m - mn) : 1.0f; m = mn;
    float ps = 0.f;
#pragma unroll
    for (int r = 0; r < 16; ++r) { s0[r] = fast_exp2(s0[r] - mn); ps += s0[r]; }
#pragma unroll
    for (int r = 0; r < 16; ++r) { s1[r] = fast_exp2(s1[r] - mn); ps += s1[r]; }
    { auto rr = __builtin_amdgcn_permlane32_swap(__float_as_uint(ps), __float_as_uint(ps), false, false);
      ps = __uint_as_float(rr[0]) + __uint_as_float(rr[1]); }
    l = l * alpha + ps;
    if (resc) {
#pragma unroll
        for (int d = 0; d < 4; ++d)
#pragma unroll
            for (int r = 0; r < 16; ++r) o[d][r] *= alpha;
    }
#define PK4(P, B_, OUT) do { const unsigned a0 = pk2(P[B_ + 0], P[B_ + 1]), a1 = pk2(P[B_ + 2], P[B_ + 3]), b0 = pk2(P[B_ + 4], P[B_ + 5]), b1 = pk2(P[B_ + 6], P[B_ + 7]); \
        auto r0 = __builtin_amdgcn_permlane32_swap(a0, b0, false, false); auto r1 = __builtin_amdgcn_permlane32_swap(a1, b1, false, false); \
        u32x4 w_ = {r0[0], r1[0], r0[1], r1[1]}; OUT = __builtin_bit_cast(bf16x8, w_); } while (0)
    PK4(s0, 0, pa[0]); PK4(s0, 8, pa[1]); PK4(s1, 0, pa[2]); PK4(s1, 8, pa[3]);
#undef PK4
}
__device__ __forceinline__ void store_o(const f32x16 (&o)[4], float inv, bf16_t* orow, int hi) {
#pragma unroll
    for (int d = 0; d < 4; ++d)
#pragma unroll
        for (int rq = 0; rq < 4; ++rq) { u32x2 w; w.x = pk2(o[d][4 * rq] * inv, o[d][4 * rq + 1] * inv); w.y = pk2(o[d][4 * rq + 2] * inv, o[d][4 * rq + 3] * inv);
            *(u32x2*)(orow + 32 * d + 8 * rq + 4 * hi) = w; }
}

template <int DQK, bool FOX>
__device__ __forceinline__ void attn_prefill_unit(LAS unsigned char* lds, const AttnSeq& a, int qb, int tid0, float bound2 = 0.f) {
    int tid = tid0; asm volatile("" : "+v"(tid));
    constexpr int RB = DQK * 2, CPR = DQK / 8, KBUF = 64 * RB, NKI = DQK / 64, NKS = DQK / 16;
    constexpr int OFF_V = 2 * KBUF, OFF_CK = OFF_V + 2 * 16384, OFF_QR = OFF_CK + 1024;
    constexpr int NQR = NKS;
    static_assert(OFF_QR + 8 * 4096 <= LDSCTL_OFF, "attention LDS map");
    const int w = __builtin_amdgcn_readfirstlane(tid >> 6), lane = tid & 63, c = lane & 31, hi = lane >> 5;
    const int q0w = qb * 256 + 32 * w, qrow = q0w + c;
    const int last_tile = q0w >> 6, ntiles = 4 * qb + 4;
    int jmin = 0;
    if (FOX) {
        LAS int* jm = (LAS int*)(lds + 2 * KBUF + 2 * 16384 + 512);
        if (tid == 0) *jm = ntiles - 1;
        __syncthreads();
        if (tid < ntiles) { const float d = a.cq[(size_t)(qb * 256) * 8] - a.ck[(size_t)(tid * 64 + 63) * 8];
            if (!(d + bound2 < -40.f)) __hip_atomic_fetch_min(jm, tid, __ATOMIC_RELAXED, __HIP_MEMORY_SCOPE_WORKGROUP); }
        __syncthreads();
        jmin = __builtin_amdgcn_readfirstlane(*jm);
    }
    int koff[NKI], voff[2];
#pragma unroll
    for (int i = 0; i < NKI; ++i) { const int s = (i * 8 + w) * 64 + lane, row = s / CPR, cp = s % CPR;
        const int ch = (DQK == 128) ? (cp ^ (row & 15)) : ((cp & ~7) | ((cp & 7) ^ ((row >> 1) & 7)));
        koff[i] = row * a.ks + ch * 8; }
#pragma unroll
    for (int i = 0; i < 2; ++i) { const int s = (i * 8 + w) * 64 + lane, d = s >> 3, cp = s & 7; voff[i] = d * KVROWS + ((cp ^ ((d >> 1) & 7)) * 8); }
    const int krow_b = c * RB;
    const int vsw = (c >> 1) & 7;
    bf16x8 qf[NQR];
    { const bf16_t* qp = a.Q + (size_t)qrow * a.qs + 8 * hi;
#pragma unroll
      for (int ks = 0; ks < NQR; ++ks) qf[ks] = *(const bf16x8*)(qp + 16 * ks);
      if (DQK == 192) {
#pragma unroll
          for (int ks = 8; ks < NKS; ++ks) *(LAS bf16x8*)(lds + OFF_QR + w * 4096 + c * 128 + (((2 * (ks - 8) + hi) ^ vsw) * 16)) = *(const bf16x8*)(qp + 16 * ks); } }
    float cq = 0.f; if (FOX) cq = a.cq[(size_t)qrow * 8];
    f32x16 o[4];
#pragma unroll
    for (int d = 0; d < 4; ++d)
#pragma unroll
        for (int r = 0; r < 16; ++r) o[d][r] = 0.f;
    float m = -1e30f, l = 0.f;
#define ATT_ISSUE(j_, b_) do { const bf16_t* kb_ = a.K + (size_t)(j_) * 64 * a.ks; const bf16_t* vb_ = a.VT + (size_t)(j_) * 64; \
        _Pragma("unroll") for (int i_ = 0; i_ < NKI; ++i_) __builtin_amdgcn_global_load_lds((const unsigned*)(kb_ + koff[i_]), (LAS unsigned*)(lds + (b_) * KBUF + (i_ * 8 + w) * 1024), 16, 0, 0); \
        _Pragma("unroll") for (int i_ = 0; i_ < 2; ++i_) __builtin_amdgcn_global_load_lds((const unsigned*)(vb_ + voff[i_]), (LAS unsigned*)(lds + OFF_V + (b_) * 16384 + (i_ * 8 + w) * 1024), 16, 0, 0); } while (0)
    ATT_ISSUE(jmin, jmin & 1);
    float ckn = 0.f;
    if (FOX && w == 0) { ckn = a.ck[(size_t)(jmin * 64 + lane) * 8]; ((LAS float*)(lds + OFF_CK))[(jmin & 1) * 64 + lane] = ckn; }
    for (int j = jmin; j < ntiles; ++j) {
        const int b = j & 1;
        VM_WAIT();
        __syncthreads();
        if (j + 1 < ntiles) { ATT_ISSUE(j + 1, b ^ 1); if (FOX && w == 0) ckn = a.ck[(size_t)((j + 1) * 64 + lane) * 8]; }
        if (j <= last_tile) {
            const LAS unsigned char* kb = lds + b * KBUF; const LAS unsigned char* vb = lds + OFF_V + b * 16384;
            f32x16 s0, s1;
#pragma unroll
            for (int r = 0; r < 16; ++r) { s0[r] = 0.f; s1[r] = 0.f; }
            constexpr int NB4 = NKS / 4;
            bf16x8 kfa[2][4], kfb[2][4];
#define ATT_LDK(dst, b4) do { _Pragma("unroll") for (int e_ = 0; e_ < 4; ++e_) { const int ks_ = 4 * (b4) + e_, ch_ = 2 * ks_ + hi; \
                const int cp_ = (DQK == 128) ? (ch_ ^ (c & 15)) : ((ch_ & ~7) | ((ch_ & 7) ^ ((c >> 1) & 7))); \
                dst[0][e_] = *(const LAS bf16x8*)(kb + krow_b + cp_ * 16); dst[1][e_] = *(const LAS bf16x8*)(kb + 32 * RB + krow_b + cp_ * 16); } } while (0)
#define ATT_MMK(src, b4) do { _Pragma("unroll") for (int e_ = 0; e_ < 4; ++e_) { const int ks_ = 4 * (b4) + e_; \
                bf16x8 qv_; if (ks_ < NQR) qv_ = qf[ks_ < NQR ? ks_ : 0]; else qv_ = *(const LAS bf16x8*)(lds + OFF_QR + w * 4096 + c * 128 + (((2 * (ks_ - 8) + hi) ^ vsw) * 16)); \
                s0 = MFMA32(src[0][e_], qv_, s0); s1 = MFMA32(src[1][e_], qv_, s1); } } while (0)
            ATT_LDK(kfa, 0);
            __builtin_amdgcn_sched_barrier(0);
            ATT_LDK(kfb, 1);
            __builtin_amdgcn_sched_barrier(0);
            ATT_MMK(kfa, 0);
            __builtin_amdgcn_sched_barrier(0);
            if (NB4 > 2) { ATT_LDK(kfa, 2 < NB4 ? 2 : 0); }
            __builtin_amdgcn_sched_barrier(0);
            ATT_MMK(kfb, 1);
            __builtin_amdgcn_sched_barrier(0);
            if (NB4 > 2) { ATT_MMK(kfa, 2 < NB4 ? 2 : 0); }
            __builtin_amdgcn_sched_barrier(0);
#undef ATT_LDK
#undef ATT_MMK
            if (FOX) {
                const LAS float* ckb = (const LAS float*)(lds + OFF_CK) + b * 64;
#pragma unroll
                for (int r = 0; r < 16; ++r) { s0[r] += cq - ckb[crow(r, hi)]; s1[r] += cq - ckb[32 + crow(r, hi)]; }
                if (j == last_tile) { const int dq = qrow - j * 64;
#pragma unroll
                    for (int r = 0; r < 16; ++r) { if (crow(r, hi) > dq) s0[r] = -__builtin_inff(); if (32 + crow(r, hi) > dq) s1[r] = -__builtin_inff(); } }
            }
            bf16x8 pa[4];
            softmax_tile(s0, s1, m, l, o, pa);
            {
                bf16x8 va[2][4], vb2[2][4];
#define ATT_LDV(dst, k0_) do { _Pragma("unroll") for (int kk_ = 0; kk_ < 2; ++kk_) _Pragma("unroll") for (int d_ = 0; d_ < 4; ++d_) { const int cp_ = (2 * ((k0_) + kk_) + hi) ^ vsw; \
                    dst[kk_][d_] = *(const LAS bf16x8*)(vb + (32 * d_ + c) * 128 + cp_ * 16); } } while (0)
#define ATT_MMV(src, k0_) do { _Pragma("unroll") for (int kk_ = 0; kk_ < 2; ++kk_) _Pragma("unroll") for (int d_ = 0; d_ < 4; ++d_) o[d_] = MFMA32(src[kk_][d_], pa[(k0_) + kk_], o[d_]); } while (0)
                ATT_LDV(va, 0);
                __builtin_amdgcn_sched_barrier(0);
                ATT_LDV(vb2, 2);
                __builtin_amdgcn_sched_barrier(0);
                ATT_MMV(va, 0);
                __builtin_amdgcn_sched_barrier(0);
                ATT_MMV(vb2, 2);
#undef ATT_LDV
#undef ATT_MMV
            }
        }
        if (FOX && w == 0 && j + 1 < ntiles) ((LAS float*)(lds + OFF_CK))[(b ^ 1) * 64 + lane] = ckn;
    }
#undef ATT_ISSUE
    store_o(o, __builtin_amdgcn_rcpf(l), a.O + (size_t)qrow * a.os, hi);
    __syncthreads();
}

template <int DQK, bool FOX>
__device__ __forceinline__ void attn_decode_unit(LAS unsigned char* lds, const AttnSeq& a, int tid0) {
    int tid = tid0; asm volatile("" : "+v"(tid));
    constexpr int NKS = DQK / 16;
    const int w = __builtin_amdgcn_readfirstlane(tid >> 6), lane = tid & 63, c = lane & 31, hi = lane >> 5, t = c & 15;
    bf16x8 qf[NKS];
    { const bf16_t* qp = a.Q + (size_t)t * a.qs + 8 * hi;
#pragma unroll
      for (int ks = 0; ks < NKS; ++ks) qf[ks] = *(const bf16x8*)(qp + 16 * ks); }
    float cq = 0.f; if (FOX) cq = a.cq[(size_t)t * 8];
    f32x16 o[4];
#pragma unroll
    for (int d = 0; d < 4; ++d)
#pragma unroll
        for (int r = 0; r < 16; ++r) o[d][r] = 0.f;
    float m = -1e30f, l = 0.f;
    const int lim = FOX ? PAST + t : KVLEN_S - 1;
    for (int j = w; j < KVS / 64; j += 8) {
        f32x16 s0, s1;
#pragma unroll
        for (int r = 0; r < 16; ++r) { s0[r] = 0.f; s1[r] = 0.f; }
        const bf16_t* kp = a.K + (size_t)(j * 64 + c) * a.ks + 8 * hi;
#pragma unroll
        for (int ks = 0; ks < NKS; ++ks) {
            if ((ks & 3) == 0) __builtin_amdgcn_sched_barrier(0);
            const bf16x8 k0 = *(const bf16x8*)(kp + 16 * ks), k1 = *(const bf16x8*)(kp + (size_t)32 * a.ks + 16 * ks);
            s0 = MFMA32(k0, qf[ks], s0); s1 = MFMA32(k1, qf[ks], s1);
        }
#pragma unroll
        for (int r = 0; r < 16; ++r) { const int k0i = j * 64 + crow(r, hi), k1i = k0i + 32;
            if (FOX) { s0[r] += cq - a.ck[(size_t)k0i * 8]; s1[r] += cq - a.ck[(size_t)k1i * 8]; }
            if (k0i > lim) s0[r] = -__builtin_inff(); if (k1i > lim) s1[r] = -__builtin_inff(); }
        bf16x8 pa[4];
        softmax_tile(s0, s1, m, l, o, pa);
#pragma unroll
        for (int d = 0; d < 4; ++d) {
            __builtin_amdgcn_sched_barrier(0);
#pragma unroll
            for (int ks = 0; ks < 4; ++ks) { const bf16x8 vf = *(const bf16x8*)(a.VT + (size_t)(32 * d + c) * KVROWS + j * 64 + 16 * ks + 8 * hi);
                o[d] = MFMA32(vf, pa[ks], o[d]); } }
    }
    LAS float* Ot = (LAS float*)lds; LAS float* ML = (LAS float*)(lds + 8 * 128 * 16 * 4);
    if (c < 16) {
#pragma unroll
        for (int d = 0; d < 4; ++d)
#pragma unroll
            for (int r = 0; r < 16; ++r) Ot[(w * 128 + 32 * d + crow(r, hi)) * 16 + c] = o[d][r];
        if (hi == 0) { ML[(w * 16 + c) * 2] = m; ML[(w * 16 + c) * 2 + 1] = l; }
    }
    __syncthreads();
    { const int q = tid & 15, dg = tid >> 4;
      float M = -1e30f;
#pragma unroll
      for (int ww = 0; ww < 8; ++ww) M = fmaxf(M, ML[(ww * 16 + q) * 2]);
      float L = 0.f, acc[4] = {0.f, 0.f, 0.f, 0.f};
#pragma unroll
      for (int ww = 0; ww < 8; ++ww) { const float f = fast_exp2(ML[(ww * 16 + q) * 2] - M); L += ML[(ww * 16 + q) * 2 + 1] * f;
#pragma unroll
          for (int e = 0; e < 4; ++e) acc[e] += Ot[(ww * 128 + 4 * dg + e) * 16 + q] * f; }
      const float inv = __builtin_amdgcn_rcpf(L);
      u32x2 wv; wv.x = pk2(acc[0] * inv, acc[1] * inv); wv.y = pk2(acc[2] * inv, acc[3] * inv);
      *(u32x2*)(a.O + (size_t)q * a.os + 4 * dg) = wv; }
    __syncthreads();
}
#define MFMA16(a, b, c) __builtin_amdgcn_mfma_f32_16x16x32_bf16((a), (b), (c), 0, 0, 0)
constexpr int SSD_XP = 72;
constexpr int SSD_BP = 136;
__device__ __forceinline__ void ssd_dt_acs(const Frame& F, const float* DTB, int m0, int L, int g, float a_neg  , LAS float* Dt, LAS float* Ac) {
    { const int l = F.tid >> 3, h = F.tid & 7; Dt[F.tid] = (l < L) ? DTB[(size_t)(m0 + l) * 16 + 8 * g + h] : 0.f; }
    __syncthreads();
    if (F.tid < 8) { float acs = 0.f; for (int l = 0; l < 64; ++l) { acs += Dt[l * 8 + F.tid] * a_neg; Ac[l * 8 + F.tid] = acs; } }
    __syncthreads();
}
__device__ __forceinline__ void phase_s1(const Params&, const Frame& F0, int layer0) {
    const Frame F = mk_frame(F0.wave);
    const PV p = pv_get(); int layer = layer0; asm volatile("" : "+s"(layer));
    const bf16_t* XC = (const bf16_t*)(p.ws() + WS_XN);
    const float* DTB = (const float*)(p.ws() + WS_DT); bf16_t* ST = (bf16_t*)(p.ws() + WS_ST); float* CDEC = (float*)(p.ws() + WS_CDEC);
    LAS float* Dt = (LAS float*)F.lds; LAS float* Ac = (LAS float*)(F.lds + 2048);
    LAS bf16_t* BT = (LAS bf16_t*)(F.lds + 4096);
    LAS bf16_t* XT = (LAS bf16_t*)(F.lds + 4096 + 128 * SSD_XP * 2) + F.wave * 64 * SSD_XP;
    const int w = F.wave, lane = F.lane, fr = lane & 15, q = lane >> 4;
    for (int unit = (F.G == 256) ? (F.bx + 88) % 256 : F.bx; unit < NCHUNK * 2; unit += F.G) {
        const int ci = unit >> 1, g = unit & 1; const bool smp = ci >= 256; const int L = smp ? 16 : 64; const int m0 = smp ? MP + (ci - 256) * 16 : ci * 64;
        const int head = 8 * g + w;
        const float a_neg = (F.tid < 8) ? -fast_exp(p.in(I_ALOG)[layer * 16 + 8 * g + F.tid]) : 0.f;
        ssd_dt_acs(F, DTB, m0, L, g, a_neg, Dt, Ac);
        const float alast = Ac[63 * 8 + w];
        if (lane == 0) CDEC[ci * 16 + head] = fast_exp(alast);
        for (int idx = F.tid; idx < 64 * 16; idx += 512) { const int l = idx >> 4, n8 = idx & 15; bf16_t v[8];
            if (l < L) *(u32x4*)v = *(const u32x4*)(XC + (size_t)(m0 + l) * 1536 + 1024 + 128 * g + 8 * n8); else *(u32x4*)v = (u32x4){0u, 0u, 0u, 0u};
#pragma unroll
            for (int e = 0; e < 8; ++e) BT[(8 * n8 + e) * SSD_XP + l] = v[e]; }
#pragma unroll
        for (int it = 0; it < 8; ++it) { const int l = 8 * it + (lane >> 3), p8 = lane & 7; float xv[8];
            if (l < L) unpack8(*(const u32x4*)(XC + (size_t)(m0 + l) * 1536 + head * 64 + 8 * p8), xv); else { for (int e = 0; e < 8; ++e) xv[e] = 0.f; }
            const float wgt = fast_exp(alast - Ac[l * 8 + w]) * Dt[l * 8 + w];
#pragma unroll
            for (int e = 0; e < 8; ++e) XT[(8 * p8 + e) * SSD_XP + l] = f2bf(xv[e] * wgt); }
        __syncthreads();
#pragma unroll 1
        for (int nh = 0; nh < 2; ++nh) {
            f32x4 acc[4][4];
#pragma unroll
            for (int nb = 0; nb < 4; ++nb)
#pragma unroll
                for (int pb = 0; pb < 4; ++pb) acc[nb][pb] = (f32x4){0.f, 0.f, 0.f, 0.f};
#pragma unroll
            for (int ks = 0; ks < 2; ++ks) {
                bf16x8 xf[4];
#pragma unroll
                for (int pb = 0; pb < 4; ++pb) xf[pb] = *(const LAS bf16x8*)(XT + (16 * pb + fr) * SSD_XP + 32 * ks + 8 * q);
#pragma unroll
                for (int nb = 0; nb < 4; ++nb) { const bf16x8 bf = *(const LAS bf16x8*)(BT + (64 * nh + 16 * nb + fr) * SSD_XP + 32 * ks + 8 * q);
#pragma unroll
                    for (int pb = 0; pb < 4; ++pb) acc[nb][pb] = MFMA16(bf, xf[pb], acc[nb][pb]); }
            }
            bf16_t* so = ST + (size_t)(ci * 16 + head) * 8192;
#pragma unroll
            for (int nb = 0; nb < 4; ++nb)
#pragma unroll
                for (int pb = 0; pb < 4; ++pb) { u32x2 o; o.x = pk2(acc[nb][pb][0], acc[nb][pb][1]); o.y = pk2(acc[nb][pb][2], acc[nb][pb][3]); *(u32x2*)(so + (size_t)(16 * pb + fr) * 128 + 64 * nh + 16 * nb + 4 * q) = o; }
        }
        __syncthreads();
    }
}
__device__ __forceinline__ void phase_s2(const Params&, const Frame& F0, int layer0) {
    const Frame F = mk_frame(F0.wave);
    const PV p = pv_get(); int layer = layer0; asm volatile("" : "+s"(layer));
    const bf16_t* ST = (const bf16_t*)(p.ws() + WS_ST); const float* CDEC = (const float*)(p.ws() + WS_CDEC); bf16_t* HB = (bf16_t*)(p.ws() + WS_HB);
    float* o_p = p.out() + O_PSSM + (size_t)layer * 131072; float* o_s = p.out() + O_SSSM + (size_t)layer * NB * 131072;
    const float* h0s = p.in(I_SSM) + (size_t)layer * NB * 131072;
    if (F.tid < 256) for (size_t e2 = (size_t)F.bx * 256 + F.tid; e2 < 65536; e2 += (size_t)F.G * 256) { const size_t e = 2 * e2; const int head = (int)(e >> 13);
        float h0 = 0.f, h1 = 0.f;
        for (int c0 = 0; c0 < 256; c0 += 32) { unsigned tw[32]; float dv[32];
#pragma unroll
            for (int i = 0; i < 32; ++i) { tw[i] = *(const unsigned*)(ST + (size_t)(c0 + i) * 131072 + e); dv[i] = CDEC[(c0 + i) * 16 + head]; }
#pragma unroll
            for (int i = 0; i < 32; ++i) { *(unsigned*)(HB + (size_t)(c0 + i) * 131072 + e) = pk2(h0, h1); h0 = h0 * dv[i] + bf_lo(tw[i]); h1 = h1 * dv[i] + bf_hi(tw[i]); } }
        *(f32x2*)(o_p + e) = (f32x2){h0, h1}; }
    const size_t gt = (size_t)F.bx * 512 + F.tid, NT = (size_t)F.G * 512;
    for (size_t i2 = gt; i2 < (size_t)NB * 65536; i2 += NT) { const size_t i = 2 * i2; const int b = (int)(i >> 17); const size_t e = i & 131071; const int head = (int)(e >> 13), ci = 256 + b;
        const f32x2 h0 = *(const f32x2*)(h0s + i); const unsigned tw = *(const unsigned*)(ST + (size_t)ci * 131072 + e); const float cd = CDEC[ci * 16 + head];
        *(unsigned*)(HB + (size_t)ci * 131072 + e) = pk2(h0[0], h0[1]); *(f32x2*)(o_s + i) = (f32x2){h0[0] * cd + bf_lo(tw), h0[1] * cd + bf_hi(tw)}; }
}
__device__ __forceinline__ void phase_s3(const Params&, const Frame& F0, int layer0) {
    const Frame F = mk_frame(F0.wave);
    const PV p = pv_get(); int layer = layer0; asm volatile("" : "+s"(layer));
    const bf16_t* XC = (const bf16_t*)(p.ws() + WS_XN); bf16_t* U = (bf16_t*)(p.ws() + WS_U);
    const float* DTB = (const float*)(p.ws() + WS_DT);
    LAS float* Dt = (LAS float*)F.lds; LAS float* Ac = (LAS float*)(F.lds + 2048); LAS float* Rs = (LAS float*)(F.lds + 4096);
    LAS bf16_t* Bs = (LAS bf16_t*)(F.lds + 4608);
    LAS bf16_t* Cs = (LAS bf16_t*)(F.lds + 4608 + 64 * SSD_BP * 2);
    LAS bf16_t* XT = (LAS bf16_t*)(F.lds + 4608 + 2 * 64 * SSD_BP * 2) + F.wave * 64 * SSD_XP;
    const int w = F.wave, lane = F.lane, fr = lane & 15, q = lane >> 4;
    for (int unit = F.bx; unit < NCHUNK * 2; unit += F.G) {
        const int ci = unit >> 1, g = unit & 1; const bool smp = ci >= 256; const int L = smp ? 16 : 64; const int m0 = smp ? MP + (ci - 256) * 16 : ci * 64;
        const int head = 8 * g + w;
        const float a_neg = (F.tid < 8) ? -fast_exp(p.in(I_ALOG)[layer * 16 + 8 * g + F.tid]) : 0.f;
        bf16x8 hfr[4][4];
        { const bf16_t* hb = (const bf16_t*)(p.ws() + WS_HB) + (size_t)(ci * 16 + head) * 8192 + (size_t)fr * 128 + 8 * q;
#pragma unroll
          for (int ks = 0; ks < 4; ++ks)
#pragma unroll
              for (int pb = 0; pb < 4; ++pb) hfr[ks][pb] = *(const bf16x8*)(hb + (size_t)(16 * pb) * 128 + 32 * ks); }
        __builtin_amdgcn_sched_barrier(0);
        if (F.tid < 64) Rs[F.tid] = 0.f;
        ssd_dt_acs(F, DTB, m0, L, g, a_neg, Dt, Ac);
        for (int idx = F.tid; idx < 64 * 16; idx += 512) { const int l = idx >> 4, n8 = idx & 15; u32x4 vb = {0u, 0u, 0u, 0u}, vc = {0u, 0u, 0u, 0u};
            if (l < L) { const bf16_t* src = XC + (size_t)(m0 + l) * 1536 + 1024 + 128 * g + 8 * n8; vb = *(const u32x4*)src; vc = *(const u32x4*)(src + 256); }
            *(LAS u32x4*)(Bs + l * SSD_BP + 8 * n8) = vb; *(LAS u32x4*)(Cs + l * SSD_BP + 8 * n8) = vc; }
#pragma unroll
        for (int it = 0; it < 8; ++it) { const int l = 8 * it + (lane >> 3), p8 = lane & 7; bf16_t v[8];
            if (l < L) *(u32x4*)v = *(const u32x4*)(XC + (size_t)(m0 + l) * 1536 + head * 64 + 8 * p8); else *(u32x4*)v = (u32x4){0u, 0u, 0u, 0u};
#pragma unroll
            for (int e = 0; e < 8; ++e) XT[(8 * p8 + e) * SSD_XP + l] = v[e]; }
        __syncthreads();
        f32x4 acc[4][4];
#pragma unroll
        for (int pb = 0; pb < 4; ++pb)
#pragma unroll
            for (int lb = 0; lb < 4; ++lb) acc[pb][lb] = (f32x4){0.f, 0.f, 0.f, 0.f};
#pragma unroll
        for (int ks = 0; ks < 4; ++ks) { bf16x8 cf[4];
#pragma unroll
            for (int lb = 0; lb < 4; ++lb) cf[lb] = *(const LAS bf16x8*)(Cs + (16 * lb + fr) * SSD_BP + 32 * ks + 8 * q);
#pragma unroll
            for (int pb = 0; pb < 4; ++pb) {
#pragma unroll
                for (int lb = 0; lb < 4; ++lb) acc[pb][lb] = MFMA16(hfr[ks][pb], cf[lb], acc[pb][lb]); } }
        f32x4 gt[4][4];
#pragma unroll
        for (int sb = 0; sb < 4; ++sb)
#pragma unroll
            for (int lb = 0; lb < 4; ++lb) gt[sb][lb] = (f32x4){0.f, 0.f, 0.f, 0.f};
#pragma unroll
        for (int ks = 0; ks < 4; ++ks) { bf16x8 cf[4];
#pragma unroll
            for (int lb = 0; lb < 4; ++lb) cf[lb] = *(const LAS bf16x8*)(Cs + (16 * lb + fr) * SSD_BP + 32 * ks + 8 * q);
#pragma unroll
            for (int sb = 0; sb < 4; ++sb) { const bf16x8 bf = *(const LAS bf16x8*)(Bs + (16 * sb + fr) * SSD_BP + 32 * ks + 8 * q);
#pragma unroll
                for (int lb = 0; lb < 4; ++lb) gt[sb][lb] = MFMA16(bf, cf[lb], gt[sb][lb]); } }
        float al[4];
#pragma unroll
        for (int lb = 0; lb < 4; ++lb) { al[lb] = Ac[(16 * lb + fr) * 8 + w]; const float el = fast_exp(al[lb]);
#pragma unroll
            for (int pb = 0; pb < 4; ++pb) acc[pb][lb] = acc[pb][lb] * el; }
#pragma unroll
        for (int ks2 = 0; ks2 < 2; ++ks2) {
            float as_[2][4], ds_[2][4];
#pragma unroll
            for (int jh = 0; jh < 2; ++jh)
#pragma unroll
                for (int r = 0; r < 4; ++r) { const int s = 32 * ks2 + 16 * jh + 4 * q + r; as_[jh][r] = Ac[s * 8 + w]; ds_[jh][r] = Dt[s * 8 + w]; }
            bf16x8 mf[4];
#pragma unroll
            for (int lb = 0; lb < 4; ++lb) { const int l = 16 * lb + fr; float mv[8];
#pragma unroll
                for (int jh = 0; jh < 2; ++jh)
#pragma unroll
                    for (int r = 0; r < 4; ++r) { const int s = 32 * ks2 + 16 * jh + 4 * q + r;
                        mv[4 * jh + r] = (s <= l) ? gt[2 * ks2 + jh][lb][r] * fast_exp(al[lb] - as_[jh][r]) * ds_[jh][r] : 0.f; }
                u32x4 mw; mw.x = pk2(mv[0], mv[1]); mw.y = pk2(mv[2], mv[3]); mw.z = pk2(mv[4], mv[5]); mw.w = pk2(mv[6], mv[7]);
                mf[lb] = __builtin_bit_cast(bf16x8, mw); }
#pragma unroll
            for (int pb = 0; pb < 4; ++pb) { const LAS bf16_t* xp = XT + (16 * pb + fr) * SSD_XP + 32 * ks2 + 4 * q;
                const u32x2 x0 = *(const LAS u32x2*)xp, x1 = *(const LAS u32x2*)(xp + 16);
                const u32x4 xw = {x0.x, x0.y, x1.x, x1.y}; const bf16x8 xf = __builtin_bit_cast(bf16x8, xw);
#pragma unroll
                for (int lb = 0; lb < 4; ++lb) acc[pb][lb] = MFMA16(xf, mf[lb], acc[pb][lb]); }
        }
        const float dsk = p.in(I_SD)[layer * 16 + head];
        float sq[4] = {0.f, 0.f, 0.f, 0.f};
#pragma unroll
        for (int lb = 0; lb < 4; ++lb) { const int l = 16 * lb + fr; const bool ok = l < L;
#pragma unroll
            for (int pb = 0; pb < 4; ++pb) { const int pc = 16 * pb + 4 * q;
                u32x2 xw = {0u, 0u}, zw = {0u, 0u};
                if (ok) { xw = *(const u32x2*)(XC + (size_t)(m0 + l) * 1536 + head * 64 + pc); zw = *(const u32x2*)(U + (size_t)(m0 + l) * LDU + UC_Z + head * 64 + pc); }
                f32x4 y = acc[pb][lb];
                y[0] = (y[0] + dsk * bf_lo(xw.x)) * siluf_(bf_lo(zw.x)); y[1] = (y[1] + dsk * bf_hi(xw.x)) * siluf_(bf_hi(zw.x));
                y[2] = (y[2] + dsk * bf_lo(xw.y)) * siluf_(bf_lo(zw.y)); y[3] = (y[3] + dsk * bf_hi(xw.y)) * siluf_(bf_hi(zw.y));
                acc[pb][lb] = y; sq[lb] += (y[0] * y[0] + y[1] * y[1]) + (y[2] * y[2] + y[3] * y[3]); } }
#pragma unroll
        for (int lb = 0; lb < 4; ++lb) { float s = sq[lb]; s += shx(s, 16, F.lane); s += shx(s, 32, F.lane);
            if (q == 0) __hip_atomic_fetch_add(Rs + 16 * lb + fr, s, __ATOMIC_RELAXED, __HIP_MEMORY_SCOPE_WORKGROUP); }
        __syncthreads();
#pragma unroll
        for (int lb = 0; lb < 4; ++lb) { const int l = 16 * lb + fr;
            if (l < L) { const float rs = fast_rsqrt(Rs[l] * (1.0f / 512) + EPS);
#pragma unroll
                for (int pb = 0; pb < 4; ++pb) { const int pc = 16 * pb + 4 * q; const f32x4 gn = *(const f32x4*)(p.in(I_SN) + layer * 1024 + head * 64 + pc); const f32x4 y = acc[pb][lb];
                    u32x2 ow; ow.x = pk2(y[0] * rs * gn[0], y[1] * rs * gn[1]); ow.y = pk2(y[2] * rs * gn[2], y[3] * rs * gn[3]);
                    *(u32x2*)(U + (size_t)(m0 + l) * LDU + UC_OSSD + head * 64 + pc) = ow; } } }
        __syncthreads();
    }
}
#ifndef DUPMASK
#define DUPMASK 0
#endif
__device__ __forceinline__ void phase_attn(const Params&, const Frame& F0, int layer0) {
    const Frame F = mk_frame(F0.wave);
    const PV p = pv_get(); int layer = layer0; asm volatile("" : "+s"(layer));
    bf16_t* U = (bf16_t*)(p.ws() + WS_U); const bf16_t* QM = (const bf16_t*)(p.ws() + WS_QM); const bf16_t* KM = (const bf16_t*)(p.ws() + WS_KM);
    const bf16_t* VTM = (const bf16_t*)(p.ws() + WS_VTM); const bf16_t* KFS = (const bf16_t*)(p.ws() + WS_KFS); const bf16_t* VTF = (const bf16_t*)(p.ws() + WS_VTF);
    const float* CUM = (const float*)(p.ws() + WS_CUM);
    for (int it = F.vcu; it < 256; it += F.G) {
        const int h = it >> 5, pr = it & 31;
        AttnSeq a; a.Q = QM + h * 192; a.qs = 1536; a.K = KM + h * 192; a.ks = 1536; a.VT = VTM + (size_t)h * 128 * KVROWS; a.O = U + UC_OMLA + h * 128; a.os = LDU; a.cq = nullptr; a.ck = nullptr;
#pragma unroll 1
        for (int half = 0; half < 2; ++half) attn_prefill_unit<192, false>(F.lds, a, half ? pr : 63 - pr, F.tid);
    }
#if defined(DUPMASK)
    if ((DUPMASK >> 8) & 1) for (int it = F.vcu; it < 256; it += F.G) {
        const int h = it >> 5, pr = it & 31;
        AttnSeq a; a.Q = QM + h * 192; a.qs = 1536; a.K = KM + h * 192; a.ks = 1536; a.VT = VTM + (size_t)h * 128 * KVROWS; a.O = U + UC_OMLA + h * 128; a.os = LDU; a.cq = nullptr; a.ck = nullptr;
#pragma unroll 1
        for (int half = 0; half < 2; ++half) attn_prefill_unit<192, false>(F.lds, a, half ? pr : 63 - pr, F.tid);
    }
#endif
    for (int it = F.vcu; it < 256; it += F.G) {
        const int h = it >> 5, pr = it & 31;
        AttnSeq a; a.Q = U + UC_FQ + h * 128; a.qs = LDU; a.K = U + UC_FK + h * 128; a.ks = LDU; a.VT = VTF + (size_t)h * 128 * KVROWS; a.O = U + UC_OFOX + h * 128; a.os = LDU; a.cq = CUM + h; a.ck = CUM + h;
        const unsigned* ctl = (const unsigned*)(p.ws() + WS_CTL);
        float kn2; { float v = __uint_as_float(ctl[CW_KN2 + (layer * 64 + F.lane) * 8 + h]);
#pragma unroll
            for (int o = 1; o < 64; o <<= 1) v = fmaxf(v, shx(v, o, F.lane)); kn2 = v; }
#pragma unroll 1
        for (int half = 0; half < 2; ++half) { const int qb = half ? pr : 63 - pr;
            attn_prefill_unit<128, true>(F.lds, a, qb, F.tid, 2.02f * __builtin_amdgcn_sqrtf(__uint_as_float(ctl[CW_QN2 + (layer * 64 + qb) * 8 + h]) * kn2)); }
    }
#if defined(DUPMASK)
    if ((DUPMASK >> 9) & 1) for (int it = F.vcu; it < 256; it += F.G) {
        const int h = it >> 5, pr = it & 31;
        AttnSeq a; a.Q = U + UC_FQ + h * 128; a.qs = LDU; a.K = U + UC_FK + h * 128; a.ks = LDU; a.VT = VTF + (size_t)h * 128 * KVROWS; a.O = (bf16_t*)(p.ws() + WS_ST) + h * 128; a.os = 1024; a.cq = CUM + h; a.ck = CUM + h;
        const unsigned* ctl = (const unsigned*)(p.ws() + WS_CTL);
        float kn2; { float v = __uint_as_float(ctl[CW_KN2 + (layer * 64 + F.lane) * 8 + h]);
#pragma unroll
            for (int o = 1; o < 64; o <<= 1) v = fmaxf(v, shx(v, o, F.lane)); kn2 = v; }
#pragma unroll 1
        for (int half = 0; half < 2; ++half) { const int qb = half ? pr : 63 - pr;
            attn_prefill_unit<128, true>(F.lds, a, qb, F.tid, 2.02f * __builtin_amdgcn_sqrtf(__uint_as_float(ctl[CW_QN2 + (layer * 64 + qb) * 8 + h]) * kn2)); }
    }
#endif
    for (int it = F.vcu; it < 2 * NB * 8; it += F.G) {
        const int kind = it >> 7, s = (it & 127) >> 3, h = it & 7; const size_t q0 = (size_t)MP + 16 * s, k0 = (size_t)MP + (size_t)s * KVS;
        if (kind == 0) { AttnSeq a; a.Q = QM + q0 * 1536 + h * 192; a.qs = 1536; a.K = KM + k0 * 1536 + h * 192; a.ks = 1536; a.VT = VTM + (size_t)h * 128 * KVROWS + k0; a.O = U + q0 * LDU + UC_OMLA + h * 128; a.os = LDU; a.cq = nullptr; a.ck = nullptr;
          attn_decode_unit<192, false>(F.lds, a, F.tid); }
        else { AttnSeq a; a.Q = U + q0 * LDU + UC_FQ + h * 128; a.qs = LDU; a.K = KFS + (size_t)s * KVS * 1024 + h * 128; a.ks = 1024; a.VT = VTF + (size_t)h * 128 * KVROWS + k0; a.O = U + q0 * LDU + UC_OFOX + h * 128; a.os = LDU;
          a.cq = CUM + (k0 + PAST) * 8 + h; a.ck = CUM + k0 * 8 + h;
          attn_decode_unit<128, true>(F.lds, a, F.tid); }
    }
}

#define LAUNDER_P const PV p = pv_get()
#define LAUNDER_PL const PV p = pv_get(); int layer = layer0; asm volatile("" : "+s"(layer))
__device__ __forceinline__ void ph_gateup(const Params&, const Frame& F0, size_t woff) {
    const Frame F = mk_frame(F0.wave);
    LAUNDER_P; bf16_t* W = (bf16_t*)(p.ws() + WS_W); bf16_t* XN = (bf16_t*)(p.ws() + WS_XB); bf16_t* H = (bf16_t*)(p.ws() + WS_U);
    pg8::Gemm g{XN, W + woff, 64, 64, MT, 2 * FF, D, (size_t)MT * 128, (size_t)2 * FF * 128}; pg8::StaticOrder S; S.init(MT, 2 * FF, F.G, F.bx, D); S.nrev = true;
    EpiSwiGLU E{H, (const float*)(p.ws() + WS_SS) + RS_OFF}; pg8::gemm_phase<EpiSwiGLU, pg8::StaticOrder, true, true>(F.lds, g, S, E, F.wave);
}
__device__ __forceinline__ void ph_down(const Params&, const Frame& F0, size_t woff, bool from_input, bool dummy = false) {
    const Frame F = mk_frame(F0.wave);
    LAUNDER_P; bf16_t* W = (bf16_t*)(p.ws() + WS_W); bf16_t* H = (bf16_t*)(p.ws() + WS_U);
    pg8::Gemm g{H, W + woff, 64, 64, MT, D, FF, (size_t)MT * 128, (size_t)D * 128}; pg8::SplitOrder S;
    S.init(MT, D, F.G, F.bx, FF);
    EpiResid E{(bf16_t*)(p.ws() + (dummy ? WS_ST : WS_XB)), (float*)(p.ws() + WS_SS), 0.5f, (float*)(p.ws() + WS_PART), (LAS float*)(F.lds + RING_BYTES + 1024)}; pg8::gemm_phase<EpiResid, pg8::SplitOrder, true, true>(F.lds, g, S, E, F.wave);
}
__device__ __forceinline__ void ph_win(const Params&, const Frame& F0, int layer0) {
    const Frame F = mk_frame(F0.wave);
    LAUNDER_PL; bf16_t* W = (bf16_t*)(p.ws() + WS_W); bf16_t* XN = (bf16_t*)(p.ws() + WS_XB); bf16_t* U = (bf16_t*)(p.ws() + WS_U);
    pg8::Gemm g{XN, W + W_IN, 64, 64, MT, NWIN, D, (size_t)MT * 128, (size_t)NWIN * 128}; pg8::StaticOrder S; S.init(MT, NWIN, F.G, F.bx, D);
    EpiWin E{U, (float*)(p.ws() + WS_US), p.out() + O_PFK + (size_t)layer * MP * 1024, p.out() + O_SFK + (size_t)layer * MS * 1024,
             p.out() + O_PFV + (size_t)layer * MP * 1024, p.out() + O_SFV + (size_t)layer * MS * 1024, (const float*)(p.ws() + WS_SS) + RS_OFF};
    pg8::gemm_phase<EpiWin, pg8::StaticOrder, true, true>(F.lds, g, S, E, F.wave);
}
__device__ __forceinline__ void ph_uq(const Params&, const Frame& F0) {
    const Frame F = mk_frame(F0.wave);
    LAUNDER_P; bf16_t* W = (bf16_t*)(p.ws() + WS_W); bf16_t* U = (bf16_t*)(p.ws() + WS_U);
    pg8::Gemm g{U + UC_QLAT, W + W_UQ, LDU, 512, MT, 1536, 512}; pg8::StaticOrder S; S.init(MT, 1536, F.G, F.bx, 512);
    EpiUq E{(bf16_t*)(p.ws() + WS_QM), (const f32x2*)(p.ws() + WS_ROPE)}; pg8::gemm_phase<EpiUq, pg8::StaticOrder, true, true>(F.lds, g, S, E, F.wave);
}
__device__ __forceinline__ void ph_ukv(const Params&, const Frame& F0) {
    const Frame F = mk_frame(F0.wave);
    LAUNDER_P; bf16_t* W = (bf16_t*)(p.ws() + WS_W);
    pg8::Gemm g{(const bf16_t*)(p.ws() + WS_CKV), W + W_UKV, 512, 512, KVROWS, 2048, 512}; pg8::StaticOrder S; S.init(KVROWS, 2048, F.G, (F.G == 256) ? (F.bx + 120) % 256 : F.bx, 512);
    EpiUkv E{(bf16_t*)(p.ws() + WS_KM), (bf16_t*)(p.ws() + WS_VTM)}; pg8::gemm_phase<EpiUkv, pg8::StaticOrder, true, true>(F.lds, g, S, E, F.wave);
}
template <int BR> __device__ __forceinline__ void ph_merge(const Params&, const Frame& F0) {
    const Frame F = mk_frame(F0.wave);
    LAUNDER_P; bf16_t* W = (bf16_t*)(p.ws() + WS_W); bf16_t* U = (bf16_t*)(p.ws() + WS_U); bf16_t* XN = (bf16_t*)(p.ws() + WS_XN);
    constexpr int acol = BR == 0 ? UC_OMLA : (BR == 1 ? UC_OSSD : UC_OFOX);
    pg8::StaticOrder S; S.init(MP, D, F.G, F.bx, 1024, true);
    pg8::Gemm g{U + acol, W + W_BR + (size_t)BR * D * 1024, LDU, 1024, MP, D, 1024}; EpiMerge<BR> E{U, XN}; pg8::gemm_phase<EpiMerge<BR>, pg8::StaticOrder, true, true>(F.lds, g, S, E, F.wave);
}
__device__ __forceinline__ void ph_merge_sample(const Params&, const Frame& F0, int layer0) {
    const Frame F = mk_frame(F0.wave);
    LAUNDER_PL; bf16_t* W = (bf16_t*)(p.ws() + WS_W); bf16_t* U = (bf16_t*)(p.ws() + WS_U); bf16_t* XN = (bf16_t*)(p.ws() + WS_XN);
    pg8::SampleMergeOrder S; S.c = F.bx;
    pg8::Gemm g{U, W + W_BR, LDU, 1024, MT, 3 * D, 1024};
    EpiMergeSample E{U, XN, (float*)(p.ws() + WS_PART), (unsigned*)(p.ws() + WS_CTL) + CW_MGC + layer * 8 * 64, (LAS unsigned*)(F.lds + RING_BYTES)};
    pg8::gemm_phase<EpiMergeSample, pg8::SampleMergeOrder, true, true>(F.lds, g, S, E, F.wave);
}
__device__ __forceinline__ void ph_wout(const Params&, const Frame& F0, bool dummy = false) {
    const Frame F = mk_frame(F0.wave);
    LAUNDER_P; bf16_t* W = (bf16_t*)(p.ws() + WS_W); bf16_t* XN = (bf16_t*)(p.ws() + WS_XN);
    pg8::Gemm g{XN, W + W_OUT, D, D, MT, D, D}; pg8::SplitOrder S; S.init(MT, D, F.G, F.bx, D);
    EpiResid E{(bf16_t*)(p.ws() + (dummy ? WS_ST : WS_XB)), (float*)(p.ws() + WS_SS), 1.0f, (float*)(p.ws() + WS_PART), (LAS float*)(F.lds + RING_BYTES + 1024)}; pg8::gemm_phase<EpiResid, pg8::SplitOrder, true, true>(F.lds, g, S, E, F.wave);
}
__device__ __forceinline__ void ph_norm(const Params&, const Frame& F0, int layer0, int which, bool from_input) {
    const Frame F = mk_frame(F0.wave);
    LAUNDER_PL; float* ys = p.out() + O_YS;
    (void)which; (void)layer;
    phase_prep(F, from_input ? p.in(I_XP) : nullptr, from_input ? p.in(I_XS) : ys, (bf16_t*)(p.ws() + WS_XB), (float*)(p.ws() + WS_SS), from_input ? ys : nullptr, from_input ? nullptr : (const float*)(p.ws() + WS_PART));
}

constexpr int PH_PER_LAYER = 15, N_PHASES = NL * PH_PER_LAYER + 1;
#ifndef N_LAUNCHES
#define N_LAUNCHES 1
#endif
#ifndef PHMASK
#define PHMASK 0xffff
#endif
#ifndef DUPMASK
#define DUPMASK 0
#endif
#define DUP(k) (((DUPMASK) >> (k)) & 1)

__global__ void __launch_bounds__(512, 2) hybrid_fwd(Params p) {
    extern __shared__ __attribute__((aligned(16))) unsigned char lds_raw[];
    const int wave_k = __builtin_amdgcn_readfirstlane((int)threadIdx.x >> 6);
    const Frame F = mk_frame(wave_k);
    volatile LAS unsigned* MISC = (volatile LAS unsigned*)(F.lds + MISC_OFF);
    for (int u = F.tid; u < (LDS_BYTES - LDSCTL_OFF) / 4; u += 512) ((LAS unsigned*)(F.lds + LDSCTL_OFF))[u] = 0u;
    __syncthreads();
    const PV pk = pv_get();
    unsigned* ctl = (unsigned*)(pk.ws() + WS_CTL);
    const int lo = pk.ph_lo(), hi = pk.ph_hi();
    XcdBarrier bar; bar.bar = ctl + CW_BAR; bar.x = 0; bar.st = nullptr;
    if (hi - lo > 1) bar = xcd_barrier_post(ctl + CW_BAR, MISC + 8, F.tid);
#define IN(k) ((((PHMASK) >> (((k) == NL * PH_PER_LAYER) ? 15 : ((k) % PH_PER_LAYER))) & 1) && lo <= (k) && (k) < hi)
#define SEAM(k) do { if (IN(k) && IN((k) + 1)) xcd_barrier(bar, wave_k); } while (0)
    if (IN(0)) phase_rope_table(F);
#pragma unroll 1
    for (int layer = 0; layer < NL; ++layer) {
        const int pb = layer * PH_PER_LAYER;
        if (IN(pb + 0)) { phase_convert(p, F, layer); if (DUP(0)) phase_convert(p, F, layer); }
        if (IN(pb + 1)) { ph_norm(p, F, layer, I_F1N, layer == 0); if (DUP(1)) ph_norm(p, F, layer, I_F1N, layer == 0); }
        SEAM(pb + 1);
        if (IN(pb + 2)) { ph_gateup(p, F, W_GU1); if (DUP(2)) ph_gateup(p, F, W_GU1); }
        SEAM(pb + 2);
        if (IN(pb + 3)) { if (DUP(3)) ph_down(p, F, W_D1, layer == 0, true); ph_down(p, F, W_D1, layer == 0); }
        SEAM(pb + 3);
        if (IN(pb + 4)) ph_norm(p, F, layer, I_MIXN, false);
        SEAM(pb + 4);
        if (IN(pb + 5)) { ph_win(p, F, layer); if (DUP(5)) ph_win(p, F, layer); }
        SEAM(pb + 5);
        if (IN(pb + 6)) phase_t1(p, F, layer);
        SEAM(pb + 6);
        if (IN(pb + 7)) { phase_t2(p, F); ph_uq(p, F); ph_ukv(p, F); phase_s1(p, F, layer); if (DUP(7)) { ph_uq(p, F); ph_ukv(p, F); } if (DUP(6)) phase_s1(p, F, layer); }
        SEAM(pb + 7);
        if (IN(pb + 8)) { phase_attn(p, F, layer); phase_s2(p, F, layer); }
        SEAM(pb + 8);
        if (IN(pb + 9)) phase_s3(p, F, layer);
        SEAM(pb + 9);
        if (IN(pb + 10)) { ph_merge_sample(p, F, layer); ph_merge<0>(p, F); ph_merge<1>(p, F); ph_merge<2>(p, F); }
        SEAM(pb + 10);
        if (IN(pb + 11)) { if (DUP(11)) ph_wout(p, F, true); ph_wout(p, F); }
        SEAM(pb + 11);
        if (IN(pb + 12)) ph_norm(p, F, layer, I_F2N, false);
        SEAM(pb + 12);
        if (IN(pb + 13)) ph_gateup(p, F, W_GU2);
        SEAM(pb + 13);
        if (IN(pb + 14)) ph_down(p, F, W_D2, false);
        SEAM(pb + 14);
    }
    if (IN(NL * PH_PER_LAYER)) { const PV q = pv_get(); const Frame F2 = mk_frame(wave_k); phase_final_norm(F2, q.out() + O_YP, (const bf16_t*)(q.ws() + WS_XB), q.in(I_FN), (const float*)(q.ws() + WS_PART)); }
#undef IN
#undef SEAM
}

extern "C" void kernel_launch(void* const* d_in, const int* in_sizes, int n_in, void* d_out, int out_size, void* d_ws, size_t ws_size, hipStream_t stream) {
    static int grid = 0;
    if (grid == 0) {
        if (n_in != N_IN || (size_t)out_size != O_TOTAL || ws_size < WS_END) { fprintf(stderr, "kernel_launch: unexpected shapes: n_in %d out %d ws %zu (need %zu)\n", n_in, out_size, ws_size, (size_t)WS_END); grid = -1; return; }
        int dev = 0, cus = 0, per_cu = 0;
        if (hipGetDevice(&dev) != hipSuccess || hipDeviceGetAttribute(&cus, hipDeviceAttributeMultiprocessorCount, dev) != hipSuccess) { grid = -1; return; }
        if (hipFuncSetAttribute((const void*)hybrid_fwd, hipFuncAttributeMaxDynamicSharedMemorySize, LDS_BYTES) != hipSuccess) { fprintf(stderr, "kernel_launch: hipFuncSetAttribute failed\n"); grid = -1; return; }
        if (hipOccupancyMaxActiveBlocksPerMultiprocessor(&per_cu, (const void*)hybrid_fwd, 512, LDS_BYTES) != hipSuccess || per_cu < 1) { fprintf(stderr, "kernel_launch: occupancy query says %d\n", per_cu); }
        (void)hipGetLastError();
        grid = cus;
    }
    if (grid < 0) return;
    (void)hipMemsetAsync((char*)d_ws + WS_CTL, 0, CTL_BYTES, stream);
    Params p{};
    for (int i = 0; i < N_IN; ++i) p.in[i] = (const float*)d_in[i];
    p.out = (float*)d_out; p.ws = (unsigned char*)d_ws;
#if defined(PROBE_K)
    p.ph_lo = 0; p.ph_hi = PROBE_K;
    hipLaunchKernelGGL(hybrid_fwd, dim3(grid), dim3(512), LDS_BYTES, stream, p);
    (void)hipMemsetAsync((char*)d_ws + WS_CTL, 0, CTL_BYTES, stream);
    p.ph_lo = 0; p.ph_hi = N_PHASES;
    hipLaunchKernelGGL(hybrid_fwd, dim3(grid), dim3(512), LDS_BYTES, stream, p);
#elif N_LAUNCHES == 1
    p.ph_lo = 0; p.ph_hi = N_PHASES;
    hipLaunchKernelGGL(hybrid_fwd, dim3(grid), dim3(512), LDS_BYTES, stream, p);
#else
    for (int k = 0; k < N_PHASES; ++k) { p.ph_lo = k; p.ph_hi = k + 1; hipLaunchKernelGGL(hybrid_fwd, dim3(grid), dim3(512), LDS_BYTES, stream, p); }
#endif
}
```
